# Optimizing an MI355X kernel written in HIP

```python
import jax, jax.numpy as jnp
from jax import lax
import numpy as np

D_MODEL = 1024
BATCH = 1
SEQ = 16384
DEPTH = 4

N_MIXERS = 2
EPS = 1e-6
GLA_HEADS = 4
GLA_DK = D_MODEL // 2 // GLA_HEADS
GLA_DV = D_MODEL // GLA_HEADS
GLA_GATE_RANK = 16
GLA_GATE_NORM = 16.0
GLA_CHUNK = 64
GLA_IN = 2 * GLA_HEADS * GLA_DK + 2 * GLA_HEADS * GLA_DV + GLA_GATE_RANK
MOBA_HEADS = 8
MOBA_HD = D_MODEL // MOBA_HEADS
MOBA_BLOCK = 256
MOBA_TOPK = 3
MOBA_QCHUNK = 64
MOBA_IN = 3 * MOBA_HEADS * MOBA_HD
ROPE_THETA = 10000.0
D_FF = 4 * D_MODEL
N_GLA_LAYERS = (DEPTH + 1) // 2
N_MOBA_LAYERS = DEPTH // 2

kernel_name = "hybrid_gla_moba_adaln_trunk"


def rms_norm(t, g):
    tf = t.astype(jnp.float32)
    y = tf * lax.rsqrt(jnp.mean(tf * tf, axis=-1, keepdims=True) + EPS)
    return (y * g.astype(jnp.float32)).astype(t.dtype)


def rope(t, positions):
    half = t.shape[-1] // 2
    inv_freq = ROPE_THETA ** (-jnp.arange(half, dtype=jnp.float32) / half)
    ang = positions.astype(jnp.float32)[..., None] * inv_freq
    cos = jnp.cos(ang)[:, :, None, :]
    sin = jnp.sin(ang)[:, :, None, :]
    t1, t2 = t[..., :half], t[..., half:]
    return jnp.concatenate([t1 * cos - t2 * sin, t2 * cos + t1 * sin], axis=-1)


def gla_mixer(h, w_in, w_gate_up, b_gate, onorm_g, w_out):
    B, S, _ = h.shape
    H, DK, DV, L = GLA_HEADS, GLA_DK, GLA_DV, GLA_CHUNK
    NC = S // L
    f32 = jnp.float32
    splits = np.cumsum([H * DK, H * DK, H * DV, H * DV]).tolist()
    q, k, v, r, glr = jnp.split(h @ w_in, splits, axis=-1)
    g = jax.nn.log_sigmoid((glr @ w_gate_up + b_gate).astype(f32)) / GLA_GATE_NORM
    q = q.astype(f32).reshape(B, NC, L, H, DK) * (DK ** -0.5)
    k = k.astype(f32).reshape(B, NC, L, H, DK)
    v = v.astype(f32).reshape(B, NC, L, H, DV)
    G = jnp.cumsum(g.reshape(B, NC, L, H, DK), axis=2)
    G_last = G[:, :, -1]
    q_dec = q * jnp.exp(G)
    k_inv = k * jnp.exp(-G)
    causal = jnp.tril(jnp.ones((L, L), dtype=bool))
    A = jnp.where(causal, jnp.einsum('bnihd,bnjhd->bnhij', q_dec, k_inv), 0.0)
    o_intra = jnp.einsum('bnhij,bnjhv->bnihv', A, v)
    k_tail = k * jnp.exp(G_last[:, :, None] - G)
    U = jnp.einsum('bnjhd,bnjhv->bnhdv', k_tail, v)
    decay = jnp.exp(G_last)

    def step(state, inp):
        a, u = inp
        return a[..., None] * state + u, state

    _, states = lax.scan(step, jnp.zeros((B, H, DK, DV), f32),
                         (jnp.moveaxis(decay, 1, 0), jnp.moveaxis(U, 1, 0)))
    states = jnp.moveaxis(states, 0, 1)
    o_inter = jnp.einsum('bnihd,bnhdv->bnihv', q_dec, states)
    o = (o_intra + o_inter).reshape(B, S, H, DV)
    o = rms_norm(o, onorm_g).reshape(B, S, H * DV) * jax.nn.silu(r.astype(f32))
    return o.astype(h.dtype) @ w_out


def moba_mixer(h, positions, w_in, q_norm_g, k_norm_g, w_out):
    B, S, _ = h.shape
    H, HD, BS, C = MOBA_HEADS, MOBA_HD, MOBA_BLOCK, MOBA_QCHUNK
    f32 = jnp.float32
    q, k, v = jnp.split(h @ w_in, 3, axis=-1)
    q = rope(rms_norm(q.reshape(B, S, H, HD).astype(f32), q_norm_g), positions)
    k = rope(rms_norm(k.reshape(B, S, H, HD).astype(f32), k_norm_g), positions)
    v = v.reshape(B, S, H, HD).astype(f32)
    NB = -(-S // BS)
    Sp = NB * BS
    pad = ((0, 0), (0, Sp - S), (0, 0), (0, 0))
    q, k, v = jnp.pad(q, pad), jnp.pad(k, pad), jnp.pad(v, pad)
    k_blocks = k.reshape(B, NB, BS, H, HD).transpose(0, 3, 1, 2, 4)
    v_blocks = v.reshape(B, NB, BS, H, HD).transpose(0, 3, 1, 2, 4)
    k_mean = jnp.mean(k_blocks, axis=3)
    gate = jnp.einsum('bshd,bhnd->bshn', q, k_mean)
    own_blk = jnp.arange(Sp) // BS
    past = jnp.arange(NB)[None, :] < own_blk[:, None]
    gate = jnp.where(past[None, :, None, :], gate, -jnp.inf)
    topk = min(MOBA_TOPK, NB)
    _, sel = lax.top_k(gate, topk)
    valid = sel < own_blk[None, :, None, None]

    NQ = Sp // C

    def chunkify(t):
        return jnp.moveaxis(t.reshape(B, NQ, C, *t.shape[2:]), 1, 0)

    scale = HD ** -0.5
    b_idx = jnp.arange(B)[:, None, None, None]
    h_idx = jnp.arange(H)[None, None, :, None]
    q_off = jnp.arange(C)
    k_off = jnp.arange(BS)

    def attend(args):
        ci, qc, sc, vc = args
        s0 = ci * C
        start = (s0 // BS) * BS
        k_own = lax.dynamic_slice_in_dim(k, start, BS, axis=1)
        v_own = lax.dynamic_slice_in_dim(v, start, BS, axis=1)
        kg = k_blocks[b_idx, h_idx, sc]
        vg = v_blocks[b_idx, h_idx, sc]
        s_sel = jnp.einsum('bchd,bchjkd->bchjk', qc, kg) * scale
        s_sel = jnp.where(vc[..., None], s_sel, -jnp.inf).reshape(B, C, H, topk * BS)
        s_own = jnp.einsum('bchd,bkhd->bchk', qc, k_own) * scale
        causal = (start + k_off)[None, :] <= (s0 + q_off)[:, None]
        s_own = jnp.where(causal[None, :, None, :], s_own, -jnp.inf)
        p = jax.nn.softmax(jnp.concatenate([s_sel, s_own], axis=-1), axis=-1)
        p_sel = p[..., :topk * BS].reshape(B, C, H, topk, BS)
        p_own = p[..., topk * BS:]
        return (jnp.einsum('bchjk,bchjkd->bchd', p_sel, vg)
                + jnp.einsum('bchk,bkhd->bchd', p_own, v_own))

    out = lax.map(attend, (jnp.arange(NQ), chunkify(q), chunkify(sel), chunkify(valid)))
    out = jnp.moveaxis(out, 0, 1).reshape(B, Sp, H * HD)[:, :S]
    return out.astype(h.dtype) @ w_out


def sq_relu_mlp(h, w1, w2):
    return jnp.square(jax.nn.relu(h @ w1)) @ w2


def setup_inputs(seed: int = 0) -> dict:
    key = jax.random.key(seed)
    ks = jax.random.split(key, 20)
    D = D_MODEL
    nrm = lambda k, shape, fan_in: jax.random.normal(k, shape, jnp.float32) * (fan_in ** -0.5)
    x = jax.random.normal(ks[0], (BATCH, SEQ, D), jnp.float32)
    c = jax.random.normal(ks[1], (BATCH, D), jnp.float32)
    positions = jnp.broadcast_to(jnp.arange(SEQ, dtype=jnp.int32), (BATCH, SEQ))
    return {
        "x": x,
        "c": c,
        "positions": positions,
        "ada_w": nrm(ks[2], (DEPTH, D, 6 * D), D),
        "ada_b": 0.01 * jax.random.normal(ks[3], (DEPTH, 6 * D), jnp.float32),
        "norm_mix_g": 1.0 + 0.05 * jax.random.normal(ks[4], (DEPTH, D), jnp.float32),
        "norm_mlp_g": 1.0 + 0.05 * jax.random.normal(ks[5], (DEPTH, D), jnp.float32),
        "gla_w_in": nrm(ks[6], (N_GLA_LAYERS, D, GLA_IN), D),
        "gla_w_gate_up": nrm(ks[7], (N_GLA_LAYERS, GLA_GATE_RANK, GLA_HEADS * GLA_DK), GLA_GATE_RANK),
        "gla_b_gate": 0.01 * jax.random.normal(ks[8], (N_GLA_LAYERS, GLA_HEADS * GLA_DK), jnp.float32),
        "gla_onorm_g": 1.0 + 0.05 * jax.random.normal(ks[9], (N_GLA_LAYERS, GLA_DV), jnp.float32),
        "gla_w_out": nrm(ks[10], (N_GLA_LAYERS, GLA_HEADS * GLA_DV, D), GLA_HEADS * GLA_DV),
        "moba_w_in": nrm(ks[11], (N_MOBA_LAYERS, D, MOBA_IN), D),
        "moba_q_norm_g": 1.0 + 0.05 * jax.random.normal(ks[12], (N_MOBA_LAYERS, MOBA_HD), jnp.float32),
        "moba_k_norm_g": 1.0 + 0.05 * jax.random.normal(ks[13], (N_MOBA_LAYERS, MOBA_HD), jnp.float32),
        "moba_w_out": nrm(ks[14], (N_MOBA_LAYERS, MOBA_HEADS * MOBA_HD, D), MOBA_HEADS * MOBA_HD),
        "mlp_w1": nrm(ks[15], (DEPTH, D, D_FF), D),
        "mlp_w2": nrm(ks[16], (DEPTH, D_FF, D), D_FF),
    }


def reference(x, c, positions, ada_w, ada_b, norm_mix_g, norm_mlp_g,
              gla_w_in, gla_w_gate_up, gla_b_gate, gla_onorm_g, gla_w_out,
              moba_w_in, moba_q_norm_g, moba_k_norm_g, moba_w_out,
              mlp_w1, mlp_w2):
    c_act = jax.nn.silu(c)
    for i in range(DEPTH):
        mod = (c_act @ ada_w[i] + ada_b[i])[:, None, :]
        sh1, sc1, g1, sh2, sc2, g2 = jnp.split(mod, 6, axis=-1)
        h = rms_norm(x, norm_mix_g[i]) * (1 + sc1) + sh1
        j = i // N_MIXERS
        if i % N_MIXERS == 0:
            y = gla_mixer(h, gla_w_in[j], gla_w_gate_up[j], gla_b_gate[j],
                          gla_onorm_g[j], gla_w_out[j])
        else:
            y = moba_mixer(h, positions, moba_w_in[j], moba_q_norm_g[j],
                           moba_k_norm_g[j], moba_w_out[j])
        x = x + g1 * y
        h = rms_norm(x, norm_mlp_g[i]) * (1 + sc2) + sh2
        x = x + g2 * sq_relu_mlp(h, mlp_w1[i], mlp_w2[i])
    return x
```

```cpp
#include <hip/hip_runtime.h>
#include <cstdio>
#include <cstdint>
#include <cmath>

constexpr int D = 1024, S = 16384, DEPTH = 4, DFF = 4096;
constexpr int GLA_H = 4, GLA_DK = 128, GLA_DV = 256, GLA_R = 16, GLA_IN = 3088;
constexpr int MB_H = 8, MB_HD = 128, MB_BS = 256, MB_NB = 64, MB_IN = 3072;
constexpr float EPS = 1e-6f;

__device__ __forceinline__ float wave_sum(float v) {
#pragma unroll
    for (int o = 1; o < 64; o <<= 1) v += __shfl_xor(v, o);
    return v;
}
__device__ __forceinline__ float wave_max(float v) {
#pragma unroll
    for (int o = 1; o < 64; o <<= 1) v = fmaxf(v, __shfl_xor(v, o));
    return v;
}
__device__ __forceinline__ float silu_f(float x) { return x / (1.f + expf(-x)); }
__device__ __forceinline__ float logsigmoid_f(float x) { return fminf(x, 0.f) - log1pf(expf(-fabsf(x))); }

__device__ __forceinline__ void sincos_acc(double ang, float& s, float& c) {
    const double n = rint(ang * 0.15915494309189535);
    double r = fma(-n, 6.283185307179586, ang); r = fma(-n, 2.4492935982947064e-16, r);
    const double x = r * 0.25, x2 = x * x;
    const double sn = x * (1.0 + x2 * (-1.0 / 6 + x2 * (1.0 / 120 + x2 * (-1.0 / 5040 + x2 * (1.0 / 362880 + x2 * (-1.0 / 39916800 + x2 * (1.0 / 6227020800.0)))))));
    const double cs = 1.0 + x2 * (-0.5 + x2 * (1.0 / 24 + x2 * (-1.0 / 720 + x2 * (1.0 / 40320 + x2 * (-1.0 / 3628800 + x2 * (1.0 / 479001600 + x2 * (-1.0 / 87178291200.0)))))));
    const double s2 = 2 * sn * cs, c2 = 1 - 2 * sn * sn;
    s = (float)(2 * s2 * c2); c = (float)(1 - 2 * s2 * s2);
}

__global__ void k_mod(const float* __restrict__ c, const float* __restrict__ ada_w, const float* __restrict__ ada_b, float* __restrict__ mod) {
    const int idx = blockIdx.x * blockDim.x + threadIdx.x;
    if (idx >= DEPTH * 6 * D) return;
    const int i = idx / (6 * D), n = idx % (6 * D);
    const float* w = ada_w + (size_t)i * D * 6 * D + n;
    float acc = 0.f;
    for (int k = 0; k < D; ++k) acc += silu_f(c[k]) * w[(size_t)k * 6 * D];
    mod[idx] = acc + ada_b[idx];
}

__global__ __launch_bounds__(256) void k_norm_mod(const float* __restrict__ x, const float* __restrict__ g, const float* __restrict__ sc, const float* __restrict__ sh, float* __restrict__ h) {
    __shared__ float red[4];
    const int row = blockIdx.x, tid = threadIdx.x;
    const float4 v = ((const float4*)(x + (size_t)row * D))[tid];
    float ss = v.x * v.x + v.y * v.y + v.z * v.z + v.w * v.w;
    ss = wave_sum(ss);
    if ((tid & 63) == 0) red[tid >> 6] = ss;
    __syncthreads();
    const float tot = red[0] + red[1] + red[2] + red[3];
    const float r = 1.0f / sqrtf(tot * (1.f / D) + EPS);
    const float4 gg = ((const float4*)g)[tid], s1 = ((const float4*)sc)[tid], s0 = ((const float4*)sh)[tid];
    float4 o;
    o.x = v.x * r * gg.x * (1.f + s1.x) + s0.x;
    o.y = v.y * r * gg.y * (1.f + s1.y) + s0.y;
    o.z = v.z * r * gg.z * (1.f + s1.z) + s0.z;
    o.w = v.w * r * gg.w * (1.f + s1.w) + s0.w;
    ((float4*)(h + (size_t)row * D))[tid] = o;
}

template <int EPI>
__global__ __launch_bounds__(256) void k_gemm(const float* __restrict__ A, int lda, const float* __restrict__ B, int ldb, float* C, int ldc, int N, int K, const float* __restrict__ gate) {
    __shared__ float As[16][132];
    __shared__ float Bs[16][132];
    const int tid = threadIdx.x, tx = tid & 15, ty = tid >> 4;
    const int m0 = blockIdx.y * 128, n0 = blockIdx.x * 128;
    float acc[8][8];
#pragma unroll
    for (int i = 0; i < 8; ++i)
#pragma unroll
        for (int j = 0; j < 8; ++j) acc[i][j] = 0.f;
    for (int k0 = 0; k0 < K; k0 += 16) {
#pragma unroll
        for (int i = 0; i < 2; ++i) {
            const int e = tid + i * 256;
            const int r = e >> 2, c4 = (e & 3) * 4;
            const float4 a = *(const float4*)(A + (size_t)(m0 + r) * lda + k0 + c4);
            As[c4 + 0][r] = a.x; As[c4 + 1][r] = a.y; As[c4 + 2][r] = a.z; As[c4 + 3][r] = a.w;
        }
#pragma unroll
        for (int i = 0; i < 2; ++i) {
            const int e = tid + i * 256;
            const int r = e >> 5, c4 = (e & 31) * 4;
            float4 b = make_float4(0.f, 0.f, 0.f, 0.f);
            if (n0 + c4 < N) b = *(const float4*)(B + (size_t)(k0 + r) * ldb + n0 + c4);
            *(float4*)&Bs[r][c4] = b;
        }
        __syncthreads();
#pragma unroll
        for (int k = 0; k < 16; ++k) {
            const float4 a0 = *(const float4*)&As[k][ty * 4], a1 = *(const float4*)&As[k][64 + ty * 4];
            const float4 b0 = *(const float4*)&Bs[k][tx * 4], b1 = *(const float4*)&Bs[k][64 + tx * 4];
            const float av[8] = {a0.x, a0.y, a0.z, a0.w, a1.x, a1.y, a1.z, a1.w};
            const float bv[8] = {b0.x, b0.y, b0.z, b0.w, b1.x, b1.y, b1.z, b1.w};
#pragma unroll
            for (int i = 0; i < 8; ++i)
#pragma unroll
                for (int j = 0; j < 8; ++j) acc[i][j] += av[i] * bv[j];
        }
        __syncthreads();
    }
#pragma unroll
    for (int i = 0; i < 8; ++i) {
        const int row = m0 + (i < 4 ? ty * 4 + i : 64 + ty * 4 + (i - 4));
#pragma unroll
        for (int jh = 0; jh < 2; ++jh) {
            const int col = n0 + jh * 64 + tx * 4;
            if (col < N) {
                float4 v = make_float4(acc[i][jh * 4 + 0], acc[i][jh * 4 + 1], acc[i][jh * 4 + 2], acc[i][jh * 4 + 3]);
                float* p = C + (size_t)row * ldc + col;
                if (EPI == 1) {
                    const float4 o = *(const float4*)p; const float4 gt = *(const float4*)(gate + col);
                    v.x = o.x + gt.x * v.x; v.y = o.y + gt.y * v.y; v.z = o.z + gt.z * v.z; v.w = o.w + gt.w * v.w;
                } else if (EPI == 2) {
                    v.x = fmaxf(v.x, 0.f); v.y = fmaxf(v.y, 0.f); v.z = fmaxf(v.z, 0.f); v.w = fmaxf(v.w, 0.f);
                    v.x *= v.x; v.y *= v.y; v.z *= v.z; v.w *= v.w;
                }
                *(float4*)p = v;
            }
        }
    }
}

__global__ void k_gla_gate(const float* __restrict__ qkv, const float* __restrict__ wup, const float* __restrict__ bg, float* __restrict__ g) {
    const size_t idx = (size_t)blockIdx.x * blockDim.x + threadIdx.x;
    const int t = (int)(idx >> 9), j = (int)(idx & 511);
    const float* glr = qkv + (size_t)t * GLA_IN + 3072;
    float acc = bg[j];
#pragma unroll
    for (int r = 0; r < GLA_R; ++r) acc += glr[r] * wup[r * 512 + j];
    g[idx] = logsigmoid_f(acc) * (1.f / 16.f);
}
__global__ __launch_bounds__(256) void k_gla_recur(const float* __restrict__ qkv, const float* __restrict__ g, float* __restrict__ o) {
    __shared__ float sq[16][128], sk[16][128], sa[16][128];
    const int h = blockIdx.x, tid = threadIdx.x;
    float St[128];
#pragma unroll
    for (int d = 0; d < 128; ++d) St[d] = 0.f;
    const float qs = 0.08838834764831845f;
    for (int t0 = 0; t0 < S; t0 += 16) {
        float vv[16];
#pragma unroll
        for (int tt = 0; tt < 16; ++tt) vv[tt] = qkv[(size_t)(t0 + tt) * GLA_IN + 1024 + h * 256 + tid];
#pragma unroll
        for (int i = 0; i < 8; ++i) {
            const int e = tid + i * 256, tok = e >> 7, d = e & 127;
            const float* row = qkv + (size_t)(t0 + tok) * GLA_IN;
            sq[tok][d] = row[h * 128 + d] * qs;
            sk[tok][d] = row[512 + h * 128 + d];
            sa[tok][d] = expf(g[(size_t)(t0 + tok) * 512 + h * 128 + d]);
        }
        __syncthreads();
#pragma unroll 1
        for (int tt = 0; tt < 16; ++tt) {
            const float v = vv[0];
#pragma unroll
            for (int i = 0; i < 15; ++i) vv[i] = vv[i + 1];
            float acc = 0.f;
#pragma unroll
            for (int d = 0; d < 128; ++d) { St[d] = sa[tt][d] * St[d] + sk[tt][d] * v; acc += sq[tt][d] * St[d]; }
            o[(size_t)(t0 + tt) * D + h * 256 + tid] = acc;
        }
        __syncthreads();
    }
}
__global__ __launch_bounds__(256) void k_gla_post(float* __restrict__ o, const float* __restrict__ qkv, const float* __restrict__ og) {
    const int w = blockIdx.x * 4 + (threadIdx.x >> 6), lane = threadIdx.x & 63;
    const int t = w >> 2, h = w & 3;
    float4 v = *(const float4*)(o + (size_t)t * D + h * 256 + lane * 4);
    const float ss = wave_sum(v.x * v.x + v.y * v.y + v.z * v.z + v.w * v.w);
    const float r = 1.0f / sqrtf(ss * (1.f / 256.f) + EPS);
    const float4 gg = *(const float4*)(og + lane * 4);
    const float4 rr = *(const float4*)(qkv + (size_t)t * GLA_IN + 2048 + h * 256 + lane * 4);
    v.x = v.x * r * gg.x * silu_f(rr.x); v.y = v.y * r * gg.y * silu_f(rr.y); v.z = v.z * r * gg.z * silu_f(rr.z); v.w = v.w * r * gg.w * silu_f(rr.w);
    *(float4*)(o + (size_t)t * D + h * 256 + lane * 4) = v;
}

__global__ __launch_bounds__(256) void k_moba_qk(float* __restrict__ qkv, const int* __restrict__ pos, const float* __restrict__ qg, const float* __restrict__ kg) {
    const int w = blockIdx.x * 4 + (threadIdx.x >> 6), lane = threadIdx.x & 63;
    const int t = w >> 4, which = (w >> 3) & 1, h = w & 7;
    float* p = qkv + (size_t)t * MB_IN + which * 1024 + h * 128;
    const float* g = which ? kg : qg;
    float t1 = p[lane], t2 = p[lane + 64];
    const float ss = wave_sum(t1 * t1 + t2 * t2);
    const float r = 1.0f / sqrtf(ss * (1.f / 128.f) + EPS);
    t1 = t1 * r * g[lane]; t2 = t2 * r * g[lane + 64];
    const float inv_freq = (float)exp2(-(double)lane * (13.287712379549449 / 64.0));
    const float angf = (float)pos[t] * inv_freq;
    float cs, sn; sincos_acc((double)angf, sn, cs);
    p[lane] = t1 * cs - t2 * sn;
    p[lane + 64] = t2 * cs + t1 * sn;
}
__global__ __launch_bounds__(128) void k_moba_kmean(const float* __restrict__ qkv, float* __restrict__ kmean) {
    const int h = blockIdx.x >> 6, n = blockIdx.x & 63, d = threadIdx.x;
    float acc = 0.f;
    for (int j = 0; j < MB_BS; ++j) acc += qkv[(size_t)(n * MB_BS + j) * MB_IN + 1024 + h * 128 + d];
    kmean[(size_t)blockIdx.x * 128 + d] = acc * (1.f / MB_BS);
}
__global__ __launch_bounds__(64) void k_moba_attn(const float* __restrict__ qkv, const float* __restrict__ kmean, float* __restrict__ out) {
    __shared__ float sq[128];
    __shared__ float sp[1024];
    __shared__ int skey[1024];
    const int t = blockIdx.x >> 3, h = blockIdx.x & 7, lane = threadIdx.x;
    const float* qp = qkv + (size_t)t * MB_IN + h * 128;
    sq[lane] = qp[lane]; sq[lane + 64] = qp[lane + 64];
    __syncthreads();
    const int own = t >> 8;
    float gate = -INFINITY;
    if (lane < own) {
        const float* km = kmean + ((size_t)h * 64 + lane) * 128;
        float a = 0.f;
        for (int d = 0; d < 128; ++d) a += sq[d] * km[d];
        gate = a;
    }
    int s0 = -1, s1 = -1, s2 = -1;
#pragma unroll
    for (int j = 0; j < 3; ++j) {
        const float m = wave_max(gate);
        int idx = -1;
        if (m > -INFINITY) { const unsigned long long b = __ballot(gate == m); idx = __ffsll((long long)b) - 1; }
        if (j == 0) s0 = idx; else if (j == 1) s1 = idx; else s2 = idx;
        if (lane == idx) gate = -INFINITY;
    }
    int nk = 0;
    if (s0 >= 0) { for (int i = lane; i < 256; i += 64) skey[nk + i] = s0 * 256 + i; nk += 256; }
    if (s1 >= 0) { for (int i = lane; i < 256; i += 64) skey[nk + i] = s1 * 256 + i; nk += 256; }
    if (s2 >= 0) { for (int i = lane; i < 256; i += 64) skey[nk + i] = s2 * 256 + i; nk += 256; }
    const int nown = t - own * 256 + 1;
    for (int i = lane; i < nown; i += 64) skey[nk + i] = own * 256 + i;
    nk += nown;
    __syncthreads();
    const float scale = 0.08838834764831845f;
    float mx = -INFINITY;
    for (int i = lane; i < nk; i += 64) {
        const float* kp = qkv + (size_t)skey[i] * MB_IN + 1024 + h * 128;
        float a = 0.f;
        for (int d = 0; d < 128; d += 4) { const float4 kk = *(const float4*)(kp + d); a += sq[d] * kk.x + sq[d + 1] * kk.y + sq[d + 2] * kk.z + sq[d + 3] * kk.w; }
        a *= scale; sp[i] = a; mx = fmaxf(mx, a);
    }
    mx = wave_max(mx);
    float sum = 0.f;
    for (int i = lane; i < nk; i += 64) { const float p = expf(sp[i] - mx); sp[i] = p; sum += p; }
    sum = wave_sum(sum);
    __syncthreads();
    float o0 = 0.f, o1 = 0.f;
    for (int i = 0; i < nk; ++i) {
        const float* vp = qkv + (size_t)skey[i] * MB_IN + 2048 + h * 128;
        const float p = sp[i];
        o0 += p * vp[lane]; o1 += p * vp[lane + 64];
    }
    const float inv = 1.f / sum;
    out[(size_t)t * D + h * 128 + lane] = o0 * inv;
    out[(size_t)t * D + h * 128 + lane + 64] = o1 * inv;
}

extern "C" void kernel_launch(void* const* d_in, const int* in_sizes, int n_in, void* d_out, int out_size, void* d_ws, size_t ws_size, hipStream_t stream) {
    const float* x_in = (const float*)d_in[0];
    const float* c = (const float*)d_in[1];
    const int* pos = (const int*)d_in[2];
    const float* ada_w = (const float*)d_in[3];
    const float* ada_b = (const float*)d_in[4];
    const float* norm_mix_g = (const float*)d_in[5];
    const float* norm_mlp_g = (const float*)d_in[6];
    const float* gla_w_in = (const float*)d_in[7];
    const float* gla_w_gate_up = (const float*)d_in[8];
    const float* gla_b_gate = (const float*)d_in[9];
    const float* gla_onorm_g = (const float*)d_in[10];
    const float* gla_w_out = (const float*)d_in[11];
    const float* moba_w_in = (const float*)d_in[12];
    const float* moba_q_norm_g = (const float*)d_in[13];
    const float* moba_k_norm_g = (const float*)d_in[14];
    const float* moba_w_out = (const float*)d_in[15];
    const float* mlp_w1 = (const float*)d_in[16];
    const float* mlp_w2 = (const float*)d_in[17];
    float* x = (float*)d_out;
    char* ws = (char*)d_ws;
    const size_t MiB = 1u << 20;
    float* mod = (float*)(ws);
    float* R0 = (float*)(ws + 1 * MiB);
    float* R1 = (float*)(ws + 65 * MiB);
    float* R2 = (float*)(ws + 260 * MiB);
    if (ws_size < 300 * MiB) { fprintf(stderr, "ws too small: %zu\n", ws_size); return; }

    hipMemcpyAsync(x, x_in, (size_t)S * D * 4, hipMemcpyDeviceToDevice, stream);
    k_mod<<<(DEPTH * 6 * D + 255) / 256, 256, 0, stream>>>(c, ada_w, ada_b, mod);
    for (int i = 0; i < DEPTH; ++i) {
        const float* m = mod + (size_t)i * 6 * D;
        const float *sh1 = m, *sc1 = m + D, *g1 = m + 2 * D, *sh2 = m + 3 * D, *sc2 = m + 4 * D, *g2 = m + 5 * D;
        const int j = i / 2;
        k_norm_mod<<<S, 256, 0, stream>>>(x, norm_mix_g + (size_t)i * D, sc1, sh1, R0);
        if (i % 2 == 0) {
            k_gemm<0><<<dim3((GLA_IN + 127) / 128, S / 128), 256, 0, stream>>>(R0, D, gla_w_in + (size_t)j * D * GLA_IN, GLA_IN, R1, GLA_IN, GLA_IN, D, nullptr);
            k_gla_gate<<<(S * 512) / 256, 256, 0, stream>>>(R1, gla_w_gate_up + (size_t)j * GLA_R * 512, gla_b_gate + (size_t)j * 512, R2);
            k_gla_recur<<<GLA_H, 256, 0, stream>>>(R1, R2, R0);
            k_gla_post<<<S * GLA_H / 4, 256, 0, stream>>>(R0, R1, gla_onorm_g + (size_t)j * GLA_DV);
            k_gemm<1><<<dim3(D / 128, S / 128), 256, 0, stream>>>(R0, D, gla_w_out + (size_t)j * D * D, D, x, D, D, D, g1);
        } else {
            k_gemm<0><<<dim3(MB_IN / 128, S / 128), 256, 0, stream>>>(R0, D, moba_w_in + (size_t)j * D * MB_IN, MB_IN, R1, MB_IN, MB_IN, D, nullptr);
            k_moba_qk<<<S * 16 / 4, 256, 0, stream>>>(R1, pos, moba_q_norm_g + (size_t)j * MB_HD, moba_k_norm_g + (size_t)j * MB_HD);
            k_moba_kmean<<<MB_H * MB_NB, 128, 0, stream>>>(R1, R2);
            k_moba_attn<<<S * MB_H, 64, 0, stream>>>(R1, R2, R0);
            k_gemm<1><<<dim3(D / 128, S / 128), 256, 0, stream>>>(R0, D, moba_w_out + (size_t)j * D * D, D, x, D, D, D, g1);
        }
        k_norm_mod<<<S, 256, 0, stream>>>(x, norm_mlp_g + (size_t)i * D, sc2, sh2, R0);
        for (int half = 0; half < 2; ++half) {
            const size_t r0 = (size_t)half * (S / 2);
            k_gemm<2><<<dim3(DFF / 128, S / 2 / 128), 256, 0, stream>>>(R0 + r0 * D, D, mlp_w1 + (size_t)i * D * DFF, DFF, R1, DFF, DFF, D, nullptr);
            k_gemm<1><<<dim3(D / 128, S / 2 / 128), 256, 0, stream>>>(R1, DFF, mlp_w2 + (size_t)i * DFF * D, D, x + r0 * D, D, D, DFF, g2);
        }
    }
}
```

```cpp
#include <hip/hip_runtime.h>
#include <hip/hip_cooperative_groups.h>
#include <cstdio>
#include <cstdint>
#include <cmath>
namespace cg = cooperative_groups;
constexpr int D = 1024, S = 16384, DEPTH = 4, DFF = 4096;
constexpr int GLA_IN = 3088, MB_IN = 3072;
constexpr float EPS = 1e-6f;
#define LAS __attribute__((address_space(3)))
#define GAS __attribute__((address_space(1)))
typedef unsigned short bf16_t;
typedef short bf16x8 __attribute__((ext_vector_type(8)));
typedef short s16x4 __attribute__((ext_vector_type(4)));
typedef float f32x4 __attribute__((ext_vector_type(4)));
typedef float f32x16 __attribute__((ext_vector_type(16)));
typedef float f32x2 __attribute__((ext_vector_type(2)));
typedef unsigned u32x4 __attribute__((ext_vector_type(4)));
typedef unsigned u32x2 __attribute__((ext_vector_type(2)));
typedef __bf16 bf16x2_t __attribute__((ext_vector_type(2)));

__device__ __forceinline__ unsigned cvtpk(float lo, float hi) { f32x2 v = {lo, hi}; bf16x2_t b = __builtin_convertvector(v, bf16x2_t); return __builtin_bit_cast(unsigned, b); }
__device__ __forceinline__ float bf2f(unsigned short b) { return __uint_as_float((unsigned)b << 16); }
__device__ __forceinline__ float bflo(unsigned w) { return __uint_as_float(w << 16); }
__device__ __forceinline__ float bfhi(unsigned w) { return __uint_as_float(w & 0xffff0000u); }

namespace pg8 {
constexpr int BM = 256, BK = 64, HALF = 128, HTB = HALF * BK * 2, STAGE_BYTES = 8 * HTB, NXCD = 8, WGM = 8;
__host__ __device__ __forceinline__ int lds_byte(int r, int c) { const int st = (r >> 4) * 2 + (c >> 5), rr = r & 15, cc = c & 31, ob = rr * 64 + cc * 2; return st * 1024 + (ob ^ (((ob >> 9) & 1) << 5)); }
__host__ __device__ __forceinline__ void stage_rc(int b, int& R, int& C) { const int st = b / 1024, sb = b % 1024, swz = sb ^ (((sb >> 9) & 1) << 5); R = (st >> 1) * 16 + swz / 64; C = (st & 1) * 32 + (swz % 64) / 2; }
__host__ __device__ __forceinline__ int perm32(int rho) { const int n = rho >> 4, i = rho & 15; return 8 * (i >> 2) + 4 * n + (i & 3); }
struct Unit { int pm, pn; };
struct Gemm { const bf16_t* A; const bf16_t* Bt; int M, N, K; };
struct StaticOrder {
    int nM, nN, nwg, G, c;
    __host__ __device__ void init(int M, int N, int G_, int c_) { nM = M / BM; nN = N / BM; nwg = nM * nN; G = G_; c = c_; }
    __host__ __device__ bool next(int i, Unit& u) const {
        const long L = (long)i * G + c; if (L >= nwg) return false;
        int wgid = (int)L; { const int q = nwg / NXCD, r = nwg % NXCD, xcd = wgid % NXCD, off = wgid / NXCD; wgid = (xcd < r ? xcd * (q + 1) : r * (q + 1) + (xcd - r) * q) + off; }
        const int nig = WGM * nN, gid = wgid / nig, fm = gid * WGM, gsz = (nM - fm) < WGM ? (nM - fm) : WGM;
        u.pm = fm + ((wgid % nig) % gsz); u.pn = (wgid % nig) / gsz; return true;
    }
    __device__ __forceinline__ void a_ready(const Unit&) const {}
    __device__ __forceinline__ void done(const Unit&) const {}
};
template <int ACT  > struct EpiBf16 {
    static constexpr bool PERM = true, AFTER_DRAIN = false;
    bf16_t* O; int ldc;
    __device__ __forceinline__ void operator()(const f32x4 (&acc)[2][2][4][2], const Unit& u, int wr, int wc, int fr, int fq) const {
        const int row0 = u.pm * BM + wr * 64 + fr; const int col0 = u.pn * BM + wc * 32 + 8 * fq;
#pragma unroll
        for (int ai = 0; ai < 2; ++ai)
#pragma unroll
            for (int m = 0; m < 4; ++m) { bf16_t* rowp = O + (size_t)(row0 + ai * HALF + m * 16) * ldc + col0;
#pragma unroll
                for (int bj = 0; bj < 2; ++bj) { f32x4 v0 = acc[ai][bj][m][0], v1 = acc[ai][bj][m][1];
                    if (ACT == 1) {
#pragma unroll
                        for (int e = 0; e < 4; ++e) { float a = fmaxf(v0[e], 0.f); v0[e] = a * a; float b = fmaxf(v1[e], 0.f); v1[e] = b * b; } }
                    u32x4 w; w.x = cvtpk(v0[0], v0[1]); w.y = cvtpk(v0[2], v0[3]); w.z = cvtpk(v1[0], v1[1]); w.w = cvtpk(v1[2], v1[3]);
                    *(u32x4*)(rowp + bj * HALF) = w; } }
    }
};
struct EpiResid {
    static constexpr bool PERM = false, AFTER_DRAIN = false;
    const float* base; float* out; int ldc; const float* gate;
    __device__ __forceinline__ void operator()(const f32x4 (&acc)[2][2][4][2], const Unit& u, int wr, int wc, int fr, int fq) const {
        const int row0 = u.pm * BM + wr * 64 + fr, col0 = u.pn * BM + wc * 32 + 4 * fq;
        f32x4 gv[2][2];
#pragma unroll
        for (int bj = 0; bj < 2; ++bj)
#pragma unroll
            for (int n = 0; n < 2; ++n) gv[bj][n] = *(const f32x4*)(gate + col0 + bj * HALF + n * 16);
#pragma unroll
        for (int ai = 0; ai < 2; ++ai)
#pragma unroll
            for (int m = 0; m < 4; ++m) { const size_t off = (size_t)(row0 + ai * HALF + m * 16) * ldc + col0;
#pragma unroll
                for (int bj = 0; bj < 2; ++bj)
#pragma unroll
                    for (int n = 0; n < 2; ++n) { const f32x4 b = *(const f32x4*)(base + off + bj * HALF + n * 16);
                        *(f32x4*)(out + off + bj * HALF + n * 16) = b + gv[bj][n] * acc[ai][bj][m][n]; } }
    }
};

template <class Epi, class Sched, bool ALIGN_EPI = false, bool SP2 = false>
__device__ __forceinline__ void gemm_phase(LAS unsigned char* lds, const Gemm g, const Sched& S, const Epi& E) {
    int tid_ = threadIdx.x; asm volatile("" : "+v"(tid_));
    const int tid = tid_, wid = __builtin_amdgcn_readfirstlane(tid >> 6), lane = tid & 63, wr = wid >> 2, wc = wid & 3, fr = lane & 15, fq = lane >> 4;
    const int K = g.K, nt = K / BK;
    unsigned voffA[2], voffB[2];
#pragma unroll
    for (int i = 0; i < 2; ++i) { int R, C; stage_rc(tid * 16 + i * 8192, R, C); const int Rb = Epi::PERM ? ((R & ~31) + perm32(R & 31)) : R;
        voffA[i] = (unsigned)(R * K + C) * 2u; voffB[i] = (unsigned)(Rb * K + C) * 2u; }
    const size_t kstep = (size_t)(BK * 2);
    const size_t hstep = (size_t)HALF * K * 2;
    const size_t tstep = 2 * hstep;
    const unsigned ldsw = (unsigned)wid * 1024u;
    const int aoff = lds_byte(wr * 64 + fr, fq * 8), boff = lds_byte(wc * 32 + fr, fq * 8);
#define PG8_SA(b, h) (((b) * 2 + (h)) * HTB)
#define PG8_SB(b, h) ((4 + (b) * 2 + (h)) * HTB)
#define PG8_STAGE(bufoff, gbase, voff) do { _Pragma("unroll") for (int _i = 0; _i < 2; ++_i) \
        __builtin_amdgcn_global_load_lds((const unsigned*)((const char*)(gbase) + (voff)[_i]), (LAS unsigned*)(lds + (bufoff) + ldsw + _i * 8192), 16, 0, 0); } while (0)
#define PG8_LDA(dst, b, h) do { _Pragma("unroll") for (int m = 0; m < 4; ++m) _Pragma("unroll") for (int k = 0; k < 2; ++k) dst[m][k] = *(const LAS bf16x8*)(lds + PG8_SA(b, h) + aoff + m * 2048 + k * 1024); } while (0)
#define PG8_LDB(dst, b, h) do { _Pragma("unroll") for (int n = 0; n < 2; ++n) _Pragma("unroll") for (int k = 0; k < 2; ++k) dst[n][k] = *(const LAS bf16x8*)(lds + PG8_SB(b, h) + boff + n * 2048 + k * 1024); } while (0)
#define PG8_MMA(ai, bj, At, Bt) do { __builtin_amdgcn_s_setprio(1); _Pragma("unroll") for (int m = 0; m < 4; ++m) _Pragma("unroll") for (int n = 0; n < 2; ++n) _Pragma("unroll") for (int k = 0; k < 2; ++k) \
        acc[ai][bj][m][n] = __builtin_amdgcn_mfma_f32_16x16x32_bf16(Bt[n][k], At[m][k], acc[ai][bj][m][n], 0, 0, 0); __builtin_amdgcn_s_setprio(0); } while (0)
#define PG8_WAIT_V(n) asm volatile("s_waitcnt vmcnt(" #n ")" ::: "memory")
#define PG8_WAIT_L(n) asm volatile("s_waitcnt lgkmcnt(" #n ")" ::: "memory")
#define PG8_BAR __builtin_amdgcn_s_barrier()
#define PG8_SCHED __builtin_amdgcn_sched_barrier(0)
    Unit cur, nxt; int ui = 0;
    if (!S.next(0, cur)) return;
    f32x4 acc[2][2][4][2];
#pragma unroll
    for (int a = 0; a < 2; ++a)
#pragma unroll
        for (int b = 0; b < 2; ++b)
#pragma unroll
            for (int m = 0; m < 4; ++m)
#pragma unroll
                for (int n = 0; n < 2; ++n) acc[a][b][m][n] = (f32x4){0.f, 0.f, 0.f, 0.f};
    bf16x8 At[4][2], B0[2][2], B1[2][2];
    const char* cA = (const char*)g.A + (size_t)cur.pm * tstep; const char* cB = (const char*)g.Bt + (size_t)cur.pn * tstep;
    S.a_ready(cur);
    if constexpr (SP2) {
        PG8_STAGE(PG8_SB(0, 0), cB, voffB); PG8_STAGE(PG8_SB(0, 1), cB + hstep, voffB); PG8_STAGE(PG8_SA(0, 0), cA, voffA); PG8_STAGE(PG8_SA(0, 1), cA + hstep, voffA);
        if (wr == 1) PG8_BAR;
        PG8_WAIT_V(2); PG8_BAR;
        PG8_STAGE(PG8_SB(1, 0), cB + kstep, voffB); PG8_STAGE(PG8_SA(1, 0), cA + kstep, voffA); PG8_STAGE(PG8_SB(1, 1), cB + hstep + kstep, voffB);
        PG8_WAIT_V(6); PG8_BAR;
    } else {
        PG8_STAGE(PG8_SB(0, 0), cB, voffB); PG8_STAGE(PG8_SA(0, 0), cA, voffA); PG8_STAGE(PG8_SB(0, 1), cB + hstep, voffB); PG8_STAGE(PG8_SA(0, 1), cA + hstep, voffA);
        if (wr == 1) PG8_BAR;
        PG8_WAIT_V(4); PG8_BAR;
        PG8_STAGE(PG8_SB(1, 0), cB + kstep, voffB); PG8_STAGE(PG8_SA(1, 0), cA + kstep, voffA); PG8_STAGE(PG8_SB(1, 1), cB + hstep + kstep, voffB);
        PG8_WAIT_V(6); PG8_BAR;
    }
    for (;;) {
        const bool has_next = S.next(ui + 1, nxt);
        const char* nA = has_next ? (const char*)g.A + (size_t)nxt.pm * tstep : cA; const char* nB = has_next ? (const char*)g.Bt + (size_t)nxt.pn * tstep : cB;
        for (int t = 0; t < nt; t += 2) {
            const bool last = (t == nt - 2);
            const char* a1 = cA + (size_t)(t + 1) * kstep;
            const char* a2 = last ? nA : cA + (size_t)(t + 2) * kstep; const char* b2 = last ? nB : cB + (size_t)(t + 2) * kstep;
            const char* a3 = a2 + kstep; const char* b3 = b2 + kstep;
            if (last && has_next) S.a_ready(nxt);
            if constexpr (SP2) {
            PG8_LDB(B0, 0, 0); PG8_LDB(B1, 0, 1); PG8_SCHED; PG8_LDA(At, 0, 0); PG8_STAGE(PG8_SA(1, 1), a1 + hstep, voffA);
            PG8_WAIT_V(8); PG8_WAIT_L(0); PG8_BAR; PG8_MMA(0, 0, At, B0); PG8_MMA(0, 1, At, B1); PG8_BAR; PG8_SCHED;
            PG8_LDA(At, 0, 1); PG8_STAGE(PG8_SB(0, 0), b2, voffB); PG8_STAGE(PG8_SB(0, 1), b2 + hstep, voffB); PG8_STAGE(PG8_SA(0, 0), a2, voffA);
            PG8_WAIT_V(8); PG8_WAIT_L(0); PG8_BAR; PG8_MMA(1, 0, At, B0); PG8_MMA(1, 1, At, B1); PG8_BAR; PG8_SCHED;
            PG8_LDB(B0, 1, 0); PG8_LDB(B1, 1, 1); PG8_SCHED; PG8_LDA(At, 1, 0); PG8_STAGE(PG8_SA(0, 1), a2 + hstep, voffA);
            PG8_WAIT_V(8); PG8_WAIT_L(0); PG8_BAR; PG8_MMA(0, 0, At, B0); PG8_MMA(0, 1, At, B1); PG8_BAR; PG8_SCHED;
            PG8_LDA(At, 1, 1); PG8_STAGE(PG8_SB(1, 0), b3, voffB); PG8_STAGE(PG8_SB(1, 1), b3 + hstep, voffB); PG8_STAGE(PG8_SA(1, 0), a3, voffA);
            PG8_WAIT_V(8); PG8_WAIT_L(0); PG8_BAR; PG8_MMA(1, 0, At, B0); PG8_MMA(1, 1, At, B1); PG8_BAR; PG8_SCHED;
            } else {
            PG8_LDB(B0, 0, 0); PG8_SCHED; PG8_LDA(At, 0, 0); PG8_STAGE(PG8_SA(1, 1), a1 + hstep, voffA);
            PG8_WAIT_L(8); PG8_BAR; PG8_WAIT_L(0); PG8_MMA(0, 0, At, B0); PG8_BAR; PG8_SCHED;
            PG8_LDB(B1, 0, 1); PG8_STAGE(PG8_SB(0, 0), b2, voffB);
            PG8_BAR; PG8_WAIT_L(0); PG8_MMA(0, 1, At, B1); PG8_BAR;
            PG8_LDA(At, 0, 1); PG8_STAGE(PG8_SA(0, 0), a2, voffA);
            PG8_BAR; PG8_WAIT_L(0); PG8_MMA(1, 0, At, B0); PG8_BAR; PG8_SCHED;
            PG8_STAGE(PG8_SB(0, 1), b2 + hstep, voffB);
            PG8_WAIT_V(6); PG8_BAR; PG8_MMA(1, 1, At, B1); PG8_BAR;
            PG8_LDB(B0, 1, 0); PG8_SCHED; PG8_LDA(At, 1, 0); PG8_STAGE(PG8_SA(0, 1), a2 + hstep, voffA);
            PG8_WAIT_L(8); PG8_BAR; PG8_WAIT_L(0); PG8_MMA(0, 0, At, B0); PG8_BAR; PG8_SCHED;
            PG8_LDB(B1, 1, 1); PG8_STAGE(PG8_SB(1, 0), b3, voffB);
            PG8_BAR; PG8_WAIT_L(0); PG8_MMA(0, 1, At, B1); PG8_BAR;
            PG8_LDA(At, 1, 1); PG8_STAGE(PG8_SA(1, 0), a3, voffA);
            PG8_BAR; PG8_WAIT_L(0); PG8_MMA(1, 0, At, B0); PG8_BAR; PG8_SCHED;
            PG8_STAGE(PG8_SB(1, 1), b3 + hstep, voffB);
            PG8_WAIT_V(6); PG8_BAR; PG8_MMA(1, 1, At, B1); PG8_BAR;
            }
        }
        if constexpr (ALIGN_EPI) { if (wr == 0) PG8_BAR; }
        if constexpr (!Epi::AFTER_DRAIN) { E(acc, cur, wr, wc, fr, fq); S.done(cur); }
        if (!has_next) break;
#pragma unroll
        for (int a = 0; a < 2; ++a)
#pragma unroll
            for (int b = 0; b < 2; ++b)
#pragma unroll
                for (int m = 0; m < 4; ++m)
#pragma unroll
                    for (int n = 0; n < 2; ++n) acc[a][b][m][n] = (f32x4){0.f, 0.f, 0.f, 0.f};
        cur = nxt; cA = nA; cB = nB; ++ui;
        if constexpr (ALIGN_EPI) { if (wr == 1) PG8_BAR; }
    }
    PG8_WAIT_V(0);
    if constexpr (!ALIGN_EPI) { if (wr == 0) PG8_BAR; }
    PG8_BAR;
#undef PG8_SA
#undef PG8_SB
#undef PG8_STAGE
#undef PG8_LDA
#undef PG8_LDB
#undef PG8_MMA
#undef PG8_WAIT_V
#undef PG8_WAIT_L
#undef PG8_BAR
#undef PG8_SCHED
}
}

#define XB_TMO      128
#define XB_XCNT(j)  (256  + 64 * (j))
#define XB_XSUB(j)  (1280 + 64 * (j))
#define XB_XGEN(j)  (2304 + 64 * (j))
#define XB_TOP      3328
#define XB_TOPGEN   3392
#define XCD_BAR_WORDS 3456
#define XB_SPIN_CAP (1u << 18)
__device__ __forceinline__ unsigned xb_ld(unsigned* p)              { return __hip_atomic_load(p, __ATOMIC_RELAXED, __HIP_MEMORY_SCOPE_AGENT); }
__device__ __forceinline__ unsigned xb_add(unsigned* p, unsigned v) { return __hip_atomic_fetch_add(p, v, __ATOMIC_RELAXED, __HIP_MEMORY_SCOPE_AGENT); }
__device__ __forceinline__ unsigned xb_xcc_id() { return (unsigned)__builtin_amdgcn_s_getreg((3 << 11) | 20) & 0xFu; }
#define XB_SPIN(cond, bar) do { unsigned _sp = 0; while (cond) { __builtin_amdgcn_s_sleep(1); \
    if ((++_sp & 255u) == 0u) { if (xb_ld(&(bar)[XB_TMO])) break; if (_sp > XB_SPIN_CAP) { atomicAdd(&(bar)[XB_TMO], 1u); break; } } } } while (0)
struct XcdBarrier { unsigned* bar; unsigned x; volatile LAS unsigned* st; };
__device__ __forceinline__ XcdBarrier xcd_barrier_post(unsigned* bar, volatile LAS unsigned* st) {
    XcdBarrier b; b.bar = bar; b.x = xb_xcc_id(); b.st = st;
    if (threadIdx.x == 0) (void)xb_add(&bar[XB_XCNT(b.x)], 1u);
    return b;
}
__device__ __forceinline__ void xcd_barrier_complete(unsigned* bar, unsigned x, unsigned& nloc, unsigned& nx) {
    const unsigned G = gridDim.x * gridDim.y * gridDim.z;
    unsigned sum, cnt, mine, sp = 0u;
    for (;;) {
        sum = 0u; cnt = 0u; mine = 0u;
#pragma unroll
        for (unsigned j = 0; j < 16; ++j) { const unsigned c = xb_ld(&bar[XB_XCNT(j)]); sum += c; cnt += (c > 0u) ? 1u : 0u; mine = (j == x) ? c : mine; }
        if (sum == G) break;
        __builtin_amdgcn_s_sleep(1);
        if ((++sp & 255u) == 0u) { if (xb_ld(&bar[XB_TMO])) break; if (sp > XB_SPIN_CAP) { atomicAdd(&bar[XB_TMO], 1u); break; } }
    }
    nloc = mine > 0u ? mine : 1u; nx = cnt > 0u ? cnt : 1u;
}
__device__ __forceinline__ void xcd_barrier(const XcdBarrier& b) {
    asm volatile("s_waitcnt vmcnt(0)" ::: "memory");
    __syncthreads();
    if (threadIdx.x == 0) {
        unsigned* bar = b.bar;
        __builtin_amdgcn_s_waitcnt(0);
        unsigned nloc = b.st[0], nx = b.st[1];
        if (nloc == 0u) { xcd_barrier_complete(bar, b.x, nloc, nx); b.st[0] = nloc; b.st[1] = nx; }
        const unsigned old = xb_add(&bar[XB_XSUB(b.x)], 1u);
        const unsigned gen = old / nloc;
        if (old + 1u == (gen + 1u) * nloc) {
            __builtin_amdgcn_fence(__ATOMIC_RELEASE, "agent");
            asm volatile("s_waitcnt vmcnt(0)" ::: "memory");
            const unsigned og = xb_add(&bar[XB_TOP], 1u);
            const unsigned tg = og / nx;
            if (og + 1u == (tg + 1u) * nx) xb_add(&bar[XB_TOPGEN], 1u);
            else XB_SPIN(xb_ld(&bar[XB_TOPGEN]) == tg, bar);
            __builtin_amdgcn_fence(__ATOMIC_ACQUIRE, "agent");
            xb_add(&bar[XB_XGEN(b.x)], 1u);
            asm volatile("s_waitcnt vmcnt(0)" ::: "memory");
        } else {
            XB_SPIN(xb_ld(&bar[XB_XGEN(b.x)]) == gen, bar);
            __builtin_amdgcn_fence(__ATOMIC_ACQUIRE, "agent");
            asm volatile("s_waitcnt vmcnt(0)" ::: "memory");
        }
    }
    __syncthreads();
}
constexpr int NWAVES = 8, NTHR = 512;
constexpr int LDS_BYTES = 147456;
constexpr int RING_BYTES = 131072;
constexpr int MISC_OFF = LDS_BYTES - 256;
constexpr size_t MiB = 1u << 20;
constexpr size_t WS_CTL = 0, CTL_ZERO_BYTES = 1 * MiB;
constexpr size_t WS_MOD = 1 * MiB;
constexpr size_t WS_COS = 2 * MiB, WS_SIN = 6 * MiB;
constexpr size_t WS_WGIN = 10 * MiB;
constexpr size_t WS_WGLR = 22 * MiB;
constexpr size_t WS_WGOUT = 23 * MiB;
constexpr size_t WS_WMIN = 27 * MiB;
constexpr size_t WS_WMOUT = 39 * MiB;
constexpr size_t WS_W1 = 43 * MiB;
constexpr size_t WS_W2 = 75 * MiB;
constexpr size_t WS_H = 107 * MiB;
constexpr size_t WS_MIX = 139 * MiB;
constexpr size_t WS_QKV = 171 * MiB;
constexpr size_t WS_AUX = 267 * MiB;
constexpr size_t WS_HID = 171 * MiB;
constexpr size_t WS_END = 363 * MiB;
constexpr size_t WS_SBUF = WS_AUX;
constexpr size_t WS_GLR = WS_AUX + 80 * MiB;
constexpr size_t WS_DG = WS_AUX + 81 * MiB;
constexpr size_t WS_KMEAN = WS_H;
constexpr size_t WS_LPART = WS_H + 1 * MiB;
constexpr size_t WS_LIST = WS_H + 4 * MiB;
constexpr int CW_BAR = 4096;
constexpr int CW_MCNT = 16384;
struct Frame {
    LAS unsigned char* lds;
    int tid, lane, wave, vcu, G;
};
__device__ __forceinline__ Frame opaque(const Frame& F0) { Frame F = F0; int t = F0.tid; asm volatile("" : "+v"(t)); F.tid = t; F.lane = t & 63; F.wave = __builtin_amdgcn_readfirstlane(t >> 6); return F; }
__device__ __forceinline__ float wave_sum(float v) {
#pragma unroll
    for (int o = 1; o < 64; o <<= 1) v += __shfl_xor(v, o);
    return v;
}
__device__ __forceinline__ float silu_f(float x) { return x / (1.f + __expf(-x)); }
__device__ __forceinline__ void sincos_acc(double ang, float& s, float& c) {
    const double n = rint(ang * 0.15915494309189535);
    double r = fma(-n, 6.283185307179586, ang); r = fma(-n, 2.4492935982947064e-16, r);
    const double x = r * 0.25, x2 = x * x;
    const double sn = x * (1.0 + x2 * (-1.0 / 6 + x2 * (1.0 / 120 + x2 * (-1.0 / 5040 + x2 * (1.0 / 362880 + x2 * (-1.0 / 39916800 + x2 * (1.0 / 6227020800.0)))))));
    const double cs = 1.0 + x2 * (-0.5 + x2 * (1.0 / 24 + x2 * (-1.0 / 720 + x2 * (1.0 / 40320 + x2 * (-1.0 / 3628800 + x2 * (1.0 / 479001600 + x2 * (-1.0 / 87178291200.0)))))));
    const double s2 = 2 * sn * cs, c2 = 1 - 2 * sn * sn;
    s = (float)(2 * s2 * c2); c = (float)(1 - 2 * s2 * s2);
}
__device__ __forceinline__ void transpose_item(const float* __restrict__ W, int ld, int n_off, int n_cnt, int K, bf16_t* WT, LAS float* scr, int item, int lane) {
    const int nblk = (n_cnt + 31) >> 5, kb = item / nblk, nb = item - kb * nblk, k0 = 64 * kb, n0 = 32 * nb;
    const int nn = n0 + (lane & 31);
    const bool ok = nn < n_cnt;
#pragma unroll 8
    for (int i = 0; i < 32; ++i) { const int kk = 2 * i + (lane >> 5); scr[kk * 33 + (lane & 31)] = ok ? W[(size_t)(k0 + kk) * ld + n_off + nn] : 0.f; }
    asm volatile("s_waitcnt lgkmcnt(0)" ::: "memory");
    const int c = lane & 7;
#pragma unroll
    for (int j = 0; j < 4; ++j) { const int n = (lane >> 3) + 8 * j; const LAS float* s = scr + (8 * c) * 33 + n;
        u32x4 o; o.x = cvtpk(s[0 * 33], s[1 * 33]); o.y = cvtpk(s[2 * 33], s[3 * 33]); o.z = cvtpk(s[4 * 33], s[5 * 33]); o.w = cvtpk(s[6 * 33], s[7 * 33]);
        if (n0 + n < n_cnt) *(u32x4*)(WT + (size_t)(n0 + n) * K + k0 + 8 * c) = o; }
    asm volatile("s_waitcnt lgkmcnt(0)" ::: "memory");
}
struct MegaArgs {
    const float* in[18]; float* out; unsigned char* ws; int ph_lo, ph_hi;
};
__device__ __forceinline__ void p0_prologue(const Frame& F0, const MegaArgs& a) {
    const Frame F = opaque(F0);
    unsigned char* ws = a.ws;
    {
        LAS float* scr = (LAS float*)(F.lds + F.wave * 16384);
        const int gw = F.vcu * NWAVES + F.wave, NGW = F.G * NWAVES;
        constexpr int I_GIN = 16 * 96, I_GLR = 16, I_SQ = 16 * 32, I_W1 = 16 * 128, I_W2 = 64 * 32;
        constexpr int NITEMS = 2 * I_GIN + 2 * I_GLR + 2 * I_SQ + 2 * I_GIN + 2 * I_SQ + 4 * I_W1 + 4 * I_W2;
        for (int it = gw; it < NITEMS; it += NGW) {
            int r = it;
            if (r < 2 * I_GIN) { const int j = r / I_GIN; transpose_item(a.in[7] + (size_t)j * D * GLA_IN, GLA_IN, 0, 3072, D, (bf16_t*)(ws + WS_WGIN) + (size_t)j * 3072 * D, scr, r % I_GIN, F.lane); continue; } r -= 2 * I_GIN;
            if (r < 2 * I_GLR) { const int j = r / I_GLR; transpose_item(a.in[7] + (size_t)j * D * GLA_IN, GLA_IN, 3072, 16, D, (bf16_t*)(ws + WS_WGLR) + (size_t)j * 16 * D, scr, r % I_GLR, F.lane); continue; } r -= 2 * I_GLR;
            if (r < 2 * I_SQ) { const int j = r / I_SQ; transpose_item(a.in[11] + (size_t)j * D * D, D, 0, D, D, (bf16_t*)(ws + WS_WGOUT) + (size_t)j * D * D, scr, r % I_SQ, F.lane); continue; } r -= 2 * I_SQ;
            if (r < 2 * I_GIN) { const int j = r / I_GIN; transpose_item(a.in[12] + (size_t)j * D * MB_IN, MB_IN, 0, 3072, D, (bf16_t*)(ws + WS_WMIN) + (size_t)j * 3072 * D, scr, r % I_GIN, F.lane); continue; } r -= 2 * I_GIN;
            if (r < 2 * I_SQ) { const int j = r / I_SQ; transpose_item(a.in[15] + (size_t)j * D * D, D, 0, D, D, (bf16_t*)(ws + WS_WMOUT) + (size_t)j * D * D, scr, r % I_SQ, F.lane); continue; } r -= 2 * I_SQ;
            if (r < 4 * I_W1) { const int j = r / I_W1; transpose_item(a.in[16] + (size_t)j * D * DFF, DFF, 0, DFF, D, (bf16_t*)(ws + WS_W1) + (size_t)j * DFF * D, scr, r % I_W1, F.lane); continue; } r -= 4 * I_W1;
            { const int j = r / I_W2; transpose_item(a.in[17] + (size_t)j * DFF * D, D, 0, D, DFF, (bf16_t*)(ws + WS_W2) + (size_t)j * D * DFF, scr, r % I_W2, F.lane); }
        }
    }
    __syncthreads();
    {
        const float* c = a.in[1]; const float* ada_w = a.in[3]; const float* ada_b = a.in[4]; float* mod = (float*)(ws + WS_MOD);
        LAS float* red = (LAS float*)F.lds;
        const int kg = F.tid >> 5, cl = F.tid & 31;
        for (int chunk = F.vcu; chunk < 256; chunk += F.G) {
            float part[3];
#pragma unroll
            for (int cc = 0; cc < 3; ++cc) {
                const int col = chunk * 96 + cc * 32 + cl, i = col / (6 * D), n = col - i * 6 * D;
                const float* w = ada_w + (size_t)i * D * 6 * D + (size_t)(kg * 64) * 6 * D + n;
                float acc = 0.f;
#pragma unroll 8
                for (int k = 0; k < 64; ++k) acc += silu_f(c[kg * 64 + k]) * w[(size_t)k * 6 * D];
                part[cc] = acc;
            }
#pragma unroll
            for (int cc = 0; cc < 3; ++cc) red[kg * 96 + cc * 32 + cl] = part[cc];
            __syncthreads();
            if (F.tid < 96) { float s = 0.f;
#pragma unroll
                for (int g = 0; g < 16; ++g) s += red[g * 96 + F.tid];
                mod[chunk * 96 + F.tid] = s + ada_b[chunk * 96 + F.tid]; }
            __syncthreads();
        }
    }
    {
        const int* pos = (const int*)a.in[2]; float* ct = (float*)(ws + WS_COS); float* st = (float*)(ws + WS_SIN);
        for (int idx = F.vcu * NTHR + F.tid; idx < S * 64; idx += F.G * NTHR) {
            const int t = idx >> 6, i = idx & 63;
            const float inv_freq = (float)exp2(-(double)i * (13.287712379549449 / 64.0));
            const float angf = (float)pos[t] * inv_freq;
            float sn, cs; sincos_acc((double)angf, sn, cs);
            ct[idx] = cs; st[idx] = sn;
        }
    }
}
__device__ __forceinline__ void norm_phase(const Frame& F0, const float* __restrict__ x, const float* __restrict__ g, const float* __restrict__ sc, const float* __restrict__ sh, bf16_t* __restrict__ h) {
    const Frame F = opaque(F0);
    f32x4 ga[4], gb[4];
#pragma unroll
    for (int j = 0; j < 4; ++j) { const f32x4 gg = ((const f32x4*)g)[F.lane + 64 * j], s1 = ((const f32x4*)sc)[F.lane + 64 * j]; ga[j] = gg * (s1 + 1.0f); gb[j] = ((const f32x4*)sh)[F.lane + 64 * j]; }
    const int gw = F.vcu * NWAVES + F.wave, NGW = F.G * NWAVES;
    for (int m = gw; m < S; m += NGW) {
        const f32x4* xr = (const f32x4*)(x + (size_t)m * D) + F.lane;
        f32x4 v[4]; float ss = 0.f;
#pragma unroll
        for (int j = 0; j < 4; ++j) { v[j] = xr[64 * j]; ss += (v[j].x * v[j].x + v[j].y * v[j].y) + (v[j].z * v[j].z + v[j].w * v[j].w); }
        const float r = 1.0f / sqrtf(wave_sum(ss) * (1.f / D) + EPS);
        u32x2* o8 = (u32x2*)(h + (size_t)m * D) + F.lane;
#pragma unroll
        for (int j = 0; j < 4; ++j) { const f32x4 y = v[j] * r * ga[j] + gb[j]; u32x2 w; w.x = cvtpk(y.x, y.y); w.y = cvtpk(y.z, y.w); o8[64 * j] = w; }
    }
}
__device__ __forceinline__ void glr_phase(const Frame& F0, const bf16_t* __restrict__ H, const bf16_t* __restrict__ WglrT, float* __restrict__ glr) {
    const Frame F = opaque(F0);
    if (F.wave >= 4) return;
    const int l15 = F.lane & 15, q = F.lane >> 4;
    for (int rb = F.vcu; rb < S / 64; rb += F.G) {
        const int row0 = rb * 64 + F.wave * 16;
        const bf16_t* ap = H + (size_t)(row0 + l15) * D + 8 * q;
        const bf16_t* bp = WglrT + (size_t)l15 * D + 8 * q;
        f32x4 acc = {0.f, 0.f, 0.f, 0.f};
#pragma unroll 8
        for (int ks = 0; ks < 32; ++ks) {
            const bf16x8 av = *(const bf16x8*)(ap + ks * 32), bv = *(const bf16x8*)(bp + ks * 32);
            acc = __builtin_amdgcn_mfma_f32_16x16x32_bf16(av, bv, acc, 0, 0, 0);
        }
#pragma unroll
        for (int r = 0; r < 4; ++r) glr[(size_t)(row0 + 4 * q + r) * 16 + l15] = acc[r];
    }
}
typedef short v4i16_t __attribute__((ext_vector_type(4)));
__device__ __forceinline__ s16x4 vtr(const LAS unsigned char* p) { return __builtin_bit_cast(s16x4, __builtin_amdgcn_ds_read_tr16_b64_v4i16((LAS v4i16_t*)p)); }
__device__ __forceinline__ int crow(int reg, int h) { return (reg & 3) + 8 * (reg >> 2) + 4 * h; }
__device__ __forceinline__ unsigned off_b(unsigned row, unsigned ch) { return 272u * row + 16u * ch; }
__device__ __forceinline__ unsigned tr_addr(unsigned lane, unsigned c, unsigned rowblk) {
    const unsigned blk = (lane >> 4) & 1, q = (lane & 15) >> 2, p = lane & 3;
    return off_b(rowblk + q, 4 * c + 2 * blk + (p >> 1)) + 8 * (p & 1);
}
constexpr int GL_IMG = 64 * 272, GL_PST = 144;
constexpr int GL_QD = 0, GL_KI = GL_IMG, GL_KT = 2 * GL_IMG, GL_V = 3 * GL_IMG, GL_P = 5 * GL_IMG, GL_GL = GL_P + 64 * GL_PST, GL_SEG = GL_GL + 4096, GL_DEC = GL_SEG + 2048, GL_RED = GL_DEC + 512;
static_assert(GL_RED + 2048 <= RING_BYTES, "gla lds");
#define MFMA32(a, b, c) __builtin_amdgcn_mfma_f32_32x32x16_bf16((a), (b), (c), 0, 0, 0)

template <bool WITH_Q>
__device__ __forceinline__ float gla_chunk_prep(const Frame& F, const bf16_t* __restrict__ QKV, const float* __restrict__ GLR, int t0, int hd, const float (&wup)[16], float bgv) {
    LAS unsigned char* lds = F.lds;
    const int d = F.tid & 127, seg = F.tid >> 7;
    unsigned short qv[16], kv[16];
#pragma unroll
    for (int ii = 0; ii < 16; ++ii) {
        const bf16_t* row = QKV + (size_t)(t0 + seg * 16 + ii) * 3072;
        if (WITH_Q) qv[ii] = row[hd * 128 + d];
        kv[ii] = row[512 + hd * 128 + d];
    }
    if (F.tid < 256) { const f32x4 gv = *(const f32x4*)(GLR + (size_t)t0 * 16 + F.tid * 4); *(LAS f32x4*)(lds + GL_GL + F.tid * 16) = gv; }
#pragma unroll
    for (int k = 0; k < 4; ++k) {
        const int c = F.tid + 512 * k, j = c >> 5, ch = c & 31;
        const u32x4 vv = *(const u32x4*)(QKV + (size_t)(t0 + j) * 3072 + 1024 + hd * 256 + ch * 8);
        *(LAS u32x4*)(lds + GL_V + (ch >> 4) * GL_IMG + off_b(j, ch & 15)) = vv;
    }
    __syncthreads();
    float Gl[16]; float run = 0.f;
#pragma unroll
    for (int ii = 0; ii < 16; ++ii) {
        const LAS f32x4* gp = (const LAS f32x4*)(lds + GL_GL + (seg * 16 + ii) * 64);
        float x = bgv;
#pragma unroll
        for (int r4 = 0; r4 < 4; ++r4) { const f32x4 gq = gp[r4]; x += gq.x * wup[4 * r4] + gq.y * wup[4 * r4 + 1] + gq.z * wup[4 * r4 + 2] + gq.w * wup[4 * r4 + 3]; }
        const float ls = fminf(x, 0.f) - __logf(1.f + __expf(-fabsf(x)));
        run += ls * (1.f / 16.f); Gl[ii] = run;
    }
    ((LAS float*)(lds + GL_SEG))[seg * 128 + d] = run;
    __syncthreads();
    float offs = 0.f, glast = 0.f;
#pragma unroll
    for (int s = 0; s < 4; ++s) { const float v = ((LAS float*)(lds + GL_SEG))[s * 128 + d]; glast += v; if (s < seg) offs += v; }
    const float qs = 0.08838834764831845f;
#pragma unroll
    for (int ii = 0; ii < 16; ++ii) {
        const int i = seg * 16 + ii; const float G = Gl[ii] + offs;
        const unsigned a = off_b(i, d >> 3) + 2 * (d & 7);
        const float kf = bf2f(kv[ii]);
        if (WITH_Q) {
            *(LAS unsigned short*)(lds + GL_QD + a) = (unsigned short)(cvtpk(bf2f(qv[ii]) * qs * __expf(G), 0.f) & 0xffffu);
            *(LAS unsigned short*)(lds + GL_KI + a) = (unsigned short)(cvtpk(kf * __expf(-G), 0.f) & 0xffffu);
        }
        *(LAS unsigned short*)(lds + GL_KT + a) = (unsigned short)(cvtpk(kf * __expf(glast - G), 0.f) & 0xffffu);
    }
    if (seg == 0) ((LAS float*)(lds + GL_DEC))[d] = __expf(glast);
    __syncthreads();
    return glast;
}
__device__ __forceinline__ void gla_state_update(const Frame& F, f32x16 (&St)[4]) {
    LAS unsigned char* lds = F.lds;
    const int h = F.lane >> 5, w = F.wave;
    const LAS float* dec = (const LAS float*)(lds + GL_DEC);
#pragma unroll
    for (int db = 0; db < 4; ++db)
#pragma unroll
        for (int r = 0; r < 16; ++r) St[db][r] *= dec[32 * db + crow(r, h)];
    const LAS unsigned char* vimg = lds + GL_V + (w >> 2) * GL_IMG;
#pragma unroll
    for (int ks = 0; ks < 4; ++ks) {
        const s16x4 vlo = vtr(vimg + tr_addr(F.lane, w & 3, 16 * ks + 8 * h)), vhi = vtr(vimg + tr_addr(F.lane, w & 3, 16 * ks + 8 * h + 4));
        const bf16x8 vb = __builtin_shufflevector(vlo, vhi, 0, 1, 2, 3, 4, 5, 6, 7);
#pragma unroll
        for (int db = 0; db < 4; ++db) {
            const s16x4 klo = vtr(lds + GL_KT + tr_addr(F.lane, db, 16 * ks + 8 * h)), khi = vtr(lds + GL_KT + tr_addr(F.lane, db, 16 * ks + 8 * h + 4));
            const bf16x8 ka = __builtin_shufflevector(klo, khi, 0, 1, 2, 3, 4, 5, 6, 7);
            St[db] = MFMA32(ka, vb, St[db]);
        }
    }
}
__device__ __forceinline__ void gla_load_w(const float* __restrict__ wupg, const float* __restrict__ bgg, int hd, int d, float (&wup)[16], float& bgv) {
#pragma unroll
    for (int r = 0; r < 16; ++r) wup[r] = wupg[r * 512 + hd * 128 + d];
    bgv = bgg[hd * 128 + d];
}
__device__ __forceinline__ void gla_g1(const Frame& F0, const bf16_t* __restrict__ QKV, const float* __restrict__ GLR, const float* __restrict__ wupg, const float* __restrict__ bgg, float* __restrict__ SBUF, float* __restrict__ DG) {
    const Frame F = opaque(F0);
    const int h = F.lane >> 5, w = F.wave;
    for (int u = F.vcu; u < 256; u += F.G) {
        const int gi = u >> 2, hd = u & 3;
        float wup[16], bgv; gla_load_w(wupg, bgg, hd, F.tid & 127, wup, bgv);
        f32x16 St[4];
#pragma unroll
        for (int db = 0; db < 4; ++db)
#pragma unroll
            for (int r = 0; r < 16; ++r) St[db][r] = 0.f;
        float gsum = 0.f;
#pragma unroll 1
        for (int c = 0; c < 4; ++c) {
            gsum += gla_chunk_prep<false>(F, QKV, GLR, gi * 256 + c * 64, hd, wup, bgv);
            gla_state_update(F, St);
            __syncthreads();
        }
        float* sp = SBUF + ((size_t)u * 128) * 256 + 32 * w + (F.lane & 31);
#pragma unroll
        for (int db = 0; db < 4; ++db)
#pragma unroll
            for (int r = 0; r < 16; ++r) sp[(size_t)(32 * db + crow(r, h)) * 256] = St[db][r];
        if (F.tid < 128) DG[u * 128 + F.tid] = __expf(gsum);
    }
}
__device__ __forceinline__ void gla_g2(const Frame& F0, float* __restrict__ SBUF, const float* __restrict__ DG) {
    const Frame F = opaque(F0);
    for (int e = F.vcu * NTHR + F.tid; e < 4 * 128 * 256; e += F.G * NTHR) {
        const int hd = e >> 15, d = (e >> 8) & 127;
        float run = 0.f;
#pragma unroll 1
        for (int g0 = 0; g0 < 64; g0 += 8) {
            float tmp[8], dec[8];
#pragma unroll
            for (int k = 0; k < 8; ++k) { const int g = g0 + k; tmp[k] = SBUF[(size_t)(g * 4 + hd) * 32768 + (e & 32767)]; dec[k] = DG[(g * 4 + hd) * 128 + d]; }
#pragma unroll
            for (int k = 0; k < 8; ++k) { const int g = g0 + k; SBUF[(size_t)(g * 4 + hd) * 32768 + (e & 32767)] = run; run = dec[k] * run + tmp[k]; }
        }
    }
}
__device__ __forceinline__ void gla_g3(const Frame& F0, const bf16_t* __restrict__ QKV, const float* __restrict__ GLR, const float* __restrict__ wupg, const float* __restrict__ bgg,
                                       const float* __restrict__ SBUF, const float* __restrict__ og, bf16_t* __restrict__ MIX) {
    const Frame F = opaque(F0);
    LAS unsigned char* lds = F.lds;
    const int h = F.lane >> 5, w = F.wave, l31 = F.lane & 31;
    for (int u = F.vcu; u < 256; u += F.G) {
        const int gi = u >> 2, hd = u & 3;
        float wup[16], bgv; gla_load_w(wupg, bgg, hd, F.tid & 127, wup, bgv);
        f32x16 St[4];
        { const float* sp = SBUF + ((size_t)u * 128) * 256 + 32 * w + l31;
#pragma unroll
          for (int db = 0; db < 4; ++db)
#pragma unroll
              for (int r = 0; r < 16; ++r) St[db][r] = sp[(size_t)(32 * db + crow(r, h)) * 256]; }
#pragma unroll 1
        for (int c = 0; c < 4; ++c) {
            const int t0 = gi * 256 + c * 64;
            (void)gla_chunk_prep<true>(F, QKV, GLR, t0, hd, wup, bgv);
            if (w < 3) {
                const int ib = (w >= 1), jb = (w == 2);
                f32x16 acc;
#pragma unroll
                for (int r = 0; r < 16; ++r) acc[r] = 0.f;
#pragma unroll
                for (int s = 0; s < 8; ++s) {
                    const bf16x8 a = *(const LAS bf16x8*)(lds + GL_QD + off_b(32 * ib + l31, 2 * s + h));
                    const bf16x8 b = *(const LAS bf16x8*)(lds + GL_KI + off_b(32 * jb + l31, 2 * s + h));
                    acc = MFMA32(a, b, acc);
                }
                const int jabs = 32 * jb + l31;
#pragma unroll
                for (int r = 0; r < 16; ++r) { const int iabs = 32 * ib + crow(r, h); const float pv = (jabs <= iabs) ? acc[r] : 0.f;
                    *(LAS unsigned short*)(lds + GL_P + iabs * GL_PST + 2 * jabs) = (unsigned short)(cvtpk(pv, 0.f) & 0xffffu); }
            }
            f32x16 oT[2];
#pragma unroll
            for (int ib = 0; ib < 2; ++ib)
#pragma unroll
                for (int r = 0; r < 16; ++r) oT[ib][r] = 0.f;
#pragma unroll
            for (int db = 0; db < 4; ++db)
#pragma unroll
                for (int s = 0; s < 2; ++s) {
                    u32x4 pk; pk.x = cvtpk(St[db][8 * s + 0], St[db][8 * s + 1]); pk.y = cvtpk(St[db][8 * s + 2], St[db][8 * s + 3]); pk.z = cvtpk(St[db][8 * s + 4], St[db][8 * s + 5]); pk.w = cvtpk(St[db][8 * s + 6], St[db][8 * s + 7]);
                    const bf16x8 xa = __builtin_bit_cast(bf16x8, pk);
#pragma unroll
                    for (int ib = 0; ib < 2; ++ib) {
                        const u32x2 qlo = *(const LAS u32x2*)(lds + GL_QD + off_b(32 * ib + l31, 4 * db + 2 * s + 0) + 8 * h);
                        const u32x2 qhi = *(const LAS u32x2*)(lds + GL_QD + off_b(32 * ib + l31, 4 * db + 2 * s + 1) + 8 * h);
                        u32x4 qq; qq.x = qlo.x; qq.y = qlo.y; qq.z = qhi.x; qq.w = qhi.y;
                        oT[ib] = MFMA32(xa, __builtin_bit_cast(bf16x8, qq), oT[ib]);
                    }
                }
            __syncthreads();
            {
                const LAS unsigned char* vimg = lds + GL_V + (w >> 2) * GL_IMG;
#pragma unroll
                for (int ks = 0; ks < 4; ++ks) {
                    const s16x4 vlo = vtr(vimg + tr_addr(F.lane, w & 3, 16 * ks + 8 * h)), vhi = vtr(vimg + tr_addr(F.lane, w & 3, 16 * ks + 8 * h + 4));
                    const bf16x8 va = __builtin_shufflevector(vlo, vhi, 0, 1, 2, 3, 4, 5, 6, 7);
#pragma unroll
                    for (int ib = 0; ib < 2; ++ib) {
                        if (ib == 0 && ks >= 2) continue;
                        const int irow = 32 * ib + l31;
                        const bf16x8 pb = *(const LAS bf16x8*)(lds + GL_P + irow * GL_PST + 16 * (2 * ks + h));
                        oT[ib] = MFMA32(va, pb, oT[ib]);
                    }
                }
            }
            float ssq[2];
#pragma unroll
            for (int ib = 0; ib < 2; ++ib) { float s = 0.f;
#pragma unroll
                for (int r = 0; r < 16; ++r) s += oT[ib][r] * oT[ib][r];
                s += __shfl_xor(s, 32); ssq[ib] = s; }
            if (h == 0) { ((LAS float*)(lds + GL_RED))[w * 64 + l31] = ssq[0]; ((LAS float*)(lds + GL_RED))[w * 64 + 32 + l31] = ssq[1]; }
            __syncthreads();
#pragma unroll
            for (int ib = 0; ib < 2; ++ib) {
                float tot = 0.f;
#pragma unroll
                for (int ww = 0; ww < 8; ++ww) tot += ((LAS float*)(lds + GL_RED))[ww * 64 + 32 * ib + l31];
                const float rn = 1.0f / sqrtf(tot * (1.f / 256.f) + EPS);
                const int t = t0 + 32 * ib + l31;
#pragma unroll
                for (int g = 0; g < 4; ++g) {
                    const int e0 = 32 * w + 8 * g + 4 * h;
                    const u32x2 rg = *(const u32x2*)(QKV + (size_t)t * 3072 + 2048 + hd * 256 + e0);
                    const f32x4 ogv = *(const f32x4*)(og + e0);
                    const float r0 = bflo(rg.x), r1 = bfhi(rg.x), r2 = bflo(rg.y), r3 = bfhi(rg.y);
                    const float y0 = oT[ib][4 * g + 0] * rn * ogv.x * (r0 / (1.f + __expf(-r0)));
                    const float y1 = oT[ib][4 * g + 1] * rn * ogv.y * (r1 / (1.f + __expf(-r1)));
                    const float y2 = oT[ib][4 * g + 2] * rn * ogv.z * (r2 / (1.f + __expf(-r2)));
                    const float y3 = oT[ib][4 * g + 3] * rn * ogv.w * (r3 / (1.f + __expf(-r3)));
                    u32x2 o; o.x = cvtpk(y0, y1); o.y = cvtpk(y2, y3);
                    *(u32x2*)(MIX + (size_t)t * D + hd * 256 + e0) = o;
                }
            }
            if (c < 3) gla_state_update(F, St);
            __syncthreads();
        }
    }
}
constexpr int MB_LIST_H = 516096;
__device__ __forceinline__ int mb_list_off(int n) { return 256 * (63 * n - (n * (n - 1)) / 2); }
constexpr int MB_KIMG = 0, MB_VIMG = 256 * 272, MB_PRE = 2 * 256 * 272, MB_TOK = MB_PRE + 2064, MB_END = MB_TOK + 1024;
static_assert(MB_END <= MISC_OFF, "moba lds");

__device__ __forceinline__ void moba_m1(const Frame& F0, bf16_t* __restrict__ QKV, const float* __restrict__ COS, const float* __restrict__ SIN,
                                        const float* __restrict__ qg, const float* __restrict__ kg, float* __restrict__ KMEAN) {
    const Frame F = opaque(F0);
    LAS unsigned char* lds = F.lds;
    const int hh = F.lane >> 3, j = F.lane & 7;
    for (int u = F.vcu; u < 192; u += F.G) {
        const int which = (u >= 128), n = which ? (u - 128) : (u >> 1);
        const int tbase = which ? n * 256 : n * 256 + (u & 1) * 128, cnt = which ? 256 : 128;
        const float* g = which ? kg : qg;
        float g1[8], g2[8], a1[8], a2[8];
#pragma unroll
        for (int e = 0; e < 8; ++e) { g1[e] = g[8 * j + e]; g2[e] = g[64 + 8 * j + e]; a1[e] = 0.f; a2[e] = 0.f; }
#pragma unroll 2
        for (int it = F.wave; it < cnt; it += NWAVES) {
            const int t = tbase + it;
            bf16_t* p = QKV + (size_t)t * 3072 + which * 1024 + hh * 128 + 8 * j;
            const u32x4 ra = *(const u32x4*)p, rb = *(const u32x4*)(p + 64);
            const f32x4 c0 = *(const f32x4*)(COS + (size_t)t * 64 + 8 * j), c1 = *(const f32x4*)(COS + (size_t)t * 64 + 8 * j + 4);
            const f32x4 s0 = *(const f32x4*)(SIN + (size_t)t * 64 + 8 * j), s1 = *(const f32x4*)(SIN + (size_t)t * 64 + 8 * j + 4);
            float x1[8] = {bflo(ra.x), bfhi(ra.x), bflo(ra.y), bfhi(ra.y), bflo(ra.z), bfhi(ra.z), bflo(ra.w), bfhi(ra.w)};
            float x2[8] = {bflo(rb.x), bfhi(rb.x), bflo(rb.y), bfhi(rb.y), bflo(rb.z), bfhi(rb.z), bflo(rb.w), bfhi(rb.w)};
            const float cs[8] = {c0.x, c0.y, c0.z, c0.w, c1.x, c1.y, c1.z, c1.w};
            const float sn[8] = {s0.x, s0.y, s0.z, s0.w, s1.x, s1.y, s1.z, s1.w};
            float ss = 0.f;
#pragma unroll
            for (int e = 0; e < 8; ++e) ss += x1[e] * x1[e] + x2[e] * x2[e];
            ss += __shfl_xor(ss, 1); ss += __shfl_xor(ss, 2); ss += __shfl_xor(ss, 4);
            const float r = 1.0f / sqrtf(ss * (1.f / 128.f) + EPS);
            float o1[8], o2[8];
#pragma unroll
            for (int e = 0; e < 8; ++e) { const float y1 = x1[e] * r * g1[e], y2 = x2[e] * r * g2[e]; o1[e] = y1 * cs[e] - y2 * sn[e]; o2[e] = y2 * cs[e] + y1 * sn[e]; a1[e] += o1[e]; a2[e] += o2[e]; }
            u32x4 wa, wb;
            wa.x = cvtpk(o1[0], o1[1]); wa.y = cvtpk(o1[2], o1[3]); wa.z = cvtpk(o1[4], o1[5]); wa.w = cvtpk(o1[6], o1[7]);
            wb.x = cvtpk(o2[0], o2[1]); wb.y = cvtpk(o2[2], o2[3]); wb.z = cvtpk(o2[4], o2[5]); wb.w = cvtpk(o2[6], o2[7]);
            *(u32x4*)p = wa; *(u32x4*)(p + 64) = wb;
        }
        if (which) {
            LAS float* red = (LAS float*)lds;
#pragma unroll
            for (int e = 0; e < 8; ++e) { red[(F.wave * 64 + F.lane) * 16 + e] = a1[e]; red[(F.wave * 64 + F.lane) * 16 + 8 + e] = a2[e]; }
            __syncthreads();
#pragma unroll
            for (int k = 0; k < 2; ++k) {
                const int o = F.tid * 2 + k, head = o >> 7, d = o & 127;
                const int ln = head * 8 + ((d & 63) >> 3), slot = (d >> 6) * 8 + (d & 7);
                float s = 0.f;
#pragma unroll
                for (int w = 0; w < 8; ++w) s += red[(w * 64 + ln) * 16 + slot];
                KMEAN[((size_t)head * 64 + n) * 128 + d] = s * (1.f / 256.f);
            }
            __syncthreads();
        }
    }
}
#define MB_INS(v, i) do { const float v_ = (v); const int i_ = (i); \
    const bool b0_ = v_ > v0 || (v_ == v0 && i_ < i0), b1_ = v_ > v1 || (v_ == v1 && i_ < i1), b2_ = v_ > v2 || (v_ == v2 && i_ < i2); \
    if (b0_) { v2 = v1; i2 = i1; v1 = v0; i1 = i0; v0 = v_; i0 = i_; } else if (b1_) { v2 = v1; i2 = i1; v1 = v_; i1 = i_; } else if (b2_) { v2 = v_; i2 = i_; } } while (0)
__device__ __forceinline__ void moba_m2(const Frame& F0, const bf16_t* __restrict__ QKV, const float* __restrict__ KMEAN, unsigned* __restrict__ gcnt, int* __restrict__ LIST) {
    const Frame F = opaque(F0);
    LAS unsigned char* lds = F.lds;
    LAS int* cntl = (LAS int*)lds;
    const int h2 = F.lane >> 5, l31 = F.lane & 31, w = F.wave;
    for (int u = F.vcu; u < 512; u += F.G) {
        const int b = u >> 3, h = u & 7;
        if (b == 0) continue;
        if (F.tid < 64) cntl[F.tid] = 0;
        __syncthreads();
        const int t = b * 256 + 32 * w + l31;
        bf16x8 qf[8];
#pragma unroll
        for (int s = 0; s < 8; ++s) qf[s] = *(const bf16x8*)(QKV + (size_t)t * 3072 + h * 128 + 16 * s + 8 * h2);
        float v0 = -INFINITY, v1 = -INFINITY, v2 = -INFINITY; int i0 = 64, i1 = 64, i2 = 64;
#pragma unroll
        for (int nb = 0; nb < 2; ++nb) {
            if (nb == 1 && b <= 32) continue;
            f32x16 acc;
#pragma unroll
            for (int r = 0; r < 16; ++r) acc[r] = 0.f;
            const float* kmp = KMEAN + ((size_t)h * 64 + 32 * nb + l31) * 128 + 8 * h2;
#pragma unroll
            for (int s = 0; s < 8; ++s) {
                const f32x4 ka = *(const f32x4*)(kmp + 16 * s), kb = *(const f32x4*)(kmp + 16 * s + 4);
                u32x4 hi; hi.x = cvtpk(ka.x, ka.y); hi.y = cvtpk(ka.z, ka.w); hi.z = cvtpk(kb.x, kb.y); hi.w = cvtpk(kb.z, kb.w);
                u32x4 lo; lo.x = cvtpk(ka.x - bflo(hi.x), ka.y - bfhi(hi.x)); lo.y = cvtpk(ka.z - bflo(hi.y), ka.w - bfhi(hi.y));
                lo.z = cvtpk(kb.x - bflo(hi.z), kb.y - bfhi(hi.z)); lo.w = cvtpk(kb.z - bflo(hi.w), kb.w - bfhi(hi.w));
                acc = MFMA32(__builtin_bit_cast(bf16x8, hi), qf[s], acc);
                acc = MFMA32(__builtin_bit_cast(bf16x8, lo), qf[s], acc);
            }
#pragma unroll
            for (int r = 0; r < 16; ++r) { const int n = 32 * nb + crow(r, h2); const float gv = (n < b) ? acc[r] : -INFINITY; MB_INS(gv, n); }
        }
        { const float p0 = __shfl_xor(v0, 32), p1 = __shfl_xor(v1, 32), p2 = __shfl_xor(v2, 32); const int q0 = __shfl_xor(i0, 32), q1 = __shfl_xor(i1, 32), q2 = __shfl_xor(i2, 32);
          MB_INS(p0, q0); MB_INS(p1, q1); MB_INS(p2, q2); }
        int pos0 = 0, pos1 = 0, pos2 = 0;
        const bool e0 = (h2 == 0) && (v0 > -INFINITY), e1 = (h2 == 0) && (v1 > -INFINITY), e2 = (h2 == 0) && (v2 > -INFINITY);
        if (e0) pos0 = __hip_atomic_fetch_add(cntl + i0, 1, __ATOMIC_RELAXED, __HIP_MEMORY_SCOPE_WORKGROUP);
        if (e1) pos1 = __hip_atomic_fetch_add(cntl + i1, 1, __ATOMIC_RELAXED, __HIP_MEMORY_SCOPE_WORKGROUP);
        if (e2) pos2 = __hip_atomic_fetch_add(cntl + i2, 1, __ATOMIC_RELAXED, __HIP_MEMORY_SCOPE_WORKGROUP);
        __syncthreads();
        if (F.tid < 64) { const int c = cntl[F.tid]; int base = 0; if (c > 0) base = (int)__hip_atomic_fetch_add(gcnt + h * 64 + F.tid, (unsigned)c, __ATOMIC_RELAXED, __HIP_MEMORY_SCOPE_AGENT); cntl[64 + F.tid] = base; }
        __syncthreads();
        int* lst = LIST + (size_t)h * MB_LIST_H;
        if (e0) lst[mb_list_off(i0) + cntl[64 + i0] + pos0] = (t << 2) | 0;
        if (e1) lst[mb_list_off(i1) + cntl[64 + i1] + pos1] = (t << 2) | 1;
        if (e2) lst[mb_list_off(i2) + cntl[64 + i2] + pos2] = (t << 2) | 2;
        __syncthreads();
    }
}
__device__ __forceinline__ void moba_m3(const Frame& F0, const bf16_t* __restrict__ QKV, const unsigned* __restrict__ gcnt, const int* __restrict__ LIST,
                                        bf16_t* __restrict__ OPART, bf16_t* __restrict__ MIX, float* __restrict__ LPART) {
    const Frame F = opaque(F0);
    LAS unsigned char* lds = F.lds;
    LAS int* pre = (LAS int*)(lds + MB_PRE);
    LAS int* tokw = (LAS int*)(lds + MB_TOK) + F.wave * 32;
    const int h2 = F.lane >> 5, l31 = F.lane & 31, w = F.wave;
    { int v = ((int)gcnt[F.tid] + 255) >> 8; pre[F.tid] = v; __syncthreads();
#pragma unroll 1
      for (int o = 1; o < 512; o <<= 1) { const int add = (F.tid >= o) ? pre[F.tid - o] : 0; __syncthreads(); pre[F.tid] += add; __syncthreads(); } }
    const int total = 512 + pre[511];
    for (int v = F.vcu; v < total; v += F.G) {
        int h, n, slot3_tile = -1, count = 256, lbase = 0;
        if (v < 512) { n = v >> 3; h = v & 7; }
        else {
            const int x = v - 512; int lo_ = 0, hi_ = 511;
            while (lo_ < hi_) { const int mid = (lo_ + hi_) >> 1; if (pre[mid] > x) hi_ = mid; else lo_ = mid + 1; }
            const int hn = lo_; h = hn >> 6; n = hn & 63;
            slot3_tile = x - (hn ? pre[hn - 1] : 0);
            count = (int)gcnt[hn] - slot3_tile * 256; if (count > 256) count = 256;
            lbase = h * MB_LIST_H + mb_list_off(n) + slot3_tile * 256;
        }
        const bool own = (slot3_tile < 0);
#pragma unroll
        for (int k = 0; k < 8; ++k) {
            const int c = F.tid + 512 * k, r = c >> 4, ch = c & 15;
            const bf16_t* src = QKV + (size_t)(n * 256 + r) * 3072 + 1024 + h * 128 + 8 * ch;
            const u32x4 kk = *(const u32x4*)src, vv = *(const u32x4*)(src + 1024);
            *(LAS u32x4*)(lds + MB_KIMG + r * 272 + 16 * ch) = kk; *(LAS u32x4*)(lds + MB_VIMG + r * 272 + 16 * ch) = vv;
        }
        const int qi = 32 * w + l31;
        int ent;
        if (own) ent = ((n * 256 + qi) << 2) | 3;
        else ent = (qi < count) ? LIST[lbase + qi] : -1;
        const int tq = (ent >= 0) ? (ent >> 2) : (n * 256);
        if (h2 == 0) tokw[l31] = ent;
        bf16x8 qf[8];
#pragma unroll
        for (int s = 0; s < 8; ++s) qf[s] = *(const bf16x8*)(QKV + (size_t)tq * 3072 + h * 128 + 16 * s + 8 * h2);
        __syncthreads();
        f32x16 O[4];
#pragma unroll
        for (int db = 0; db < 4; ++db)
#pragma unroll
            for (int r = 0; r < 16; ++r) O[db][r] = 0.f;
        float lsum = 0.f;
        const int nkt = own ? (w + 1) : 8;
        const LAS unsigned char* kb = lds + MB_KIMG + l31 * 272 + 16 * h2;
        const LAS unsigned char* vb = lds + MB_VIMG + (4 * h2 + ((F.lane & 15) >> 2)) * 272 + 32 * ((F.lane >> 4) & 1) + 8 * (F.lane & 3);
        const float cexp = 0.08838834764831845f * 1.4426950408889634f;
#pragma unroll 1
        for (int kt = 0; kt < nkt; ++kt) {
            f32x16 acc;
#pragma unroll
            for (int r = 0; r < 16; ++r) acc[r] = 0.f;
#pragma unroll
            for (int s = 0; s < 8; ++s) { const bf16x8 ka = *(const LAS bf16x8*)(kb + kt * (32 * 272) + 32 * s); acc = MFMA32(ka, qf[s], acc); }
            float pr[16];
#pragma unroll
            for (int r = 0; r < 16; ++r) { float p = __builtin_amdgcn_exp2f(acc[r] * cexp); if (own && (32 * kt + crow(r, h2) > qi)) p = 0.f; pr[r] = p; lsum += p; }
#pragma unroll
            for (int s2 = 0; s2 < 2; ++s2) {
                u32x4 pk; pk.x = cvtpk(pr[8 * s2 + 0], pr[8 * s2 + 1]); pk.y = cvtpk(pr[8 * s2 + 2], pr[8 * s2 + 3]); pk.z = cvtpk(pr[8 * s2 + 4], pr[8 * s2 + 5]); pk.w = cvtpk(pr[8 * s2 + 6], pr[8 * s2 + 7]);
                const bf16x8 pa = __builtin_bit_cast(bf16x8, pk);
#pragma unroll
                for (int db = 0; db < 4; ++db) {
                    const LAS unsigned char* vp = vb + kt * (32 * 272) + s2 * (16 * 272) + 64 * db;
                    const s16x4 vlo = vtr(vp), vhi = vtr(vp + 8 * 272);
                    O[db] = MFMA32(pa, __builtin_shufflevector(vlo, vhi, 0, 1, 2, 3, 4, 5, 6, 7), O[db]);
                }
            }
        }
        lsum += __shfl_xor(lsum, 32);
        if (h2 == 0 && ent >= 0) LPART[((size_t)(ent & 3) * S + (ent >> 2)) * 8 + h] = lsum;
#pragma unroll
        for (int r = 0; r < 16; ++r) {
            const int er = tokw[crow(r, h2)];
            if (er >= 0) {
                const int sl = er & 3, tr_ = er >> 2;
                bf16_t* dst = (sl == 3) ? (MIX + (size_t)tr_ * D) : (OPART + ((size_t)sl * S + tr_) * D);
#pragma unroll
                for (int db = 0; db < 4; ++db) dst[h * 128 + 32 * db + l31] = (bf16_t)(cvtpk(O[db][r], 0.f) & 0xffffu);
            }
        }
        __syncthreads();
    }
}
__device__ __forceinline__ void moba_m4(const Frame& F0, const bf16_t* __restrict__ OPART, const float* __restrict__ LPART, bf16_t* __restrict__ MIX) {
    const Frame F = opaque(F0);
    for (int it = F.vcu * NTHR + F.tid; it < S * 128; it += F.G * NTHR) {
        const int t = it >> 7, c8 = it & 127, h = c8 >> 4;
        const int nsel = (t >> 8) < 3 ? (t >> 8) : 3;
        const u32x4 m = *(const u32x4*)(MIX + (size_t)t * D + c8 * 8);
        float o[8] = {bflo(m.x), bfhi(m.x), bflo(m.y), bfhi(m.y), bflo(m.z), bfhi(m.z), bflo(m.w), bfhi(m.w)};
        float l = LPART[((size_t)3 * S + t) * 8 + h];
#pragma unroll
        for (int sl = 0; sl < 3; ++sl) {
            if (sl < nsel) {
                const u32x4 p = *(const u32x4*)(OPART + ((size_t)sl * S + t) * D + c8 * 8);
                o[0] += bflo(p.x); o[1] += bfhi(p.x); o[2] += bflo(p.y); o[3] += bfhi(p.y); o[4] += bflo(p.z); o[5] += bfhi(p.z); o[6] += bflo(p.w); o[7] += bfhi(p.w);
                l += LPART[((size_t)sl * S + t) * 8 + h];
            }
        }
        const float inv = 1.f / l;
        u32x4 r; r.x = cvtpk(o[0] * inv, o[1] * inv); r.y = cvtpk(o[2] * inv, o[3] * inv); r.z = cvtpk(o[4] * inv, o[5] * inv); r.w = cvtpk(o[6] * inv, o[7] * inv);
        *(u32x4*)(MIX + (size_t)t * D + c8 * 8) = r;
    }
}
__device__ __forceinline__ float wave_max(float v) {
#pragma unroll
    for (int o = 1; o < 64; o <<= 1) v = fmaxf(v, __shfl_xor(v, o));
    return v;
}
__device__ __forceinline__ float logsigmoid_f(float x) { return fminf(x, 0.f) - log1pf(expf(-fabsf(x))); }
__global__ void nk_gla_gate(const float* __restrict__ glr, const float* __restrict__ wup, const float* __restrict__ bg, float* __restrict__ g) {
    const size_t idx = (size_t)blockIdx.x * blockDim.x + threadIdx.x;
    const int t = (int)(idx >> 9), j = (int)(idx & 511);
    float acc = bg[j];
#pragma unroll
    for (int r = 0; r < 16; ++r) acc += glr[(size_t)t * 16 + r] * wup[r * 512 + j];
    g[idx] = logsigmoid_f(acc) * (1.f / 16.f);
}
__global__ __launch_bounds__(256) void nk_gla_recur(const bf16_t* __restrict__ qkv, const float* __restrict__ g, float* __restrict__ o) {
    __shared__ float sq[16][128], sk[16][128], sa[16][128];
    const int h = blockIdx.x, tid = threadIdx.x;
    float St[128];
#pragma unroll
    for (int d = 0; d < 128; ++d) St[d] = 0.f;
    const float qs = 0.08838834764831845f;
    for (int t0 = 0; t0 < S; t0 += 16) {
        float vv[16];
#pragma unroll
        for (int tt = 0; tt < 16; ++tt) vv[tt] = bf2f(qkv[(size_t)(t0 + tt) * 3072 + 1024 + h * 256 + tid]);
#pragma unroll
        for (int i = 0; i < 8; ++i) {
            const int e = tid + i * 256, tok = e >> 7, d = e & 127;
            const bf16_t* row = qkv + (size_t)(t0 + tok) * 3072;
            sq[tok][d] = bf2f(row[h * 128 + d]) * qs;
            sk[tok][d] = bf2f(row[512 + h * 128 + d]);
            sa[tok][d] = expf(g[(size_t)(t0 + tok) * 512 + h * 128 + d]);
        }
        __syncthreads();
#pragma unroll 1
        for (int tt = 0; tt < 16; ++tt) {
            const float v = vv[0];
#pragma unroll
            for (int i = 0; i < 15; ++i) vv[i] = vv[i + 1];
            float acc = 0.f;
#pragma unroll
            for (int d = 0; d < 128; ++d) { St[d] = sa[tt][d] * St[d] + sk[tt][d] * v; acc += sq[tt][d] * St[d]; }
            o[(size_t)(t0 + tt) * D + h * 256 + tid] = acc;
        }
        __syncthreads();
    }
}
__global__ __launch_bounds__(256) void nk_gla_post(const float* __restrict__ o, const bf16_t* __restrict__ qkv, const float* __restrict__ og, bf16_t* __restrict__ mix) {
    const int w = blockIdx.x * 4 + (threadIdx.x >> 6), lane = threadIdx.x & 63;
    const int t = w >> 2, h = w & 3;
    f32x4 v = *(const f32x4*)(o + (size_t)t * D + h * 256 + lane * 4);
    const float ss = wave_sum(v.x * v.x + v.y * v.y + v.z * v.z + v.w * v.w);
    const float r = 1.0f / sqrtf(ss * (1.f / 256.f) + EPS);
    const f32x4 gg = *(const f32x4*)(og + lane * 4);
    const bf16_t* rp = qkv + (size_t)t * 3072 + 2048 + h * 256 + lane * 4;
    bf16_t* mp = mix + (size_t)t * D + h * 256 + lane * 4;
#pragma unroll
    for (int e = 0; e < 4; ++e) { const float rr = bf2f(rp[e]); const float y = v[e] * r * gg[e] * (rr / (1.f + expf(-rr))); mp[e] = (bf16_t)(cvtpk(y, 0.f) & 0xffffu); }
}
__global__ __launch_bounds__(256) void nk_moba_qk(bf16_t* __restrict__ qkv, const int* __restrict__ pos, const float* __restrict__ qg, const float* __restrict__ kg) {
    const int w = blockIdx.x * 4 + (threadIdx.x >> 6), lane = threadIdx.x & 63;
    const int t = w >> 4, which = (w >> 3) & 1, h = w & 7;
    bf16_t* p = qkv + (size_t)t * 3072 + which * 1024 + h * 128;
    const float* g = which ? kg : qg;
    float t1 = bf2f(p[lane]), t2 = bf2f(p[lane + 64]);
    const float ss = wave_sum(t1 * t1 + t2 * t2);
    const float r = 1.0f / sqrtf(ss * (1.f / 128.f) + EPS);
    t1 = t1 * r * g[lane]; t2 = t2 * r * g[lane + 64];
    const float inv_freq = (float)exp2(-(double)lane * (13.287712379549449 / 64.0));
    const float angf = (float)pos[t] * inv_freq;
    float cs, sn; sincos_acc((double)angf, sn, cs);
    p[lane] = (bf16_t)(cvtpk(t1 * cs - t2 * sn, 0.f) & 0xffffu);
    p[lane + 64] = (bf16_t)(cvtpk(t2 * cs + t1 * sn, 0.f) & 0xffffu);
}
__global__ __launch_bounds__(128) void nk_moba_kmean(const bf16_t* __restrict__ qkv, float* __restrict__ kmean) {
    const int h = blockIdx.x >> 6, n = blockIdx.x & 63, d = threadIdx.x;
    float acc = 0.f;
    for (int j = 0; j < 256; ++j) acc += bf2f(qkv[(size_t)(n * 256 + j) * 3072 + 1024 + h * 128 + d]);
    kmean[(size_t)blockIdx.x * 128 + d] = acc * (1.f / 256.f);
}
__global__ __launch_bounds__(64) void nk_moba_attn(const bf16_t* __restrict__ qkv, const float* __restrict__ kmean, bf16_t* __restrict__ out) {
    __shared__ float sq[128];
    __shared__ float sp[1024];
    __shared__ int skey[1024];
    const int t = blockIdx.x >> 3, h = blockIdx.x & 7, lane = threadIdx.x;
    const bf16_t* qp = qkv + (size_t)t * 3072 + h * 128;
    sq[lane] = bf2f(qp[lane]); sq[lane + 64] = bf2f(qp[lane + 64]);
    __syncthreads();
    const int own = t >> 8;
    float gate = -INFINITY;
    if (lane < own) {
        const float* km = kmean + ((size_t)h * 64 + lane) * 128;
        float a = 0.f;
        for (int d = 0; d < 128; ++d) a += sq[d] * km[d];
        gate = a;
    }
    int s0 = -1, s1 = -1, s2 = -1;
#pragma unroll
    for (int j = 0; j < 3; ++j) {
        const float m = wave_max(gate);
        int idx = -1;
        if (m > -INFINITY) { const unsigned long long b = __ballot(gate == m); idx = __ffsll((long long)b) - 1; }
        if (j == 0) s0 = idx; else if (j == 1) s1 = idx; else s2 = idx;
        if (lane == idx) gate = -INFINITY;
    }
    int nk = 0;
    if (s0 >= 0) { for (int i = lane; i < 256; i += 64) skey[nk + i] = s0 * 256 + i; nk += 256; }
    if (s1 >= 0) { for (int i = lane; i < 256; i += 64) skey[nk + i] = s1 * 256 + i; nk += 256; }
    if (s2 >= 0) { for (int i = lane; i < 256; i += 64) skey[nk + i] = s2 * 256 + i; nk += 256; }
    const int nown = t - own * 256 + 1;
    for (int i = lane; i < nown; i += 64) skey[nk + i] = own * 256 + i;
    nk += nown;
    __syncthreads();
    const float scale = 0.08838834764831845f;
    float mx = -INFINITY;
    for (int i = lane; i < nk; i += 64) {
        const bf16_t* kp = qkv + (size_t)skey[i] * 3072 + 1024 + h * 128;
        float a = 0.f;
        for (int d = 0; d < 128; d += 8) { const u32x4 kk = *(const u32x4*)(kp + d);
            a += sq[d] * bflo(kk.x) + sq[d + 1] * bfhi(kk.x) + sq[d + 2] * bflo(kk.y) + sq[d + 3] * bfhi(kk.y) + sq[d + 4] * bflo(kk.z) + sq[d + 5] * bfhi(kk.z) + sq[d + 6] * bflo(kk.w) + sq[d + 7] * bfhi(kk.w); }
        a *= scale; sp[i] = a; mx = fmaxf(mx, a);
    }
    mx = wave_max(mx);
    float sum = 0.f;
    for (int i = lane; i < nk; i += 64) { const float p = expf(sp[i] - mx); sp[i] = p; sum += p; }
    sum = wave_sum(sum);
    __syncthreads();
    float o0 = 0.f, o1 = 0.f;
    for (int i = 0; i < nk; ++i) {
        const bf16_t* vp = qkv + (size_t)skey[i] * 3072 + 2048 + h * 128;
        const float p = sp[i];
        o0 += p * bf2f(vp[lane]); o1 += p * bf2f(vp[lane + 64]);
    }
    const float inv = 1.f / sum;
    out[(size_t)t * D + h * 128 + lane] = (bf16_t)(cvtpk(o0 * inv, 0.f) & 0xffffu);
    out[(size_t)t * D + h * 128 + lane + 64] = (bf16_t)(cvtpk(o1 * inv, 0.f) & 0xffffu);
}
constexpr int PH_PER_LAYER = 10, PH_L0 = 2, N_PHASES = PH_L0 + DEPTH * PH_PER_LAYER;
__global__ void __launch_bounds__(NTHR, 2) mega(MegaArgs args) {
    extern __shared__ __attribute__((aligned(16))) unsigned char lds_raw[];
    Frame F;
    F.lds = (LAS unsigned char*)lds_raw;
    F.tid = threadIdx.x; F.lane = F.tid & 63; F.wave = __builtin_amdgcn_readfirstlane(F.tid >> 6);
    F.G = gridDim.x; { const int bx = blockIdx.x; F.vcu = (F.G % 8 == 0) ? (bx % 8) * (F.G / 8) + bx / 8 : bx; }
    volatile LAS unsigned* MISC = (volatile LAS unsigned*)(F.lds + MISC_OFF);
    unsigned char* ws = args.ws;
    unsigned* ctl = (unsigned*)(ws + WS_CTL);
    for (int u = F.tid; u < (LDS_BYTES - MISC_OFF) / 4; u += NTHR) ((LAS unsigned*)(F.lds + MISC_OFF))[u] = 0u;
    __syncthreads();
    XcdBarrier bar = xcd_barrier_post(ctl + CW_BAR, MISC + 8);
    const int lo = args.ph_lo, hi = args.ph_hi;
#define IN(k) (lo <= (k) && (k) < hi)
#define SEAM(k) do { if (lo <= (k) && (k) + 1 < hi) xcd_barrier(bar); } while (0)
    const float* mod = (const float*)(ws + WS_MOD);
    bf16_t* H = (bf16_t*)(ws + WS_H); bf16_t* MIX = (bf16_t*)(ws + WS_MIX); bf16_t* QKV = (bf16_t*)(ws + WS_QKV); bf16_t* HID = (bf16_t*)(ws + WS_HID);
    float* xout = args.out;

    if (IN(0)) { p0_prologue(F, args); }
    if (lo <= 0 && 1 < hi) { cg::this_grid().sync(); }
    if (IN(1)) { norm_phase(F, args.in[0], args.in[5], mod + D, mod, H); }
    SEAM(1);
#pragma unroll 1
    for (int L = 0; L < DEPTH; ++L) {
        const int pb = PH_L0 + L * PH_PER_LAYER, j = L >> 1;
        const float* m = mod + (size_t)L * 6 * D;
        const float* xin = (L == 0) ? args.in[0] : xout;
        if (pb + PH_PER_LAYER <= lo || pb >= hi) continue;
        if ((L & 1) == 0) {
            if (IN(pb + 0)) {
                pg8::Gemm g{H, (const bf16_t*)(ws + WS_WGIN) + (size_t)j * 3072 * D, S, 3072, D}; pg8::StaticOrder So; So.init(S, 3072, F.G, (int)blockIdx.x);
                pg8::EpiBf16<0> E{QKV, 3072};
                pg8::gemm_phase<pg8::EpiBf16<0>, pg8::StaticOrder, true, true>(F.lds, g, So, E);
                glr_phase(F, H, (const bf16_t*)(ws + WS_WGLR) + (size_t)j * 16 * D, (float*)(ws + WS_GLR));
            }
            SEAM(pb + 0);
        } else {
            if (IN(pb + 0)) {
                pg8::Gemm g{H, (const bf16_t*)(ws + WS_WMIN) + (size_t)j * 3072 * D, S, 3072, D}; pg8::StaticOrder So; So.init(S, 3072, F.G, (int)blockIdx.x);
                pg8::EpiBf16<0> E{QKV, 3072};
                pg8::gemm_phase<pg8::EpiBf16<0>, pg8::StaticOrder, true, true>(F.lds, g, So, E);
            }
            SEAM(pb + 0);
        }
        if ((L & 1) == 0) {
            const float* wupg = args.in[8] + (size_t)j * 16 * 512; const float* bgg = args.in[9] + (size_t)j * 512;
            if (IN(pb + 1)) gla_g1(F, QKV, (const float*)(ws + WS_GLR), wupg, bgg, (float*)(ws + WS_SBUF), (float*)(ws + WS_DG));
            SEAM(pb + 1);
            if (IN(pb + 2)) gla_g2(F, (float*)(ws + WS_SBUF), (const float*)(ws + WS_DG));
            SEAM(pb + 2);
            if (IN(pb + 3)) gla_g3(F, QKV, (const float*)(ws + WS_GLR), wupg, bgg, (const float*)(ws + WS_SBUF), args.in[10] + (size_t)j * 256, MIX);
            if (lo <= pb + 3 && pb + 5 < hi) xcd_barrier(bar);
        } else {
            unsigned* gcnt = ctl + CW_MCNT + j * 512;
            if (IN(pb + 1)) moba_m1(F, QKV, (const float*)(ws + WS_COS), (const float*)(ws + WS_SIN), args.in[13] + (size_t)j * 128, args.in[14] + (size_t)j * 128, (float*)(ws + WS_KMEAN));
            SEAM(pb + 1);
            if (IN(pb + 2)) moba_m2(F, QKV, (const float*)(ws + WS_KMEAN), gcnt, (int*)(ws + WS_LIST));
            SEAM(pb + 2);
            if (IN(pb + 3)) moba_m3(F, QKV, gcnt, (const int*)(ws + WS_LIST), (bf16_t*)(ws + WS_AUX), MIX, (float*)(ws + WS_LPART));
            SEAM(pb + 3);
            if (IN(pb + 4)) moba_m4(F, (const bf16_t*)(ws + WS_AUX), (const float*)(ws + WS_LPART), MIX);
            SEAM(pb + 4);
        }
        if (IN(pb + 5)) {
            const bf16_t* wo = ((L & 1) == 0) ? (const bf16_t*)(ws + WS_WGOUT) + (size_t)j * D * D : (const bf16_t*)(ws + WS_WMOUT) + (size_t)j * D * D;
            pg8::Gemm g{MIX, wo, S, D, D}; pg8::StaticOrder So; So.init(S, D, F.G, (int)blockIdx.x);
            pg8::EpiResid E{xin, xout, D, m + 2 * D};
            pg8::gemm_phase<pg8::EpiResid, pg8::StaticOrder, false, true>(F.lds, g, So, E);
        }
        SEAM(pb + 5);
        if (IN(pb + 6)) { norm_phase(F, xout, args.in[6] + (size_t)L * D, m + 4 * D, m + 3 * D, H); }
        SEAM(pb + 6);
        if (IN(pb + 7)) {
            pg8::Gemm g{H, (const bf16_t*)(ws + WS_W1) + (size_t)L * DFF * D, S, DFF, D}; pg8::StaticOrder So; So.init(S, DFF, F.G, (int)blockIdx.x);
            pg8::EpiBf16<1> E{HID, DFF};
            pg8::gemm_phase<pg8::EpiBf16<1>, pg8::StaticOrder, true, true>(F.lds, g, So, E);
        }
        SEAM(pb + 7);
        if (IN(pb + 8)) {
            pg8::Gemm g{HID, (const bf16_t*)(ws + WS_W2) + (size_t)L * D * DFF, S, D, DFF}; pg8::StaticOrder So; So.init(S, D, F.G, (int)blockIdx.x);
            pg8::EpiResid E{xout, xout, D, m + 5 * D};
            pg8::gemm_phase<pg8::EpiResid, pg8::StaticOrder, false, true>(F.lds, g, So, E);
        }
        SEAM(pb + 8);
        if (IN(pb + 9) && L + 1 < DEPTH) { const float* mn = mod + (size_t)(L + 1) * 6 * D; norm_phase(F, xout, args.in[5] + (size_t)(L + 1) * D, mn + D, mn, H); }
        if (L + 1 < DEPTH) SEAM(pb + 9);
    }
#undef IN
#undef SEAM
}
static int g_grid = 0;
static void launch_mega(MegaArgs a, int lo, int hi, hipStream_t stream) {
    a.ph_lo = lo; a.ph_hi = hi;
    (void)hipMemsetAsync((char*)a.ws + WS_CTL + CW_BAR * 4, 0, XCD_BAR_WORDS * 4, stream);
    void* params[] = {&a};
    hipError_t e = hipLaunchCooperativeKernel((const void*)mega, dim3(g_grid), dim3(NTHR), params, LDS_BYTES, stream);
    if (e != hipSuccess) fprintf(stderr, "cooperative launch failed: %s (grid %d)\n", hipGetErrorString(e), g_grid);
}
extern "C" void kernel_launch(void* const* d_in, const int* in_sizes, int n_in, void* d_out, int out_size, void* d_ws, size_t ws_size, hipStream_t stream) {
    if (g_grid == 0) {
        int dev = 0, cus = 0, per_cu = 0;
        (void)hipGetDevice(&dev);
        (void)hipDeviceGetAttribute(&cus, hipDeviceAttributeMultiprocessorCount, dev);
        (void)hipFuncSetAttribute((const void*)mega, hipFuncAttributeMaxDynamicSharedMemorySize, LDS_BYTES);
        (void)hipOccupancyMaxActiveBlocksPerMultiprocessor(&per_cu, (const void*)mega, NTHR, LDS_BYTES);
        if (per_cu < 1) { fprintf(stderr, "occupancy query says %d blocks/CU\n", per_cu); per_cu = 1; }
        g_grid = cus;
        if (ws_size < WS_END || n_in != 18) { fprintf(stderr, "bad ws_size %zu / n_in %d\n", ws_size, n_in); g_grid = -1; }
    }
    if (g_grid < 0) return;
    (void)hipMemsetAsync((char*)d_ws + WS_CTL, 0, CTL_ZERO_BYTES, stream);
    MegaArgs a{};
    for (int i = 0; i < 18; ++i) a.in[i] = (const float*)d_in[i];
    a.out = (float*)d_out; a.ws = (unsigned char*)d_ws;
    launch_mega(a, 0, N_PHASES, stream);
}
```

```cpp
#include <hip/hip_runtime.h>
#include <hip/hip_cooperative_groups.h>
#include <cstdio>
#include <cstdint>
#include <cmath>
namespace cg = cooperative_groups;
constexpr int D = 1024, S = 16384, DEPTH = 4, DFF = 4096;
constexpr int GLA_IN = 3088, MB_IN = 3072;
constexpr float EPS = 1e-6f;
#ifndef PROBE
#define PROBE 0
#endif
#ifndef TCAT
#define TCAT 0
#endif
#ifndef TBLK
#define TBLK 0
#endif
#define LAS __attribute__((address_space(3)))
#define GAS __attribute__((address_space(1)))
typedef unsigned short bf16_t;
typedef short bf16x8 __attribute__((ext_vector_type(8)));
typedef short s16x4 __attribute__((ext_vector_type(4)));
typedef float f32x4 __attribute__((ext_vector_type(4)));
typedef float f32x16 __attribute__((ext_vector_type(16)));
typedef float f32x2 __attribute__((ext_vector_type(2)));
typedef unsigned u32x4 __attribute__((ext_vector_type(4)));
typedef unsigned u32x2 __attribute__((ext_vector_type(2)));
typedef __bf16 bf16x2_t __attribute__((ext_vector_type(2)));

__device__ __forceinline__ unsigned cvtpk(float lo, float hi) { f32x2 v = {lo, hi}; bf16x2_t b = __builtin_convertvector(v, bf16x2_t); return __builtin_bit_cast(unsigned, b); }
__device__ __forceinline__ float bf2f(unsigned short b) { return __uint_as_float((unsigned)b << 16); }
__device__ __forceinline__ float bflo(unsigned w) { return __uint_as_float(w << 16); }
__device__ __forceinline__ float bfhi(unsigned w) { return __uint_as_float(w & 0xffff0000u); }

#ifndef WT_STORES
#define WT_STORES 0
#endif
__device__ __forceinline__ void st16_wt(void* p, u32x4 v) {
#if WT_STORES
    asm volatile("global_store_dwordx4 %0, %1, off sc1\n\ts_nop 1" :: "v"(p), "v"(v) : "memory");
#else
    *(u32x4*)p = v;
#endif
}
__device__ __forceinline__ void st16_wt(void* p, f32x4 v) { st16_wt(p, __builtin_bit_cast(u32x4, v)); }
namespace pg8 {
constexpr int BM = 256, BK = 64, HALF = 128, HTB = HALF * BK * 2, STAGE_BYTES = 8 * HTB, NXCD = 8, WGM = 8;
__host__ __device__ __forceinline__ int lds_byte(int r, int c) { const int st = (r >> 4) * 2 + (c >> 5), rr = r & 15, cc = c & 31, ob = rr * 64 + cc * 2; return st * 1024 + (ob ^ (((ob >> 9) & 1) << 5)); }
__host__ __device__ __forceinline__ void stage_rc(int b, int& R, int& C) { const int st = b / 1024, sb = b % 1024, swz = sb ^ (((sb >> 9) & 1) << 5); R = (st >> 1) * 16 + swz / 64; C = (st & 1) * 32 + (swz % 64) / 2; }
__host__ __device__ __forceinline__ int perm32(int rho) { const int n = rho >> 4, i = rho & 15; return 8 * (i >> 2) + 4 * n + (i & 3); }
struct Unit { int pm, pn; };
struct Gemm { const bf16_t* A; const bf16_t* Bt; int M, N, K; };
struct StaticOrder {
    int nM, nN, nwg, G, c;
    __host__ __device__ void init(int M, int N, int G_, int c_) { nM = M / BM; nN = N / BM; nwg = nM * nN; G = G_; c = c_; }
    __host__ __device__ bool next(int i, Unit& u) const {
        const long L = (long)i * G + c; if (L >= nwg) return false;
        int wgid = (int)L; { const int q = nwg / NXCD, r = nwg % NXCD, xcd = wgid % NXCD, off = wgid / NXCD; wgid = (xcd < r ? xcd * (q + 1) : r * (q + 1) + (xcd - r) * q) + off; }
        const int nig = WGM * nN, gid = wgid / nig, fm = gid * WGM, gsz = (nM - fm) < WGM ? (nM - fm) : WGM;
        u.pm = fm + ((wgid % nig) % gsz); u.pn = (wgid % nig) / gsz; return true;
    }
    __device__ __forceinline__ void a_ready(const Unit&) const {}
    __device__ __forceinline__ void done(const Unit&) const {}
};
struct MaskOrder : StaticOrder {
    __device__ bool next(int i, Unit& u) const { const bool ok = StaticOrder::next(i, u); u.pm &= 7; u.pn &= 3; return ok; }
};
template <int ACT  > struct EpiBf16 {
    static constexpr bool PERM = true, AFTER_DRAIN = false;
    bf16_t* O; int ldc;
    __device__ __forceinline__ void operator()(const f32x4 (&acc)[2][2][4][2], const Unit& u, int wr, int wc, int fr, int fq) const {
        const int row0 = u.pm * BM + wr * 64 + fr; const int col0 = u.pn * BM + wc * 32 + 8 * fq;
#pragma unroll
        for (int ai = 0; ai < 2; ++ai)
#pragma unroll
            for (int m = 0; m < 4; ++m) { bf16_t* rowp = O + (size_t)(row0 + ai * HALF + m * 16) * ldc + col0;
#pragma unroll
                for (int bj = 0; bj < 2; ++bj) { f32x4 v0 = acc[ai][bj][m][0], v1 = acc[ai][bj][m][1];
                    if (ACT == 1) {
#pragma unroll
                        for (int e = 0; e < 4; ++e) { float a = fmaxf(v0[e], 0.f); v0[e] = a * a; float b = fmaxf(v1[e], 0.f); v1[e] = b * b; } }
                    u32x4 w; w.x = cvtpk(v0[0], v0[1]); w.y = cvtpk(v0[2], v0[3]); w.z = cvtpk(v1[0], v1[1]); w.w = cvtpk(v1[2], v1[3]);
                    st16_wt(rowp + bj * HALF, w); } }
    }
};
struct EpiResid {
    static constexpr bool PERM = false, AFTER_DRAIN = false;
    const float* base; float* out; int ldc; const float* gate;
    __device__ __forceinline__ void operator()(const f32x4 (&acc)[2][2][4][2], const Unit& u, int wr, int wc, int fr, int fq) const {
        const int row0 = u.pm * BM + wr * 64 + fr, col0 = u.pn * BM + wc * 32 + 4 * fq;
        f32x4 gv[2][2];
#pragma unroll
        for (int bj = 0; bj < 2; ++bj)
#pragma unroll
            for (int n = 0; n < 2; ++n) gv[bj][n] = *(const f32x4*)(gate + col0 + bj * HALF + n * 16);
#pragma unroll
        for (int ai = 0; ai < 2; ++ai)
#pragma unroll
            for (int m = 0; m < 4; ++m) { const size_t off = (size_t)(row0 + ai * HALF + m * 16) * ldc + col0;
#pragma unroll
                for (int bj = 0; bj < 2; ++bj)
#pragma unroll
                    for (int n = 0; n < 2; ++n) { const f32x4 b = *(const f32x4*)(base + off + bj * HALF + n * 16);
                        st16_wt(out + off + bj * HALF + n * 16, b + gv[bj][n] * acc[ai][bj][m][n]); } }
    }
};

struct EpiResidNorm {
    static constexpr bool PERM = false, AFTER_DRAIN = true;
    const float* base; float* out; int ldc; const float* gate;
    const float* ng; const float* sc; const float* sh; bf16_t* H;
    float* xbuf; unsigned* cnt; unsigned* tmo; float eps;
    __device__ __forceinline__ void operator()(const f32x4 (&)[2][2][4][2], const Unit&, int, int, int, int) const {}
    __device__ __forceinline__ void fused(f32x4 (&acc)[2][2][4][2], const Unit& u, int wr, int wc, int fr, int fq, LAS unsigned char* lds, int wid, int lane) const {
        LAS float* P = (LAS float*)lds;
        LAS float* Sr = (LAS float*)(lds + 4096);
        LAS unsigned* flag = (LAS unsigned*)(lds + 4096 + 1024);
        const int row0 = u.pm * BM + wr * 64 + fr, col0 = u.pn * BM + wc * 32 + 4 * fq;
        {
            f32x4 gv[2][2];
#pragma unroll
            for (int bj = 0; bj < 2; ++bj)
#pragma unroll
                for (int n = 0; n < 2; ++n) gv[bj][n] = *(const f32x4*)(gate + col0 + bj * HALF + n * 16);
#pragma unroll
            for (int ai = 0; ai < 2; ++ai)
#pragma unroll
                for (int m = 0; m < 4; ++m) { const size_t off = (size_t)(row0 + ai * HALF + m * 16) * ldc + col0;
                    float s = 0.f;
#pragma unroll
                    for (int bj = 0; bj < 2; ++bj)
#pragma unroll
                        for (int n = 0; n < 2; ++n) { const f32x4 b = *(const f32x4*)(base + off + bj * HALF + n * 16);
                            const f32x4 x = b + gv[bj][n] * acc[ai][bj][m][n]; acc[ai][bj][m][n] = x;
                            st16_wt(out + off + bj * HALF + n * 16, x); s += (x[0] * x[0] + x[1] * x[1]) + (x[2] * x[2] + x[3] * x[3]); }
                    s += __shfl_xor(s, 16); s += __shfl_xor(s, 32);
                    if (fq == 0) P[(ai * HALF + wr * 64 + m * 16 + fr) * 4 + wc] = s;
                    if (m & 1) asm volatile("" ::: "memory"); }
        }
        asm volatile("s_waitcnt lgkmcnt(0)" ::: "memory"); __builtin_amdgcn_s_barrier(); asm volatile("" ::: "memory");
        const int row = wid * 32 + (lane & 31);
        if (lane < 32) {
            const float tot = (P[row * 4 + 0] + P[row * 4 + 1]) + (P[row * 4 + 2] + P[row * 4 + 3]);
            __hip_atomic_store((unsigned*)xbuf + ((size_t)(u.pm * BM + row) * 4 + u.pn), __float_as_uint(tot), __ATOMIC_RELAXED, __HIP_MEMORY_SCOPE_AGENT);
        }
        asm volatile("s_waitcnt vmcnt(0)" ::: "memory");
        if (lane == 0) __hip_atomic_fetch_add(cnt + 64 * u.pm, 1u, __ATOMIC_RELAXED, __HIP_MEMORY_SCOPE_AGENT);
        if (wid == 0) {
            unsigned sp = 0; bool dead = false;
            for (;;) {
                if ((unsigned)__builtin_amdgcn_readfirstlane(__hip_atomic_load(cnt + 64 * u.pm, __ATOMIC_RELAXED, __HIP_MEMORY_SCOPE_AGENT)) >= 32u) break;
                __builtin_amdgcn_s_sleep(2);
                if (++sp > (1u << 20)) { if (lane == 0) __hip_atomic_store(tmo, 1u, __ATOMIC_RELAXED, __HIP_MEMORY_SCOPE_AGENT); dead = true; break; }
            }
            __builtin_amdgcn_fence(__ATOMIC_ACQUIRE, "agent");
            if (lane == 0) flag[0] = dead ? 1u : 0u;
        }
        asm volatile("s_waitcnt vmcnt(0) lgkmcnt(0)" ::: "memory"); __builtin_amdgcn_s_barrier(); asm volatile("" ::: "memory");
        if (lane < 32) {
            const unsigned* slot = (const unsigned*)xbuf + (size_t)(u.pm * BM + row) * 4; float t = 0.f;
#pragma unroll
            for (int k = 0; k < 4; ++k) t += __uint_as_float(__hip_atomic_load(slot + k, __ATOMIC_RELAXED, __HIP_MEMORY_SCOPE_AGENT));
            Sr[row] = 1.0f / sqrtf(t * (1.0f / 1024.0f) + eps);
        }
        asm volatile("s_waitcnt lgkmcnt(0)" ::: "memory"); __builtin_amdgcn_s_barrier(); asm volatile("" ::: "memory");
        float rs[2][4];
#pragma unroll
        for (int ai = 0; ai < 2; ++ai)
#pragma unroll
            for (int m = 0; m < 4; ++m) rs[ai][m] = Sr[ai * HALF + wr * 64 + m * 16 + fr];
#pragma unroll
        for (int bj = 0; bj < 2; ++bj)
#pragma unroll
            for (int n = 0; n < 2; ++n) { const int c = col0 + bj * HALF + n * 16;
                const f32x4 ga = *(const f32x4*)(ng + c) * (*(const f32x4*)(sc + c) + 1.0f), gb = *(const f32x4*)(sh + c);
#pragma unroll
                for (int ai = 0; ai < 2; ++ai)
#pragma unroll
                    for (int m = 0; m < 4; ++m) { const int r = ai * HALF + wr * 64 + m * 16 + fr; const size_t off = (size_t)(u.pm * BM + r) * ldc + c;
                        const f32x4 y = acc[ai][bj][m][n] * rs[ai][m] * ga + gb; u32x2 w; w.x = cvtpk(y[0], y[1]); w.y = cvtpk(y[2], y[3]);
                        *(u32x2*)(H + off) = w; } }
    }
};

template <class Epi, class Sched, bool ALIGN_EPI = false, bool SP2 = false>
__device__ __forceinline__ void gemm_phase(LAS unsigned char* lds, const Gemm g, const Sched& S, const Epi& E) {
    int tid_ = threadIdx.x; asm volatile("" : "+v"(tid_));
    const int tid = tid_, wid = __builtin_amdgcn_readfirstlane(tid >> 6), lane = tid & 63, wr = wid >> 2, wc = wid & 3, fr = lane & 15, fq = lane >> 4;
    const int K = g.K, nt = K / BK;
    unsigned voffA[2], voffB[2];
#pragma unroll
    for (int i = 0; i < 2; ++i) { int R, C; stage_rc(tid * 16 + i * 8192, R, C); const int Rb = Epi::PERM ? ((R & ~31) + perm32(R & 31)) : R;
        voffA[i] = (unsigned)(R * K + C) * 2u; voffB[i] = (unsigned)(Rb * K + C) * 2u; }
    const size_t kstep = (size_t)(BK * 2);
    const size_t hstep = (size_t)HALF * K * 2;
    const size_t tstep = 2 * hstep;
    const unsigned ldsw = (unsigned)wid * 1024u;
    const int aoff = lds_byte(wr * 64 + fr, fq * 8), boff = lds_byte(wc * 32 + fr, fq * 8);
#define PG8_SA(b, h) (((b) * 2 + (h)) * HTB)
#define PG8_SB(b, h) ((4 + (b) * 2 + (h)) * HTB)
#define PG8_STAGE(bufoff, gbase, voff) do { _Pragma("unroll") for (int _i = 0; _i < 2; ++_i) \
        __builtin_amdgcn_global_load_lds((const unsigned*)((const char*)(gbase) + (voff)[_i]), (LAS unsigned*)(lds + (bufoff) + ldsw + _i * 8192), 16, 0, 0); } while (0)
#define PG8_LDA(dst, b, h) do { _Pragma("unroll") for (int m = 0; m < 4; ++m) _Pragma("unroll") for (int k = 0; k < 2; ++k) dst[m][k] = *(const LAS bf16x8*)(lds + PG8_SA(b, h) + aoff + m * 2048 + k * 1024); } while (0)
#define PG8_LDB(dst, b, h) do { _Pragma("unroll") for (int n = 0; n < 2; ++n) _Pragma("unroll") for (int k = 0; k < 2; ++k) dst[n][k] = *(const LAS bf16x8*)(lds + PG8_SB(b, h) + boff + n * 2048 + k * 1024); } while (0)
#define PG8_MMA(ai, bj, At, Bt) do { __builtin_amdgcn_s_setprio(1); _Pragma("unroll") for (int m = 0; m < 4; ++m) _Pragma("unroll") for (int n = 0; n < 2; ++n) _Pragma("unroll") for (int k = 0; k < 2; ++k) \
        acc[ai][bj][m][n] = __builtin_amdgcn_mfma_f32_16x16x32_bf16(Bt[n][k], At[m][k], acc[ai][bj][m][n], 0, 0, 0); __builtin_amdgcn_s_setprio(0); } while (0)
#define PG8_WAIT_V(n) asm volatile("s_waitcnt vmcnt(" #n ")" ::: "memory")
#define PG8_WAIT_L(n) asm volatile("s_waitcnt lgkmcnt(" #n ")" ::: "memory")
#define PG8_BAR __builtin_amdgcn_s_barrier()
#define PG8_SCHED __builtin_amdgcn_sched_barrier(0)
    Unit cur, nxt; int ui = 0;
    if (!S.next(0, cur)) return;
    f32x4 acc[2][2][4][2];
#pragma unroll
    for (int a = 0; a < 2; ++a)
#pragma unroll
        for (int b = 0; b < 2; ++b)
#pragma unroll
            for (int m = 0; m < 4; ++m)
#pragma unroll
                for (int n = 0; n < 2; ++n) acc[a][b][m][n] = (f32x4){0.f, 0.f, 0.f, 0.f};
    bf16x8 At[4][2], B0[2][2], B1[2][2];
    const char* cA = (const char*)g.A + (size_t)cur.pm * tstep; const char* cB = (const char*)g.Bt + (size_t)cur.pn * tstep;
    S.a_ready(cur);
    if constexpr (SP2) {
        PG8_STAGE(PG8_SB(0, 0), cB, voffB); PG8_STAGE(PG8_SB(0, 1), cB + hstep, voffB); PG8_STAGE(PG8_SA(0, 0), cA, voffA); PG8_STAGE(PG8_SA(0, 1), cA + hstep, voffA);
        if (wr == 1) PG8_BAR;
        PG8_WAIT_V(2); PG8_BAR;
        PG8_STAGE(PG8_SB(1, 0), cB + kstep, voffB); PG8_STAGE(PG8_SA(1, 0), cA + kstep, voffA); PG8_STAGE(PG8_SB(1, 1), cB + hstep + kstep, voffB);
        PG8_WAIT_V(6); PG8_BAR;
    } else {
        PG8_STAGE(PG8_SB(0, 0), cB, voffB); PG8_STAGE(PG8_SA(0, 0), cA, voffA); PG8_STAGE(PG8_SB(0, 1), cB + hstep, voffB); PG8_STAGE(PG8_SA(0, 1), cA + hstep, voffA);
        if (wr == 1) PG8_BAR;
        PG8_WAIT_V(4); PG8_BAR;
        PG8_STAGE(PG8_SB(1, 0), cB + kstep, voffB); PG8_STAGE(PG8_SA(1, 0), cA + kstep, voffA); PG8_STAGE(PG8_SB(1, 1), cB + hstep + kstep, voffB);
        PG8_WAIT_V(6); PG8_BAR;
    }
    for (;;) {
        const bool has_next = S.next(ui + 1, nxt);
        const char* nA = has_next ? (const char*)g.A + (size_t)nxt.pm * tstep : cA; const char* nB = has_next ? (const char*)g.Bt + (size_t)nxt.pn * tstep : cB;
        for (int t = 0; t < nt; t += 2) {
            const bool last = (t == nt - 2);
            const char* a1 = cA + (size_t)(t + 1) * kstep;
            const char* a2 = last ? nA : cA + (size_t)(t + 2) * kstep; const char* b2 = last ? nB : cB + (size_t)(t + 2) * kstep;
            const char* a3 = a2 + kstep; const char* b3 = b2 + kstep;
            if (last && has_next) S.a_ready(nxt);
            if constexpr (SP2) {
            PG8_LDB(B0, 0, 0); PG8_LDB(B1, 0, 1); PG8_SCHED; PG8_LDA(At, 0, 0); PG8_STAGE(PG8_SA(1, 1), a1 + hstep, voffA);
            PG8_WAIT_V(8); PG8_WAIT_L(0); PG8_BAR; PG8_MMA(0, 0, At, B0); PG8_MMA(0, 1, At, B1); PG8_BAR; PG8_SCHED;
            PG8_LDA(At, 0, 1); PG8_STAGE(PG8_SB(0, 0), b2, voffB); PG8_STAGE(PG8_SB(0, 1), b2 + hstep, voffB); PG8_STAGE(PG8_SA(0, 0), a2, voffA);
            PG8_WAIT_V(8); PG8_WAIT_L(0); PG8_BAR; PG8_MMA(1, 0, At, B0); PG8_MMA(1, 1, At, B1); PG8_BAR; PG8_SCHED;
            PG8_LDB(B0, 1, 0); PG8_LDB(B1, 1, 1); PG8_SCHED; PG8_LDA(At, 1, 0); PG8_STAGE(PG8_SA(0, 1), a2 + hstep, voffA);
            PG8_WAIT_V(8); PG8_WAIT_L(0); PG8_BAR; PG8_MMA(0, 0, At, B0); PG8_MMA(0, 1, At, B1); PG8_BAR; PG8_SCHED;
            PG8_LDA(At, 1, 1); PG8_STAGE(PG8_SB(1, 0), b3, voffB); PG8_STAGE(PG8_SB(1, 1), b3 + hstep, voffB); PG8_STAGE(PG8_SA(1, 0), a3, voffA);
            PG8_WAIT_V(8); PG8_WAIT_L(0); PG8_BAR; PG8_MMA(1, 0, At, B0); PG8_MMA(1, 1, At, B1); PG8_BAR; PG8_SCHED;
            } else {
            PG8_LDB(B0, 0, 0); PG8_SCHED; PG8_LDA(At, 0, 0); PG8_STAGE(PG8_SA(1, 1), a1 + hstep, voffA);
            PG8_WAIT_L(8); PG8_BAR; PG8_WAIT_L(0); PG8_MMA(0, 0, At, B0); PG8_BAR; PG8_SCHED;
            PG8_LDB(B1, 0, 1); PG8_STAGE(PG8_SB(0, 0), b2, voffB);
            PG8_BAR; PG8_WAIT_L(0); PG8_MMA(0, 1, At, B1); PG8_BAR;
            PG8_LDA(At, 0, 1); PG8_STAGE(PG8_SA(0, 0), a2, voffA);
            PG8_BAR; PG8_WAIT_L(0); PG8_MMA(1, 0, At, B0); PG8_BAR; PG8_SCHED;
            PG8_STAGE(PG8_SB(0, 1), b2 + hstep, voffB);
            PG8_WAIT_V(6); PG8_BAR; PG8_MMA(1, 1, At, B1); PG8_BAR;
            PG8_LDB(B0, 1, 0); PG8_SCHED; PG8_LDA(At, 1, 0); PG8_STAGE(PG8_SA(0, 1), a2 + hstep, voffA);
            PG8_WAIT_L(8); PG8_BAR; PG8_WAIT_L(0); PG8_MMA(0, 0, At, B0); PG8_BAR; PG8_SCHED;
            PG8_LDB(B1, 1, 1); PG8_STAGE(PG8_SB(1, 0), b3, voffB);
            PG8_BAR; PG8_WAIT_L(0); PG8_MMA(0, 1, At, B1); PG8_BAR;
            PG8_LDA(At, 1, 1); PG8_STAGE(PG8_SA(1, 0), a3, voffA);
            PG8_BAR; PG8_WAIT_L(0); PG8_MMA(1, 0, At, B0); PG8_BAR; PG8_SCHED;
            PG8_STAGE(PG8_SB(1, 1), b3 + hstep, voffB);
            PG8_WAIT_V(6); PG8_BAR; PG8_MMA(1, 1, At, B1); PG8_BAR;
            }
        }
        if constexpr (ALIGN_EPI) { if (wr == 0) PG8_BAR; }
        if constexpr (!Epi::AFTER_DRAIN) { E(acc, cur, wr, wc, fr, fq); S.done(cur); }
        if (!has_next) break;
#pragma unroll
        for (int a = 0; a < 2; ++a)
#pragma unroll
            for (int b = 0; b < 2; ++b)
#pragma unroll
                for (int m = 0; m < 4; ++m)
#pragma unroll
                    for (int n = 0; n < 2; ++n) acc[a][b][m][n] = (f32x4){0.f, 0.f, 0.f, 0.f};
        cur = nxt; cA = nA; cB = nB; ++ui;
        if constexpr (ALIGN_EPI) { if (wr == 1) PG8_BAR; }
    }
    PG8_WAIT_V(0);
    if constexpr (!ALIGN_EPI) { if (wr == 0) PG8_BAR; }
    PG8_BAR;
    if constexpr (Epi::AFTER_DRAIN) { E.fused(acc, cur, wr, wc, fr, fq, lds, wid, lane); }
#undef PG8_SA
#undef PG8_SB
#undef PG8_STAGE
#undef PG8_LDA
#undef PG8_LDB
#undef PG8_MMA
#undef PG8_WAIT_V
#undef PG8_WAIT_L
#undef PG8_BAR
#undef PG8_SCHED
}
}

#define XB_TMO      128
#define XB_XCNT(j)  (256  + 64 * (j))
#define XB_XSUB(j)  (1280 + 64 * (j))
#define XB_XGEN(j)  (2304 + 64 * (j))
#define XB_TOP      3328
#define XB_TOPGEN   3392
#define XCD_BAR_WORDS 3456
#define XB_SPIN_CAP (1u << 18)
__device__ __forceinline__ unsigned xb_ld(unsigned* p)              { return __hip_atomic_load(p, __ATOMIC_RELAXED, __HIP_MEMORY_SCOPE_AGENT); }
__device__ __forceinline__ unsigned xb_add(unsigned* p, unsigned v) { return __hip_atomic_fetch_add(p, v, __ATOMIC_RELAXED, __HIP_MEMORY_SCOPE_AGENT); }
__device__ __forceinline__ unsigned xb_xcc_id() { return (unsigned)__builtin_amdgcn_s_getreg((3 << 11) | 20) & 0xFu; }
#define XB_SPIN(cond, bar) do { unsigned _sp = 0; while (cond) { __builtin_amdgcn_s_sleep(1); \
    if ((++_sp & 255u) == 0u) { if (xb_ld(&(bar)[XB_TMO])) break; if (_sp > XB_SPIN_CAP) { atomicAdd(&(bar)[XB_TMO], 1u); break; } } } } while (0)
struct XcdBarrier { unsigned* bar; unsigned x; volatile LAS unsigned* st; };
__device__ __forceinline__ XcdBarrier xcd_barrier_post(unsigned* bar, volatile LAS unsigned* st) {
    XcdBarrier b; b.bar = bar; b.x = xb_xcc_id(); b.st = st;
    if (threadIdx.x == 0) (void)xb_add(&bar[XB_XCNT(b.x)], 1u);
    return b;
}
__device__ __forceinline__ void xcd_barrier_complete(unsigned* bar, unsigned x, unsigned& nloc, unsigned& nx) {
    const unsigned G = gridDim.x * gridDim.y * gridDim.z;
    unsigned sum, cnt, mine, sp = 0u;
    for (;;) {
        sum = 0u; cnt = 0u; mine = 0u;
#pragma unroll
        for (unsigned j = 0; j < 16; ++j) { const unsigned c = xb_ld(&bar[XB_XCNT(j)]); sum += c; cnt += (c > 0u) ? 1u : 0u; }
        mine = xb_ld(&bar[XB_XCNT(x)]);
        if (sum == G) break;
        __builtin_amdgcn_s_sleep(1);
        if ((++sp & 255u) == 0u) { if (xb_ld(&bar[XB_TMO])) break; if (sp > XB_SPIN_CAP) { atomicAdd(&bar[XB_TMO], 1u); break; } }
    }
    nloc = mine > 0u ? mine : 1u; nx = cnt > 0u ? cnt : 1u;
}
__device__ __forceinline__ void xcd_barrier(const XcdBarrier& b) {
    asm volatile("s_waitcnt vmcnt(0)" ::: "memory");
    __syncthreads();
    if (threadIdx.x == 0) {
        unsigned* bar = b.bar; asm volatile("" : "+s"(bar));
        __builtin_amdgcn_s_waitcnt(0);
        unsigned nloc = b.st[0], nx = b.st[1];
        if (nloc == 0u) { xcd_barrier_complete(bar, b.x, nloc, nx); b.st[0] = nloc; b.st[1] = nx; }
        const unsigned old = xb_add(&bar[XB_XSUB(b.x)], 1u);
        const unsigned gen = old / nloc;
        if (old + 1u == (gen + 1u) * nloc) {
            __builtin_amdgcn_fence(__ATOMIC_RELEASE, "agent");
            asm volatile("s_waitcnt vmcnt(0)" ::: "memory");
            const unsigned og = xb_add(&bar[XB_TOP], 1u);
            const unsigned tg = og / nx;
            if (og + 1u == (tg + 1u) * nx) xb_add(&bar[XB_TOPGEN], 1u);
            else XB_SPIN(xb_ld(&bar[XB_TOPGEN]) == tg, bar);
            __builtin_amdgcn_fence(__ATOMIC_ACQUIRE, "agent");
            xb_add(&bar[XB_XGEN(b.x)], 1u);
            asm volatile("s_waitcnt vmcnt(0)" ::: "memory");
        } else {
            XB_SPIN(xb_ld(&bar[XB_XGEN(b.x)]) == gen, bar);
            __builtin_amdgcn_fence(__ATOMIC_ACQUIRE, "agent");
            asm volatile("s_waitcnt vmcnt(0)" ::: "memory");
        }
    }
    __syncthreads();
}
constexpr int NWAVES = 8, NTHR = 512;
constexpr int LDS_BYTES = 147456;
constexpr int RING_BYTES = 131072;
constexpr int MISC_OFF = LDS_BYTES - 256;
constexpr size_t MiB = 1u << 20;
constexpr size_t WS_CTL = 0, CTL_ZERO_BYTES = 1 * MiB;
constexpr size_t WS_MOD = 1 * MiB;
constexpr size_t WS_COS = 2 * MiB, WS_SIN = 6 * MiB;
constexpr size_t WS_WGIN = 10 * MiB;
constexpr size_t WS_WGLR = 22 * MiB;
constexpr size_t WS_WGOUT = 23 * MiB;
constexpr size_t WS_WMIN = 27 * MiB;
constexpr size_t WS_WMOUT = 39 * MiB;
constexpr size_t WS_W1 = 43 * MiB;
constexpr size_t WS_W2 = 75 * MiB;
constexpr size_t WS_H = 107 * MiB;
constexpr size_t WS_MIX = 139 * MiB;
constexpr size_t WS_QKV = 171 * MiB;
constexpr size_t WS_AUX = 267 * MiB;
constexpr size_t WS_HID = 171 * MiB;
constexpr size_t WS_END = 363 * MiB;
constexpr size_t WS_SBUF = WS_AUX;
constexpr size_t WS_GLR = WS_AUX + 80 * MiB;
constexpr size_t WS_DG = WS_AUX + 81 * MiB;
constexpr size_t WS_KMEAN = WS_H;
constexpr size_t WS_LPART = WS_H + 1 * MiB;
constexpr size_t WS_LIST = WS_H + 4 * MiB;
constexpr int CW_BAR = 4096;
constexpr int CW_MCNT = 16384;
constexpr int CW_TMO = 0;
constexpr int CW_SEAM = 32768, SEAM_BANK = 64 * 64;
constexpr size_t WS_XBUF = WS_MOD + 512 * 1024;
struct Frame {
    LAS unsigned char* lds;
    int tid, lane, wave, vcu, G;
};
__device__ __forceinline__ Frame opaque(const Frame& F0) { Frame F = F0; int t = F0.tid; asm volatile("" : "+v"(t)); F.tid = t; F.lane = t & 63; F.wave = __builtin_amdgcn_readfirstlane(t >> 6); return F; }
__device__ __forceinline__ float wave_sum(float v) {
#pragma unroll
    for (int o = 1; o < 64; o <<= 1) v += __shfl_xor(v, o);
    return v;
}
__device__ __forceinline__ float silu_f(float x) { return x / (1.f + __expf(-x)); }
__device__ __forceinline__ void sincos_acc(double ang, float& s, float& c) {
    const double n = rint(ang * 0.15915494309189535);
    double r = fma(-n, 6.283185307179586, ang); r = fma(-n, 2.4492935982947064e-16, r);
    const double x = r * 0.25, x2 = x * x;
    const double sn = x * (1.0 + x2 * (-1.0 / 6 + x2 * (1.0 / 120 + x2 * (-1.0 / 5040 + x2 * (1.0 / 362880 + x2 * (-1.0 / 39916800 + x2 * (1.0 / 6227020800.0)))))));
    const double cs = 1.0 + x2 * (-0.5 + x2 * (1.0 / 24 + x2 * (-1.0 / 720 + x2 * (1.0 / 40320 + x2 * (-1.0 / 3628800 + x2 * (1.0 / 479001600 + x2 * (-1.0 / 87178291200.0)))))));
    const double s2 = 2 * sn * cs, c2 = 1 - 2 * sn * sn;
    s = (float)(2 * s2 * c2); c = (float)(1 - 2 * s2 * s2);
}
constexpr int TR_SCR = 64 * 65 * 4;
struct TrItem { const float* W; int ld, n_off, n_cnt, K; bf16_t* WT; int item; };
__device__ __forceinline__ void tr_load(const TrItem& t, int lane, f32x4 (&v)[16]) {
    const int nblk = (t.n_cnt + 63) >> 6, kb = t.item / nblk, nb = t.item - kb * nblk, k0 = 64 * kb, n0 = 64 * nb;
    const int c4 = (lane & 15) * 4, kr = lane >> 4;
    const bool ok = (n0 + c4) < t.n_cnt;
#pragma unroll
    for (int i = 0; i < 16; ++i) v[i] = ok ? *(const f32x4*)(t.W + (size_t)(k0 + 4 * i + kr) * t.ld + t.n_off + n0 + c4) : (f32x4){0.f, 0.f, 0.f, 0.f};
}
__device__ __forceinline__ void tr_store(const TrItem& t, int lane, const f32x4 (&v)[16], LAS float* scr) {
    const int nblk = (t.n_cnt + 63) >> 6, kb = t.item / nblk, nb = t.item - kb * nblk, k0 = 64 * kb, n0 = 64 * nb;
    const int c4 = (lane & 15) * 4, kr = lane >> 4;
#pragma unroll
    for (int i = 0; i < 16; ++i) { LAS float* s = scr + (4 * i + kr) * 65 + c4; s[0] = v[i].x; s[1] = v[i].y; s[2] = v[i].z; s[3] = v[i].w; }
    asm volatile("s_waitcnt lgkmcnt(0)" ::: "memory");
    const int c = lane & 7;
#pragma unroll
    for (int j = 0; j < 8; ++j) { const int n = (lane >> 3) + 8 * j; const LAS float* s = scr + (8 * c) * 65 + n;
        u32x4 o; o.x = cvtpk(s[0 * 65], s[1 * 65]); o.y = cvtpk(s[2 * 65], s[3 * 65]); o.z = cvtpk(s[4 * 65], s[5 * 65]); o.w = cvtpk(s[6 * 65], s[7 * 65]);
        if (n0 + n < t.n_cnt) *(u32x4*)(t.WT + (size_t)(n0 + n) * t.K + k0 + 8 * c) = o; }
    asm volatile("s_waitcnt lgkmcnt(0)" ::: "memory");
}
struct MegaArgs {
    const float* in[18]; float* out; unsigned char* ws; int ph_lo, ph_hi;
};
__device__ __forceinline__ void p0_prologue(const Frame& F0, const MegaArgs& a) {
    const Frame F = opaque(F0);
    unsigned char* ws = a.ws;
    {
        LAS float* scr = (LAS float*)(F.lds + F.wave * TR_SCR);
        const int gw = F.vcu * NWAVES + F.wave, NGW = F.G * NWAVES;
        constexpr int I_GIN = 16 * 48, I_GLR = 16, I_SQ = 16 * 16, I_W1 = 16 * 64, I_W2 = 64 * 16;
        constexpr int NITEMS = 2 * I_GIN + 2 * I_GLR + 2 * I_SQ + 2 * I_GIN + 2 * I_SQ + 4 * I_W1 + 4 * I_W2;
        auto decode = [&](int it) -> TrItem {
            int r = it;
            if (r < 2 * I_GIN) { const int j = r / I_GIN; return TrItem{a.in[7] + (size_t)j * D * GLA_IN, GLA_IN, 0, 3072, D, (bf16_t*)(ws + WS_WGIN) + (size_t)j * 3072 * D, r % I_GIN}; } r -= 2 * I_GIN;
            if (r < 2 * I_GLR) { const int j = r / I_GLR; return TrItem{a.in[7] + (size_t)j * D * GLA_IN, GLA_IN, 3072, 16, D, (bf16_t*)(ws + WS_WGLR) + (size_t)j * 16 * D, r % I_GLR}; } r -= 2 * I_GLR;
            if (r < 2 * I_SQ) { const int j = r / I_SQ; return TrItem{a.in[11] + (size_t)j * D * D, D, 0, D, D, (bf16_t*)(ws + WS_WGOUT) + (size_t)j * D * D, r % I_SQ}; } r -= 2 * I_SQ;
            if (r < 2 * I_GIN) { const int j = r / I_GIN; return TrItem{a.in[12] + (size_t)j * D * MB_IN, MB_IN, 0, 3072, D, (bf16_t*)(ws + WS_WMIN) + (size_t)j * 3072 * D, r % I_GIN}; } r -= 2 * I_GIN;
            if (r < 2 * I_SQ) { const int j = r / I_SQ; return TrItem{a.in[15] + (size_t)j * D * D, D, 0, D, D, (bf16_t*)(ws + WS_WMOUT) + (size_t)j * D * D, r % I_SQ}; } r -= 2 * I_SQ;
            if (r < 4 * I_W1) { const int j = r / I_W1; return TrItem{a.in[16] + (size_t)j * D * DFF, DFF, 0, DFF, D, (bf16_t*)(ws + WS_W1) + (size_t)j * DFF * D, r % I_W1}; } r -= 4 * I_W1;
            { const int j = r / I_W2; return TrItem{a.in[17] + (size_t)j * DFF * D, D, 0, D, DFF, (bf16_t*)(ws + WS_W2) + (size_t)j * D * DFF, r % I_W2}; }
        };
        f32x4 va[16], vb[16];
        int it = gw;
        if (it < NITEMS) { TrItem cur = decode(it); tr_load(cur, F.lane, va);
            for (;;) {
                const int itn = it + NGW; TrItem nx = cur; const bool more = itn < NITEMS;
                if (more) { nx = decode(itn); tr_load(nx, F.lane, vb); }
                tr_store(cur, F.lane, va, scr);
                if (!more) break;
                const int itn2 = itn + NGW; const bool more2 = itn2 < NITEMS; TrItem nx2 = nx;
                if (more2) { nx2 = decode(itn2); tr_load(nx2, F.lane, va); }
                tr_store(nx, F.lane, vb, scr);
                if (!more2) break;
                cur = nx2; it = itn2;
            }
        }
    }
    __syncthreads();
    {
        const float* c = a.in[1]; const float* ada_w = a.in[3]; const float* ada_b = a.in[4]; float* mod = (float*)(ws + WS_MOD);
        LAS float* sc = (LAS float*)F.lds;
        LAS float* red = (LAS float*)F.lds + 1024;
        for (int k = F.tid; k < D; k += NTHR) sc[k] = silu_f(c[k]);
        __syncthreads();
        const int kg = F.tid >> 5, cl = F.tid & 31;
        for (int chunk = F.vcu; chunk < 256; chunk += F.G) {
            float part[3];
#pragma unroll
            for (int cc = 0; cc < 3; ++cc) {
                const int col = chunk * 96 + cc * 32 + cl, i = col / (6 * D), n = col - i * 6 * D;
                const float* w = ada_w + (size_t)i * D * 6 * D + (size_t)(kg * 64) * 6 * D + n;
                float wv[64];
#pragma unroll
                for (int k = 0; k < 64; ++k) wv[k] = w[(size_t)k * 6 * D];
                float acc = 0.f;
#pragma unroll
                for (int k = 0; k < 64; ++k) acc += sc[kg * 64 + k] * wv[k];
                part[cc] = acc;
            }
#pragma unroll
            for (int cc = 0; cc < 3; ++cc) red[kg * 96 + cc * 32 + cl] = part[cc];
            __syncthreads();
            if (F.tid < 96) { float s = 0.f;
#pragma unroll
                for (int g = 0; g < 16; ++g) s += red[g * 96 + F.tid];
                mod[chunk * 96 + F.tid] = s + ada_b[chunk * 96 + F.tid]; }
            __syncthreads();
        }
    }
    {
        const int* pos = (const int*)a.in[2]; float* ct = (float*)(ws + WS_COS); float* st = (float*)(ws + WS_SIN);
        for (int idx = F.vcu * NTHR + F.tid; idx < S * 64; idx += F.G * NTHR) {
            const int t = idx >> 6, i = idx & 63;
            const float inv_freq = (float)exp2(-(double)i * (13.287712379549449 / 64.0));
            const float angf = (float)pos[t] * inv_freq;
            float sn, cs; sincos_acc((double)angf, sn, cs);
            ct[idx] = cs; st[idx] = sn;
        }
    }
}
__device__ __forceinline__ void norm_phase(const Frame& F0, const float* __restrict__ x, const float* __restrict__ g, const float* __restrict__ sc, const float* __restrict__ sh, bf16_t* __restrict__ h) {
    const Frame F = opaque(F0);
    f32x4 ga[4], gb[4];
#pragma unroll
    for (int j = 0; j < 4; ++j) { const f32x4 gg = ((const f32x4*)g)[F.lane + 64 * j], s1 = ((const f32x4*)sc)[F.lane + 64 * j]; ga[j] = gg * (s1 + 1.0f); gb[j] = ((const f32x4*)sh)[F.lane + 64 * j]; }
    const int gw = F.vcu * NWAVES + F.wave, NGW = F.G * NWAVES;
    for (int m = gw; m < S; m += NGW) {
        const f32x4* xr = (const f32x4*)(x + (size_t)m * D) + F.lane;
        f32x4 v[4]; float ss = 0.f;
#pragma unroll
        for (int j = 0; j < 4; ++j) { v[j] = xr[64 * j]; ss += (v[j].x * v[j].x + v[j].y * v[j].y) + (v[j].z * v[j].z + v[j].w * v[j].w); }
        const float r = 1.0f / sqrtf(wave_sum(ss) * (1.f / D) + EPS);
        u32x2* o8 = (u32x2*)(h + (size_t)m * D) + F.lane;
#pragma unroll
        for (int j = 0; j < 4; ++j) { const f32x4 y = v[j] * r * ga[j] + gb[j]; u32x2 w; w.x = cvtpk(y.x, y.y); w.y = cvtpk(y.z, y.w); o8[64 * j] = w; }
    }
}
__device__ __forceinline__ void glr_phase(const Frame& F0, const bf16_t* __restrict__ H, const bf16_t* __restrict__ WglrT, float* __restrict__ glr) {
    const Frame F = opaque(F0);
    if (F.wave >= 4) return;
    const int l15 = F.lane & 15, q = F.lane >> 4;
    for (int rb = F.vcu; rb < S / 64; rb += F.G) {
        const int row0 = rb * 64 + F.wave * 16;
        const bf16_t* ap = H + (size_t)(row0 + l15) * D + 8 * q;
        const bf16_t* bp = WglrT + (size_t)l15 * D + 8 * q;
        f32x4 acc = {0.f, 0.f, 0.f, 0.f};
#pragma unroll 8
        for (int ks = 0; ks < 32; ++ks) {
            const bf16x8 av = *(const bf16x8*)(ap + ks * 32), bv = *(const bf16x8*)(bp + ks * 32);
            acc = __builtin_amdgcn_mfma_f32_16x16x32_bf16(av, bv, acc, 0, 0, 0);
        }
#pragma unroll
        for (int r = 0; r < 4; ++r) glr[(size_t)(row0 + 4 * q + r) * 16 + l15] = acc[r];
    }
}
typedef short v4i16_t __attribute__((ext_vector_type(4)));
__device__ __forceinline__ s16x4 vtr(const LAS unsigned char* p) { return __builtin_bit_cast(s16x4, __builtin_amdgcn_ds_read_tr16_b64_v4i16((LAS v4i16_t*)p)); }
__device__ __forceinline__ int crow(int reg, int h) { return (reg & 3) + 8 * (reg >> 2) + 4 * h; }
__device__ __forceinline__ unsigned off_b(unsigned row, unsigned ch) { return 272u * row + 16u * ch; }
__device__ __forceinline__ unsigned tr_addr(unsigned lane, unsigned c, unsigned rowblk) {
    const unsigned blk = (lane >> 4) & 1, q = (lane & 15) >> 2, p = lane & 3;
    return off_b(rowblk + q, 4 * c + 2 * blk + (p >> 1)) + 8 * (p & 1);
}
constexpr int GL_IMG = 64 * 272, GL_PST = 144;
constexpr int GL_QD = 0, GL_KI = GL_IMG, GL_KT = 2 * GL_IMG, GL_V = 3 * GL_IMG, GL_P = 5 * GL_IMG, GL_GL = GL_P + 64 * GL_PST, GL_SEG = GL_GL + 4096, GL_DEC = GL_SEG + 2048, GL_RED = GL_DEC + 512;
static_assert(GL_RED + 2048 <= RING_BYTES, "gla lds");
#define MFMA32(a, b, c) __builtin_amdgcn_mfma_f32_32x32x16_bf16((a), (b), (c), 0, 0, 0)

struct GlaPre { f32x4 ga, gb; unsigned qk[16]; };
__device__ __forceinline__ void gla_prefetch_g(const Frame& F, const float* __restrict__ GLR, int t0, GlaPre& P) {
    const int ib = F.wave >> 2, l31 = F.lane & 31, h = F.lane >> 5;
    const float* gp = GLR + (size_t)(t0 + 32 * ib + l31) * 16 + 8 * h;
    P.ga = *(const f32x4*)gp; P.gb = *(const f32x4*)(gp + 4);
}
template <bool WITH_Q>
__device__ __forceinline__ void gla_prefetch(const Frame& F, const bf16_t* __restrict__ QKV, const float* __restrict__ GLR, int t0, int hd, GlaPre& P);
template <bool WITH_Q>
__device__ __forceinline__ void gla_prefetch_qk(const Frame& F, const bf16_t* __restrict__ QKV, int t0, int hd, GlaPre& P) {
    const int w = F.wave, ib = w >> 2, db = w & 3, l31 = F.lane & 31, h = F.lane >> 5;
#pragma unroll
    for (int r = 0; r < 16; ++r) {
        const bf16_t* row = QKV + (size_t)(t0 + 32 * ib + crow(r, h)) * 3072 + hd * 128 + 32 * db + l31;
        const unsigned kk = row[512]; const unsigned qq = WITH_Q ? (unsigned)row[0] : 0u;
        P.qk[r] = qq | (kk << 16);
    }
}
template <bool WITH_Q>
__device__ __forceinline__ void gla_prefetch(const Frame& F, const bf16_t* __restrict__ QKV, const float* __restrict__ GLR, int t0, int hd, GlaPre& P) {
    gla_prefetch_g(F, GLR, t0, P); gla_prefetch_qk<WITH_Q>(F, QKV, t0, hd, P);
}
struct GlaW { u32x4 bhi, blo; float bias; };
__device__ __forceinline__ void gla_load_w(const float* __restrict__ wupg, const float* __restrict__ bgg, int hd, const Frame& F, GlaW& W) {
    const int db = F.wave & 3, l31 = F.lane & 31, h = F.lane >> 5, d = hd * 128 + 32 * db + l31;
    float wv[8];
#pragma unroll
    for (int j = 0; j < 8; ++j) wv[j] = wupg[(8 * h + j) * 512 + d];
    W.bhi.x = cvtpk(wv[0], wv[1]); W.bhi.y = cvtpk(wv[2], wv[3]); W.bhi.z = cvtpk(wv[4], wv[5]); W.bhi.w = cvtpk(wv[6], wv[7]);
    W.blo.x = cvtpk(wv[0] - bflo(W.bhi.x), wv[1] - bfhi(W.bhi.x)); W.blo.y = cvtpk(wv[2] - bflo(W.bhi.y), wv[3] - bfhi(W.bhi.y));
    W.blo.z = cvtpk(wv[4] - bflo(W.bhi.z), wv[5] - bfhi(W.bhi.z)); W.blo.w = cvtpk(wv[6] - bflo(W.bhi.w), wv[7] - bfhi(W.bhi.w));
    W.bias = bgg[d];
}
template <bool WITH_Q>
__device__ __forceinline__ float gla_chunk_prep(const Frame& F, const GlaPre& P, const GlaW& W, const bf16_t* __restrict__ QKV, int t0, int hd) {
    LAS unsigned char* lds = F.lds;
    const int w = F.wave, ib = w >> 2, db = w & 3, l31 = F.lane & 31, h = F.lane >> 5, d = 32 * db + l31;
    u32x4 vv[4];
#pragma unroll
    for (int k = 0; k < 4; ++k) { const int c = F.tid + 512 * k, j = c >> 5, ch = c & 31; vv[k] = *(const u32x4*)(QKV + (size_t)(t0 + j) * 3072 + 1024 + hd * 256 + ch * 8); }
    u32x4 ahi, alo;
    ahi.x = cvtpk(P.ga.x, P.ga.y); ahi.y = cvtpk(P.ga.z, P.ga.w); ahi.z = cvtpk(P.gb.x, P.gb.y); ahi.w = cvtpk(P.gb.z, P.gb.w);
    alo.x = cvtpk(P.ga.x - bflo(ahi.x), P.ga.y - bfhi(ahi.x)); alo.y = cvtpk(P.ga.z - bflo(ahi.y), P.ga.w - bfhi(ahi.y));
    alo.z = cvtpk(P.gb.x - bflo(ahi.z), P.gb.y - bfhi(ahi.z)); alo.w = cvtpk(P.gb.z - bflo(ahi.w), P.gb.w - bfhi(ahi.w));
    f32x16 X;
#pragma unroll
    for (int r = 0; r < 16; ++r) X[r] = W.bias;
    X = MFMA32(__builtin_bit_cast(bf16x8, ahi), __builtin_bit_cast(bf16x8, W.bhi), X);
    X = MFMA32(__builtin_bit_cast(bf16x8, alo), __builtin_bit_cast(bf16x8, W.bhi), X);
    X = MFMA32(__builtin_bit_cast(bf16x8, ahi), __builtin_bit_cast(bf16x8, W.blo), X);
    float G[16], sk[4];
#pragma unroll
    for (int k = 0; k < 4; ++k) { float run = 0.f;
#pragma unroll
        for (int j = 0; j < 4; ++j) { const float x = X[4 * k + j]; const float ls = fminf(x, 0.f) - __logf(1.f + __expf(-fabsf(x))); run += ls * (1.f / 16.f); G[4 * k + j] = run; }
        sk[k] = run; }
    float base = 0.f, tot;
    {
        float ps[4];
#pragma unroll
        for (int k = 0; k < 4; ++k) ps[k] = __shfl_xor(sk[k], 32);
#pragma unroll
        for (int k = 0; k < 4; ++k) { const float bk = base + (h ? ps[k] : 0.f);
#pragma unroll
            for (int j = 0; j < 4; ++j) G[4 * k + j] += bk;
            base += sk[k] + ps[k]; }
        tot = base;
    }
    LAS float* HT = (LAS float*)(lds + GL_SEG);
    if (h == 0) HT[ib * 128 + d] = tot;
#pragma unroll
    for (int k = 0; k < 4; ++k) { const int c = F.tid + 512 * k, j = c >> 5, ch = c & 31; *(LAS u32x4*)(lds + GL_V + (ch >> 4) * GL_IMG + off_b(j, ch & 15)) = vv[k]; }
    __syncthreads();
    const float t0h = HT[d], t1h = HT[128 + d], glast = t0h + t1h;
    const float add = ib ? t0h : 0.f;
    const float qs = 0.08838834764831845f;
#pragma unroll
    for (int r = 0; r < 16; ++r) {
        const int i = 32 * ib + crow(r, h); const float Gv = G[r] + add;
        const unsigned a = off_b(i, d >> 3) + 2 * (d & 7);
        const float kf = bfhi(P.qk[r]);
        if (WITH_Q) {
            *(LAS unsigned short*)(lds + GL_QD + a) = (unsigned short)(cvtpk(bflo(P.qk[r]) * qs * __expf(Gv), 0.f) & 0xffffu);
            *(LAS unsigned short*)(lds + GL_KI + a) = (unsigned short)(cvtpk(kf * __expf(-Gv), 0.f) & 0xffffu);
        }
        *(LAS unsigned short*)(lds + GL_KT + a) = (unsigned short)(cvtpk(kf * __expf(glast - Gv), 0.f) & 0xffffu);
    }
    if (ib == 0 && h == 0) ((LAS float*)(lds + GL_DEC))[d] = __expf(glast);
    __syncthreads();
    return glast;
}
__device__ __forceinline__ void gla_state_update(const Frame& F, f32x16 (&St)[4]) {
    LAS unsigned char* lds = F.lds;
    const int h = F.lane >> 5, w = F.wave;
    const LAS float* dec = (const LAS float*)(lds + GL_DEC);
#pragma unroll
    for (int db = 0; db < 4; ++db)
#pragma unroll
        for (int r = 0; r < 16; ++r) St[db][r] *= dec[32 * db + crow(r, h)];
    const LAS unsigned char* vimg = lds + GL_V + (w >> 2) * GL_IMG;
#pragma unroll
    for (int ks = 0; ks < 4; ++ks) {
        const s16x4 vlo = vtr(vimg + tr_addr(F.lane, w & 3, 16 * ks + 8 * h)), vhi = vtr(vimg + tr_addr(F.lane, w & 3, 16 * ks + 8 * h + 4));
        const bf16x8 vb = __builtin_shufflevector(vlo, vhi, 0, 1, 2, 3, 4, 5, 6, 7);
#pragma unroll
        for (int db = 0; db < 4; ++db) {
            const s16x4 klo = vtr(lds + GL_KT + tr_addr(F.lane, db, 16 * ks + 8 * h)), khi = vtr(lds + GL_KT + tr_addr(F.lane, db, 16 * ks + 8 * h + 4));
            const bf16x8 ka = __builtin_shufflevector(klo, khi, 0, 1, 2, 3, 4, 5, 6, 7);
            St[db] = MFMA32(ka, vb, St[db]);
        }
    }
}
__device__ __forceinline__ void gla_g1(const Frame& F0, const bf16_t* __restrict__ QKV, const float* __restrict__ GLR, const float* __restrict__ wupg, const float* __restrict__ bgg, float* __restrict__ SBUF, float* __restrict__ DG) {
    const Frame F = opaque(F0);
    const int h = F.lane >> 5, w = F.wave;
    for (int u = F.vcu; u < 256; u += F.G) {
        const int gi = u >> 2, hd = u & 3;
        GlaW W; gla_load_w(wupg, bgg, hd, F, W);
        f32x16 St[4];
#pragma unroll
        for (int db = 0; db < 4; ++db)
#pragma unroll
            for (int r = 0; r < 16; ++r) St[db][r] = 0.f;
        float gsum = 0.f;
        GlaPre P; gla_prefetch<false>(F, QKV, GLR, gi * 256, hd, P);
#pragma unroll 1
        for (int c = 0; c < 4; ++c) {
            gsum += gla_chunk_prep<false>(F, P, W, QKV, gi * 256 + c * 64, hd);
            if (c < 3) gla_prefetch<false>(F, QKV, GLR, gi * 256 + (c + 1) * 64, hd, P);
            gla_state_update(F, St);
            __syncthreads();
        }
        float* sp = SBUF + ((size_t)u * 128) * 256 + 32 * w + (F.lane & 31);
#pragma unroll
        for (int db = 0; db < 4; ++db)
#pragma unroll
            for (int r = 0; r < 16; ++r) sp[(size_t)(32 * db + crow(r, h)) * 256] = St[db][r];
        if ((w >> 2) == 0 && h == 0) DG[u * 128 + 32 * (w & 3) + (F.lane & 31)] = __expf(gsum);
    }
}
__device__ __forceinline__ void gla_g2(const Frame& F0, float* __restrict__ SBUF, const float* __restrict__ DG) {
    const Frame F = opaque(F0);
    for (int e = F.vcu * NTHR + F.tid; e < 4 * 128 * 256; e += F.G * NTHR) {
        const int hd = e >> 15, d = (e >> 8) & 127;
        float run = 0.f;
#pragma unroll 1
        for (int g0 = 0; g0 < 64; g0 += 8) {
            float tmp[8], dec[8];
#pragma unroll
            for (int k = 0; k < 8; ++k) { const int g = g0 + k; tmp[k] = SBUF[(size_t)(g * 4 + hd) * 32768 + (e & 32767)]; dec[k] = DG[(g * 4 + hd) * 128 + d]; }
#pragma unroll
            for (int k = 0; k < 8; ++k) { const int g = g0 + k; SBUF[(size_t)(g * 4 + hd) * 32768 + (e & 32767)] = run; run = dec[k] * run + tmp[k]; }
        }
    }
}
__device__ __forceinline__ void gla_g3(const Frame& F0, const bf16_t* __restrict__ QKV, const float* __restrict__ GLR, const float* __restrict__ wupg, const float* __restrict__ bgg,
                                       const float* __restrict__ SBUF, const float* __restrict__ og, bf16_t* __restrict__ MIX) {
    const Frame F = opaque(F0);
    LAS unsigned char* lds = F.lds;
    const int h = F.lane >> 5, w = F.wave, l31 = F.lane & 31;
    for (int u = F.vcu; u < 256; u += F.G) {
        const int gi = u >> 2, hd = u & 3;
        GlaW W; gla_load_w(wupg, bgg, hd, F, W);
        f32x16 St[4];
        { const float* sp = SBUF + ((size_t)u * 128) * 256 + 32 * w + l31;
#pragma unroll
          for (int db = 0; db < 4; ++db)
#pragma unroll
              for (int r = 0; r < 16; ++r) St[db][r] = sp[(size_t)(32 * db + crow(r, h)) * 256]; }
#pragma unroll 1
        for (int c = 0; c < 4; ++c) {
            const int t0 = gi * 256 + c * 64;
            { GlaPre P; gla_prefetch<true>(F, QKV, GLR, t0, hd, P); (void)gla_chunk_prep<true>(F, P, W, QKV, t0, hd); }
            if (w < 3) {
                const int ib = (w >= 1), jb = (w == 2);
                f32x16 acc;
#pragma unroll
                for (int r = 0; r < 16; ++r) acc[r] = 0.f;
#pragma unroll
                for (int s = 0; s < 8; ++s) {
                    const bf16x8 a = *(const LAS bf16x8*)(lds + GL_QD + off_b(32 * ib + l31, 2 * s + h));
                    const bf16x8 b = *(const LAS bf16x8*)(lds + GL_KI + off_b(32 * jb + l31, 2 * s + h));
                    acc = MFMA32(a, b, acc);
                }
                const int jabs = 32 * jb + l31;
#pragma unroll
                for (int r = 0; r < 16; ++r) { const int iabs = 32 * ib + crow(r, h); const float pv = (jabs <= iabs) ? acc[r] : 0.f;
                    *(LAS unsigned short*)(lds + GL_P + iabs * GL_PST + 2 * jabs) = (unsigned short)(cvtpk(pv, 0.f) & 0xffffu); }
            }
            f32x16 oT[2];
#pragma unroll
            for (int ib = 0; ib < 2; ++ib)
#pragma unroll
                for (int r = 0; r < 16; ++r) oT[ib][r] = 0.f;
#pragma unroll
            for (int db = 0; db < 4; ++db)
#pragma unroll
                for (int s = 0; s < 2; ++s) {
                    u32x4 pk; pk.x = cvtpk(St[db][8 * s + 0], St[db][8 * s + 1]); pk.y = cvtpk(St[db][8 * s + 2], St[db][8 * s + 3]); pk.z = cvtpk(St[db][8 * s + 4], St[db][8 * s + 5]); pk.w = cvtpk(St[db][8 * s + 6], St[db][8 * s + 7]);
                    const bf16x8 xa = __builtin_bit_cast(bf16x8, pk);
#pragma unroll
                    for (int ib = 0; ib < 2; ++ib) {
                        const u32x2 qlo = *(const LAS u32x2*)(lds + GL_QD + off_b(32 * ib + l31, 4 * db + 2 * s + 0) + 8 * h);
                        const u32x2 qhi = *(const LAS u32x2*)(lds + GL_QD + off_b(32 * ib + l31, 4 * db + 2 * s + 1) + 8 * h);
                        u32x4 qq; qq.x = qlo.x; qq.y = qlo.y; qq.z = qhi.x; qq.w = qhi.y;
                        oT[ib] = MFMA32(xa, __builtin_bit_cast(bf16x8, qq), oT[ib]);
                    }
                }
            __syncthreads();
            {
                const LAS unsigned char* vimg = lds + GL_V + (w >> 2) * GL_IMG;
#pragma unroll
                for (int ks = 0; ks < 4; ++ks) {
                    const s16x4 vlo = vtr(vimg + tr_addr(F.lane, w & 3, 16 * ks + 8 * h)), vhi = vtr(vimg + tr_addr(F.lane, w & 3, 16 * ks + 8 * h + 4));
                    const bf16x8 va = __builtin_shufflevector(vlo, vhi, 0, 1, 2, 3, 4, 5, 6, 7);
#pragma unroll
                    for (int ib = 0; ib < 2; ++ib) {
                        if (ib == 0 && ks >= 2) continue;
                        const int irow = 32 * ib + l31;
                        const bf16x8 pb = *(const LAS bf16x8*)(lds + GL_P + irow * GL_PST + 16 * (2 * ks + h));
                        oT[ib] = MFMA32(va, pb, oT[ib]);
                    }
                }
            }
            float ssq[2];
#pragma unroll
            for (int ib = 0; ib < 2; ++ib) { float s = 0.f;
#pragma unroll
                for (int r = 0; r < 16; ++r) s += oT[ib][r] * oT[ib][r];
                s += __shfl_xor(s, 32); ssq[ib] = s; }
            if (h == 0) { ((LAS float*)(lds + GL_RED))[w * 64 + l31] = ssq[0]; ((LAS float*)(lds + GL_RED))[w * 64 + 32 + l31] = ssq[1]; }
            __syncthreads();
#pragma unroll
            for (int ib = 0; ib < 2; ++ib) {
                float tot = 0.f;
#pragma unroll
                for (int ww = 0; ww < 8; ++ww) tot += ((LAS float*)(lds + GL_RED))[ww * 64 + 32 * ib + l31];
                const float rn = 1.0f / sqrtf(tot * (1.f / 256.f) + EPS);
                const int t = t0 + 32 * ib + l31;
#pragma unroll
                for (int g = 0; g < 4; ++g) {
                    const int e0 = 32 * w + 8 * g + 4 * h;
                    const u32x2 rg = *(const u32x2*)(QKV + (size_t)t * 3072 + 2048 + hd * 256 + e0);
                    const f32x4 ogv = *(const f32x4*)(og + e0);
                    const float r0 = bflo(rg.x), r1 = bfhi(rg.x), r2 = bflo(rg.y), r3 = bfhi(rg.y);
                    const float y0 = oT[ib][4 * g + 0] * rn * ogv.x * (r0 / (1.f + __expf(-r0)));
                    const float y1 = oT[ib][4 * g + 1] * rn * ogv.y * (r1 / (1.f + __expf(-r1)));
                    const float y2 = oT[ib][4 * g + 2] * rn * ogv.z * (r2 / (1.f + __expf(-r2)));
                    const float y3 = oT[ib][4 * g + 3] * rn * ogv.w * (r3 / (1.f + __expf(-r3)));
                    u32x2 o; o.x = cvtpk(y0, y1); o.y = cvtpk(y2, y3);
                    *(u32x2*)(MIX + (size_t)t * D + hd * 256 + e0) = o;
                }
            }
            if (c < 3) gla_state_update(F, St);
            __syncthreads();
        }
    }
}
constexpr int MB_LIST_H = 516096;
__device__ __forceinline__ int mb_list_off(int n) { return 256 * (63 * n - (n * (n - 1)) / 2); }
constexpr int MB_OST = 2 * 128 * 256, MB_OSTW = 32 * 264;
constexpr int MB_PRE = MB_OST + 8 * MB_OSTW, MB_END = MB_PRE + 2064;
static_assert(MB_END <= MISC_OFF, "moba lds");

__device__ __forceinline__ void moba_m1(const Frame& F0, bf16_t* __restrict__ QKV, const float* __restrict__ COS, const float* __restrict__ SIN,
                                        const float* __restrict__ qg, const float* __restrict__ kg, float* __restrict__ KMEAN) {
    const Frame F = opaque(F0);
    LAS unsigned char* lds = F.lds;
    const int hh = F.lane >> 3, j = F.lane & 7;
    for (int u = F.vcu; u < 512; u += F.G) {
        const int which = (u >= 256), n = (u & 255) >> 2, part = u & 3;
        const int tbase = n * 256 + part * 64, cnt = 64;
        const float* g = which ? kg : qg;
        const float gsc = which ? 1.0f : (0.08838834764831845f * 1.4426950408889634f);
        float g1[8], g2[8], a1[8], a2[8];
#pragma unroll
        for (int e = 0; e < 8; ++e) { g1[e] = g[8 * j + e] * gsc; g2[e] = g[64 + 8 * j + e] * gsc; a1[e] = 0.f; a2[e] = 0.f; }
#pragma unroll 4
        for (int it = F.wave; it < cnt; it += NWAVES) {
            const int t = tbase + it;
            bf16_t* p = QKV + (size_t)t * 3072 + which * 1024 + hh * 128 + 8 * j;
            const u32x4 ra = *(const u32x4*)p, rb = *(const u32x4*)(p + 64);
            const f32x4 c0 = *(const f32x4*)(COS + (size_t)t * 64 + 8 * j), c1 = *(const f32x4*)(COS + (size_t)t * 64 + 8 * j + 4);
            const f32x4 s0 = *(const f32x4*)(SIN + (size_t)t * 64 + 8 * j), s1 = *(const f32x4*)(SIN + (size_t)t * 64 + 8 * j + 4);
            float x1[8] = {bflo(ra.x), bfhi(ra.x), bflo(ra.y), bfhi(ra.y), bflo(ra.z), bfhi(ra.z), bflo(ra.w), bfhi(ra.w)};
            float x2[8] = {bflo(rb.x), bfhi(rb.x), bflo(rb.y), bfhi(rb.y), bflo(rb.z), bfhi(rb.z), bflo(rb.w), bfhi(rb.w)};
            const float cs[8] = {c0.x, c0.y, c0.z, c0.w, c1.x, c1.y, c1.z, c1.w};
            const float sn[8] = {s0.x, s0.y, s0.z, s0.w, s1.x, s1.y, s1.z, s1.w};
            float ss = 0.f;
#pragma unroll
            for (int e = 0; e < 8; ++e) ss += x1[e] * x1[e] + x2[e] * x2[e];
            ss += __shfl_xor(ss, 1); ss += __shfl_xor(ss, 2); ss += __shfl_xor(ss, 4);
            const float r = 1.0f / sqrtf(ss * (1.f / 128.f) + EPS);
            float o1[8], o2[8];
#pragma unroll
            for (int e = 0; e < 8; ++e) { const float y1 = x1[e] * r * g1[e], y2 = x2[e] * r * g2[e]; o1[e] = y1 * cs[e] - y2 * sn[e]; o2[e] = y2 * cs[e] + y1 * sn[e]; a1[e] += o1[e]; a2[e] += o2[e]; }
            u32x4 wa, wb;
            wa.x = cvtpk(o1[0], o1[1]); wa.y = cvtpk(o1[2], o1[3]); wa.z = cvtpk(o1[4], o1[5]); wa.w = cvtpk(o1[6], o1[7]);
            wb.x = cvtpk(o2[0], o2[1]); wb.y = cvtpk(o2[2], o2[3]); wb.z = cvtpk(o2[4], o2[5]); wb.w = cvtpk(o2[6], o2[7]);
            *(u32x4*)p = wa; *(u32x4*)(p + 64) = wb;
        }
        if (which) {
            LAS float* red = (LAS float*)lds;
#pragma unroll
            for (int e = 0; e < 8; ++e) { red[(F.wave * 64 + F.lane) * 16 + e] = a1[e]; red[(F.wave * 64 + F.lane) * 16 + 8 + e] = a2[e]; }
            __syncthreads();
#pragma unroll
            for (int k = 0; k < 2; ++k) {
                const int o = F.tid * 2 + k, head = o >> 7, d = o & 127;
                const int ln = head * 8 + ((d & 63) >> 3), slot = (d >> 6) * 8 + (d & 7);
                float s = 0.f;
#pragma unroll
                for (int w = 0; w < 8; ++w) s += red[(w * 64 + ln) * 16 + slot];
                KMEAN[(((size_t)part * 8 + head) * 64 + n) * 128 + d] = s * (1.f / 256.f);
            }
            __syncthreads();
        }
    }
}
#define MB_INS(v, i) do { const float v_ = (v); const int i_ = (i); \
    const bool b0_ = v_ > v0 || (v_ == v0 && i_ < i0), b1_ = v_ > v1 || (v_ == v1 && i_ < i1), b2_ = v_ > v2 || (v_ == v2 && i_ < i2); \
    if (b0_) { v2 = v1; i2 = i1; v1 = v0; i1 = i0; v0 = v_; i0 = i_; } else if (b1_) { v2 = v1; i2 = i1; v1 = v_; i1 = i_; } else if (b2_) { v2 = v_; i2 = i_; } } while (0)
__device__ __forceinline__ void moba_m2(const Frame& F0, const bf16_t* __restrict__ QKV, const float* __restrict__ KMEAN, unsigned* __restrict__ gcnt, int* __restrict__ LIST) {
    const Frame F = opaque(F0);
    LAS unsigned char* lds = F.lds;
    LAS int* cntl = (LAS int*)lds;
    LAS float* kml = (LAS float*)(lds + 1024);
    const int h2 = F.lane >> 5, l31 = F.lane & 31, w = F.wave;
    for (int u = F.vcu; u < 512; u += F.G) {
        const int b = u >> 3, h = u & 7;
        if (b == 0) continue;
        if (F.tid < 64) cntl[F.tid] = 0;
#pragma unroll
        for (int k = 0; k < 4; ++k) { const int idx = F.tid + 512 * k, nr = idx >> 5, c4 = (idx & 31) * 4;
            if (nr < b) { const float* src = KMEAN + ((size_t)h * 64 + nr) * 128 + c4;
                const f32x4 v = (*(const f32x4*)src + *(const f32x4*)(src + 8 * 64 * 128)) + (*(const f32x4*)(src + 2 * 8 * 64 * 128) + *(const f32x4*)(src + 3 * 8 * 64 * 128));
                *(LAS f32x4*)(kml + nr * 132 + c4) = v; } }
        __syncthreads();
        const int t = b * 256 + 32 * w + l31;
        bf16x8 qf[8];
#pragma unroll
        for (int s = 0; s < 8; ++s) qf[s] = *(const bf16x8*)(QKV + (size_t)t * 3072 + h * 128 + 16 * s + 8 * h2);
        float v0 = -INFINITY, v1 = -INFINITY, v2 = -INFINITY; int i0 = 64, i1 = 64, i2 = 64;
#pragma unroll
        for (int nb = 0; nb < 2; ++nb) {
            if (nb == 1 && b <= 32) continue;
            f32x16 acc;
#pragma unroll
            for (int r = 0; r < 16; ++r) acc[r] = 0.f;
            const LAS float* kmp = kml + (32 * nb + l31) * 132 + 8 * h2;
#pragma unroll
            for (int s = 0; s < 8; ++s) {
                const f32x4 ka = *(const LAS f32x4*)(kmp + 16 * s), kb = *(const LAS f32x4*)(kmp + 16 * s + 4);
                u32x4 hi; hi.x = cvtpk(ka.x, ka.y); hi.y = cvtpk(ka.z, ka.w); hi.z = cvtpk(kb.x, kb.y); hi.w = cvtpk(kb.z, kb.w);
                u32x4 lo; lo.x = cvtpk(ka.x - bflo(hi.x), ka.y - bfhi(hi.x)); lo.y = cvtpk(ka.z - bflo(hi.y), ka.w - bfhi(hi.y));
                lo.z = cvtpk(kb.x - bflo(hi.z), kb.y - bfhi(hi.z)); lo.w = cvtpk(kb.z - bflo(hi.w), kb.w - bfhi(hi.w));
                acc = MFMA32(__builtin_bit_cast(bf16x8, hi), qf[s], acc);
                acc = MFMA32(__builtin_bit_cast(bf16x8, lo), qf[s], acc);
            }
#pragma unroll
            for (int r = 0; r < 16; ++r) { const int n = 32 * nb + crow(r, h2); const float gv = (n < b) ? acc[r] : -INFINITY; MB_INS(gv, n); }
        }
        { const float p0 = __shfl_xor(v0, 32), p1 = __shfl_xor(v1, 32), p2 = __shfl_xor(v2, 32); const int q0 = __shfl_xor(i0, 32), q1 = __shfl_xor(i1, 32), q2 = __shfl_xor(i2, 32);
          MB_INS(p0, q0); MB_INS(p1, q1); MB_INS(p2, q2); }
        int pos0 = 0, pos1 = 0, pos2 = 0;
        const bool e0 = (h2 == 0) && (v0 > -INFINITY), e1 = (h2 == 0) && (v1 > -INFINITY), e2 = (h2 == 0) && (v2 > -INFINITY);
        if (e0) pos0 = __hip_atomic_fetch_add(cntl + i0, 1, __ATOMIC_RELAXED, __HIP_MEMORY_SCOPE_WORKGROUP);
        if (e1) pos1 = __hip_atomic_fetch_add(cntl + i1, 1, __ATOMIC_RELAXED, __HIP_MEMORY_SCOPE_WORKGROUP);
        if (e2) pos2 = __hip_atomic_fetch_add(cntl + i2, 1, __ATOMIC_RELAXED, __HIP_MEMORY_SCOPE_WORKGROUP);
        __syncthreads();
        if (F.tid < 64) { const int c = cntl[F.tid]; int base = 0; if (c > 0) base = (int)__hip_atomic_fetch_add(gcnt + h * 64 + F.tid, (unsigned)c, __ATOMIC_RELAXED, __HIP_MEMORY_SCOPE_AGENT); cntl[64 + F.tid] = base; }
        __syncthreads();
        int* lst = LIST + (size_t)h * MB_LIST_H;
        if (e0) lst[mb_list_off(i0) + cntl[64 + i0] + pos0] = (t << 2) | 0;
        if (e1) lst[mb_list_off(i1) + cntl[64 + i1] + pos1] = (t << 2) | 1;
        if (e2) lst[mb_list_off(i2) + cntl[64 + i2] + pos2] = (t << 2) | 2;
        __syncthreads();
    }
}
constexpr int MB_HALF = 128 * 256;
__device__ __forceinline__ unsigned off_x(unsigned row, unsigned ch) { return 256u * row + 16u * (ch ^ (((row & 3) << 2) | ((row >> 2) & 3))); }
__device__ __forceinline__ void mb_decode(int v, const LAS int* pre, const unsigned* __restrict__ gcnt, int& h, int& n, int& count, int& lbase, bool& own) {
    if (v < 512) { n = v >> 3; h = v & 7; count = 256; lbase = 0; own = true; return; }
    const int x = v - 512; int lo_ = 0, hi_ = 511;
    while (lo_ < hi_) { const int mid = (lo_ + hi_) >> 1; if (pre[mid] > x) hi_ = mid; else lo_ = mid + 1; }
    const int hn = lo_; h = hn >> 6; n = hn & 63;
    const int tile = x - (hn ? pre[hn - 1] : 0);
    count = (int)gcnt[hn] - tile * 256; if (count > 256) count = 256;
    lbase = h * MB_LIST_H + mb_list_off(n) + tile * 256; own = false;
}
#define MB_STAGE(hh_, nn_, hf_, buf_) do { _Pragma("unroll") for (int k_ = 0; k_ < 4; ++k_) { const int pc_ = w * 4 + k_;               \
        const int r_ = 4 * pc_ + (F.lane >> 4); const int ch_ = (F.lane & 15) ^ (((r_ & 3) << 2) | ((r_ >> 2) & 3)); \
        const bf16_t* src_ = QKV + (size_t)((nn_) * 256 + (hf_) * 128 + r_) * 3072 + 1024 + (hh_) * 128 + 8 * ch_; \
        __builtin_amdgcn_global_load_lds((const unsigned*)src_, (LAS unsigned*)(lds + (buf_) * 2 * MB_HALF + pc_ * 1024), 16, 0, 0); \
        __builtin_amdgcn_global_load_lds((const unsigned*)(src_ + 1024), (LAS unsigned*)(lds + (buf_) * 2 * MB_HALF + MB_HALF + pc_ * 1024), 16, 0, 0); } } while (0)
#define MB_VMWAIT() asm volatile("s_waitcnt vmcnt(0)" ::: "memory")
#define MB_ENT(entv_, own_, nn_, cnt_, lb_) do { const int qi_ = 32 * w + l31; \
        if (own_) entv_ = (((nn_) * 256 + qi_) << 2) | 3; else entv_ = (qi_ < (cnt_)) ? LIST[(lb_) + qi_] : -1; } while (0)
#define MB_GATHER(entv_, qv_, nn_, hh_) do { \
        const int tq_ = (entv_ >= 0) ? (entv_ >> 2) : ((nn_) * 256); \
        _Pragma("unroll") for (int s_ = 0; s_ < 8; ++s_) qv_[s_] = *(const bf16x8*)(QKV + (size_t)tq_ * 3072 + (hh_) * 128 + 16 * s_ + 8 * h2); } while (0)
#define MB_COMPUTE(buf_, hf_, nkt_, own_) do { \
        const LAS unsigned char* kb_ = lds + (buf_) * 2 * MB_HALF + 256 * l31; \
        const LAS unsigned char* vb_ = lds + (buf_) * 2 * MB_HALF + MB_HALF + 256 * (4 * h2 + vq) + 8 * (vp & 1); \
        _Pragma("unroll 1") for (int kt_ = 0; kt_ < (nkt_); ++kt_) { \
            bf16x8 ka_[4]; \
            _Pragma("unroll") for (int s_ = 0; s_ < 4; ++s_) ka_[s_] = *(const LAS bf16x8*)(kb_ + kt_ * (32 * 256) + 16 * ((2 * s_ + h2) ^ fK)); \
            f32x16 acc_; _Pragma("unroll") for (int r_ = 0; r_ < 16; ++r_) acc_[r_] = 0.f; \
            _Pragma("unroll") for (int s_ = 0; s_ < 4; ++s_) acc_ = MFMA32(ka_[s_], qf[s_], acc_); \
            _Pragma("unroll") for (int s_ = 0; s_ < 4; ++s_) ka_[s_] = *(const LAS bf16x8*)(kb_ + kt_ * (32 * 256) + 16 * ((2 * (s_ + 4) + h2) ^ fK)); \
            _Pragma("unroll") for (int s_ = 0; s_ < 4; ++s_) acc_ = MFMA32(ka_[s_], qf[s_ + 4], acc_); \
            s16x4 vl0_[4], vh0_[4]; \
            _Pragma("unroll") for (int db_ = 0; db_ < 4; ++db_) { const LAS unsigned char* vp_ = vb_ + (kt_ * 32) * 256 + 64 * (db_ ^ vq); \
                vl0_[db_] = vtr(vp_ + 16 * (vj ^ h2)); vh0_[db_] = vtr(vp_ + 8 * 256 + 16 * (vj ^ (2 + h2))); } \
            float pr_[16]; \
            _Pragma("unroll") for (int r_ = 0; r_ < 16; ++r_) { float p_ = __builtin_amdgcn_exp2f(acc_[r_]); if ((own_) && (128 * (hf_) + 32 * kt_ + crow(r_, h2) > 32 * w + l31)) p_ = 0.f; pr_[r_] = p_; lsum += p_; } \
            { u32x4 pk_; pk_.x = cvtpk(pr_[0], pr_[1]); pk_.y = cvtpk(pr_[2], pr_[3]); pk_.z = cvtpk(pr_[4], pr_[5]); pk_.w = cvtpk(pr_[6], pr_[7]); \
              const bf16x8 pb_ = __builtin_bit_cast(bf16x8, pk_); \
              _Pragma("unroll") for (int db_ = 0; db_ < 4; ++db_) O[db_] = MFMA32(__builtin_shufflevector(vl0_[db_], vh0_[db_], 0, 1, 2, 3, 4, 5, 6, 7), pb_, O[db_]); } \
            _Pragma("unroll") for (int db_ = 0; db_ < 4; ++db_) { const LAS unsigned char* vp_ = vb_ + (kt_ * 32 + 16) * 256 + 64 * (db_ ^ vq); \
                vl0_[db_] = vtr(vp_ + 16 * (vj ^ h2)); vh0_[db_] = vtr(vp_ + 8 * 256 + 16 * (vj ^ (2 + h2))); } \
            { u32x4 pk_; pk_.x = cvtpk(pr_[8], pr_[9]); pk_.y = cvtpk(pr_[10], pr_[11]); pk_.z = cvtpk(pr_[12], pr_[13]); pk_.w = cvtpk(pr_[14], pr_[15]); \
              const bf16x8 pb_ = __builtin_bit_cast(bf16x8, pk_); \
              _Pragma("unroll") for (int db_ = 0; db_ < 4; ++db_) O[db_] = MFMA32(__builtin_shufflevector(vl0_[db_], vh0_[db_], 0, 1, 2, 3, 4, 5, 6, 7), pb_, O[db_]); } } } while (0)
__device__ __forceinline__ void moba_m3(const Frame& F0, const bf16_t* __restrict__ QKV, const unsigned* __restrict__ gcnt, const int* __restrict__ LIST,
                                        bf16_t* __restrict__ OPART, bf16_t* __restrict__ MIX, float* __restrict__ LPART) {
    const Frame F = opaque(F0);
    LAS unsigned char* lds = F.lds;
    LAS int* pre = (LAS int*)(lds + MB_PRE);
    const int h2 = F.lane >> 5, l31 = F.lane & 31, w = F.wave;
    const int fK = ((l31 & 3) << 2) | ((l31 >> 2) & 3);
    const int vq = (F.lane & 15) >> 2, vp = F.lane & 3, vj = 2 * ((F.lane >> 4) & 1) + (vp >> 1);
    { int v = ((int)gcnt[F.tid] + 255) >> 8; pre[F.tid] = v; __syncthreads();
#pragma unroll 1
      for (int o = 1; o < 512; o <<= 1) { const int add = (F.tid >= o) ? pre[F.tid - o] : 0; __syncthreads(); pre[F.tid] += add; __syncthreads(); } }
    const int total = 512 + pre[511];
    const int n_units = (total - F.vcu + F.G - 1) / F.G;
    if (n_units == 0) return;
#define MB_UNIT_V(it_) (F.vcu + (it_) * F.G)
    int h, n, count, lbase; bool own;
    mb_decode(MB_UNIT_V(0), pre, gcnt, h, n, count, lbase, own);
    int ent; bf16x8 qf[8];
    MB_ENT(ent, own, n, count, lbase);
    MB_GATHER(ent, qf, n, h);
    MB_STAGE(h, n, 0, 0);
    MB_VMWAIT();
    __syncthreads();
#pragma unroll 1
    for (int it = 0; it < n_units; ++it) {
        f32x16 O[4];
#pragma unroll
        for (int db = 0; db < 4; ++db)
#pragma unroll
            for (int r = 0; r < 16; ++r) O[db][r] = 0.f;
        float lsum = 0.f;
        MB_STAGE(h, n, 1, 1);
        { const int nkt = own ? ((w + 1 < 4) ? (w + 1) : 4) : 4; MB_COMPUTE(0, 0, nkt, own); }
        const bool more = (it + 1 < n_units);
        int h_n = h, n_n = n, count_n = count, lbase_n = lbase; bool own_n = own;
        int ent_n = -1;
        if (more) { mb_decode(MB_UNIT_V(it + 1), pre, gcnt, h_n, n_n, count_n, lbase_n, own_n); MB_ENT(ent_n, own_n, n_n, count_n, lbase_n); }
        MB_VMWAIT();
        __syncthreads();
        if (more) MB_STAGE(h_n, n_n, 0, 0);
        { const int nkt = own ? ((w >= 4) ? (w - 3) : 0) : 4; MB_COMPUTE(1, 1, nkt, own); }
        const int ent_c = ent, h_c = h;
        if (more) MB_GATHER(ent_n, qf, n_n, h_n);
        lsum += __shfl_xor(lsum, 32);
        if (ent_c >= 0 && h2 == 0) LPART[((size_t)(ent_c & 3) * S + (ent_c >> 2)) * 8 + h_c] = lsum;
        __syncthreads();
        {
            LAS unsigned char* ost = lds + MB_OST + w * MB_OSTW;
#pragma unroll
            for (int db = 0; db < 4; ++db)
#pragma unroll
                for (int g = 0; g < 4; ++g) { u32x2 o; o.x = cvtpk(O[db][4 * g + 0], O[db][4 * g + 1]); o.y = cvtpk(O[db][4 * g + 2], O[db][4 * g + 3]);
                    *(LAS u32x2*)(ost + l31 * 264 + 2 * (32 * db + 8 * g + 4 * h2)) = o; }
            asm volatile("s_waitcnt lgkmcnt(0)" ::: "memory");
#pragma unroll
            for (int i = 0; i < 8; ++i) {
                const int row = 4 * i + (F.lane >> 4), ch = F.lane & 15;
                const int er = __shfl(ent_c, row);
                const u32x4 v = *(const LAS u32x4*)(ost + row * 264 + 16 * ch);
                if (er >= 0) { const int sl = er & 3, tq = er >> 2;
                    bf16_t* dst = ((sl == 3) ? (MIX + (size_t)tq * D) : (OPART + ((size_t)sl * S + tq) * D)) + h_c * 128 + 8 * ch;
                    *(u32x4*)dst = v; }
            }
        }
        if (more) { h = h_n; n = n_n; count = count_n; lbase = lbase_n; own = own_n; ent = ent_n; }
        MB_VMWAIT();
        __syncthreads();
    }
#undef MB_UNIT_V
}
__device__ __forceinline__ void moba_m4(const Frame& F0, const bf16_t* __restrict__ OPART, const float* __restrict__ LPART, bf16_t* __restrict__ MIX) {
    const Frame F = opaque(F0);
    for (int it = F.vcu * NTHR + F.tid; it < S * 128; it += F.G * NTHR) {
        const int t = it >> 7, c8 = it & 127, h = c8 >> 4;
        const int nsel = (t >> 8) < 3 ? (t >> 8) : 3;
        const u32x4 m = *(const u32x4*)(MIX + (size_t)t * D + c8 * 8);
        float o[8] = {bflo(m.x), bfhi(m.x), bflo(m.y), bfhi(m.y), bflo(m.z), bfhi(m.z), bflo(m.w), bfhi(m.w)};
        float l = LPART[((size_t)3 * S + t) * 8 + h];
#pragma unroll
        for (int sl = 0; sl < 3; ++sl) {
            if (sl < nsel) {
                const u32x4 p = *(const u32x4*)(OPART + ((size_t)sl * S + t) * D + c8 * 8);
                o[0] += bflo(p.x); o[1] += bfhi(p.x); o[2] += bflo(p.y); o[3] += bfhi(p.y); o[4] += bflo(p.z); o[5] += bfhi(p.z); o[6] += bflo(p.w); o[7] += bfhi(p.w);
                l += LPART[((size_t)sl * S + t) * 8 + h];
            }
        }
        const float inv = 1.f / l;
        u32x4 r; r.x = cvtpk(o[0] * inv, o[1] * inv); r.y = cvtpk(o[2] * inv, o[3] * inv); r.z = cvtpk(o[4] * inv, o[5] * inv); r.w = cvtpk(o[6] * inv, o[7] * inv);
        *(u32x4*)(MIX + (size_t)t * D + c8 * 8) = r;
    }
}
__device__ __forceinline__ float wave_max(float v) {
#pragma unroll
    for (int o = 1; o < 64; o <<= 1) v = fmaxf(v, __shfl_xor(v, o));
    return v;
}
__device__ __forceinline__ float logsigmoid_f(float x) { return fminf(x, 0.f) - log1pf(expf(-fabsf(x))); }
__global__ void nk_gla_gate(const float* __restrict__ glr, const float* __restrict__ wup, const float* __restrict__ bg, float* __restrict__ g) {
    const size_t idx = (size_t)blockIdx.x * blockDim.x + threadIdx.x;
    const int t = (int)(idx >> 9), j = (int)(idx & 511);
    float acc = bg[j];
#pragma unroll
    for (int r = 0; r < 16; ++r) acc += glr[(size_t)t * 16 + r] * wup[r * 512 + j];
    g[idx] = logsigmoid_f(acc) * (1.f / 16.f);
}
__global__ __launch_bounds__(256) void nk_gla_recur(const bf16_t* __restrict__ qkv, const float* __restrict__ g, float* __restrict__ o) {
    __shared__ float sq[16][128], sk[16][128], sa[16][128];
    const int h = blockIdx.x, tid = threadIdx.x;
    float St[128];
#pragma unroll
    for (int d = 0; d < 128; ++d) St[d] = 0.f;
    const float qs = 0.08838834764831845f;
    for (int t0 = 0; t0 < S; t0 += 16) {
        float vv[16];
#pragma unroll
        for (int tt = 0; tt < 16; ++tt) vv[tt] = bf2f(qkv[(size_t)(t0 + tt) * 3072 + 1024 + h * 256 + tid]);
#pragma unroll
        for (int i = 0; i < 8; ++i) {
            const int e = tid + i * 256, tok = e >> 7, d = e & 127;
            const bf16_t* row = qkv + (size_t)(t0 + tok) * 3072;
            sq[tok][d] = bf2f(row[h * 128 + d]) * qs;
            sk[tok][d] = bf2f(row[512 + h * 128 + d]);
            sa[tok][d] = expf(g[(size_t)(t0 + tok) * 512 + h * 128 + d]);
        }
        __syncthreads();
#pragma unroll 1
        for (int tt = 0; tt < 16; ++tt) {
            const float v = vv[0];
#pragma unroll
            for (int i = 0; i < 15; ++i) vv[i] = vv[i + 1];
            float acc = 0.f;
#pragma unroll
            for (int d = 0; d < 128; ++d) { St[d] = sa[tt][d] * St[d] + sk[tt][d] * v; acc += sq[tt][d] * St[d]; }
            o[(size_t)(t0 + tt) * D + h * 256 + tid] = acc;
        }
        __syncthreads();
    }
}
__global__ __launch_bounds__(256) void nk_gla_post(const float* __restrict__ o, const bf16_t* __restrict__ qkv, const float* __restrict__ og, bf16_t* __restrict__ mix) {
    const int w = blockIdx.x * 4 + (threadIdx.x >> 6), lane = threadIdx.x & 63;
    const int t = w >> 2, h = w & 3;
    f32x4 v = *(const f32x4*)(o + (size_t)t * D + h * 256 + lane * 4);
    const float ss = wave_sum(v.x * v.x + v.y * v.y + v.z * v.z + v.w * v.w);
    const float r = 1.0f / sqrtf(ss * (1.f / 256.f) + EPS);
    const f32x4 gg = *(const f32x4*)(og + lane * 4);
    const bf16_t* rp = qkv + (size_t)t * 3072 + 2048 + h * 256 + lane * 4;
    bf16_t* mp = mix + (size_t)t * D + h * 256 + lane * 4;
#pragma unroll
    for (int e = 0; e < 4; ++e) { const float rr = bf2f(rp[e]); const float y = v[e] * r * gg[e] * (rr / (1.f + expf(-rr))); mp[e] = (bf16_t)(cvtpk(y, 0.f) & 0xffffu); }
}
__global__ __launch_bounds__(256) void nk_moba_qk(bf16_t* __restrict__ qkv, const int* __restrict__ pos, const float* __restrict__ qg, const float* __restrict__ kg) {
    const int w = blockIdx.x * 4 + (threadIdx.x >> 6), lane = threadIdx.x & 63;
    const int t = w >> 4, which = (w >> 3) & 1, h = w & 7;
    bf16_t* p = qkv + (size_t)t * 3072 + which * 1024 + h * 128;
    const float* g = which ? kg : qg;
    float t1 = bf2f(p[lane]), t2 = bf2f(p[lane + 64]);
    const float ss = wave_sum(t1 * t1 + t2 * t2);
    const float r = 1.0f / sqrtf(ss * (1.f / 128.f) + EPS);
    t1 = t1 * r * g[lane]; t2 = t2 * r * g[lane + 64];
    const float inv_freq = (float)exp2(-(double)lane * (13.287712379549449 / 64.0));
    const float angf = (float)pos[t] * inv_freq;
    float cs, sn; sincos_acc((double)angf, sn, cs);
    p[lane] = (bf16_t)(cvtpk(t1 * cs - t2 * sn, 0.f) & 0xffffu);
    p[lane + 64] = (bf16_t)(cvtpk(t2 * cs + t1 * sn, 0.f) & 0xffffu);
}
__global__ __launch_bounds__(128) void nk_moba_kmean(const bf16_t* __restrict__ qkv, float* __restrict__ kmean) {
    const int h = blockIdx.x >> 6, n = blockIdx.x & 63, d = threadIdx.x;
    float acc = 0.f;
    for (int j = 0; j < 256; ++j) acc += bf2f(qkv[(size_t)(n * 256 + j) * 3072 + 1024 + h * 128 + d]);
    kmean[(size_t)blockIdx.x * 128 + d] = acc * (1.f / 256.f);
}
__global__ __launch_bounds__(64) void nk_moba_attn(const bf16_t* __restrict__ qkv, const float* __restrict__ kmean, bf16_t* __restrict__ out) {
    __shared__ float sq[128];
    __shared__ float sp[1024];
    __shared__ int skey[1024];
    const int t = blockIdx.x >> 3, h = blockIdx.x & 7, lane = threadIdx.x;
    const bf16_t* qp = qkv + (size_t)t * 3072 + h * 128;
    sq[lane] = bf2f(qp[lane]); sq[lane + 64] = bf2f(qp[lane + 64]);
    __syncthreads();
    const int own = t >> 8;
    float gate = -INFINITY;
    if (lane < own) {
        const float* km = kmean + ((size_t)h * 64 + lane) * 128;
        float a = 0.f;
        for (int d = 0; d < 128; ++d) a += sq[d] * km[d];
        gate = a;
    }
    int s0 = -1, s1 = -1, s2 = -1;
#pragma unroll
    for (int j = 0; j < 3; ++j) {
        const float m = wave_max(gate);
        int idx = -1;
        if (m > -INFINITY) { const unsigned long long b = __ballot(gate == m); idx = __ffsll((long long)b) - 1; }
        if (j == 0) s0 = idx; else if (j == 1) s1 = idx; else s2 = idx;
        if (lane == idx) gate = -INFINITY;
    }
    int nk = 0;
    if (s0 >= 0) { for (int i = lane; i < 256; i += 64) skey[nk + i] = s0 * 256 + i; nk += 256; }
    if (s1 >= 0) { for (int i = lane; i < 256; i += 64) skey[nk + i] = s1 * 256 + i; nk += 256; }
    if (s2 >= 0) { for (int i = lane; i < 256; i += 64) skey[nk + i] = s2 * 256 + i; nk += 256; }
    const int nown = t - own * 256 + 1;
    for (int i = lane; i < nown; i += 64) skey[nk + i] = own * 256 + i;
    nk += nown;
    __syncthreads();
    const float scale = 0.08838834764831845f;
    float mx = -INFINITY;
    for (int i = lane; i < nk; i += 64) {
        const bf16_t* kp = qkv + (size_t)skey[i] * 3072 + 1024 + h * 128;
        float a = 0.f;
        for (int d = 0; d < 128; d += 8) { const u32x4 kk = *(const u32x4*)(kp + d);
            a += sq[d] * bflo(kk.x) + sq[d + 1] * bfhi(kk.x) + sq[d + 2] * bflo(kk.y) + sq[d + 3] * bfhi(kk.y) + sq[d + 4] * bflo(kk.z) + sq[d + 5] * bfhi(kk.z) + sq[d + 6] * bflo(kk.w) + sq[d + 7] * bfhi(kk.w); }
        a *= scale; sp[i] = a; mx = fmaxf(mx, a);
    }
    mx = wave_max(mx);
    float sum = 0.f;
    for (int i = lane; i < nk; i += 64) { const float p = expf(sp[i] - mx); sp[i] = p; sum += p; }
    sum = wave_sum(sum);
    __syncthreads();
    float o0 = 0.f, o1 = 0.f;
    for (int i = 0; i < nk; ++i) {
        const bf16_t* vp = qkv + (size_t)skey[i] * 3072 + 2048 + h * 128;
        const float p = sp[i];
        o0 += p * bf2f(vp[lane]); o1 += p * bf2f(vp[lane + 64]);
    }
    const float inv = 1.f / sum;
    out[(size_t)t * D + h * 128 + lane] = (bf16_t)(cvtpk(o0 * inv, 0.f) & 0xffffu);
    out[(size_t)t * D + h * 128 + lane + 64] = (bf16_t)(cvtpk(o1 * inv, 0.f) & 0xffffu);
}
constexpr int PH_PER_LAYER = 10, PH_L0 = 2, N_PHASES = PH_L0 + DEPTH * PH_PER_LAYER;
__global__ void __launch_bounds__(NTHR, 2) mega(MegaArgs args) {
    extern __shared__ __attribute__((aligned(16))) unsigned char lds_raw[];
    Frame F;
    F.lds = (LAS unsigned char*)lds_raw;
    F.tid = threadIdx.x; F.lane = F.tid & 63; F.wave = __builtin_amdgcn_readfirstlane(F.tid >> 6);
    F.G = gridDim.x; { const int bx = blockIdx.x; F.vcu = (F.G % 8 == 0) ? (bx % 8) * (F.G / 8) + bx / 8 : bx; }
    volatile LAS unsigned* MISC = (volatile LAS unsigned*)(F.lds + MISC_OFF);
    unsigned char* ws = args.ws;
    unsigned* ctl = (unsigned*)(ws + WS_CTL);
    for (int u = F.tid; u < (LDS_BYTES - MISC_OFF) / 4; u += NTHR) ((LAS unsigned*)(F.lds + MISC_OFF))[u] = 0u;
    __syncthreads();
    XcdBarrier bar = xcd_barrier_post(ctl + CW_BAR, MISC + 8);
    const int lo = args.ph_lo, hi = args.ph_hi;
#define IN(k) (lo <= (k) && (k) < hi)
#define SEAM(k) do { if (lo <= (k) && (k) + 1 < hi) xcd_barrier(bar); } while (0)
    const float* mod = (const float*)(ws + WS_MOD);
    bf16_t* H = (bf16_t*)(ws + WS_H); bf16_t* MIX = (bf16_t*)(ws + WS_MIX); bf16_t* QKV = (bf16_t*)(ws + WS_QKV); bf16_t* HID = (bf16_t*)(ws + WS_HID);
    float* xout = args.out;

    if (IN(0)) { p0_prologue(F, args); }
#if PROBE == 6
    xcd_barrier(bar); p0_prologue(F, args);
#endif
#if PROBE == 7
    for (int q_ = 0; q_ < 40; ++q_) xcd_barrier(bar);
#endif
    if (lo < 0) cg::this_grid().sync();
    if (lo <= 0 && 1 < hi) xcd_barrier(bar);
    if (IN(1)) { norm_phase(F, args.in[0], args.in[5], mod + D, mod, H); }
    SEAM(1);
#pragma unroll 1
    for (int L = 0; L < DEPTH; ++L) {
        const int pb = PH_L0 + L * PH_PER_LAYER, j = L >> 1;
        const float* m = mod + (size_t)L * 6 * D;
        const float* xin = (L == 0) ? args.in[0] : xout;
        if (pb + PH_PER_LAYER <= lo || pb >= hi) continue;
        if ((L & 1) == 0) {
            if (IN(pb + 0)) {
                pg8::Gemm g{H, (const bf16_t*)(ws + WS_WGIN) + (size_t)j * 3072 * D, S, 3072, D}; pg8::StaticOrder So; So.init(S, 3072, F.G, (int)blockIdx.x);
                pg8::EpiBf16<0> E{QKV, 3072};
                pg8::gemm_phase<pg8::EpiBf16<0>, pg8::StaticOrder, true, true>(F.lds, g, So, E);
#if PROBE == 1
                xcd_barrier(bar); pg8::gemm_phase<pg8::EpiBf16<0>, pg8::StaticOrder, true, true>(F.lds, g, So, E);
#endif
                glr_phase(F, H, (const bf16_t*)(ws + WS_WGLR) + (size_t)j * 16 * D, (float*)(ws + WS_GLR));
            }
            SEAM(pb + 0);
        } else {
            if (IN(pb + 0)) {
                pg8::Gemm g{H, (const bf16_t*)(ws + WS_WMIN) + (size_t)j * 3072 * D, S, 3072, D}; pg8::StaticOrder So; So.init(S, 3072, F.G, (int)blockIdx.x);
                pg8::EpiBf16<0> E{QKV, 3072};
                pg8::gemm_phase<pg8::EpiBf16<0>, pg8::StaticOrder, true, true>(F.lds, g, So, E);
#if PROBE == 1
                xcd_barrier(bar); pg8::gemm_phase<pg8::EpiBf16<0>, pg8::StaticOrder, true, true>(F.lds, g, So, E);
#endif
            }
            SEAM(pb + 0);
        }
        if ((L & 1) == 0) {
            unsigned char* ws = args.ws; asm volatile("" : "+s"(ws));
            const float* wupg = args.in[8] + (size_t)j * 16 * 512; const float* bgg = args.in[9] + (size_t)j * 512;
            if (IN(pb + 1)) gla_g1(F, QKV, (const float*)(ws + WS_GLR), wupg, bgg, (float*)(ws + WS_SBUF), (float*)(ws + WS_DG));
#if PROBE == 4
            xcd_barrier(bar); gla_g1(F, QKV, (const float*)(ws + WS_GLR), wupg, bgg, (float*)(ws + WS_SBUF), (float*)(ws + WS_DG));
#endif
            SEAM(pb + 1);
            if (IN(pb + 2)) gla_g2(F, (float*)(ws + WS_SBUF), (const float*)(ws + WS_DG));
            SEAM(pb + 2);
            if (IN(pb + 3)) gla_g3(F, QKV, (const float*)(ws + WS_GLR), wupg, bgg, (const float*)(ws + WS_SBUF), args.in[10] + (size_t)j * 256, MIX);
#if PROBE == 8
            xcd_barrier(bar); gla_g3(F, QKV, (const float*)(ws + WS_GLR), wupg, bgg, (const float*)(ws + WS_SBUF), args.in[10] + (size_t)j * 256, MIX);
#endif
            if (lo <= pb + 3 && pb + 5 < hi) xcd_barrier(bar);
        } else {
            unsigned char* ws = args.ws; asm volatile("" : "+s"(ws));
            unsigned* gcnt = (unsigned*)(ws + WS_CTL) + CW_MCNT + j * 512;
            if (IN(pb + 1)) moba_m1(F, QKV, (const float*)(ws + WS_COS), (const float*)(ws + WS_SIN), args.in[13] + (size_t)j * 128, args.in[14] + (size_t)j * 128, (float*)(ws + WS_KMEAN));
            SEAM(pb + 1);
            if (IN(pb + 2)) moba_m2(F, QKV, (const float*)(ws + WS_KMEAN), gcnt, (int*)(ws + WS_LIST));
            SEAM(pb + 2);
            if (IN(pb + 3)) moba_m3(F, QKV, gcnt, (const int*)(ws + WS_LIST), (bf16_t*)(ws + WS_AUX), MIX, (float*)(ws + WS_LPART));
#if PROBE == 5
            xcd_barrier(bar); moba_m3(F, QKV, gcnt, (const int*)(ws + WS_LIST), (bf16_t*)(ws + WS_AUX), MIX, (float*)(ws + WS_LPART));
#endif
            SEAM(pb + 3);
            if (IN(pb + 4)) moba_m4(F, (const bf16_t*)(ws + WS_AUX), (const float*)(ws + WS_LPART), MIX);
            SEAM(pb + 4);
        }
        if (IN(pb + 5)) {
            const bf16_t* wo = ((L & 1) == 0) ? (const bf16_t*)(ws + WS_WGOUT) + (size_t)j * D * D : (const bf16_t*)(ws + WS_WMOUT) + (size_t)j * D * D;
            pg8::Gemm g{MIX, wo, S, D, D}; pg8::StaticOrder So; So.init(S, D, F.G, (int)blockIdx.x);
            pg8::EpiResidNorm E{xin, xout, D, m + 2 * D, args.in[6] + (size_t)L * D, m + 4 * D, m + 3 * D, H, (float*)(ws + WS_XBUF), ctl + CW_SEAM + (2 * L) * SEAM_BANK, ctl + CW_TMO, EPS};
            pg8::gemm_phase<pg8::EpiResidNorm, pg8::StaticOrder, false, true>(F.lds, g, So, E);
        }
        SEAM(pb + 5);
        if (IN(pb + 7)) {
            pg8::Gemm g{H, (const bf16_t*)(ws + WS_W1) + (size_t)L * DFF * D, S, DFF, D}; pg8::StaticOrder So; So.init(S, DFF, F.G, (int)blockIdx.x);
            pg8::EpiBf16<1> E{HID, DFF};
            pg8::gemm_phase<pg8::EpiBf16<1>, pg8::StaticOrder, true, true>(F.lds, g, So, E);
#if PROBE == 2
            xcd_barrier(bar); pg8::gemm_phase<pg8::EpiBf16<1>, pg8::StaticOrder, true, true>(F.lds, g, So, E);
#endif
#if PROBE == 10
            { xcd_barrier(bar); pg8::MaskOrder Sm; Sm.init(S, DFF, F.G, (int)blockIdx.x); pg8::EpiBf16<1> E2{MIX, DFF};
              pg8::gemm_phase<pg8::EpiBf16<1>, pg8::MaskOrder, true, true>(F.lds, g, Sm, E2); }
#endif
        }
        SEAM(pb + 7);
        if (IN(pb + 8)) {
            pg8::Gemm g{HID, (const bf16_t*)(ws + WS_W2) + (size_t)L * D * DFF, S, D, DFF}; pg8::StaticOrder So; So.init(S, D, F.G, (int)blockIdx.x);
            pg8::EpiResid E{xout, xout, D, m + 5 * D};
#if PROBE == 9
            { pg8::EpiResid E2{xout, (float*)(ws + WS_QKV) + (size_t)40 * 1024 * 1024, D, m + 5 * D}; pg8::gemm_phase<pg8::EpiResid, pg8::StaticOrder, false, true>(F.lds, g, So, E2); xcd_barrier(bar); }
#endif
#if PROBE == 11
            { pg8::MaskOrder Sm; Sm.init(S, D, F.G, (int)blockIdx.x); pg8::EpiResid E2{xout, (float*)(ws + WS_QKV) + (size_t)40 * 1024 * 1024, D, m + 5 * D}; pg8::gemm_phase<pg8::EpiResid, pg8::MaskOrder, false, true>(F.lds, g, Sm, E2); xcd_barrier(bar); }
#endif
            if (L + 1 < DEPTH) {
                const float* mn = mod + (size_t)(L + 1) * 6 * D;
                pg8::EpiResidNorm EN{xout, xout, D, m + 5 * D, args.in[5] + (size_t)(L + 1) * D, mn + D, mn, H, (float*)(ws + WS_XBUF), ctl + CW_SEAM + (2 * L + 1) * SEAM_BANK, ctl + CW_TMO, EPS};
                pg8::gemm_phase<pg8::EpiResidNorm, pg8::StaticOrder, false, true>(F.lds, g, So, EN);
            } else
            pg8::gemm_phase<pg8::EpiResid, pg8::StaticOrder, false, true>(F.lds, g, So, E);
        }
        if (L + 1 < DEPTH) SEAM(pb + 8);
    }
#undef IN
#undef SEAM
}
static int g_grid = 0;
static void launch_mega(MegaArgs a, int lo, int hi, hipStream_t stream) {
    a.ph_lo = lo; a.ph_hi = hi;
    (void)hipMemsetAsync((char*)a.ws + WS_CTL + CW_BAR * 4, 0, XCD_BAR_WORDS * 4, stream);
    void* params[] = {&a};
    hipError_t e = hipLaunchCooperativeKernel((const void*)mega, dim3(g_grid), dim3(NTHR), params, LDS_BYTES, stream);
    if (e != hipSuccess) fprintf(stderr, "cooperative launch failed: %s (grid %d)\n", hipGetErrorString(e), g_grid);
}
extern "C" void kernel_launch(void* const* d_in, const int* in_sizes, int n_in, void* d_out, int out_size, void* d_ws, size_t ws_size, hipStream_t stream) {
    if (g_grid == 0) {
        int dev = 0, cus = 0, per_cu = 0;
        (void)hipGetDevice(&dev);
        (void)hipDeviceGetAttribute(&cus, hipDeviceAttributeMultiprocessorCount, dev);
        (void)hipFuncSetAttribute((const void*)mega, hipFuncAttributeMaxDynamicSharedMemorySize, LDS_BYTES);
        (void)hipOccupancyMaxActiveBlocksPerMultiprocessor(&per_cu, (const void*)mega, NTHR, LDS_BYTES);
        if (per_cu < 1) { fprintf(stderr, "occupancy query says %d blocks/CU\n", per_cu); per_cu = 1; }
        g_grid = cus;
        if (ws_size < WS_END || n_in != 18) { fprintf(stderr, "bad ws_size %zu / n_in %d\n", ws_size, n_in); g_grid = -1; }
    }
    if (g_grid < 0) return;
    (void)hipMemsetAsync((char*)d_ws + WS_CTL, 0, CTL_ZERO_BYTES, stream);
    MegaArgs a{};
    for (int i = 0; i < 18; ++i) a.in[i] = (const float*)d_in[i];
    a.out = (float*)d_out; a.ws = (unsigned char*)d_ws;
    launch_mega(a, 0, N_PHASES, stream);
}
```

```cpp
#include <hip/hip_runtime.h>
#include <hip/hip_cooperative_groups.h>
#include <cstdio>
#include <cstdint>
#include <cmath>
namespace cg = cooperative_groups;
constexpr int D = 1024, S = 16384, DEPTH = 4, DFF = 4096;
constexpr int GLA_IN = 3088, MB_IN = 3072;
constexpr float EPS = 1e-6f;
#ifndef PROBE
#define PROBE 0
#endif
#ifndef TCAT
#define TCAT 0
#endif
#ifndef TBLK
#define TBLK 0
#endif
#define LAS __attribute__((address_space(3)))
#define GAS __attribute__((address_space(1)))
typedef unsigned short bf16_t;
typedef short bf16x8 __attribute__((ext_vector_type(8)));
typedef short s16x4 __attribute__((ext_vector_type(4)));
typedef float f32x4 __attribute__((ext_vector_type(4)));
typedef float f32x16 __attribute__((ext_vector_type(16)));
typedef float f32x2 __attribute__((ext_vector_type(2)));
typedef unsigned u32x4 __attribute__((ext_vector_type(4)));
typedef unsigned u32x2 __attribute__((ext_vector_type(2)));
typedef __bf16 bf16x2_t __attribute__((ext_vector_type(2)));

__device__ __forceinline__ unsigned cvtpk(float lo, float hi) { f32x2 v = {lo, hi}; bf16x2_t b = __builtin_convertvector(v, bf16x2_t); return __builtin_bit_cast(unsigned, b); }
__device__ __forceinline__ float bf2f(unsigned short b) { return __uint_as_float((unsigned)b << 16); }
__device__ __forceinline__ float bflo(unsigned w) { return __uint_as_float(w << 16); }
__device__ __forceinline__ float bfhi(unsigned w) { return __uint_as_float(w & 0xffff0000u); }

#ifndef WT_STORES
#define WT_STORES 0
#endif
__device__ __forceinline__ void st16_wt(void* p, u32x4 v) {
#if WT_STORES
    asm volatile("global_store_dwordx4 %0, %1, off sc1\n\ts_nop 1" :: "v"(p), "v"(v) : "memory");
#else
    *(u32x4*)p = v;
#endif
}
__device__ __forceinline__ void st16_wt(void* p, f32x4 v) { st16_wt(p, __builtin_bit_cast(u32x4, v)); }
namespace pg8 {
constexpr int BM = 256, BK = 64, HALF = 128, HTB = HALF * BK * 2, STAGE_BYTES = 8 * HTB, NXCD = 8, WGM = 8;
__host__ __device__ __forceinline__ int lds_byte(int r, int c) { const int st = (r >> 4) * 2 + (c >> 5), rr = r & 15, cc = c & 31, ob = rr * 64 + cc * 2; return st * 1024 + (ob ^ (((ob >> 9) & 1) << 5)); }
__host__ __device__ __forceinline__ void stage_rc(int b, int& R, int& C) { const int st = b / 1024, sb = b % 1024, swz = sb ^ (((sb >> 9) & 1) << 5); R = (st >> 1) * 16 + swz / 64; C = (st & 1) * 32 + (swz % 64) / 2; }
__host__ __device__ __forceinline__ int perm32(int rho) { const int n = rho >> 4, i = rho & 15; return 8 * (i >> 2) + 4 * n + (i & 3); }
struct Unit { int pm, pn; };
struct Gemm { const bf16_t* A; const bf16_t* Bt; int M, N, K; };
struct StaticOrder {
    int nM, nN, nwg, G, c;
    __host__ __device__ void init(int M, int N, int G_, int c_) { nM = M / BM; nN = N / BM; nwg = nM * nN; G = G_; c = c_; }
    __host__ __device__ bool next(int i, Unit& u) const {
        const long L = (long)i * G + c; if (L >= nwg) return false;
        int wgid = (int)L; { const int q = nwg / NXCD, r = nwg % NXCD, xcd = wgid % NXCD, off = wgid / NXCD; wgid = (xcd < r ? xcd * (q + 1) : r * (q + 1) + (xcd - r) * q) + off; }
        const int nig = WGM * nN, gid = wgid / nig, fm = gid * WGM, gsz = (nM - fm) < WGM ? (nM - fm) : WGM;
        u.pm = fm + ((wgid % nig) % gsz); u.pn = (wgid % nig) / gsz; return true;
    }
    __device__ __forceinline__ void a_ready(const Unit&) const {}
    __device__ __forceinline__ void done(const Unit&) const {}
};
struct MaskOrder : StaticOrder {
    __device__ bool next(int i, Unit& u) const { const bool ok = StaticOrder::next(i, u); u.pm &= 7; u.pn &= 3; return ok; }
};
template <int ACT  > struct EpiBf16 {
    static constexpr bool PERM = true, AFTER_DRAIN = false;
    bf16_t* O; int ldc;
    __device__ __forceinline__ void operator()(const f32x4 (&acc)[2][2][4][2], const Unit& u, int wr, int wc, int fr, int fq) const {
        const int row0 = u.pm * BM + wr * 64 + fr; const int col0 = u.pn * BM + wc * 32 + 8 * fq;
#pragma unroll
        for (int ai = 0; ai < 2; ++ai)
#pragma unroll
            for (int m = 0; m < 4; ++m) { bf16_t* rowp = O + (size_t)(row0 + ai * HALF + m * 16) * ldc + col0;
#pragma unroll
                for (int bj = 0; bj < 2; ++bj) { f32x4 v0 = acc[ai][bj][m][0], v1 = acc[ai][bj][m][1];
                    if (ACT == 1) {
#pragma unroll
                        for (int e = 0; e < 4; ++e) { float a = fmaxf(v0[e], 0.f); v0[e] = a * a; float b = fmaxf(v1[e], 0.f); v1[e] = b * b; } }
                    u32x4 w; w.x = cvtpk(v0[0], v0[1]); w.y = cvtpk(v0[2], v0[3]); w.z = cvtpk(v1[0], v1[1]); w.w = cvtpk(v1[2], v1[3]);
                    st16_wt(rowp + bj * HALF, w); } }
    }
};
struct EpiResid {
    static constexpr bool PERM = false, AFTER_DRAIN = false;
    const bf16_t* base; float* out; int ldc; const float* gate;
    __device__ __forceinline__ void operator()(const f32x4 (&acc)[2][2][4][2], const Unit& u, int wr, int wc, int fr, int fq) const {
        const int row0 = u.pm * BM + wr * 64 + fr, col0 = u.pn * BM + wc * 32 + 4 * fq;
        f32x4 gv[2][2];
#pragma unroll
        for (int bj = 0; bj < 2; ++bj)
#pragma unroll
            for (int n = 0; n < 2; ++n) gv[bj][n] = *(const f32x4*)(gate + col0 + bj * HALF + n * 16);
#pragma unroll
        for (int ai = 0; ai < 2; ++ai)
#pragma unroll
            for (int m = 0; m < 4; ++m) { const size_t off = (size_t)(row0 + ai * HALF + m * 16) * ldc + col0;
#pragma unroll
                for (int bj = 0; bj < 2; ++bj)
#pragma unroll
                    for (int n = 0; n < 2; ++n) { const u32x2 bb = *(const u32x2*)(base + off + bj * HALF + n * 16); const f32x4 b = {bflo(bb.x), bfhi(bb.x), bflo(bb.y), bfhi(bb.y)};
                        st16_wt(out + off + bj * HALF + n * 16, b + gv[bj][n] * acc[ai][bj][m][n]); } }
    }
};

template <bool BASE_F32> struct EpiResidNorm {
    static constexpr bool PERM = false, AFTER_DRAIN = true;
    const void* base; bf16_t* out; int ldc; const float* gate;
    const float* ng; const float* sc; const float* sh; bf16_t* H;
    float* xbuf; unsigned* cnt; unsigned* tmo; float eps;
    __device__ __forceinline__ void operator()(const f32x4 (&)[2][2][4][2], const Unit&, int, int, int, int) const {}
    __device__ __forceinline__ void fused(f32x4 (&acc)[2][2][4][2], const Unit& u, int wr, int wc, int fr, int fq, LAS unsigned char* lds, int wid, int lane) const {
        LAS float* P = (LAS float*)lds;
        LAS float* Sr = (LAS float*)(lds + 4096);
        LAS unsigned* flag = (LAS unsigned*)(lds + 4096 + 1024);
        const int row0 = u.pm * BM + wr * 64 + fr, col0 = u.pn * BM + wc * 32 + 4 * fq;
        {
            f32x4 gv[2][2];
#pragma unroll
            for (int bj = 0; bj < 2; ++bj)
#pragma unroll
                for (int n = 0; n < 2; ++n) gv[bj][n] = *(const f32x4*)(gate + col0 + bj * HALF + n * 16);
#pragma unroll
            for (int ai = 0; ai < 2; ++ai)
#pragma unroll
                for (int m = 0; m < 4; ++m) { const size_t off = (size_t)(row0 + ai * HALF + m * 16) * ldc + col0;
                    float s = 0.f;
#pragma unroll
                    for (int bj = 0; bj < 2; ++bj)
#pragma unroll
                        for (int n = 0; n < 2; ++n) { f32x4 b;
                            if constexpr (BASE_F32) b = *(const f32x4*)((const float*)base + off + bj * HALF + n * 16);
                            else { const u32x2 bb = *(const u32x2*)((const bf16_t*)base + off + bj * HALF + n * 16); b = (f32x4){bflo(bb.x), bfhi(bb.x), bflo(bb.y), bfhi(bb.y)}; }
                            const f32x4 x = b + gv[bj][n] * acc[ai][bj][m][n]; acc[ai][bj][m][n] = x;
                            { u32x2 xw; xw.x = cvtpk(x[0], x[1]); xw.y = cvtpk(x[2], x[3]); *(u32x2*)(out + off + bj * HALF + n * 16) = xw; } s += (x[0] * x[0] + x[1] * x[1]) + (x[2] * x[2] + x[3] * x[3]); }
                    s += __shfl_xor(s, 16); s += __shfl_xor(s, 32);
                    if (fq == 0) P[(ai * HALF + wr * 64 + m * 16 + fr) * 4 + wc] = s;
                    if (m & 1) asm volatile("" ::: "memory"); }
        }
        asm volatile("s_waitcnt lgkmcnt(0)" ::: "memory"); __builtin_amdgcn_s_barrier(); asm volatile("" ::: "memory");
        const int row = wid * 32 + (lane & 31);
        if (lane < 32) {
            const float tot = (P[row * 4 + 0] + P[row * 4 + 1]) + (P[row * 4 + 2] + P[row * 4 + 3]);
            __hip_atomic_store((unsigned*)xbuf + ((size_t)(u.pm * BM + row) * 4 + u.pn), __float_as_uint(tot), __ATOMIC_RELAXED, __HIP_MEMORY_SCOPE_AGENT);
        }
        asm volatile("s_waitcnt vmcnt(0)" ::: "memory");
        if (lane == 0) __hip_atomic_fetch_add(cnt + 64 * u.pm, 1u, __ATOMIC_RELAXED, __HIP_MEMORY_SCOPE_AGENT);
        if (wid == 0) {
            unsigned sp = 0; bool dead = false;
            for (;;) {
                if ((unsigned)__builtin_amdgcn_readfirstlane(__hip_atomic_load(cnt + 64 * u.pm, __ATOMIC_RELAXED, __HIP_MEMORY_SCOPE_AGENT)) >= 32u) break;
                __builtin_amdgcn_s_sleep(2);
                if (++sp > (1u << 20)) { if (lane == 0) __hip_atomic_store(tmo, 1u, __ATOMIC_RELAXED, __HIP_MEMORY_SCOPE_AGENT); dead = true; break; }
            }
            __builtin_amdgcn_fence(__ATOMIC_ACQUIRE, "agent");
            if (lane == 0) flag[0] = dead ? 1u : 0u;
        }
        asm volatile("s_waitcnt vmcnt(0) lgkmcnt(0)" ::: "memory"); __builtin_amdgcn_s_barrier(); asm volatile("" ::: "memory");
        if (lane < 32) {
            const unsigned* slot = (const unsigned*)xbuf + (size_t)(u.pm * BM + row) * 4; float t = 0.f;
#pragma unroll
            for (int k = 0; k < 4; ++k) t += __uint_as_float(__hip_atomic_load(slot + k, __ATOMIC_RELAXED, __HIP_MEMORY_SCOPE_AGENT));
            Sr[row] = 1.0f / sqrtf(t * (1.0f / 1024.0f) + eps);
        }
        asm volatile("s_waitcnt lgkmcnt(0)" ::: "memory"); __builtin_amdgcn_s_barrier(); asm volatile("" ::: "memory");
        float rs[2][4];
#pragma unroll
        for (int ai = 0; ai < 2; ++ai)
#pragma unroll
            for (int m = 0; m < 4; ++m) rs[ai][m] = Sr[ai * HALF + wr * 64 + m * 16 + fr];
#pragma unroll
        for (int bj = 0; bj < 2; ++bj)
#pragma unroll
            for (int n = 0; n < 2; ++n) { const int c = col0 + bj * HALF + n * 16;
                const f32x4 ga = *(const f32x4*)(ng + c) * (*(const f32x4*)(sc + c) + 1.0f), gb = *(const f32x4*)(sh + c);
#pragma unroll
                for (int ai = 0; ai < 2; ++ai)
#pragma unroll
                    for (int m = 0; m < 4; ++m) { const int r = ai * HALF + wr * 64 + m * 16 + fr; const size_t off = (size_t)(u.pm * BM + r) * ldc + c;
                        const f32x4 y = acc[ai][bj][m][n] * rs[ai][m] * ga + gb; u32x2 w; w.x = cvtpk(y[0], y[1]); w.y = cvtpk(y[2], y[3]);
                        *(u32x2*)(H + off) = w; } }
    }
};

template <class Epi, class Sched, bool ALIGN_EPI = false, bool SP2 = false>
__device__ __forceinline__ void gemm_phase(LAS unsigned char* lds, const Gemm g, const Sched& S, const Epi& E) {
    int tid_ = threadIdx.x; asm volatile("" : "+v"(tid_));
    const int tid = tid_, wid = __builtin_amdgcn_readfirstlane(tid >> 6), lane = tid & 63, wr = wid >> 2, wc = wid & 3, fr = lane & 15, fq = lane >> 4;
    const int K = g.K, nt = K / BK;
    unsigned voffA[2], voffB[2];
#pragma unroll
    for (int i = 0; i < 2; ++i) { int R, C; stage_rc(tid * 16 + i * 8192, R, C); const int Rb = Epi::PERM ? ((R & ~31) + perm32(R & 31)) : R;
        voffA[i] = (unsigned)(R * K + C) * 2u; voffB[i] = (unsigned)(Rb * K + C) * 2u; }
    const size_t kstep = (size_t)(BK * 2);
    const size_t hstep = (size_t)HALF * K * 2;
    const size_t tstep = 2 * hstep;
    const unsigned ldsw = (unsigned)wid * 1024u;
    const int aoff = lds_byte(wr * 64 + fr, fq * 8), boff = lds_byte(wc * 32 + fr, fq * 8);
#define PG8_SA(b, h) (((b) * 2 + (h)) * HTB)
#define PG8_SB(b, h) ((4 + (b) * 2 + (h)) * HTB)
#define PG8_STAGE(bufoff, gbase, voff) do { _Pragma("unroll") for (int _i = 0; _i < 2; ++_i) \
        __builtin_amdgcn_global_load_lds((const unsigned*)((const char*)(gbase) + (voff)[_i]), (LAS unsigned*)(lds + (bufoff) + ldsw + _i * 8192), 16, 0, 0); } while (0)
#define PG8_LDA(dst, b, h) do { _Pragma("unroll") for (int m = 0; m < 4; ++m) _Pragma("unroll") for (int k = 0; k < 2; ++k) dst[m][k] = *(const LAS bf16x8*)(lds + PG8_SA(b, h) + aoff + m * 2048 + k * 1024); } while (0)
#define PG8_LDB(dst, b, h) do { _Pragma("unroll") for (int n = 0; n < 2; ++n) _Pragma("unroll") for (int k = 0; k < 2; ++k) dst[n][k] = *(const LAS bf16x8*)(lds + PG8_SB(b, h) + boff + n * 2048 + k * 1024); } while (0)
#define PG8_MMA(ai, bj, At, Bt) do { __builtin_amdgcn_s_setprio(1); _Pragma("unroll") for (int m = 0; m < 4; ++m) _Pragma("unroll") for (int n = 0; n < 2; ++n) _Pragma("unroll") for (int k = 0; k < 2; ++k) \
        acc[ai][bj][m][n] = __builtin_amdgcn_mfma_f32_16x16x32_bf16(Bt[n][k], At[m][k], acc[ai][bj][m][n], 0, 0, 0); __builtin_amdgcn_s_setprio(0); } while (0)
#define PG8_WAIT_V(n) asm volatile("s_waitcnt vmcnt(" #n ")" ::: "memory")
#define PG8_WAIT_L(n) asm volatile("s_waitcnt lgkmcnt(" #n ")" ::: "memory")
#define PG8_BAR __builtin_amdgcn_s_barrier()
#define PG8_SCHED __builtin_amdgcn_sched_barrier(0)
    Unit cur, nxt; int ui = 0;
    if (!S.next(0, cur)) return;
    f32x4 acc[2][2][4][2];
#pragma unroll
    for (int a = 0; a < 2; ++a)
#pragma unroll
        for (int b = 0; b < 2; ++b)
#pragma unroll
            for (int m = 0; m < 4; ++m)
#pragma unroll
                for (int n = 0; n < 2; ++n) acc[a][b][m][n] = (f32x4){0.f, 0.f, 0.f, 0.f};
    bf16x8 At[4][2], B0[2][2], B1[2][2];
    const char* cA = (const char*)g.A + (size_t)cur.pm * tstep; const char* cB = (const char*)g.Bt + (size_t)cur.pn * tstep;
    S.a_ready(cur);
    if constexpr (SP2) {
        PG8_STAGE(PG8_SB(0, 0), cB, voffB); PG8_STAGE(PG8_SB(0, 1), cB + hstep, voffB); PG8_STAGE(PG8_SA(0, 0), cA, voffA); PG8_STAGE(PG8_SA(0, 1), cA + hstep, voffA);
        if (wr == 1) PG8_BAR;
        PG8_WAIT_V(2); PG8_BAR;
        PG8_STAGE(PG8_SB(1, 0), cB + kstep, voffB); PG8_STAGE(PG8_SA(1, 0), cA + kstep, voffA); PG8_STAGE(PG8_SB(1, 1), cB + hstep + kstep, voffB);
        PG8_WAIT_V(6); PG8_BAR;
    } else {
        PG8_STAGE(PG8_SB(0, 0), cB, voffB); PG8_STAGE(PG8_SA(0, 0), cA, voffA); PG8_STAGE(PG8_SB(0, 1), cB + hstep, voffB); PG8_STAGE(PG8_SA(0, 1), cA + hstep, voffA);
        if (wr == 1) PG8_BAR;
        PG8_WAIT_V(4); PG8_BAR;
        PG8_STAGE(PG8_SB(1, 0), cB + kstep, voffB); PG8_STAGE(PG8_SA(1, 0), cA + kstep, voffA); PG8_STAGE(PG8_SB(1, 1), cB + hstep + kstep, voffB);
        PG8_WAIT_V(6); PG8_BAR;
    }
    for (;;) {
        const bool has_next = S.next(ui + 1, nxt);
        const char* nA = has_next ? (const char*)g.A + (size_t)nxt.pm * tstep : cA; const char* nB = has_next ? (const char*)g.Bt + (size_t)nxt.pn * tstep : cB;
        for (int t = 0; t < nt; t += 2) {
            const bool last = (t == nt - 2);
            const char* a1 = cA + (size_t)(t + 1) * kstep;
            const char* a2 = last ? nA : cA + (size_t)(t + 2) * kstep; const char* b2 = last ? nB : cB + (size_t)(t + 2) * kstep;
            const char* a3 = a2 + kstep; const char* b3 = b2 + kstep;
            if (last && has_next) S.a_ready(nxt);
            if constexpr (SP2) {
            PG8_LDB(B0, 0, 0); PG8_LDB(B1, 0, 1); PG8_SCHED; PG8_LDA(At, 0, 0); PG8_STAGE(PG8_SA(1, 1), a1 + hstep, voffA);
            PG8_WAIT_V(8); PG8_WAIT_L(0); PG8_BAR; PG8_MMA(0, 0, At, B0); PG8_MMA(0, 1, At, B1); PG8_BAR; PG8_SCHED;
            PG8_LDA(At, 0, 1); PG8_STAGE(PG8_SB(0, 0), b2, voffB); PG8_STAGE(PG8_SB(0, 1), b2 + hstep, voffB); PG8_STAGE(PG8_SA(0, 0), a2, voffA);
            PG8_WAIT_V(8); PG8_WAIT_L(0); PG8_BAR; PG8_MMA(1, 0, At, B0); PG8_MMA(1, 1, At, B1); PG8_BAR; PG8_SCHED;
            PG8_LDB(B0, 1, 0); PG8_LDB(B1, 1, 1); PG8_SCHED; PG8_LDA(At, 1, 0); PG8_STAGE(PG8_SA(0, 1), a2 + hstep, voffA);
            PG8_WAIT_V(8); PG8_WAIT_L(0); PG8_BAR; PG8_MMA(0, 0, At, B0); PG8_MMA(0, 1, At, B1); PG8_BAR; PG8_SCHED;
            PG8_LDA(At, 1, 1); PG8_STAGE(PG8_SB(1, 0), b3, voffB); PG8_STAGE(PG8_SB(1, 1), b3 + hstep, voffB); PG8_STAGE(PG8_SA(1, 0), a3, voffA);
            PG8_WAIT_V(8); PG8_WAIT_L(0); PG8_BAR; PG8_MMA(1, 0, At, B0); PG8_MMA(1, 1, At, B1); PG8_BAR; PG8_SCHED;
            } else {
            PG8_LDB(B0, 0, 0); PG8_SCHED; PG8_LDA(At, 0, 0); PG8_STAGE(PG8_SA(1, 1), a1 + hstep, voffA);
            PG8_WAIT_L(8); PG8_BAR; PG8_WAIT_L(0); PG8_MMA(0, 0, At, B0); PG8_BAR; PG8_SCHED;
            PG8_LDB(B1, 0, 1); PG8_STAGE(PG8_SB(0, 0), b2, voffB);
            PG8_BAR; PG8_WAIT_L(0); PG8_MMA(0, 1, At, B1); PG8_BAR;
            PG8_LDA(At, 0, 1); PG8_STAGE(PG8_SA(0, 0), a2, voffA);
            PG8_BAR; PG8_WAIT_L(0); PG8_MMA(1, 0, At, B0); PG8_BAR; PG8_SCHED;
            PG8_STAGE(PG8_SB(0, 1), b2 + hstep, voffB);
            PG8_WAIT_V(6); PG8_BAR; PG8_MMA(1, 1, At, B1); PG8_BAR;
            PG8_LDB(B0, 1, 0); PG8_SCHED; PG8_LDA(At, 1, 0); PG8_STAGE(PG8_SA(0, 1), a2 + hstep, voffA);
            PG8_WAIT_L(8); PG8_BAR; PG8_WAIT_L(0); PG8_MMA(0, 0, At, B0); PG8_BAR; PG8_SCHED;
            PG8_LDB(B1, 1, 1); PG8_STAGE(PG8_SB(1, 0), b3, voffB);
            PG8_BAR; PG8_WAIT_L(0); PG8_MMA(0, 1, At, B1); PG8_BAR;
            PG8_LDA(At, 1, 1); PG8_STAGE(PG8_SA(1, 0), a3, voffA);
            PG8_BAR; PG8_WAIT_L(0); PG8_MMA(1, 0, At, B0); PG8_BAR; PG8_SCHED;
            PG8_STAGE(PG8_SB(1, 1), b3 + hstep, voffB);
            PG8_WAIT_V(6); PG8_BAR; PG8_MMA(1, 1, At, B1); PG8_BAR;
            }
        }
        if constexpr (ALIGN_EPI) { if (wr == 0) PG8_BAR; }
        if constexpr (!Epi::AFTER_DRAIN) { E(acc, cur, wr, wc, fr, fq); S.done(cur); }
        if (!has_next) break;
#pragma unroll
        for (int a = 0; a < 2; ++a)
#pragma unroll
            for (int b = 0; b < 2; ++b)
#pragma unroll
                for (int m = 0; m < 4; ++m)
#pragma unroll
                    for (int n = 0; n < 2; ++n) acc[a][b][m][n] = (f32x4){0.f, 0.f, 0.f, 0.f};
        cur = nxt; cA = nA; cB = nB; ++ui;
        if constexpr (ALIGN_EPI) { if (wr == 1) PG8_BAR; }
    }
    PG8_WAIT_V(0);
    if constexpr (!ALIGN_EPI) { if (wr == 0) PG8_BAR; }
    PG8_BAR;
    if constexpr (Epi::AFTER_DRAIN) { E.fused(acc, cur, wr, wc, fr, fq, lds, wid, lane); }
#undef PG8_SA
#undef PG8_SB
#undef PG8_STAGE
#undef PG8_LDA
#undef PG8_LDB
#undef PG8_MMA
#undef PG8_WAIT_V
#undef PG8_WAIT_L
#undef PG8_BAR
#undef PG8_SCHED
}
}

#define XB_TMO      128
#define XB_XCNT(j)  (256  + 64 * (j))
#define XB_XSUB(j)  (1280 + 64 * (j))
#define XB_XGEN(j)  (2304 + 64 * (j))
#define XB_TOP      3328
#define XB_TOPGEN   3392
#define XCD_BAR_WORDS 3456
#define XB_SPIN_CAP (1u << 18)
__device__ __forceinline__ unsigned xb_ld(unsigned* p)              { return __hip_atomic_load(p, __ATOMIC_RELAXED, __HIP_MEMORY_SCOPE_AGENT); }
__device__ __forceinline__ unsigned xb_add(unsigned* p, unsigned v) { return __hip_atomic_fetch_add(p, v, __ATOMIC_RELAXED, __HIP_MEMORY_SCOPE_AGENT); }
__device__ __forceinline__ unsigned xb_xcc_id() { return (unsigned)__builtin_amdgcn_s_getreg((3 << 11) | 20) & 0xFu; }
#define XB_SPIN(cond, bar) do { unsigned _sp = 0; while (cond) { __builtin_amdgcn_s_sleep(1); \
    if ((++_sp & 255u) == 0u) { if (xb_ld(&(bar)[XB_TMO])) break; if (_sp > XB_SPIN_CAP) { atomicAdd(&(bar)[XB_TMO], 1u); break; } } } } while (0)
struct XcdBarrier { unsigned* bar; unsigned x; volatile LAS unsigned* st; };
__device__ __forceinline__ XcdBarrier xcd_barrier_post(unsigned* bar, volatile LAS unsigned* st) {
    XcdBarrier b; b.bar = bar; b.x = xb_xcc_id(); b.st = st;
    if (threadIdx.x == 0) (void)xb_add(&bar[XB_XCNT(b.x)], 1u);
    return b;
}
__device__ __forceinline__ void xcd_barrier_complete(unsigned* bar, unsigned x, unsigned& nloc, unsigned& nx) {
    const unsigned G = gridDim.x * gridDim.y * gridDim.z;
    unsigned sum, cnt, mine, sp = 0u;
    for (;;) {
        sum = 0u; cnt = 0u; mine = 0u;
#pragma unroll
        for (unsigned j = 0; j < 16; ++j) { const unsigned c = xb_ld(&bar[XB_XCNT(j)]); sum += c; cnt += (c > 0u) ? 1u : 0u; }
        mine = xb_ld(&bar[XB_XCNT(x)]);
        if (sum == G) break;
        __builtin_amdgcn_s_sleep(1);
        if ((++sp & 255u) == 0u) { if (xb_ld(&bar[XB_TMO])) break; if (sp > XB_SPIN_CAP) { atomicAdd(&bar[XB_TMO], 1u); break; } }
    }
    nloc = mine > 0u ? mine : 1u; nx = cnt > 0u ? cnt : 1u;
}
__device__ __forceinline__ void xcd_barrier(const XcdBarrier& b) {
    asm volatile("s_waitcnt vmcnt(0)" ::: "memory");
    __syncthreads();
    if (threadIdx.x == 0) {
        unsigned* bar = b.bar; asm volatile("" : "+s"(bar));
        __builtin_amdgcn_s_waitcnt(0);
        unsigned nloc = b.st[0], nx = b.st[1];
        if (nloc == 0u) { xcd_barrier_complete(bar, b.x, nloc, nx); b.st[0] = nloc; b.st[1] = nx; }
        const unsigned old = xb_add(&bar[XB_XSUB(b.x)], 1u);
        const unsigned gen = old / nloc;
        if (old + 1u == (gen + 1u) * nloc) {
            __builtin_amdgcn_fence(__ATOMIC_RELEASE, "agent");
            asm volatile("s_waitcnt vmcnt(0)" ::: "memory");
            const unsigned og = xb_add(&bar[XB_TOP], 1u);
            const unsigned tg = og / nx;
            if (og + 1u == (tg + 1u) * nx) xb_add(&bar[XB_TOPGEN], 1u);
            else XB_SPIN(xb_ld(&bar[XB_TOPGEN]) == tg, bar);
            __builtin_amdgcn_fence(__ATOMIC_ACQUIRE, "agent");
            xb_add(&bar[XB_XGEN(b.x)], 1u);
            asm volatile("s_waitcnt vmcnt(0)" ::: "memory");
        } else {
            XB_SPIN(xb_ld(&bar[XB_XGEN(b.x)]) == gen, bar);
            __builtin_amdgcn_fence(__ATOMIC_ACQUIRE, "agent");
            asm volatile("s_waitcnt vmcnt(0)" ::: "memory");
        }
    }
    __syncthreads();
}
constexpr int NWAVES = 8, NTHR = 512;
constexpr int LDS_BYTES = 147456;
constexpr int RING_BYTES = 131072;
constexpr int MISC_OFF = LDS_BYTES - 256;
constexpr size_t MiB = 1u << 20;
constexpr size_t WS_CTL = 0, CTL_ZERO_BYTES = 1 * MiB;
constexpr size_t WS_MOD = 1 * MiB;
constexpr size_t WS_COS = 2 * MiB, WS_SIN = 6 * MiB;
constexpr size_t WS_WGIN = 10 * MiB;
constexpr size_t WS_WGLR = 22 * MiB;
constexpr size_t WS_WGOUT = 23 * MiB;
constexpr size_t WS_WMIN = 27 * MiB;
constexpr size_t WS_WMOUT = 39 * MiB;
constexpr size_t WS_W1 = 43 * MiB;
constexpr size_t WS_W2 = 75 * MiB;
constexpr size_t WS_H = 107 * MiB;
constexpr size_t WS_MIX = 139 * MiB;
constexpr size_t WS_QKV = 171 * MiB;
constexpr size_t WS_AUX = 267 * MiB;
constexpr size_t WS_HID = 171 * MiB;
constexpr size_t WS_END = 363 * MiB;
constexpr size_t WS_SBUF = WS_AUX;
constexpr size_t WS_GLR = WS_AUX + 32 * MiB;
constexpr size_t WS_DG = WS_AUX + 33 * MiB;
constexpr size_t WS_XB = WS_AUX + 64 * MiB;
constexpr size_t WS_KMEAN = WS_H;
constexpr size_t WS_LPART = WS_H + 1 * MiB;
constexpr size_t WS_LIST = WS_H + 4 * MiB;
constexpr int CW_BAR = 4096;
constexpr int CW_MCNT = 16384;
constexpr int CW_TMO = 0;
constexpr int CW_SEAM = 32768, SEAM_BANK = 64 * 64;
constexpr size_t WS_XBUF = WS_MOD + 512 * 1024;
struct Frame {
    LAS unsigned char* lds;
    int tid, lane, wave, vcu, G;
};
__device__ __forceinline__ Frame opaque(const Frame& F0) { Frame F = F0; int t = F0.tid; asm volatile("" : "+v"(t)); F.tid = t; F.lane = t & 63; F.wave = __builtin_amdgcn_readfirstlane(t >> 6); return F; }
__device__ __forceinline__ float wave_sum(float v) {
#pragma unroll
    for (int o = 1; o < 64; o <<= 1) v += __shfl_xor(v, o);
    return v;
}
__device__ __forceinline__ float silu_f(float x) { return x / (1.f + __expf(-x)); }
__device__ __forceinline__ void sincos_acc(double ang, float& s, float& c) {
    const double n = rint(ang * 0.15915494309189535);
    double r = fma(-n, 6.283185307179586, ang); r = fma(-n, 2.4492935982947064e-16, r);
    const double x = r * 0.25, x2 = x * x;
    const double sn = x * (1.0 + x2 * (-1.0 / 6 + x2 * (1.0 / 120 + x2 * (-1.0 / 5040 + x2 * (1.0 / 362880 + x2 * (-1.0 / 39916800 + x2 * (1.0 / 6227020800.0)))))));
    const double cs = 1.0 + x2 * (-0.5 + x2 * (1.0 / 24 + x2 * (-1.0 / 720 + x2 * (1.0 / 40320 + x2 * (-1.0 / 3628800 + x2 * (1.0 / 479001600 + x2 * (-1.0 / 87178291200.0)))))));
    const double s2 = 2 * sn * cs, c2 = 1 - 2 * sn * sn;
    s = (float)(2 * s2 * c2); c = (float)(1 - 2 * s2 * s2);
}
constexpr int TR_SCR = 64 * 65 * 4;
struct TrItem { const float* W; int ld, n_off, n_cnt, K; bf16_t* WT; int item; };
__device__ __forceinline__ void tr_load(const TrItem& t, int lane, f32x4 (&v)[16]) {
    const int nblk = (t.n_cnt + 63) >> 6, kb = t.item / nblk, nb = t.item - kb * nblk, k0 = 64 * kb, n0 = 64 * nb;
    const int c4 = (lane & 15) * 4, kr = lane >> 4;
    const bool ok = (n0 + c4) < t.n_cnt;
#pragma unroll
    for (int i = 0; i < 16; ++i) v[i] = ok ? *(const f32x4*)(t.W + (size_t)(k0 + 4 * i + kr) * t.ld + t.n_off + n0 + c4) : (f32x4){0.f, 0.f, 0.f, 0.f};
}
__device__ __forceinline__ void tr_store(const TrItem& t, int lane, const f32x4 (&v)[16], LAS float* scr) {
    const int nblk = (t.n_cnt + 63) >> 6, kb = t.item / nblk, nb = t.item - kb * nblk, k0 = 64 * kb, n0 = 64 * nb;
    const int c4 = (lane & 15) * 4, kr = lane >> 4;
#pragma unroll
    for (int i = 0; i < 16; ++i) { LAS float* s = scr + (4 * i + kr) * 65 + c4; s[0] = v[i].x; s[1] = v[i].y; s[2] = v[i].z; s[3] = v[i].w; }
    asm volatile("s_waitcnt lgkmcnt(0)" ::: "memory");
    const int c = lane & 7;
#pragma unroll
    for (int j = 0; j < 8; ++j) { const int n = (lane >> 3) + 8 * j; const LAS float* s = scr + (8 * c) * 65 + n;
        u32x4 o; o.x = cvtpk(s[0 * 65], s[1 * 65]); o.y = cvtpk(s[2 * 65], s[3 * 65]); o.z = cvtpk(s[4 * 65], s[5 * 65]); o.w = cvtpk(s[6 * 65], s[7 * 65]);
        if (n0 + n < t.n_cnt) *(u32x4*)(t.WT + (size_t)(n0 + n) * t.K + k0 + 8 * c) = o; }
    asm volatile("s_waitcnt lgkmcnt(0)" ::: "memory");
}
struct MegaArgs {
    const float* in[18]; float* out; unsigned char* ws; int ph_lo, ph_hi;
};
__device__ __forceinline__ void p0_prologue(const Frame& F0, const MegaArgs& a) {
    const Frame F = opaque(F0);
    unsigned char* ws = a.ws;
    {
        LAS float* scr = (LAS float*)(F.lds + F.wave * TR_SCR);
        const int gw = F.vcu * NWAVES + F.wave, NGW = F.G * NWAVES;
        constexpr int I_GIN = 16 * 48, I_GLR = 16, I_SQ = 16 * 16, I_W1 = 16 * 64, I_W2 = 64 * 16;
        constexpr int NITEMS = 2 * I_GIN + 2 * I_GLR + 2 * I_SQ + 2 * I_GIN + 2 * I_SQ + 4 * I_W1 + 4 * I_W2;
        auto decode = [&](int it) -> TrItem {
            int r = it;
            if (r < 2 * I_GIN) { const int j = r / I_GIN; return TrItem{a.in[7] + (size_t)j * D * GLA_IN, GLA_IN, 0, 3072, D, (bf16_t*)(ws + WS_WGIN) + (size_t)j * 3072 * D, r % I_GIN}; } r -= 2 * I_GIN;
            if (r < 2 * I_GLR) { const int j = r / I_GLR; return TrItem{a.in[7] + (size_t)j * D * GLA_IN, GLA_IN, 3072, 16, D, (bf16_t*)(ws + WS_WGLR) + (size_t)j * 16 * D, r % I_GLR}; } r -= 2 * I_GLR;
            if (r < 2 * I_SQ) { const int j = r / I_SQ; return TrItem{a.in[11] + (size_t)j * D * D, D, 0, D, D, (bf16_t*)(ws + WS_WGOUT) + (size_t)j * D * D, r % I_SQ}; } r -= 2 * I_SQ;
            if (r < 2 * I_GIN) { const int j = r / I_GIN; return TrItem{a.in[12] + (size_t)j * D * MB_IN, MB_IN, 0, 3072, D, (bf16_t*)(ws + WS_WMIN) + (size_t)j * 3072 * D, r % I_GIN}; } r -= 2 * I_GIN;
            if (r < 2 * I_SQ) { const int j = r / I_SQ; return TrItem{a.in[15] + (size_t)j * D * D, D, 0, D, D, (bf16_t*)(ws + WS_WMOUT) + (size_t)j * D * D, r % I_SQ}; } r -= 2 * I_SQ;
            if (r < 4 * I_W1) { const int j = r / I_W1; return TrItem{a.in[16] + (size_t)j * D * DFF, DFF, 0, DFF, D, (bf16_t*)(ws + WS_W1) + (size_t)j * DFF * D, r % I_W1}; } r -= 4 * I_W1;
            { const int j = r / I_W2; return TrItem{a.in[17] + (size_t)j * DFF * D, D, 0, D, DFF, (bf16_t*)(ws + WS_W2) + (size_t)j * D * DFF, r % I_W2}; }
        };
        f32x4 va[16], vb[16];
        int it = gw;
        if (it < NITEMS) { TrItem cur = decode(it); tr_load(cur, F.lane, va);
            for (;;) {
                const int itn = it + NGW; TrItem nx = cur; const bool more = itn < NITEMS;
                if (more) { nx = decode(itn); tr_load(nx, F.lane, vb); }
                tr_store(cur, F.lane, va, scr);
                if (!more) break;
                const int itn2 = itn + NGW; const bool more2 = itn2 < NITEMS; TrItem nx2 = nx;
                if (more2) { nx2 = decode(itn2); tr_load(nx2, F.lane, va); }
                tr_store(nx, F.lane, vb, scr);
                if (!more2) break;
                cur = nx2; it = itn2;
            }
        }
    }
    __syncthreads();
    {
        const float* c = a.in[1]; const float* ada_w = a.in[3]; const float* ada_b = a.in[4]; float* mod = (float*)(ws + WS_MOD);
        LAS float* sc = (LAS float*)F.lds;
        LAS float* red = (LAS float*)F.lds + 1024;
        for (int k = F.tid; k < D; k += NTHR) sc[k] = silu_f(c[k]);
        __syncthreads();
        const int kg = F.tid >> 5, cl = F.tid & 31;
        for (int chunk = F.vcu; chunk < 256; chunk += F.G) {
            float part[3];
#pragma unroll
            for (int cc = 0; cc < 3; ++cc) {
                const int col = chunk * 96 + cc * 32 + cl, i = col / (6 * D), n = col - i * 6 * D;
                const float* w = ada_w + (size_t)i * D * 6 * D + (size_t)(kg * 64) * 6 * D + n;
                float wv[64];
#pragma unroll
                for (int k = 0; k < 64; ++k) wv[k] = w[(size_t)k * 6 * D];
                float acc = 0.f;
#pragma unroll
                for (int k = 0; k < 64; ++k) acc += sc[kg * 64 + k] * wv[k];
                part[cc] = acc;
            }
#pragma unroll
            for (int cc = 0; cc < 3; ++cc) red[kg * 96 + cc * 32 + cl] = part[cc];
            __syncthreads();
            if (F.tid < 96) { float s = 0.f;
#pragma unroll
                for (int g = 0; g < 16; ++g) s += red[g * 96 + F.tid];
                mod[chunk * 96 + F.tid] = s + ada_b[chunk * 96 + F.tid]; }
            __syncthreads();
        }
    }
    {
        const int* pos = (const int*)a.in[2]; float* ct = (float*)(ws + WS_COS); float* st = (float*)(ws + WS_SIN);
        for (int idx = F.vcu * NTHR + F.tid; idx < S * 64; idx += F.G * NTHR) {
            const int t = idx >> 6, i = idx & 63;
            const float inv_freq = (float)exp2(-(double)i * (13.287712379549449 / 64.0));
            const float angf = (float)pos[t] * inv_freq;
            float sn, cs; sincos_acc((double)angf, sn, cs);
            ct[idx] = cs; st[idx] = sn;
        }
    }
}
__device__ __forceinline__ void norm_phase(const Frame& F0, const float* __restrict__ x, const float* __restrict__ g, const float* __restrict__ sc, const float* __restrict__ sh, bf16_t* __restrict__ h) {
    const Frame F = opaque(F0);
    f32x4 ga[4], gb[4];
#pragma unroll
    for (int j = 0; j < 4; ++j) { const f32x4 gg = ((const f32x4*)g)[F.lane + 64 * j], s1 = ((const f32x4*)sc)[F.lane + 64 * j]; ga[j] = gg * (s1 + 1.0f); gb[j] = ((const f32x4*)sh)[F.lane + 64 * j]; }
    const int gw = F.vcu * NWAVES + F.wave, NGW = F.G * NWAVES;
    for (int m = gw; m < S; m += NGW) {
        const f32x4* xr = (const f32x4*)(x + (size_t)m * D) + F.lane;
        f32x4 v[4]; float ss = 0.f;
#pragma unroll
        for (int j = 0; j < 4; ++j) { v[j] = xr[64 * j]; ss += (v[j].x * v[j].x + v[j].y * v[j].y) + (v[j].z * v[j].z + v[j].w * v[j].w); }
        const float r = 1.0f / sqrtf(wave_sum(ss) * (1.f / D) + EPS);
        u32x2* o8 = (u32x2*)(h + (size_t)m * D) + F.lane;
#pragma unroll
        for (int j = 0; j < 4; ++j) { const f32x4 y = v[j] * r * ga[j] + gb[j]; u32x2 w; w.x = cvtpk(y.x, y.y); w.y = cvtpk(y.z, y.w); o8[64 * j] = w; }
    }
}
__device__ __forceinline__ void glr_phase(const Frame& F0, const bf16_t* __restrict__ H, const bf16_t* __restrict__ WglrT, float* __restrict__ glr) {
    const Frame F = opaque(F0);
    if (F.wave >= 4) return;
    const int l15 = F.lane & 15, q = F.lane >> 4;
    for (int rb = F.vcu; rb < S / 64; rb += F.G) {
        const int row0 = rb * 64 + F.wave * 16;
        const bf16_t* ap = H + (size_t)(row0 + l15) * D + 8 * q;
        const bf16_t* bp = WglrT + (size_t)l15 * D + 8 * q;
        f32x4 acc = {0.f, 0.f, 0.f, 0.f};
#pragma unroll 8
        for (int ks = 0; ks < 32; ++ks) {
            const bf16x8 av = *(const bf16x8*)(ap + ks * 32), bv = *(const bf16x8*)(bp + ks * 32);
            acc = __builtin_amdgcn_mfma_f32_16x16x32_bf16(av, bv, acc, 0, 0, 0);
        }
#pragma unroll
        for (int r = 0; r < 4; ++r) glr[(size_t)(row0 + 4 * q + r) * 16 + l15] = acc[r];
    }
}
typedef short v4i16_t __attribute__((ext_vector_type(4)));
__device__ __forceinline__ s16x4 vtr(const LAS unsigned char* p) { return __builtin_bit_cast(s16x4, __builtin_amdgcn_ds_read_tr16_b64_v4i16((LAS v4i16_t*)p)); }
__device__ __forceinline__ int crow(int reg, int h) { return (reg & 3) + 8 * (reg >> 2) + 4 * h; }
__device__ __forceinline__ unsigned off_b(unsigned row, unsigned ch) { return 272u * row + 16u * ch; }
__device__ __forceinline__ unsigned tr_addr(unsigned lane, unsigned c, unsigned rowblk) {
    const unsigned blk = (lane >> 4) & 1, q = (lane & 15) >> 2, p = lane & 3;
    return off_b(rowblk + q, 4 * c + 2 * blk + (p >> 1)) + 8 * (p & 1);
}
constexpr int GL_IMG = 64 * 272, GL_PST = 144;
constexpr int GL_QD = 0, GL_KI = GL_IMG, GL_KT = 2 * GL_IMG, GL_V = 3 * GL_IMG, GL_P = 5 * GL_IMG, GL_GL = GL_P + 64 * GL_PST, GL_SEG = GL_GL + 4096, GL_DEC = GL_SEG + 2048, GL_RED = GL_DEC + 512;
static_assert(GL_RED + 2048 <= RING_BYTES, "gla lds");
#define MFMA32(a, b, c) __builtin_amdgcn_mfma_f32_32x32x16_bf16((a), (b), (c), 0, 0, 0)

struct GlaPre { f32x4 ga, gb; unsigned qk[16]; };
__device__ __forceinline__ void gla_prefetch_g(const Frame& F, const float* __restrict__ GLR, int t0, GlaPre& P) {
    const int ib = F.wave >> 2, l31 = F.lane & 31, h = F.lane >> 5;
    const float* gp = GLR + (size_t)(t0 + 32 * ib + l31) * 16 + 8 * h;
    P.ga = *(const f32x4*)gp; P.gb = *(const f32x4*)(gp + 4);
}
template <bool WITH_Q>
__device__ __forceinline__ void gla_prefetch(const Frame& F, const bf16_t* __restrict__ QKV, const float* __restrict__ GLR, int t0, int hd, GlaPre& P);
template <bool WITH_Q>
__device__ __forceinline__ void gla_prefetch_qk(const Frame& F, const bf16_t* __restrict__ QKV, int t0, int hd, GlaPre& P) {
    const int w = F.wave, ib = w >> 2, db = w & 3, l31 = F.lane & 31, h = F.lane >> 5;
#pragma unroll
    for (int r = 0; r < 16; ++r) {
        const bf16_t* row = QKV + (size_t)(t0 + 32 * ib + crow(r, h)) * 3072 + hd * 128 + 32 * db + l31;
        const unsigned kk = row[512]; const unsigned qq = WITH_Q ? (unsigned)row[0] : 0u;
        P.qk[r] = qq | (kk << 16);
    }
}
template <bool WITH_Q>
__device__ __forceinline__ void gla_prefetch(const Frame& F, const bf16_t* __restrict__ QKV, const float* __restrict__ GLR, int t0, int hd, GlaPre& P) {
    gla_prefetch_g(F, GLR, t0, P); gla_prefetch_qk<WITH_Q>(F, QKV, t0, hd, P);
}
struct GlaW { u32x4 bhi, blo; float bias; };
__device__ __forceinline__ void gla_load_w(const float* __restrict__ wupg, const float* __restrict__ bgg, int hd, const Frame& F, GlaW& W) {
    const int db = F.wave & 3, l31 = F.lane & 31, h = F.lane >> 5, d = hd * 128 + 32 * db + l31;
    float wv[8];
#pragma unroll
    for (int j = 0; j < 8; ++j) wv[j] = wupg[(8 * h + j) * 512 + d];
    W.bhi.x = cvtpk(wv[0], wv[1]); W.bhi.y = cvtpk(wv[2], wv[3]); W.bhi.z = cvtpk(wv[4], wv[5]); W.bhi.w = cvtpk(wv[6], wv[7]);
    W.blo.x = cvtpk(wv[0] - bflo(W.bhi.x), wv[1] - bfhi(W.bhi.x)); W.blo.y = cvtpk(wv[2] - bflo(W.bhi.y), wv[3] - bfhi(W.bhi.y));
    W.blo.z = cvtpk(wv[4] - bflo(W.bhi.z), wv[5] - bfhi(W.bhi.z)); W.blo.w = cvtpk(wv[6] - bflo(W.bhi.w), wv[7] - bfhi(W.bhi.w));
    W.bias = bgg[d];
}
template <bool WITH_Q>
__device__ __forceinline__ float gla_chunk_prep(const Frame& F, const GlaPre& P, const GlaW& W, const bf16_t* __restrict__ QKV, int t0, int hd) {
    LAS unsigned char* lds = F.lds;
    const int w = F.wave, ib = w >> 2, db = w & 3, l31 = F.lane & 31, h = F.lane >> 5, d = 32 * db + l31;
    u32x4 vv[4];
#pragma unroll
    for (int k = 0; k < 4; ++k) { const int c = F.tid + 512 * k, j = c >> 5, ch = c & 31; vv[k] = *(const u32x4*)(QKV + (size_t)(t0 + j) * 3072 + 1024 + hd * 256 + ch * 8); }
    u32x4 ahi, alo;
    ahi.x = cvtpk(P.ga.x, P.ga.y); ahi.y = cvtpk(P.ga.z, P.ga.w); ahi.z = cvtpk(P.gb.x, P.gb.y); ahi.w = cvtpk(P.gb.z, P.gb.w);
    alo.x = cvtpk(P.ga.x - bflo(ahi.x), P.ga.y - bfhi(ahi.x)); alo.y = cvtpk(P.ga.z - bflo(ahi.y), P.ga.w - bfhi(ahi.y));
    alo.z = cvtpk(P.gb.x - bflo(ahi.z), P.gb.y - bfhi(ahi.z)); alo.w = cvtpk(P.gb.z - bflo(ahi.w), P.gb.w - bfhi(ahi.w));
    f32x16 X;
#pragma unroll
    for (int r = 0; r < 16; ++r) X[r] = W.bias;
    X = MFMA32(__builtin_bit_cast(bf16x8, ahi), __builtin_bit_cast(bf16x8, W.bhi), X);
    X = MFMA32(__builtin_bit_cast(bf16x8, alo), __builtin_bit_cast(bf16x8, W.bhi), X);
    X = MFMA32(__builtin_bit_cast(bf16x8, ahi), __builtin_bit_cast(bf16x8, W.blo), X);
    float G[16], sk[4];
#pragma unroll
    for (int k = 0; k < 4; ++k) { float run = 0.f;
#pragma unroll
        for (int j = 0; j < 4; ++j) { const float x = X[4 * k + j]; const float ls = fminf(x, 0.f) - __logf(1.f + __expf(-fabsf(x))); run += ls * (1.f / 16.f); G[4 * k + j] = run; }
        sk[k] = run; }
    float base = 0.f, tot;
    {
        float ps[4];
#pragma unroll
        for (int k = 0; k < 4; ++k) ps[k] = __shfl_xor(sk[k], 32);
#pragma unroll
        for (int k = 0; k < 4; ++k) { const float bk = base + (h ? ps[k] : 0.f);
#pragma unroll
            for (int j = 0; j < 4; ++j) G[4 * k + j] += bk;
            base += sk[k] + ps[k]; }
        tot = base;
    }
    LAS float* HT = (LAS float*)(lds + GL_SEG);
    if (h == 0) HT[ib * 128 + d] = tot;
#pragma unroll
    for (int k = 0; k < 4; ++k) { const int c = F.tid + 512 * k, j = c >> 5, ch = c & 31; *(LAS u32x4*)(lds + GL_V + (ch >> 4) * GL_IMG + off_b(j, ch & 15)) = vv[k]; }
    __syncthreads();
    const float t0h = HT[d], t1h = HT[128 + d], glast = t0h + t1h;
    const float add = ib ? t0h : 0.f;
    const float qs = 0.08838834764831845f;
#pragma unroll
    for (int r = 0; r < 16; ++r) {
        const int i = 32 * ib + crow(r, h); const float Gv = G[r] + add;
        const unsigned a = off_b(i, d >> 3) + 2 * (d & 7);
        const float kf = bfhi(P.qk[r]);
        if (WITH_Q) {
            *(LAS unsigned short*)(lds + GL_QD + a) = (unsigned short)(cvtpk(bflo(P.qk[r]) * qs * __expf(Gv), 0.f) & 0xffffu);
            *(LAS unsigned short*)(lds + GL_KI + a) = (unsigned short)(cvtpk(kf * __expf(-Gv), 0.f) & 0xffffu);
        }
        *(LAS unsigned short*)(lds + GL_KT + a) = (unsigned short)(cvtpk(kf * __expf(glast - Gv), 0.f) & 0xffffu);
    }
    if (ib == 0 && h == 0) ((LAS float*)(lds + GL_DEC))[d] = __expf(glast);
    __syncthreads();
    return glast;
}
__device__ __forceinline__ void gla_state_update(const Frame& F, f32x16 (&St)[4]) {
    LAS unsigned char* lds = F.lds;
    const int h = F.lane >> 5, w = F.wave;
    const LAS float* dec = (const LAS float*)(lds + GL_DEC);
#pragma unroll
    for (int db = 0; db < 4; ++db)
#pragma unroll
        for (int r = 0; r < 16; ++r) St[db][r] *= dec[32 * db + crow(r, h)];
    const LAS unsigned char* vimg = lds + GL_V + (w >> 2) * GL_IMG;
#pragma unroll
    for (int ks = 0; ks < 4; ++ks) {
        const s16x4 vlo = vtr(vimg + tr_addr(F.lane, w & 3, 16 * ks + 8 * h)), vhi = vtr(vimg + tr_addr(F.lane, w & 3, 16 * ks + 8 * h + 4));
        const bf16x8 vb = __builtin_shufflevector(vlo, vhi, 0, 1, 2, 3, 4, 5, 6, 7);
#pragma unroll
        for (int db = 0; db < 4; ++db) {
            const s16x4 klo = vtr(lds + GL_KT + tr_addr(F.lane, db, 16 * ks + 8 * h)), khi = vtr(lds + GL_KT + tr_addr(F.lane, db, 16 * ks + 8 * h + 4));
            const bf16x8 ka = __builtin_shufflevector(klo, khi, 0, 1, 2, 3, 4, 5, 6, 7);
            St[db] = MFMA32(ka, vb, St[db]);
        }
    }
}
__device__ __forceinline__ void gla_g1(const Frame& F0, const bf16_t* __restrict__ QKV, const float* __restrict__ GLR, const float* __restrict__ wupg, const float* __restrict__ bgg, float* __restrict__ SBUF, float* __restrict__ DG) {
    const Frame F = opaque(F0);
    const int h = F.lane >> 5, w = F.wave;
    for (int u = F.vcu; u < 256; u += F.G) {
        const int gi = u >> 2, hd = u & 3;
        GlaW W; gla_load_w(wupg, bgg, hd, F, W);
        f32x16 St[4];
#pragma unroll
        for (int db = 0; db < 4; ++db)
#pragma unroll
            for (int r = 0; r < 16; ++r) St[db][r] = 0.f;
        float gsum = 0.f;
        GlaPre P; gla_prefetch<false>(F, QKV, GLR, gi * 256, hd, P);
#pragma unroll 1
        for (int c = 0; c < 4; ++c) {
            gsum += gla_chunk_prep<false>(F, P, W, QKV, gi * 256 + c * 64, hd);
            if (c < 3) gla_prefetch<false>(F, QKV, GLR, gi * 256 + (c + 1) * 64, hd, P);
            gla_state_update(F, St);
            __syncthreads();
        }
        float* sp = SBUF + ((size_t)u * 128) * 256 + 32 * w + (F.lane & 31);
#pragma unroll
        for (int db = 0; db < 4; ++db)
#pragma unroll
            for (int r = 0; r < 16; ++r) sp[(size_t)(32 * db + crow(r, h)) * 256] = St[db][r];
        if ((w >> 2) == 0 && h == 0) DG[u * 128 + 32 * (w & 3) + (F.lane & 31)] = __expf(gsum);
    }
}
__device__ __forceinline__ void gla_g2(const Frame& F0, float* __restrict__ SBUF, const float* __restrict__ DG) {
    const Frame F = opaque(F0);
    for (int e = F.vcu * NTHR + F.tid; e < 4 * 128 * 256; e += F.G * NTHR) {
        const int hd = e >> 15, d = (e >> 8) & 127;
        float run = 0.f;
#pragma unroll 1
        for (int g0 = 0; g0 < 64; g0 += 8) {
            float tmp[8], dec[8];
#pragma unroll
            for (int k = 0; k < 8; ++k) { const int g = g0 + k; tmp[k] = SBUF[(size_t)(g * 4 + hd) * 32768 + (e & 32767)]; dec[k] = DG[(g * 4 + hd) * 128 + d]; }
#pragma unroll
            for (int k = 0; k < 8; ++k) { const int g = g0 + k; SBUF[(size_t)(g * 4 + hd) * 32768 + (e & 32767)] = run; run = dec[k] * run + tmp[k]; }
        }
    }
}
__device__ __forceinline__ void gla_g3(const Frame& F0, const bf16_t* __restrict__ QKV, const float* __restrict__ GLR, const float* __restrict__ wupg, const float* __restrict__ bgg,
                                       const float* __restrict__ SBUF, const float* __restrict__ og, bf16_t* __restrict__ MIX) {
    const Frame F = opaque(F0);
    LAS unsigned char* lds = F.lds;
    const int h = F.lane >> 5, w = F.wave, l31 = F.lane & 31;
    for (int u = F.vcu; u < 256; u += F.G) {
        const int gi = u >> 2, hd = u & 3;
        GlaW W; gla_load_w(wupg, bgg, hd, F, W);
        f32x16 St[4];
        { const float* sp = SBUF + ((size_t)u * 128) * 256 + 32 * w + l31;
#pragma unroll
          for (int db = 0; db < 4; ++db)
#pragma unroll
              for (int r = 0; r < 16; ++r) St[db][r] = sp[(size_t)(32 * db + crow(r, h)) * 256]; }
#pragma unroll 1
        for (int c = 0; c < 4; ++c) {
            const int t0 = gi * 256 + c * 64;
            { GlaPre P; gla_prefetch<true>(F, QKV, GLR, t0, hd, P); (void)gla_chunk_prep<true>(F, P, W, QKV, t0, hd); }
            if (w < 3) {
                const int ib = (w >= 1), jb = (w == 2);
                f32x16 acc;
#pragma unroll
                for (int r = 0; r < 16; ++r) acc[r] = 0.f;
#pragma unroll
                for (int s = 0; s < 8; ++s) {
                    const bf16x8 a = *(const LAS bf16x8*)(lds + GL_QD + off_b(32 * ib + l31, 2 * s + h));
                    const bf16x8 b = *(const LAS bf16x8*)(lds + GL_KI + off_b(32 * jb + l31, 2 * s + h));
                    acc = MFMA32(a, b, acc);
                }
                const int jabs = 32 * jb + l31;
#pragma unroll
                for (int r = 0; r < 16; ++r) { const int iabs = 32 * ib + crow(r, h); const float pv = (jabs <= iabs) ? acc[r] : 0.f;
                    *(LAS unsigned short*)(lds + GL_P + iabs * GL_PST + 2 * jabs) = (unsigned short)(cvtpk(pv, 0.f) & 0xffffu); }
            }
            f32x16 oT[2];
#pragma unroll
            for (int ib = 0; ib < 2; ++ib)
#pragma unroll
                for (int r = 0; r < 16; ++r) oT[ib][r] = 0.f;
#pragma unroll
            for (int db = 0; db < 4; ++db)
#pragma unroll
                for (int s = 0; s < 2; ++s) {
                    u32x4 pk; pk.x = cvtpk(St[db][8 * s + 0], St[db][8 * s + 1]); pk.y = cvtpk(St[db][8 * s + 2], St[db][8 * s + 3]); pk.z = cvtpk(St[db][8 * s + 4], St[db][8 * s + 5]); pk.w = cvtpk(St[db][8 * s + 6], St[db][8 * s + 7]);
                    const bf16x8 xa = __builtin_bit_cast(bf16x8, pk);
#pragma unroll
                    for (int ib = 0; ib < 2; ++ib) {
                        const u32x2 qlo = *(const LAS u32x2*)(lds + GL_QD + off_b(32 * ib + l31, 4 * db + 2 * s + 0) + 8 * h);
                        const u32x2 qhi = *(const LAS u32x2*)(lds + GL_QD + off_b(32 * ib + l31, 4 * db + 2 * s + 1) + 8 * h);
                        u32x4 qq; qq.x = qlo.x; qq.y = qlo.y; qq.z = qhi.x; qq.w = qhi.y;
                        oT[ib] = MFMA32(xa, __builtin_bit_cast(bf16x8, qq), oT[ib]);
                    }
                }
            __syncthreads();
            {
                const LAS unsigned char* vimg = lds + GL_V + (w >> 2) * GL_IMG;
#pragma unroll
                for (int ks = 0; ks < 4; ++ks) {
                    const s16x4 vlo = vtr(vimg + tr_addr(F.lane, w & 3, 16 * ks + 8 * h)), vhi = vtr(vimg + tr_addr(F.lane, w & 3, 16 * ks + 8 * h + 4));
                    const bf16x8 va = __builtin_shufflevector(vlo, vhi, 0, 1, 2, 3, 4, 5, 6, 7);
#pragma unroll
                    for (int ib = 0; ib < 2; ++ib) {
                        if (ib == 0 && ks >= 2) continue;
                        const int irow = 32 * ib + l31;
                        const bf16x8 pb = *(const LAS bf16x8*)(lds + GL_P + irow * GL_PST + 16 * (2 * ks + h));
                        oT[ib] = MFMA32(va, pb, oT[ib]);
                    }
                }
            }
            float ssq[2];
#pragma unroll
            for (int ib = 0; ib < 2; ++ib) { float s = 0.f;
#pragma unroll
                for (int r = 0; r < 16; ++r) s += oT[ib][r] * oT[ib][r];
                s += __shfl_xor(s, 32); ssq[ib] = s; }
            if (h == 0) { ((LAS float*)(lds + GL_RED))[w * 64 + l31] = ssq[0]; ((LAS float*)(lds + GL_RED))[w * 64 + 32 + l31] = ssq[1]; }
            __syncthreads();
#pragma unroll
            for (int ib = 0; ib < 2; ++ib) {
                float tot = 0.f;
#pragma unroll
                for (int ww = 0; ww < 8; ++ww) tot += ((LAS float*)(lds + GL_RED))[ww * 64 + 32 * ib + l31];
                const float rn = 1.0f / sqrtf(tot * (1.f / 256.f) + EPS);
                const int t = t0 + 32 * ib + l31;
#pragma unroll
                for (int g = 0; g < 4; ++g) {
                    const int e0 = 32 * w + 8 * g + 4 * h;
                    const u32x2 rg = *(const u32x2*)(QKV + (size_t)t * 3072 + 2048 + hd * 256 + e0);
                    const f32x4 ogv = *(const f32x4*)(og + e0);
                    const float r0 = bflo(rg.x), r1 = bfhi(rg.x), r2 = bflo(rg.y), r3 = bfhi(rg.y);
                    const float y0 = oT[ib][4 * g + 0] * rn * ogv.x * (r0 / (1.f + __expf(-r0)));
                    const float y1 = oT[ib][4 * g + 1] * rn * ogv.y * (r1 / (1.f + __expf(-r1)));
                    const float y2 = oT[ib][4 * g + 2] * rn * ogv.z * (r2 / (1.f + __expf(-r2)));
                    const float y3 = oT[ib][4 * g + 3] * rn * ogv.w * (r3 / (1.f + __expf(-r3)));
                    u32x2 o; o.x = cvtpk(y0, y1); o.y = cvtpk(y2, y3);
                    *(u32x2*)(MIX + (size_t)t * D + hd * 256 + e0) = o;
                }
            }
            if (c < 3) gla_state_update(F, St);
            __syncthreads();
        }
    }
}
constexpr int MB_LIST_H = 516096;
__device__ __forceinline__ int mb_list_off(int n) { return 256 * (63 * n - (n * (n - 1)) / 2); }
constexpr int MB_OST = 2 * 128 * 256, MB_OSTW = 32 * 264;
constexpr int MB_PRE = MB_OST + 8 * MB_OSTW, MB_END = MB_PRE + 2064;
static_assert(MB_END <= MISC_OFF, "moba lds");

__device__ __forceinline__ void moba_m1(const Frame& F0, bf16_t* __restrict__ QKV, const float* __restrict__ COS, const float* __restrict__ SIN,
                                        const float* __restrict__ qg, const float* __restrict__ kg, float* __restrict__ KMEAN) {
    const Frame F = opaque(F0);
    LAS unsigned char* lds = F.lds;
    const int hh = F.lane >> 3, j = F.lane & 7;
    for (int u = F.vcu; u < 512; u += F.G) {
        const int which = (u >= 256), n = (u & 255) >> 2, part = u & 3;
        const int tbase = n * 256 + part * 64, cnt = 64;
        const float* g = which ? kg : qg;
        const float gsc = which ? 1.0f : (0.08838834764831845f * 1.4426950408889634f);
        float g1[8], g2[8], a1[8], a2[8];
#pragma unroll
        for (int e = 0; e < 8; ++e) { g1[e] = g[8 * j + e] * gsc; g2[e] = g[64 + 8 * j + e] * gsc; a1[e] = 0.f; a2[e] = 0.f; }
#pragma unroll 4
        for (int it = F.wave; it < cnt; it += NWAVES) {
            const int t = tbase + it;
            bf16_t* p = QKV + (size_t)t * 3072 + which * 1024 + hh * 128 + 8 * j;
            const u32x4 ra = *(const u32x4*)p, rb = *(const u32x4*)(p + 64);
            const f32x4 c0 = *(const f32x4*)(COS + (size_t)t * 64 + 8 * j), c1 = *(const f32x4*)(COS + (size_t)t * 64 + 8 * j + 4);
            const f32x4 s0 = *(const f32x4*)(SIN + (size_t)t * 64 + 8 * j), s1 = *(const f32x4*)(SIN + (size_t)t * 64 + 8 * j + 4);
            float x1[8] = {bflo(ra.x), bfhi(ra.x), bflo(ra.y), bfhi(ra.y), bflo(ra.z), bfhi(ra.z), bflo(ra.w), bfhi(ra.w)};
            float x2[8] = {bflo(rb.x), bfhi(rb.x), bflo(rb.y), bfhi(rb.y), bflo(rb.z), bfhi(rb.z), bflo(rb.w), bfhi(rb.w)};
            const float cs[8] = {c0.x, c0.y, c0.z, c0.w, c1.x, c1.y, c1.z, c1.w};
            const float sn[8] = {s0.x, s0.y, s0.z, s0.w, s1.x, s1.y, s1.z, s1.w};
            float ss = 0.f;
#pragma unroll
            for (int e = 0; e < 8; ++e) ss += x1[e] * x1[e] + x2[e] * x2[e];
            ss += __shfl_xor(ss, 1); ss += __shfl_xor(ss, 2); ss += __shfl_xor(ss, 4);
            const float r = 1.0f / sqrtf(ss * (1.f / 128.f) + EPS);
            float o1[8], o2[8];
#pragma unroll
            for (int e = 0; e < 8; ++e) { const float y1 = x1[e] * r * g1[e], y2 = x2[e] * r * g2[e]; o1[e] = y1 * cs[e] - y2 * sn[e]; o2[e] = y2 * cs[e] + y1 * sn[e]; a1[e] += o1[e]; a2[e] += o2[e]; }
            u32x4 wa, wb;
            wa.x = cvtpk(o1[0], o1[1]); wa.y = cvtpk(o1[2], o1[3]); wa.z = cvtpk(o1[4], o1[5]); wa.w = cvtpk(o1[6], o1[7]);
            wb.x = cvtpk(o2[0], o2[1]); wb.y = cvtpk(o2[2], o2[3]); wb.z = cvtpk(o2[4], o2[5]); wb.w = cvtpk(o2[6], o2[7]);
            *(u32x4*)p = wa; *(u32x4*)(p + 64) = wb;
        }
        if (which) {
            LAS float* red = (LAS float*)lds;
#pragma unroll
            for (int e = 0; e < 8; ++e) { red[(F.wave * 64 + F.lane) * 16 + e] = a1[e]; red[(F.wave * 64 + F.lane) * 16 + 8 + e] = a2[e]; }
            __syncthreads();
#pragma unroll
            for (int k = 0; k < 2; ++k) {
                const int o = F.tid * 2 + k, head = o >> 7, d = o & 127;
                const int ln = head * 8 + ((d & 63) >> 3), slot = (d >> 6) * 8 + (d & 7);
                float s = 0.f;
#pragma unroll
                for (int w = 0; w < 8; ++w) s += red[(w * 64 + ln) * 16 + slot];
                KMEAN[(((size_t)part * 8 + head) * 64 + n) * 128 + d] = s * (1.f / 256.f);
            }
            __syncthreads();
        }
    }
}
#define MB_INS(v, i) do { const float v_ = (v); const int i_ = (i); \
    const bool b0_ = v_ > v0 || (v_ == v0 && i_ < i0), b1_ = v_ > v1 || (v_ == v1 && i_ < i1), b2_ = v_ > v2 || (v_ == v2 && i_ < i2); \
    if (b0_) { v2 = v1; i2 = i1; v1 = v0; i1 = i0; v0 = v_; i0 = i_; } else if (b1_) { v2 = v1; i2 = i1; v1 = v_; i1 = i_; } else if (b2_) { v2 = v_; i2 = i_; } } while (0)
__device__ __forceinline__ void moba_m2(const Frame& F0, const bf16_t* __restrict__ QKV, const float* __restrict__ KMEAN, unsigned* __restrict__ gcnt, int* __restrict__ LIST) {
    const Frame F = opaque(F0);
    LAS unsigned char* lds = F.lds;
    LAS int* cntl = (LAS int*)lds;
    LAS float* kml = (LAS float*)(lds + 1024);
    const int h2 = F.lane >> 5, l31 = F.lane & 31, w = F.wave;
    for (int u = F.vcu; u < 512; u += F.G) {
        const int b = u >> 3, h = u & 7;
        if (b == 0) continue;
        if (F.tid < 64) cntl[F.tid] = 0;
#pragma unroll
        for (int k = 0; k < 4; ++k) { const int idx = F.tid + 512 * k, nr = idx >> 5, c4 = (idx & 31) * 4;
            if (nr < b) { const float* src = KMEAN + ((size_t)h * 64 + nr) * 128 + c4;
                const f32x4 v = (*(const f32x4*)src + *(const f32x4*)(src + 8 * 64 * 128)) + (*(const f32x4*)(src + 2 * 8 * 64 * 128) + *(const f32x4*)(src + 3 * 8 * 64 * 128));
                *(LAS f32x4*)(kml + nr * 132 + c4) = v; } }
        __syncthreads();
        const int t = b * 256 + 32 * w + l31;
        bf16x8 qf[8];
#pragma unroll
        for (int s = 0; s < 8; ++s) qf[s] = *(const bf16x8*)(QKV + (size_t)t * 3072 + h * 128 + 16 * s + 8 * h2);
        float v0 = -INFINITY, v1 = -INFINITY, v2 = -INFINITY; int i0 = 64, i1 = 64, i2 = 64;
#pragma unroll
        for (int nb = 0; nb < 2; ++nb) {
            if (nb == 1 && b <= 32) continue;
            f32x16 acc;
#pragma unroll
            for (int r = 0; r < 16; ++r) acc[r] = 0.f;
            const LAS float* kmp = kml + (32 * nb + l31) * 132 + 8 * h2;
#pragma unroll
            for (int s = 0; s < 8; ++s) {
                const f32x4 ka = *(const LAS f32x4*)(kmp + 16 * s), kb = *(const LAS f32x4*)(kmp + 16 * s + 4);
                u32x4 hi; hi.x = cvtpk(ka.x, ka.y); hi.y = cvtpk(ka.z, ka.w); hi.z = cvtpk(kb.x, kb.y); hi.w = cvtpk(kb.z, kb.w);
                u32x4 lo; lo.x = cvtpk(ka.x - bflo(hi.x), ka.y - bfhi(hi.x)); lo.y = cvtpk(ka.z - bflo(hi.y), ka.w - bfhi(hi.y));
                lo.z = cvtpk(kb.x - bflo(hi.z), kb.y - bfhi(hi.z)); lo.w = cvtpk(kb.z - bflo(hi.w), kb.w - bfhi(hi.w));
                acc = MFMA32(__builtin_bit_cast(bf16x8, hi), qf[s], acc);
                acc = MFMA32(__builtin_bit_cast(bf16x8, lo), qf[s], acc);
            }
#pragma unroll
            for (int r = 0; r < 16; ++r) { const int n = 32 * nb + crow(r, h2); const float gv = (n < b) ? acc[r] : -INFINITY; MB_INS(gv, n); }
        }
        { const float p0 = __shfl_xor(v0, 32), p1 = __shfl_xor(v1, 32), p2 = __shfl_xor(v2, 32); const int q0 = __shfl_xor(i0, 32), q1 = __shfl_xor(i1, 32), q2 = __shfl_xor(i2, 32);
          MB_INS(p0, q0); MB_INS(p1, q1); MB_INS(p2, q2); }
        int pos0 = 0, pos1 = 0, pos2 = 0;
        const bool e0 = (h2 == 0) && (v0 > -INFINITY), e1 = (h2 == 0) && (v1 > -INFINITY), e2 = (h2 == 0) && (v2 > -INFINITY);
        if (e0) pos0 = __hip_atomic_fetch_add(cntl + i0, 1, __ATOMIC_RELAXED, __HIP_MEMORY_SCOPE_WORKGROUP);
        if (e1) pos1 = __hip_atomic_fetch_add(cntl + i1, 1, __ATOMIC_RELAXED, __HIP_MEMORY_SCOPE_WORKGROUP);
        if (e2) pos2 = __hip_atomic_fetch_add(cntl + i2, 1, __ATOMIC_RELAXED, __HIP_MEMORY_SCOPE_WORKGROUP);
        __syncthreads();
        if (F.tid < 64) { const int c = cntl[F.tid]; int base = 0; if (c > 0) base = (int)__hip_atomic_fetch_add(gcnt + h * 64 + F.tid, (unsigned)c, __ATOMIC_RELAXED, __HIP_MEMORY_SCOPE_AGENT); cntl[64 + F.tid] = base; }
        __syncthreads();
        int* lst = LIST + (size_t)h * MB_LIST_H;
        if (e0) lst[mb_list_off(i0) + cntl[64 + i0] + pos0] = (t << 2) | 0;
        if (e1) lst[mb_list_off(i1) + cntl[64 + i1] + pos1] = (t << 2) | 1;
        if (e2) lst[mb_list_off(i2) + cntl[64 + i2] + pos2] = (t << 2) | 2;
        __syncthreads();
    }
}
constexpr int MB_HALF = 128 * 256;
__device__ __forceinline__ unsigned off_x(unsigned row, unsigned ch) { return 256u * row + 16u * (ch ^ (((row & 3) << 2) | ((row >> 2) & 3))); }
__device__ __forceinline__ void mb_decode(int v, const LAS int* pre, const unsigned* __restrict__ gcnt, int& h, int& n, int& count, int& lbase, bool& own) {
    if (v < 512) { n = v >> 3; h = v & 7; count = 256; lbase = 0; own = true; return; }
    const int x = v - 512; int lo_ = 0, hi_ = 511;
    while (lo_ < hi_) { const int mid = (lo_ + hi_) >> 1; if (pre[mid] > x) hi_ = mid; else lo_ = mid + 1; }
    const int hn = lo_; h = hn >> 6; n = hn & 63;
    const int tile = x - (hn ? pre[hn - 1] : 0);
    count = (int)gcnt[hn] - tile * 256; if (count > 256) count = 256;
    lbase = h * MB_LIST_H + mb_list_off(n) + tile * 256; own = false;
}
#define MB_STAGE(hh_, nn_, hf_, buf_) do { _Pragma("unroll") for (int k_ = 0; k_ < 4; ++k_) { const int pc_ = w * 4 + k_;               \
        const int r_ = 4 * pc_ + (F.lane >> 4); const int ch_ = (F.lane & 15) ^ (((r_ & 3) << 2) | ((r_ >> 2) & 3)); \
        const bf16_t* src_ = QKV + (size_t)((nn_) * 256 + (hf_) * 128 + r_) * 3072 + 1024 + (hh_) * 128 + 8 * ch_; \
        __builtin_amdgcn_global_load_lds((const unsigned*)src_, (LAS unsigned*)(lds + (buf_) * 2 * MB_HALF + pc_ * 1024), 16, 0, 0); \
        __builtin_amdgcn_global_load_lds((const unsigned*)(src_ + 1024), (LAS unsigned*)(lds + (buf_) * 2 * MB_HALF + MB_HALF + pc_ * 1024), 16, 0, 0); } } while (0)
#define MB_VMWAIT() asm volatile("s_waitcnt vmcnt(0)" ::: "memory")
#define MB_ENT(entv_, own_, nn_, cnt_, lb_) do { const int qi_ = 32 * w + l31; \
        if (own_) entv_ = (((nn_) * 256 + qi_) << 2) | 3; else entv_ = (qi_ < (cnt_)) ? LIST[(lb_) + qi_] : -1; } while (0)
#define MB_GATHER(entv_, qv_, nn_, hh_) do { \
        const int tq_ = (entv_ >= 0) ? (entv_ >> 2) : ((nn_) * 256); \
        _Pragma("unroll") for (int s_ = 0; s_ < 8; ++s_) qv_[s_] = *(const bf16x8*)(QKV + (size_t)tq_ * 3072 + (hh_) * 128 + 16 * s_ + 8 * h2); } while (0)
#define MB_COMPUTE(buf_, hf_, nkt_, own_) do { \
        const LAS unsigned char* kb_ = lds + (buf_) * 2 * MB_HALF + 256 * l31; \
        const LAS unsigned char* vb_ = lds + (buf_) * 2 * MB_HALF + MB_HALF + 256 * (4 * h2 + vq) + 8 * (vp & 1); \
        _Pragma("unroll 1") for (int kt_ = 0; kt_ < (nkt_); ++kt_) { \
            bf16x8 ka_[4]; \
            _Pragma("unroll") for (int s_ = 0; s_ < 4; ++s_) ka_[s_] = *(const LAS bf16x8*)(kb_ + kt_ * (32 * 256) + 16 * ((2 * s_ + h2) ^ fK)); \
            f32x16 acc_; _Pragma("unroll") for (int r_ = 0; r_ < 16; ++r_) acc_[r_] = 0.f; \
            _Pragma("unroll") for (int s_ = 0; s_ < 4; ++s_) acc_ = MFMA32(ka_[s_], qf[s_], acc_); \
            _Pragma("unroll") for (int s_ = 0; s_ < 4; ++s_) ka_[s_] = *(const LAS bf16x8*)(kb_ + kt_ * (32 * 256) + 16 * ((2 * (s_ + 4) + h2) ^ fK)); \
            _Pragma("unroll") for (int s_ = 0; s_ < 4; ++s_) acc_ = MFMA32(ka_[s_], qf[s_ + 4], acc_); \
            s16x4 vl0_[4], vh0_[4]; \
            _Pragma("unroll") for (int db_ = 0; db_ < 4; ++db_) { const LAS unsigned char* vp_ = vb_ + (kt_ * 32) * 256 + 64 * (db_ ^ vq); \
                vl0_[db_] = vtr(vp_ + 16 * (vj ^ h2)); vh0_[db_] = vtr(vp_ + 8 * 256 + 16 * (vj ^ (2 + h2))); } \
            float pr_[16]; \
            _Pragma("unroll") for (int r_ = 0; r_ < 16; ++r_) { float p_ = __builtin_amdgcn_exp2f(acc_[r_]); if ((own_) && (128 * (hf_) + 32 * kt_ + crow(r_, h2) > 32 * w + l31)) p_ = 0.f; pr_[r_] = p_; lsum += p_; } \
            { u32x4 pk_; pk_.x = cvtpk(pr_[0], pr_[1]); pk_.y = cvtpk(pr_[2], pr_[3]); pk_.z = cvtpk(pr_[4], pr_[5]); pk_.w = cvtpk(pr_[6], pr_[7]); \
              const bf16x8 pb_ = __builtin_bit_cast(bf16x8, pk_); \
              _Pragma("unroll") for (int db_ = 0; db_ < 4; ++db_) O[db_] = MFMA32(__builtin_shufflevector(vl0_[db_], vh0_[db_], 0, 1, 2, 3, 4, 5, 6, 7), pb_, O[db_]); } \
            _Pragma("unroll") for (int db_ = 0; db_ < 4; ++db_) { const LAS unsigned char* vp_ = vb_ + (kt_ * 32 + 16) * 256 + 64 * (db_ ^ vq); \
                vl0_[db_] = vtr(vp_ + 16 * (vj ^ h2)); vh0_[db_] = vtr(vp_ + 8 * 256 + 16 * (vj ^ (2 + h2))); } \
            { u32x4 pk_; pk_.x = cvtpk(pr_[8], pr_[9]); pk_.y = cvtpk(pr_[10], pr_[11]); pk_.z = cvtpk(pr_[12], pr_[13]); pk_.w = cvtpk(pr_[14], pr_[15]); \
              const bf16x8 pb_ = __builtin_bit_cast(bf16x8, pk_); \
              _Pragma("unroll") for (int db_ = 0; db_ < 4; ++db_) O[db_] = MFMA32(__builtin_shufflevector(vl0_[db_], vh0_[db_], 0, 1, 2, 3, 4, 5, 6, 7), pb_, O[db_]); } } } while (0)
__device__ __forceinline__ void moba_m3(const Frame& F0, const bf16_t* __restrict__ QKV, const unsigned* __restrict__ gcnt, const int* __restrict__ LIST,
                                        bf16_t* __restrict__ OPART01, bf16_t* __restrict__ OPART2, bf16_t* __restrict__ MIX, float* __restrict__ LPART) {
    const Frame F = opaque(F0);
    LAS unsigned char* lds = F.lds;
    LAS int* pre = (LAS int*)(lds + MB_PRE);
    const int h2 = F.lane >> 5, l31 = F.lane & 31, w = F.wave;
    const int fK = ((l31 & 3) << 2) | ((l31 >> 2) & 3);
    const int vq = (F.lane & 15) >> 2, vp = F.lane & 3, vj = 2 * ((F.lane >> 4) & 1) + (vp >> 1);
    { int v = ((int)gcnt[F.tid] + 255) >> 8; pre[F.tid] = v; __syncthreads();
#pragma unroll 1
      for (int o = 1; o < 512; o <<= 1) { const int add = (F.tid >= o) ? pre[F.tid - o] : 0; __syncthreads(); pre[F.tid] += add; __syncthreads(); } }
    const int total = 512 + pre[511];
    const int n_units = (total - F.vcu + F.G - 1) / F.G;
    if (n_units == 0) return;
#define MB_UNIT_V(it_) (F.vcu + (it_) * F.G)
    int h, n, count, lbase; bool own;
    mb_decode(MB_UNIT_V(0), pre, gcnt, h, n, count, lbase, own);
    int ent; bf16x8 qf[8];
    MB_ENT(ent, own, n, count, lbase);
    MB_GATHER(ent, qf, n, h);
    MB_STAGE(h, n, 0, 0);
    MB_VMWAIT();
    __syncthreads();
#pragma unroll 1
    for (int it = 0; it < n_units; ++it) {
        f32x16 O[4];
#pragma unroll
        for (int db = 0; db < 4; ++db)
#pragma unroll
            for (int r = 0; r < 16; ++r) O[db][r] = 0.f;
        float lsum = 0.f;
        MB_STAGE(h, n, 1, 1);
        { const int nkt = own ? ((w + 1 < 4) ? (w + 1) : 4) : 4; MB_COMPUTE(0, 0, nkt, own); }
        const bool more = (it + 1 < n_units);
        int h_n = h, n_n = n, count_n = count, lbase_n = lbase; bool own_n = own;
        int ent_n = -1;
        if (more) { mb_decode(MB_UNIT_V(it + 1), pre, gcnt, h_n, n_n, count_n, lbase_n, own_n); MB_ENT(ent_n, own_n, n_n, count_n, lbase_n); }
        MB_VMWAIT();
        __syncthreads();
        if (more) MB_STAGE(h_n, n_n, 0, 0);
        { const int nkt = own ? ((w >= 4) ? (w - 3) : 0) : 4; MB_COMPUTE(1, 1, nkt, own); }
        const int ent_c = ent, h_c = h;
        if (more) MB_GATHER(ent_n, qf, n_n, h_n);
        lsum += __shfl_xor(lsum, 32);
        if (ent_c >= 0 && h2 == 0) LPART[((size_t)(ent_c & 3) * S + (ent_c >> 2)) * 8 + h_c] = lsum;
        __syncthreads();
        {
            LAS unsigned char* ost = lds + MB_OST + w * MB_OSTW;
#pragma unroll
            for (int db = 0; db < 4; ++db)
#pragma unroll
                for (int g = 0; g < 4; ++g) { u32x2 o; o.x = cvtpk(O[db][4 * g + 0], O[db][4 * g + 1]); o.y = cvtpk(O[db][4 * g + 2], O[db][4 * g + 3]);
                    *(LAS u32x2*)(ost + l31 * 264 + 2 * (32 * db + 8 * g + 4 * h2)) = o; }
            asm volatile("s_waitcnt lgkmcnt(0)" ::: "memory");
#pragma unroll
            for (int i = 0; i < 8; ++i) {
                const int row = 4 * i + (F.lane >> 4), ch = F.lane & 15;
                const int er = __shfl(ent_c, row);
                const u32x4 v = *(const LAS u32x4*)(ost + row * 264 + 16 * ch);
                if (er >= 0) { const int sl = er & 3, tq = er >> 2;
                    bf16_t* dst = ((sl == 3) ? (MIX + (size_t)tq * D) : (sl == 2) ? (OPART2 + (size_t)tq * D) : (OPART01 + ((size_t)sl * S + tq) * D)) + h_c * 128 + 8 * ch;
                    *(u32x4*)dst = v; }
            }
        }
        if (more) { h = h_n; n = n_n; count = count_n; lbase = lbase_n; own = own_n; ent = ent_n; }
        MB_VMWAIT();
        __syncthreads();
    }
#undef MB_UNIT_V
}
__device__ __forceinline__ void moba_m4(const Frame& F0, const bf16_t* __restrict__ OPART01, const bf16_t* __restrict__ OPART2, const float* __restrict__ LPART, bf16_t* __restrict__ MIX) {
    const Frame F = opaque(F0);
    for (int it = F.vcu * NTHR + F.tid; it < S * 128; it += F.G * NTHR) {
        const int t = it >> 7, c8 = it & 127, h = c8 >> 4;
        const int nsel = (t >> 8) < 3 ? (t >> 8) : 3;
        const u32x4 m = *(const u32x4*)(MIX + (size_t)t * D + c8 * 8);
        float o[8] = {bflo(m.x), bfhi(m.x), bflo(m.y), bfhi(m.y), bflo(m.z), bfhi(m.z), bflo(m.w), bfhi(m.w)};
        float l = LPART[((size_t)3 * S + t) * 8 + h];
#pragma unroll
        for (int sl = 0; sl < 3; ++sl) {
            if (sl < nsel) {
                const u32x4 p = *(const u32x4*)(((sl == 2) ? (OPART2 + (size_t)t * D) : (OPART01 + ((size_t)sl * S + t) * D)) + c8 * 8);
                o[0] += bflo(p.x); o[1] += bfhi(p.x); o[2] += bflo(p.y); o[3] += bfhi(p.y); o[4] += bflo(p.z); o[5] += bfhi(p.z); o[6] += bflo(p.w); o[7] += bfhi(p.w);
                l += LPART[((size_t)sl * S + t) * 8 + h];
            }
        }
        const float inv = 1.f / l;
        u32x4 r; r.x = cvtpk(o[0] * inv, o[1] * inv); r.y = cvtpk(o[2] * inv, o[3] * inv); r.z = cvtpk(o[4] * inv, o[5] * inv); r.w = cvtpk(o[6] * inv, o[7] * inv);
        *(u32x4*)(MIX + (size_t)t * D + c8 * 8) = r;
    }
}
__device__ __forceinline__ float wave_max(float v) {
#pragma unroll
    for (int o = 1; o < 64; o <<= 1) v = fmaxf(v, __shfl_xor(v, o));
    return v;
}
__device__ __forceinline__ float logsigmoid_f(float x) { return fminf(x, 0.f) - log1pf(expf(-fabsf(x))); }
__global__ void nk_gla_gate(const float* __restrict__ glr, const float* __restrict__ wup, const float* __restrict__ bg, float* __restrict__ g) {
    const size_t idx = (size_t)blockIdx.x * blockDim.x + threadIdx.x;
    const int t = (int)(idx >> 9), j = (int)(idx & 511);
    float acc = bg[j];
#pragma unroll
    for (int r = 0; r < 16; ++r) acc += glr[(size_t)t * 16 + r] * wup[r * 512 + j];
    g[idx] = logsigmoid_f(acc) * (1.f / 16.f);
}
__global__ __launch_bounds__(256) void nk_gla_recur(const bf16_t* __restrict__ qkv, const float* __restrict__ g, float* __restrict__ o) {
    __shared__ float sq[16][128], sk[16][128], sa[16][128];
    const int h = blockIdx.x, tid = threadIdx.x;
    float St[128];
#pragma unroll
    for (int d = 0; d < 128; ++d) St[d] = 0.f;
    const float qs = 0.08838834764831845f;
    for (int t0 = 0; t0 < S; t0 += 16) {
        float vv[16];
#pragma unroll
        for (int tt = 0; tt < 16; ++tt) vv[tt] = bf2f(qkv[(size_t)(t0 + tt) * 3072 + 1024 + h * 256 + tid]);
#pragma unroll
        for (int i = 0; i < 8; ++i) {
            const int e = tid + i * 256, tok = e >> 7, d = e & 127;
            const bf16_t* row = qkv + (size_t)(t0 + tok) * 3072;
            sq[tok][d] = bf2f(row[h * 128 + d]) * qs;
            sk[tok][d] = bf2f(row[512 + h * 128 + d]);
            sa[tok][d] = expf(g[(size_t)(t0 + tok) * 512 + h * 128 + d]);
        }
        __syncthreads();
#pragma unroll 1
        for (int tt = 0; tt < 16; ++tt) {
            const float v = vv[0];
#pragma unroll
            for (int i = 0; i < 15; ++i) vv[i] = vv[i + 1];
            float acc = 0.f;
#pragma unroll
            for (int d = 0; d < 128; ++d) { St[d] = sa[tt][d] * St[d] + sk[tt][d] * v; acc += sq[tt][d] * St[d]; }
            o[(size_t)(t0 + tt) * D + h * 256 + tid] = acc;
        }
        __syncthreads();
    }
}
__global__ __launch_bounds__(256) void nk_gla_post(const float* __restrict__ o, const bf16_t* __restrict__ qkv, const float* __restrict__ og, bf16_t* __restrict__ mix) {
    const int w = blockIdx.x * 4 + (threadIdx.x >> 6), lane = threadIdx.x & 63;
    const int t = w >> 2, h = w & 3;
    f32x4 v = *(const f32x4*)(o + (size_t)t * D + h * 256 + lane * 4);
    const float ss = wave_sum(v.x * v.x + v.y * v.y + v.z * v.z + v.w * v.w);
    const float r = 1.0f / sqrtf(ss * (1.f / 256.f) + EPS);
    const f32x4 gg = *(const f32x4*)(og + lane * 4);
    const bf16_t* rp = qkv + (size_t)t * 3072 + 2048 + h * 256 + lane * 4;
    bf16_t* mp = mix + (size_t)t * D + h * 256 + lane * 4;
#pragma unroll
    for (int e = 0; e < 4; ++e) { const float rr = bf2f(rp[e]); const float y = v[e] * r * gg[e] * (rr / (1.f + expf(-rr))); mp[e] = (bf16_t)(cvtpk(y, 0.f) & 0xffffu); }
}
__global__ __launch_bounds__(256) void nk_moba_qk(bf16_t* __restrict__ qkv, const int* __restrict__ pos, const float* __restrict__ qg, const float* __restrict__ kg) {
    const int w = blockIdx.x * 4 + (threadIdx.x >> 6), lane = threadIdx.x & 63;
    const int t = w >> 4, which = (w >> 3) & 1, h = w & 7;
    bf16_t* p = qkv + (size_t)t * 3072 + which * 1024 + h * 128;
    const float* g = which ? kg : qg;
    float t1 = bf2f(p[lane]), t2 = bf2f(p[lane + 64]);
    const float ss = wave_sum(t1 * t1 + t2 * t2);
    const float r = 1.0f / sqrtf(ss * (1.f / 128.f) + EPS);
    t1 = t1 * r * g[lane]; t2 = t2 * r * g[lane + 64];
    const float inv_freq = (float)exp2(-(double)lane * (13.287712379549449 / 64.0));
    const float angf = (float)pos[t] * inv_freq;
    float cs, sn; sincos_acc((double)angf, sn, cs);
    p[lane] = (bf16_t)(cvtpk(t1 * cs - t2 * sn, 0.f) & 0xffffu);
    p[lane + 64] = (bf16_t)(cvtpk(t2 * cs + t1 * sn, 0.f) & 0xffffu);
}
__global__ __launch_bounds__(128) void nk_moba_kmean(const bf16_t* __restrict__ qkv, float* __restrict__ kmean) {
    const int h = blockIdx.x >> 6, n = blockIdx.x & 63, d = threadIdx.x;
    float acc = 0.f;
    for (int j = 0; j < 256; ++j) acc += bf2f(qkv[(size_t)(n * 256 + j) * 3072 + 1024 + h * 128 + d]);
    kmean[(size_t)blockIdx.x * 128 + d] = acc * (1.f / 256.f);
}
__global__ __launch_bounds__(64) void nk_moba_attn(const bf16_t* __restrict__ qkv, const float* __restrict__ kmean, bf16_t* __restrict__ out) {
    __shared__ float sq[128];
    __shared__ float sp[1024];
    __shared__ int skey[1024];
    const int t = blockIdx.x >> 3, h = blockIdx.x & 7, lane = threadIdx.x;
    const bf16_t* qp = qkv + (size_t)t * 3072 + h * 128;
    sq[lane] = bf2f(qp[lane]); sq[lane + 64] = bf2f(qp[lane + 64]);
    __syncthreads();
    const int own = t >> 8;
    float gate = -INFINITY;
    if (lane < own) {
        const float* km = kmean + ((size_t)h * 64 + lane) * 128;
        float a = 0.f;
        for (int d = 0; d < 128; ++d) a += sq[d] * km[d];
        gate = a;
    }
    int s0 = -1, s1 = -1, s2 = -1;
#pragma unroll
    for (int j = 0; j < 3; ++j) {
        const float m = wave_max(gate);
        int idx = -1;
        if (m > -INFINITY) { const unsigned long long b = __ballot(gate == m); idx = __ffsll((long long)b) - 1; }
        if (j == 0) s0 = idx; else if (j == 1) s1 = idx; else s2 = idx;
        if (lane == idx) gate = -INFINITY;
    }
    int nk = 0;
    if (s0 >= 0) { for (int i = lane; i < 256; i += 64) skey[nk + i] = s0 * 256 + i; nk += 256; }
    if (s1 >= 0) { for (int i = lane; i < 256; i += 64) skey[nk + i] = s1 * 256 + i; nk += 256; }
    if (s2 >= 0) { for (int i = lane; i < 256; i += 64) skey[nk + i] = s2 * 256 + i; nk += 256; }
    const int nown = t - own * 256 + 1;
    for (int i = lane; i < nown; i += 64) skey[nk + i] = own * 256 + i;
    nk += nown;
    __syncthreads();
    const float scale = 0.08838834764831845f;
    float mx = -INFINITY;
    for (int i = lane; i < nk; i += 64) {
        const bf16_t* kp = qkv + (size_t)skey[i] * 3072 + 1024 + h * 128;
        float a = 0.f;
        for (int d = 0; d < 128; d += 8) { const u32x4 kk = *(const u32x4*)(kp + d);
            a += sq[d] * bflo(kk.x) + sq[d + 1] * bfhi(kk.x) + sq[d + 2] * bflo(kk.y) + sq[d + 3] * bfhi(kk.y) + sq[d + 4] * bflo(kk.z) + sq[d + 5] * bfhi(kk.z) + sq[d + 6] * bflo(kk.w) + sq[d + 7] * bfhi(kk.w); }
        a *= scale; sp[i] = a; mx = fmaxf(mx, a);
    }
    mx = wave_max(mx);
    float sum = 0.f;
    for (int i = lane; i < nk; i += 64) { const float p = expf(sp[i] - mx); sp[i] = p; sum += p; }
    sum = wave_sum(sum);
    __syncthreads();
    float o0 = 0.f, o1 = 0.f;
    for (int i = 0; i < nk; ++i) {
        const bf16_t* vp = qkv + (size_t)skey[i] * 3072 + 2048 + h * 128;
        const float p = sp[i];
        o0 += p * bf2f(vp[lane]); o1 += p * bf2f(vp[lane + 64]);
    }
    const float inv = 1.f / sum;
    out[(size_t)t * D + h * 128 + lane] = (bf16_t)(cvtpk(o0 * inv, 0.f) & 0xffffu);
    out[(size_t)t * D + h * 128 + lane + 64] = (bf16_t)(cvtpk(o1 * inv, 0.f) & 0xffffu);
}
constexpr int PH_PER_LAYER = 10, PH_L0 = 2, N_PHASES = PH_L0 + DEPTH * PH_PER_LAYER;
__global__ void __launch_bounds__(NTHR, 2) mega(MegaArgs args) {
    extern __shared__ __attribute__((aligned(16))) unsigned char lds_raw[];
    Frame F;
    F.lds = (LAS unsigned char*)lds_raw;
    F.tid = threadIdx.x; F.lane = F.tid & 63; F.wave = __builtin_amdgcn_readfirstlane(F.tid >> 6);
    F.G = gridDim.x; { const int bx = blockIdx.x; F.vcu = (F.G % 8 == 0) ? (bx % 8) * (F.G / 8) + bx / 8 : bx; }
    volatile LAS unsigned* MISC = (volatile LAS unsigned*)(F.lds + MISC_OFF);
    unsigned char* ws = args.ws;
    unsigned* ctl = (unsigned*)(ws + WS_CTL);
    for (int u = F.tid; u < (LDS_BYTES - MISC_OFF) / 4; u += NTHR) ((LAS unsigned*)(F.lds + MISC_OFF))[u] = 0u;
    __syncthreads();
    XcdBarrier bar = xcd_barrier_post(ctl + CW_BAR, MISC + 8);
    const int lo = args.ph_lo, hi = args.ph_hi;
#define IN(k) (lo <= (k) && (k) < hi)
#define SEAM(k) do { if (lo <= (k) && (k) + 1 < hi) xcd_barrier(bar); } while (0)
    const float* mod = (const float*)(ws + WS_MOD);
    bf16_t* H = (bf16_t*)(ws + WS_H); bf16_t* MIX = (bf16_t*)(ws + WS_MIX); bf16_t* QKV = (bf16_t*)(ws + WS_QKV); bf16_t* HID = (bf16_t*)(ws + WS_HID);
    float* xout = args.out;
    bf16_t* XB = (bf16_t*)(ws + WS_XB);

    if (IN(0)) { p0_prologue(F, args); }
    if (lo < 0) cg::this_grid().sync();
    if (lo <= 0 && 1 < hi) xcd_barrier(bar);
    if (IN(1)) { norm_phase(F, args.in[0], args.in[5], mod + D, mod, H); }
    SEAM(1);
#pragma unroll 1
    for (int L = 0; L < DEPTH; ++L) {
        const int pb = PH_L0 + L * PH_PER_LAYER, j = L >> 1;
        const float* m = mod + (size_t)L * 6 * D;
        if (pb + PH_PER_LAYER <= lo || pb >= hi) continue;
        if ((L & 1) == 0) {
            if (IN(pb + 0)) {
                pg8::Gemm g{H, (const bf16_t*)(ws + WS_WGIN) + (size_t)j * 3072 * D, S, 3072, D}; pg8::StaticOrder So; So.init(S, 3072, F.G, (int)blockIdx.x);
                pg8::EpiBf16<0> E{QKV, 3072};
                pg8::gemm_phase<pg8::EpiBf16<0>, pg8::StaticOrder, true, true>(F.lds, g, So, E);
                glr_phase(F, H, (const bf16_t*)(ws + WS_WGLR) + (size_t)j * 16 * D, (float*)(ws + WS_GLR));
            }
            SEAM(pb + 0);
        } else {
            if (IN(pb + 0)) {
                pg8::Gemm g{H, (const bf16_t*)(ws + WS_WMIN) + (size_t)j * 3072 * D, S, 3072, D}; pg8::StaticOrder So; So.init(S, 3072, F.G, (int)blockIdx.x);
                pg8::EpiBf16<0> E{QKV, 3072};
                pg8::gemm_phase<pg8::EpiBf16<0>, pg8::StaticOrder, true, true>(F.lds, g, So, E);
            }
            SEAM(pb + 0);
        }
        if ((L & 1) == 0) {
            unsigned char* ws = args.ws; asm volatile("" : "+s"(ws));
            const float* wupg = args.in[8] + (size_t)j * 16 * 512; const float* bgg = args.in[9] + (size_t)j * 512;
            if (IN(pb + 1)) gla_g1(F, QKV, (const float*)(ws + WS_GLR), wupg, bgg, (float*)(ws + WS_SBUF), (float*)(ws + WS_DG));
            SEAM(pb + 1);
            if (IN(pb + 2)) gla_g2(F, (float*)(ws + WS_SBUF), (const float*)(ws + WS_DG));
            SEAM(pb + 2);
            if (IN(pb + 3)) gla_g3(F, QKV, (const float*)(ws + WS_GLR), wupg, bgg, (const float*)(ws + WS_SBUF), args.in[10] + (size_t)j * 256, MIX);
            if (lo <= pb + 3 && pb + 5 < hi) xcd_barrier(bar);
        } else {
            unsigned char* ws = args.ws; asm volatile("" : "+s"(ws));
            unsigned* gcnt = (unsigned*)(ws + WS_CTL) + CW_MCNT + j * 512;
            if (IN(pb + 1)) moba_m1(F, QKV, (const float*)(ws + WS_COS), (const float*)(ws + WS_SIN), args.in[13] + (size_t)j * 128, args.in[14] + (size_t)j * 128, (float*)(ws + WS_KMEAN));
            SEAM(pb + 1);
            if (IN(pb + 2)) moba_m2(F, QKV, (const float*)(ws + WS_KMEAN), gcnt, (int*)(ws + WS_LIST));
            SEAM(pb + 2);
            if (IN(pb + 3)) moba_m3(F, QKV, gcnt, (const int*)(ws + WS_LIST), (bf16_t*)xout, (bf16_t*)(ws + WS_AUX), MIX, (float*)(ws + WS_LPART));
            SEAM(pb + 3);
            if (IN(pb + 4)) moba_m4(F, (const bf16_t*)xout, (const bf16_t*)(ws + WS_AUX), (const float*)(ws + WS_LPART), MIX);
            SEAM(pb + 4);
        }
        if (IN(pb + 5)) {
            const bf16_t* wo = ((L & 1) == 0) ? (const bf16_t*)(ws + WS_WGOUT) + (size_t)j * D * D : (const bf16_t*)(ws + WS_WMOUT) + (size_t)j * D * D;
            pg8::Gemm g{MIX, wo, S, D, D}; pg8::StaticOrder So; So.init(S, D, F.G, (int)blockIdx.x);
            if (L == 0) {
                pg8::EpiResidNorm<true> E{args.in[0], XB, D, m + 2 * D, args.in[6] + (size_t)L * D, m + 4 * D, m + 3 * D, H, (float*)(ws + WS_XBUF), ctl + CW_SEAM + (2 * L) * SEAM_BANK, ctl + CW_TMO, EPS};
                pg8::gemm_phase<pg8::EpiResidNorm<true>, pg8::StaticOrder, false, true>(F.lds, g, So, E);
            } else {
                pg8::EpiResidNorm<false> E{XB, XB, D, m + 2 * D, args.in[6] + (size_t)L * D, m + 4 * D, m + 3 * D, H, (float*)(ws + WS_XBUF), ctl + CW_SEAM + (2 * L) * SEAM_BANK, ctl + CW_TMO, EPS};
                pg8::gemm_phase<pg8::EpiResidNorm<false>, pg8::StaticOrder, false, true>(F.lds, g, So, E);
            }
        }
        SEAM(pb + 5);
        if (IN(pb + 7)) {
            pg8::Gemm g{H, (const bf16_t*)(ws + WS_W1) + (size_t)L * DFF * D, S, DFF, D}; pg8::StaticOrder So; So.init(S, DFF, F.G, (int)blockIdx.x);
            pg8::EpiBf16<1> E{HID, DFF};
            pg8::gemm_phase<pg8::EpiBf16<1>, pg8::StaticOrder, true, true>(F.lds, g, So, E);
        }
        SEAM(pb + 7);
        if (IN(pb + 8)) {
            pg8::Gemm g{HID, (const bf16_t*)(ws + WS_W2) + (size_t)L * D * DFF, S, D, DFF}; pg8::StaticOrder So; So.init(S, D, F.G, (int)blockIdx.x);
            pg8::EpiResid E{XB, xout, D, m + 5 * D};
            if (L + 1 < DEPTH) {
                const float* mn = mod + (size_t)(L + 1) * 6 * D;
                pg8::EpiResidNorm<false> EN{XB, XB, D, m + 5 * D, args.in[5] + (size_t)(L + 1) * D, mn + D, mn, H, (float*)(ws + WS_XBUF), ctl + CW_SEAM + (2 * L + 1) * SEAM_BANK, ctl + CW_TMO, EPS};
                pg8::gemm_phase<pg8::EpiResidNorm<false>, pg8::StaticOrder, false, true>(F.lds, g, So, EN);
            } else
            pg8::gemm_phase<pg8::EpiResid, pg8::StaticOrder, false, true>(F.lds, g, So, E);
        }
        if (L + 1 < DEPTH) SEAM(pb + 8);
    }
#undef IN
#undef SEAM
}
static int g_grid = 0;
static void launch_mega(MegaArgs a, int lo, int hi, hipStream_t stream) {
    a.ph_lo = lo; a.ph_hi = hi;
    (void)hipMemsetAsync((char*)a.ws + WS_CTL + CW_BAR * 4, 0, XCD_BAR_WORDS * 4, stream);
    void* params[] = {&a};
    hipError_t e = hipLaunchCooperativeKernel((const void*)mega, dim3(g_grid), dim3(NTHR), params, LDS_BYTES, stream);
    if (e != hipSuccess) fprintf(stderr, "cooperative launch failed: %s (grid %d)\n", hipGetErrorString(e), g_grid);
}
extern "C" void kernel_launch(void* const* d_in, const int* in_sizes, int n_in, void* d_out, int out_size, void* d_ws, size_t ws_size, hipStream_t stream) {
    if (g_grid == 0) {
        int dev = 0, cus = 0, per_cu = 0;
        (void)hipGetDevice(&dev);
        (void)hipDeviceGetAttribute(&cus, hipDeviceAttributeMultiprocessorCount, dev);
        (void)hipFuncSetAttribute((const void*)mega, hipFuncAttributeMaxDynamicSharedMemorySize, LDS_BYTES);
        (void)hipOccupancyMaxActiveBlocksPerMultiprocessor(&per_cu, (const void*)mega, NTHR, LDS_BYTES);
        if (per_cu < 1) { fprintf(stderr, "occupancy query says %d blocks/CU\n", per_cu); per_cu = 1; }
        g_grid = cus;
        if (ws_size < WS_END || n_in != 18) { fprintf(stderr, "bad ws_size %zu / n_in %d\n", ws_size, n_in); g_grid = -1; }
    }
    if (g_grid < 0) return;
    (void)hipMemsetAsync((char*)d_ws + WS_CTL, 0, CTL_ZERO_BYTES, stream);
    MegaArgs a{};
    for (int i = 0; i < 18; ++i) a.in[i] = (const float*)d_in[i];
    a.out = (float*)d_out; a.ws = (unsigned char*)d_ws;
    launch_mega(a, 0, N_PHASES, stream);
}
```

```cpp
#include <hip/hip_runtime.h>
#include <hip/hip_cooperative_groups.h>
#include <cstdio>
#include <cstdint>
#include <cmath>
namespace cg = cooperative_groups;
constexpr int D = 1024, S = 16384, DEPTH = 4, DFF = 4096;
constexpr int GLA_IN = 3088, MB_IN = 3072;
constexpr float EPS = 1e-6f;
#ifndef PROBE
#define PROBE 0
#endif
#ifndef TCAT
#define TCAT 0
#endif
#ifndef TBLK
#define TBLK 0
#endif
#define LAS __attribute__((address_space(3)))
#define GAS __attribute__((address_space(1)))
typedef unsigned short bf16_t;
typedef short bf16x8 __attribute__((ext_vector_type(8)));
typedef short s16x4 __attribute__((ext_vector_type(4)));
typedef float f32x4 __attribute__((ext_vector_type(4)));
typedef float f32x16 __attribute__((ext_vector_type(16)));
typedef float f32x2 __attribute__((ext_vector_type(2)));
typedef unsigned u32x4 __attribute__((ext_vector_type(4)));
typedef unsigned u32x2 __attribute__((ext_vector_type(2)));
typedef __bf16 bf16x2_t __attribute__((ext_vector_type(2)));

__device__ __forceinline__ unsigned cvtpk(float lo, float hi) { f32x2 v = {lo, hi}; bf16x2_t b = __builtin_convertvector(v, bf16x2_t); return __builtin_bit_cast(unsigned, b); }
__device__ __forceinline__ float bf2f(unsigned short b) { return __uint_as_float((unsigned)b << 16); }
__device__ __forceinline__ float bflo(unsigned w) { return __uint_as_float(w << 16); }
__device__ __forceinline__ float bfhi(unsigned w) { return __uint_as_float(w & 0xffff0000u); }

#ifndef WT_STORES
#define WT_STORES 0
#endif
__device__ __forceinline__ void st16_wt(void* p, u32x4 v) {
#if WT_STORES
    asm volatile("global_store_dwordx4 %0, %1, off sc1\n\ts_nop 1" :: "v"(p), "v"(v) : "memory");
#else
    *(u32x4*)p = v;
#endif
}
__device__ __forceinline__ void st16_wt(void* p, f32x4 v) { st16_wt(p, __builtin_bit_cast(u32x4, v)); }
namespace pg8 {
constexpr int BM = 256, BK = 64, HALF = 128, HTB = HALF * BK * 2, STAGE_BYTES = 8 * HTB, NXCD = 8, WGM = 8;
__host__ __device__ __forceinline__ int lds_byte(int r, int c) { const int st = (r >> 4) * 2 + (c >> 5), rr = r & 15, cc = c & 31, ob = rr * 64 + cc * 2; return st * 1024 + (ob ^ (((ob >> 9) & 1) << 5)); }
__host__ __device__ __forceinline__ void stage_rc(int b, int& R, int& C) { const int st = b / 1024, sb = b % 1024, swz = sb ^ (((sb >> 9) & 1) << 5); R = (st >> 1) * 16 + swz / 64; C = (st & 1) * 32 + (swz % 64) / 2; }
__host__ __device__ __forceinline__ int perm32(int rho) { const int n = rho >> 4, i = rho & 15; return 8 * (i >> 2) + 4 * n + (i & 3); }
struct Unit { int pm, pn; };
struct Gemm { const bf16_t* A; const bf16_t* Bt; int M, N, K; };
struct StaticOrder {
    int nM, nN, nwg, G, c;
    __host__ __device__ void init(int M, int N, int G_, int c_) { nM = M / BM; nN = N / BM; nwg = nM * nN; G = G_; c = c_; }
    __host__ __device__ bool next(int i, Unit& u) const {
        const long L = (long)i * G + c; if (L >= nwg) return false;
        int wgid = (int)L; { const int q = nwg / NXCD, r = nwg % NXCD, xcd = wgid % NXCD, off = wgid / NXCD; wgid = (xcd < r ? xcd * (q + 1) : r * (q + 1) + (xcd - r) * q) + off; }
        const int nig = WGM * nN, gid = wgid / nig, fm = gid * WGM, gsz = (nM - fm) < WGM ? (nM - fm) : WGM;
        u.pm = fm + ((wgid % nig) % gsz); u.pn = (wgid % nig) / gsz; return true;
    }
    __device__ __forceinline__ void a_ready(const Unit&) const {}
    __device__ __forceinline__ void done(const Unit&) const {}
};
struct MaskOrder : StaticOrder {
    __device__ bool next(int i, Unit& u) const { const bool ok = StaticOrder::next(i, u); u.pm &= 7; u.pn &= 3; return ok; }
};
template <int ACT  > struct EpiBf16 {
    static constexpr bool PERM = true, AFTER_DRAIN = false;
    bf16_t* O; int ldc;
    __device__ __forceinline__ void operator()(const f32x4 (&acc)[2][2][4][2], const Unit& u, int wr, int wc, int fr, int fq) const {
        const int row0 = u.pm * BM + wr * 64 + fr; const int col0 = u.pn * BM + wc * 32 + 8 * fq;
#pragma unroll
        for (int ai = 0; ai < 2; ++ai)
#pragma unroll
            for (int m = 0; m < 4; ++m) { bf16_t* rowp = O + (size_t)(row0 + ai * HALF + m * 16) * ldc + col0;
#pragma unroll
                for (int bj = 0; bj < 2; ++bj) { f32x4 v0 = acc[ai][bj][m][0], v1 = acc[ai][bj][m][1];
                    if (ACT == 1) {
#pragma unroll
                        for (int e = 0; e < 4; ++e) { float a = fmaxf(v0[e], 0.f); v0[e] = a * a; float b = fmaxf(v1[e], 0.f); v1[e] = b * b; } }
                    u32x4 w; w.x = cvtpk(v0[0], v0[1]); w.y = cvtpk(v0[2], v0[3]); w.z = cvtpk(v1[0], v1[1]); w.w = cvtpk(v1[2], v1[3]);
                    st16_wt(rowp + bj * HALF, w); } }
    }
};
struct EpiResid {
    static constexpr bool PERM = false, AFTER_DRAIN = false;
    const bf16_t* base; float* out; int ldc; const float* gate;
    __device__ __forceinline__ void operator()(const f32x4 (&acc)[2][2][4][2], const Unit& u, int wr, int wc, int fr, int fq) const {
        const int row0 = u.pm * BM + wr * 64 + fr, col0 = u.pn * BM + wc * 32 + 4 * fq;
        f32x4 gv[2][2];
#pragma unroll
        for (int bj = 0; bj < 2; ++bj)
#pragma unroll
            for (int n = 0; n < 2; ++n) gv[bj][n] = *(const f32x4*)(gate + col0 + bj * HALF + n * 16);
#pragma unroll
        for (int ai = 0; ai < 2; ++ai)
#pragma unroll
            for (int m = 0; m < 4; ++m) { const size_t off = (size_t)(row0 + ai * HALF + m * 16) * ldc + col0;
#pragma unroll
                for (int bj = 0; bj < 2; ++bj)
#pragma unroll
                    for (int n = 0; n < 2; ++n) { const u32x2 bb = *(const u32x2*)(base + off + bj * HALF + n * 16); const f32x4 b = {bflo(bb.x), bfhi(bb.x), bflo(bb.y), bfhi(bb.y)};
                        st16_wt(out + off + bj * HALF + n * 16, b + gv[bj][n] * acc[ai][bj][m][n]); } }
    }
};

template <bool BASE_F32> struct EpiResidNorm {
    static constexpr bool PERM = false, AFTER_DRAIN = true;
    const void* base; bf16_t* out; int ldc; const float* gate;
    const float* ng; const float* sc; const float* sh; bf16_t* H;
    float* xbuf; unsigned* cnt; unsigned* tmo; float eps;
    __device__ __forceinline__ void operator()(const f32x4 (&)[2][2][4][2], const Unit&, int, int, int, int) const {}
    __device__ __forceinline__ void fused(f32x4 (&acc)[2][2][4][2], const Unit& u, int wr, int wc, int fr, int fq, LAS unsigned char* lds, int wid, int lane) const {
        LAS float* P = (LAS float*)lds;
        LAS float* Sr = (LAS float*)(lds + 4096);
        LAS unsigned* flag = (LAS unsigned*)(lds + 4096 + 1024);
        const int row0 = u.pm * BM + wr * 64 + fr, col0 = u.pn * BM + wc * 32 + 4 * fq;
        {
            f32x4 gv[2][2];
#pragma unroll
            for (int bj = 0; bj < 2; ++bj)
#pragma unroll
                for (int n = 0; n < 2; ++n) gv[bj][n] = *(const f32x4*)(gate + col0 + bj * HALF + n * 16);
#pragma unroll
            for (int ai = 0; ai < 2; ++ai)
#pragma unroll
                for (int m = 0; m < 4; ++m) { const size_t off = (size_t)(row0 + ai * HALF + m * 16) * ldc + col0;
                    float s = 0.f;
#pragma unroll
                    for (int bj = 0; bj < 2; ++bj)
#pragma unroll
                        for (int n = 0; n < 2; ++n) { f32x4 b;
                            if constexpr (BASE_F32) b = *(const f32x4*)((const float*)base + off + bj * HALF + n * 16);
                            else { const u32x2 bb = *(const u32x2*)((const bf16_t*)base + off + bj * HALF + n * 16); b = (f32x4){bflo(bb.x), bfhi(bb.x), bflo(bb.y), bfhi(bb.y)}; }
                            const f32x4 x = b + gv[bj][n] * acc[ai][bj][m][n]; acc[ai][bj][m][n] = x;
                            { u32x2 xw; xw.x = cvtpk(x[0], x[1]); xw.y = cvtpk(x[2], x[3]); *(u32x2*)(out + off + bj * HALF + n * 16) = xw; } s += (x[0] * x[0] + x[1] * x[1]) + (x[2] * x[2] + x[3] * x[3]); }
                    s += __shfl_xor(s, 16); s += __shfl_xor(s, 32);
                    if (fq == 0) P[(ai * HALF + wr * 64 + m * 16 + fr) * 4 + wc] = s;
                    if (m & 1) asm volatile("" ::: "memory"); }
        }
        asm volatile("s_waitcnt lgkmcnt(0)" ::: "memory"); __builtin_amdgcn_s_barrier(); asm volatile("" ::: "memory");
        const int row = wid * 32 + (lane & 31);
        if (lane < 32) {
            const float tot = (P[row * 4 + 0] + P[row * 4 + 1]) + (P[row * 4 + 2] + P[row * 4 + 3]);
            __hip_atomic_store((unsigned*)xbuf + ((size_t)(u.pm * BM + row) * 4 + u.pn), __float_as_uint(tot), __ATOMIC_RELAXED, __HIP_MEMORY_SCOPE_AGENT);
        }
        asm volatile("s_waitcnt vmcnt(0)" ::: "memory");
        if (lane == 0) __hip_atomic_fetch_add(cnt + 64 * u.pm, 1u, __ATOMIC_RELAXED, __HIP_MEMORY_SCOPE_AGENT);
        if (wid == 0) {
            unsigned sp = 0; bool dead = false;
            for (;;) {
                if ((unsigned)__builtin_amdgcn_readfirstlane(__hip_atomic_load(cnt + 64 * u.pm, __ATOMIC_RELAXED, __HIP_MEMORY_SCOPE_AGENT)) >= 32u) break;
                __builtin_amdgcn_s_sleep(2);
                if (++sp > (1u << 20)) { if (lane == 0) __hip_atomic_store(tmo, 1u, __ATOMIC_RELAXED, __HIP_MEMORY_SCOPE_AGENT); dead = true; break; }
            }
            __builtin_amdgcn_fence(__ATOMIC_ACQUIRE, "agent");
            if (lane == 0) flag[0] = dead ? 1u : 0u;
        }
        asm volatile("s_waitcnt vmcnt(0) lgkmcnt(0)" ::: "memory"); __builtin_amdgcn_s_barrier(); asm volatile("" ::: "memory");
        if (lane < 32) {
            const unsigned* slot = (const unsigned*)xbuf + (size_t)(u.pm * BM + row) * 4; float t = 0.f;
#pragma unroll
            for (int k = 0; k < 4; ++k) t += __uint_as_float(__hip_atomic_load(slot + k, __ATOMIC_RELAXED, __HIP_MEMORY_SCOPE_AGENT));
            Sr[row] = 1.0f / sqrtf(t * (1.0f / 1024.0f) + eps);
        }
        asm volatile("s_waitcnt lgkmcnt(0)" ::: "memory"); __builtin_amdgcn_s_barrier(); asm volatile("" ::: "memory");
        float rs[2][4];
#pragma unroll
        for (int ai = 0; ai < 2; ++ai)
#pragma unroll
            for (int m = 0; m < 4; ++m) rs[ai][m] = Sr[ai * HALF + wr * 64 + m * 16 + fr];
#pragma unroll
        for (int bj = 0; bj < 2; ++bj)
#pragma unroll
            for (int n = 0; n < 2; ++n) { const int c = col0 + bj * HALF + n * 16;
                const f32x4 ga = *(const f32x4*)(ng + c) * (*(const f32x4*)(sc + c) + 1.0f), gb = *(const f32x4*)(sh + c);
#pragma unroll
                for (int ai = 0; ai < 2; ++ai)
#pragma unroll
                    for (int m = 0; m < 4; ++m) { const int r = ai * HALF + wr * 64 + m * 16 + fr; const size_t off = (size_t)(u.pm * BM + r) * ldc + c;
                        const f32x4 y = acc[ai][bj][m][n] * rs[ai][m] * ga + gb; u32x2 w; w.x = cvtpk(y[0], y[1]); w.y = cvtpk(y[2], y[3]);
                        *(u32x2*)(H + off) = w; } }
    }
};

template <class Epi, class Sched, bool ALIGN_EPI = false, bool SP2 = false>
__device__ __forceinline__ void gemm_phase(LAS unsigned char* lds, const Gemm g, const Sched& S, const Epi& E) {
    int tid_ = threadIdx.x; asm volatile("" : "+v"(tid_));
    const int tid = tid_, wid = __builtin_amdgcn_readfirstlane(tid >> 6), lane = tid & 63, wr = wid >> 2, wc = wid & 3, fr = lane & 15, fq = lane >> 4;
    const int K = g.K, nt = K / BK;
    unsigned voffA[2], voffB[2];
#pragma unroll
    for (int i = 0; i < 2; ++i) { int R, C; stage_rc(tid * 16 + i * 8192, R, C); const int Rb = Epi::PERM ? ((R & ~31) + perm32(R & 31)) : R;
        voffA[i] = (unsigned)(R * K + C) * 2u; voffB[i] = (unsigned)(Rb * K + C) * 2u; }
    const size_t kstep = (size_t)(BK * 2);
    const size_t hstep = (size_t)HALF * K * 2;
    const size_t tstep = 2 * hstep;
    const unsigned ldsw = (unsigned)wid * 1024u;
    const int aoff = lds_byte(wr * 64 + fr, fq * 8), boff = lds_byte(wc * 32 + fr, fq * 8);
#define PG8_SA(b, h) (((b) * 2 + (h)) * HTB)
#define PG8_SB(b, h) ((4 + (b) * 2 + (h)) * HTB)
#define PG8_STAGE(bufoff, gbase, voff) do { _Pragma("unroll") for (int _i = 0; _i < 2; ++_i) \
        __builtin_amdgcn_global_load_lds((const unsigned*)((const char*)(gbase) + (voff)[_i]), (LAS unsigned*)(lds + (bufoff) + ldsw + _i * 8192), 16, 0, 0); } while (0)
#define PG8_LDA(dst, b, h) do { _Pragma("unroll") for (int m = 0; m < 4; ++m) _Pragma("unroll") for (int k = 0; k < 2; ++k) dst[m][k] = *(const LAS bf16x8*)(lds + PG8_SA(b, h) + aoff + m * 2048 + k * 1024); } while (0)
#define PG8_LDB(dst, b, h) do { _Pragma("unroll") for (int n = 0; n < 2; ++n) _Pragma("unroll") for (int k = 0; k < 2; ++k) dst[n][k] = *(const LAS bf16x8*)(lds + PG8_SB(b, h) + boff + n * 2048 + k * 1024); } while (0)
#define PG8_MMA(ai, bj, At, Bt) do { __builtin_amdgcn_s_setprio(1); _Pragma("unroll") for (int m = 0; m < 4; ++m) _Pragma("unroll") for (int n = 0; n < 2; ++n) _Pragma("unroll") for (int k = 0; k < 2; ++k) \
        acc[ai][bj][m][n] = __builtin_amdgcn_mfma_f32_16x16x32_bf16(Bt[n][k], At[m][k], acc[ai][bj][m][n], 0, 0, 0); __builtin_amdgcn_s_setprio(0); } while (0)
#define PG8_WAIT_V(n) asm volatile("s_waitcnt vmcnt(" #n ")" ::: "memory")
#define PG8_WAIT_L(n) asm volatile("s_waitcnt lgkmcnt(" #n ")" ::: "memory")
#define PG8_BAR __builtin_amdgcn_s_barrier()
#define PG8_SCHED __builtin_amdgcn_sched_barrier(0)
    Unit cur, nxt; int ui = 0;
    if (!S.next(0, cur)) return;
    f32x4 acc[2][2][4][2];
#pragma unroll
    for (int a = 0; a < 2; ++a)
#pragma unroll
        for (int b = 0; b < 2; ++b)
#pragma unroll
            for (int m = 0; m < 4; ++m)
#pragma unroll
                for (int n = 0; n < 2; ++n) acc[a][b][m][n] = (f32x4){0.f, 0.f, 0.f, 0.f};
    bf16x8 At[4][2], B0[2][2], B1[2][2];
    const char* cA = (const char*)g.A + (size_t)cur.pm * tstep; const char* cB = (const char*)g.Bt + (size_t)cur.pn * tstep;
    S.a_ready(cur);
    if constexpr (SP2) {
        PG8_STAGE(PG8_SB(0, 0), cB, voffB); PG8_STAGE(PG8_SB(0, 1), cB + hstep, voffB); PG8_STAGE(PG8_SA(0, 0), cA, voffA); PG8_STAGE(PG8_SA(0, 1), cA + hstep, voffA);
        if (wr == 1) PG8_BAR;
        PG8_WAIT_V(2); PG8_BAR;
        PG8_STAGE(PG8_SB(1, 0), cB + kstep, voffB); PG8_STAGE(PG8_SA(1, 0), cA + kstep, voffA); PG8_STAGE(PG8_SB(1, 1), cB + hstep + kstep, voffB);
        PG8_WAIT_V(6); PG8_BAR;
    } else {
        PG8_STAGE(PG8_SB(0, 0), cB, voffB); PG8_STAGE(PG8_SA(0, 0), cA, voffA); PG8_STAGE(PG8_SB(0, 1), cB + hstep, voffB); PG8_STAGE(PG8_SA(0, 1), cA + hstep, voffA);
        if (wr == 1) PG8_BAR;
        PG8_WAIT_V(4); PG8_BAR;
        PG8_STAGE(PG8_SB(1, 0), cB + kstep, voffB); PG8_STAGE(PG8_SA(1, 0), cA + kstep, voffA); PG8_STAGE(PG8_SB(1, 1), cB + hstep + kstep, voffB);
        PG8_WAIT_V(6); PG8_BAR;
    }
    for (;;) {
        const bool has_next = S.next(ui + 1, nxt);
        const char* nA = has_next ? (const char*)g.A + (size_t)nxt.pm * tstep : cA; const char* nB = has_next ? (const char*)g.Bt + (size_t)nxt.pn * tstep : cB;
        for (int t = 0; t < nt; t += 2) {
            const bool last = (t == nt - 2);
            const char* a1 = cA + (size_t)(t + 1) * kstep;
            const char* a2 = last ? nA : cA + (size_t)(t + 2) * kstep; const char* b2 = last ? nB : cB + (size_t)(t + 2) * kstep;
            const char* a3 = a2 + kstep; const char* b3 = b2 + kstep;
            if (last && has_next) S.a_ready(nxt);
            if constexpr (SP2) {
            PG8_LDB(B0, 0, 0); PG8_LDB(B1, 0, 1); PG8_SCHED; PG8_LDA(At, 0, 0); PG8_STAGE(PG8_SA(1, 1), a1 + hstep, voffA);
            PG8_WAIT_V(8); PG8_WAIT_L(0); PG8_BAR; PG8_MMA(0, 0, At, B0); PG8_MMA(0, 1, At, B1); PG8_BAR; PG8_SCHED;
            PG8_LDA(At, 0, 1); PG8_STAGE(PG8_SB(0, 0), b2, voffB); PG8_STAGE(PG8_SB(0, 1), b2 + hstep, voffB); PG8_STAGE(PG8_SA(0, 0), a2, voffA);
            PG8_WAIT_V(8); PG8_WAIT_L(0); PG8_BAR; PG8_MMA(1, 0, At, B0); PG8_MMA(1, 1, At, B1); PG8_BAR; PG8_SCHED;
            PG8_LDB(B0, 1, 0); PG8_LDB(B1, 1, 1); PG8_SCHED; PG8_LDA(At, 1, 0); PG8_STAGE(PG8_SA(0, 1), a2 + hstep, voffA);
            PG8_WAIT_V(8); PG8_WAIT_L(0); PG8_BAR; PG8_MMA(0, 0, At, B0); PG8_MMA(0, 1, At, B1); PG8_BAR; PG8_SCHED;
            PG8_LDA(At, 1, 1); PG8_STAGE(PG8_SB(1, 0), b3, voffB); PG8_STAGE(PG8_SB(1, 1), b3 + hstep, voffB); PG8_STAGE(PG8_SA(1, 0), a3, voffA);
            PG8_WAIT_V(8); PG8_WAIT_L(0); PG8_BAR; PG8_MMA(1, 0, At, B0); PG8_MMA(1, 1, At, B1); PG8_BAR; PG8_SCHED;
            } else {
            PG8_LDB(B0, 0, 0); PG8_SCHED; PG8_LDA(At, 0, 0); PG8_STAGE(PG8_SA(1, 1), a1 + hstep, voffA);
            PG8_WAIT_L(8); PG8_BAR; PG8_WAIT_L(0); PG8_MMA(0, 0, At, B0); PG8_BAR; PG8_SCHED;
            PG8_LDB(B1, 0, 1); PG8_STAGE(PG8_SB(0, 0), b2, voffB);
            PG8_BAR; PG8_WAIT_L(0); PG8_MMA(0, 1, At, B1); PG8_BAR;
            PG8_LDA(At, 0, 1); PG8_STAGE(PG8_SA(0, 0), a2, voffA);
            PG8_BAR; PG8_WAIT_L(0); PG8_MMA(1, 0, At, B0); PG8_BAR; PG8_SCHED;
            PG8_STAGE(PG8_SB(0, 1), b2 + hstep, voffB);
            PG8_WAIT_V(6); PG8_BAR; PG8_MMA(1, 1, At, B1); PG8_BAR;
            PG8_LDB(B0, 1, 0); PG8_SCHED; PG8_LDA(At, 1, 0); PG8_STAGE(PG8_SA(0, 1), a2 + hstep, voffA);
            PG8_WAIT_L(8); PG8_BAR; PG8_WAIT_L(0); PG8_MMA(0, 0, At, B0); PG8_BAR; PG8_SCHED;
            PG8_LDB(B1, 1, 1); PG8_STAGE(PG8_SB(1, 0), b3, voffB);
            PG8_BAR; PG8_WAIT_L(0); PG8_MMA(0, 1, At, B1); PG8_BAR;
            PG8_LDA(At, 1, 1); PG8_STAGE(PG8_SA(1, 0), a3, voffA);
            PG8_BAR; PG8_WAIT_L(0); PG8_MMA(1, 0, At, B0); PG8_BAR; PG8_SCHED;
            PG8_STAGE(PG8_SB(1, 1), b3 + hstep, voffB);
            PG8_WAIT_V(6); PG8_BAR; PG8_MMA(1, 1, At, B1); PG8_BAR;
            }
        }
        if constexpr (ALIGN_EPI) { if (wr == 0) PG8_BAR; }
        if constexpr (!Epi::AFTER_DRAIN) { E(acc, cur, wr, wc, fr, fq); S.done(cur); }
        if (!has_next) break;
#pragma unroll
        for (int a = 0; a < 2; ++a)
#pragma unroll
            for (int b = 0; b < 2; ++b)
#pragma unroll
                for (int m = 0; m < 4; ++m)
#pragma unroll
                    for (int n = 0; n < 2; ++n) acc[a][b][m][n] = (f32x4){0.f, 0.f, 0.f, 0.f};
        cur = nxt; cA = nA; cB = nB; ++ui;
        if constexpr (ALIGN_EPI) { if (wr == 1) PG8_BAR; }
    }
    PG8_WAIT_V(0);
    if constexpr (!ALIGN_EPI) { if (wr == 0) PG8_BAR; }
    PG8_BAR;
    if constexpr (Epi::AFTER_DRAIN) { E.fused(acc, cur, wr, wc, fr, fq, lds, wid, lane); }
#undef PG8_SA
#undef PG8_SB
#undef PG8_STAGE
#undef PG8_LDA
#undef PG8_LDB
#undef PG8_MMA
#undef PG8_WAIT_V
#undef PG8_WAIT_L
#undef PG8_BAR
#undef PG8_SCHED
}
}

#define XB_TMO      128
#define XB_XCNT(j)  (256  + 64 * (j))
#define XB_XSUB(j)  (1280 + 64 * (j))
#define XB_XGEN(j)  (2304 + 64 * (j))
#define XB_TOP      3328
#define XB_TOPGEN   3392
#define XCD_BAR_WORDS 3456
#define XB_SPIN_CAP (1u << 18)
__device__ __forceinline__ unsigned xb_ld(unsigned* p)              { return __hip_atomic_load(p, __ATOMIC_RELAXED, __HIP_MEMORY_SCOPE_AGENT); }
__device__ __forceinline__ unsigned xb_add(unsigned* p, unsigned v) { return __hip_atomic_fetch_add(p, v, __ATOMIC_RELAXED, __HIP_MEMORY_SCOPE_AGENT); }
__device__ __forceinline__ unsigned xb_xcc_id() { return (unsigned)__builtin_amdgcn_s_getreg((3 << 11) | 20) & 0xFu; }
#define XB_SPIN(cond, bar) do { unsigned _sp = 0; while (cond) { __builtin_amdgcn_s_sleep(1); \
    if ((++_sp & 255u) == 0u) { if (xb_ld(&(bar)[XB_TMO])) break; if (_sp > XB_SPIN_CAP) { atomicAdd(&(bar)[XB_TMO], 1u); break; } } } } while (0)
struct XcdBarrier { unsigned* bar; unsigned x; volatile LAS unsigned* st; };
__device__ __forceinline__ XcdBarrier xcd_barrier_post(unsigned* bar, volatile LAS unsigned* st) {
    XcdBarrier b; b.bar = bar; b.x = xb_xcc_id(); b.st = st;
    if (threadIdx.x == 0) (void)xb_add(&bar[XB_XCNT(b.x)], 1u);
    return b;
}
__device__ __forceinline__ void xcd_barrier_complete(unsigned* bar, unsigned x, unsigned& nloc, unsigned& nx) {
    const unsigned G = gridDim.x * gridDim.y * gridDim.z;
    unsigned sum, cnt, mine, sp = 0u;
    for (;;) {
        sum = 0u; cnt = 0u; mine = 0u;
#pragma unroll
        for (unsigned j = 0; j < 16; ++j) { const unsigned c = xb_ld(&bar[XB_XCNT(j)]); sum += c; cnt += (c > 0u) ? 1u : 0u; }
        mine = xb_ld(&bar[XB_XCNT(x)]);
        if (sum == G) break;
        __builtin_amdgcn_s_sleep(1);
        if ((++sp & 255u) == 0u) { if (xb_ld(&bar[XB_TMO])) break; if (sp > XB_SPIN_CAP) { atomicAdd(&bar[XB_TMO], 1u); break; } }
    }
    nloc = mine > 0u ? mine : 1u; nx = cnt > 0u ? cnt : 1u;
}
__device__ __forceinline__ void xcd_barrier(const XcdBarrier& b) {
    asm volatile("s_waitcnt vmcnt(0)" ::: "memory");
    __syncthreads();
    if (threadIdx.x == 0) {
        unsigned* bar = b.bar; asm volatile("" : "+s"(bar));
        __builtin_amdgcn_s_waitcnt(0);
        unsigned nloc = b.st[0], nx = b.st[1];
        if (nloc == 0u) { xcd_barrier_complete(bar, b.x, nloc, nx); b.st[0] = nloc; b.st[1] = nx; }
        const unsigned old = xb_add(&bar[XB_XSUB(b.x)], 1u);
        const unsigned gen = old / nloc;
        if (old + 1u == (gen + 1u) * nloc) {
            __builtin_amdgcn_fence(__ATOMIC_RELEASE, "agent");
            asm volatile("s_waitcnt vmcnt(0)" ::: "memory");
            const unsigned og = xb_add(&bar[XB_TOP], 1u);
            const unsigned tg = og / nx;
            if (og + 1u == (tg + 1u) * nx) xb_add(&bar[XB_TOPGEN], 1u);
            else XB_SPIN(xb_ld(&bar[XB_TOPGEN]) == tg, bar);
            __builtin_amdgcn_fence(__ATOMIC_ACQUIRE, "agent");
            xb_add(&bar[XB_XGEN(b.x)], 1u);
            asm volatile("s_waitcnt vmcnt(0)" ::: "memory");
        } else {
            XB_SPIN(xb_ld(&bar[XB_XGEN(b.x)]) == gen, bar);
            __builtin_amdgcn_fence(__ATOMIC_ACQUIRE, "agent");
            asm volatile("s_waitcnt vmcnt(0)" ::: "memory");
        }
    }
    __syncthreads();
}
constexpr int NWAVES = 8, NTHR = 512;
constexpr int LDS_BYTES = 147456;
constexpr int RING_BYTES = 131072;
constexpr int MISC_OFF = LDS_BYTES - 256;
constexpr size_t MiB = 1u << 20;
constexpr size_t WS_CTL = 0, CTL_ZERO_BYTES = 1 * MiB;
constexpr size_t WS_MOD = 1 * MiB;
constexpr size_t WS_COS = 2 * MiB, WS_SIN = 6 * MiB;
constexpr size_t WS_WGIN = 10 * MiB;
constexpr size_t WS_WGLR = 22 * MiB;
constexpr size_t WS_WGOUT = 23 * MiB;
constexpr size_t WS_WMIN = 27 * MiB;
constexpr size_t WS_WMOUT = 39 * MiB;
constexpr size_t WS_W1 = 43 * MiB;
constexpr size_t WS_W2 = 75 * MiB;
constexpr size_t WS_H = 107 * MiB;
constexpr size_t WS_MIX = 139 * MiB;
constexpr size_t WS_QKV = 171 * MiB;
constexpr size_t WS_AUX = 267 * MiB;
constexpr size_t WS_HID = 171 * MiB;
constexpr size_t WS_END = 363 * MiB;
constexpr size_t WS_SBUF = WS_AUX;
constexpr size_t WS_GLR = WS_AUX + 32 * MiB;
constexpr size_t WS_DG = WS_AUX + 33 * MiB;
constexpr size_t WS_XB = WS_AUX + 64 * MiB;
constexpr size_t WS_KMEAN = WS_MOD + 128 * 1024;
constexpr size_t WS_LPART = WS_H + 1 * MiB;
constexpr size_t WS_LIST = WS_H + 4 * MiB;
constexpr int CW_BAR = 4096;
constexpr int CW_MCNT = 16384;
constexpr int CW_TMO = 0;
constexpr int CW_SEAM = 32768, SEAM_BANK = 64 * 64;
constexpr size_t WS_XBUF = WS_MOD + 512 * 1024;
struct Frame {
    LAS unsigned char* lds;
    int tid, lane, wave, vcu, G;
};
__device__ __forceinline__ Frame opaque(const Frame& F0) { Frame F = F0; int t = F0.tid; asm volatile("" : "+v"(t)); F.tid = t; F.lane = t & 63; F.wave = __builtin_amdgcn_readfirstlane(t >> 6); return F; }
__device__ __forceinline__ float wave_sum(float v) {
#pragma unroll
    for (int o = 1; o < 64; o <<= 1) v += __shfl_xor(v, o);
    return v;
}
__device__ __forceinline__ float silu_f(float x) { return x / (1.f + __expf(-x)); }
__device__ __forceinline__ void sincos_acc(double ang, float& s, float& c) {
    const double n = rint(ang * 0.15915494309189535);
    double r = fma(-n, 6.283185307179586, ang); r = fma(-n, 2.4492935982947064e-16, r);
    const double x = r * 0.25, x2 = x * x;
    const double sn = x * (1.0 + x2 * (-1.0 / 6 + x2 * (1.0 / 120 + x2 * (-1.0 / 5040 + x2 * (1.0 / 362880 + x2 * (-1.0 / 39916800 + x2 * (1.0 / 6227020800.0)))))));
    const double cs = 1.0 + x2 * (-0.5 + x2 * (1.0 / 24 + x2 * (-1.0 / 720 + x2 * (1.0 / 40320 + x2 * (-1.0 / 3628800 + x2 * (1.0 / 479001600 + x2 * (-1.0 / 87178291200.0)))))));
    const double s2 = 2 * sn * cs, c2 = 1 - 2 * sn * sn;
    s = (float)(2 * s2 * c2); c = (float)(1 - 2 * s2 * s2);
}
constexpr int TR_SCR = 64 * 65 * 4;
struct TrItem { const float* W; int ld, n_off, n_cnt, K; bf16_t* WT; int item; };
__device__ __forceinline__ void tr_load(const TrItem& t, int lane, f32x4 (&v)[16]) {
    const int nblk = (t.n_cnt + 63) >> 6, kb = t.item / nblk, nb = t.item - kb * nblk, k0 = 64 * kb, n0 = 64 * nb;
    const int c4 = (lane & 15) * 4, kr = lane >> 4;
    const bool ok = (n0 + c4) < t.n_cnt;
#pragma unroll
    for (int i = 0; i < 16; ++i) v[i] = ok ? *(const f32x4*)(t.W + (size_t)(k0 + 4 * i + kr) * t.ld + t.n_off + n0 + c4) : (f32x4){0.f, 0.f, 0.f, 0.f};
}
__device__ __forceinline__ void tr_store(const TrItem& t, int lane, const f32x4 (&v)[16], LAS float* scr) {
    const int nblk = (t.n_cnt + 63) >> 6, kb = t.item / nblk, nb = t.item - kb * nblk, k0 = 64 * kb, n0 = 64 * nb;
    const int c4 = (lane & 15) * 4, kr = lane >> 4;
#pragma unroll
    for (int i = 0; i < 16; ++i) { LAS float* s = scr + (4 * i + kr) * 65 + c4; s[0] = v[i].x; s[1] = v[i].y; s[2] = v[i].z; s[3] = v[i].w; }
    asm volatile("s_waitcnt lgkmcnt(0)" ::: "memory");
    const int c = lane & 7;
#pragma unroll
    for (int j = 0; j < 8; ++j) { const int n = (lane >> 3) + 8 * j; const LAS float* s = scr + (8 * c) * 65 + n;
        u32x4 o; o.x = cvtpk(s[0 * 65], s[1 * 65]); o.y = cvtpk(s[2 * 65], s[3 * 65]); o.z = cvtpk(s[4 * 65], s[5 * 65]); o.w = cvtpk(s[6 * 65], s[7 * 65]);
        if (n0 + n < t.n_cnt) *(u32x4*)(t.WT + (size_t)(n0 + n) * t.K + k0 + 8 * c) = o; }
    asm volatile("s_waitcnt lgkmcnt(0)" ::: "memory");
}
struct MegaArgs {
    const float* in[18]; float* out; unsigned char* ws; int ph_lo, ph_hi;
};
__device__ __forceinline__ void p0_prologue(const Frame& F0, const MegaArgs& a) {
    const Frame F = opaque(F0);
    unsigned char* ws = a.ws;
    {
        LAS float* scr = (LAS float*)(F.lds + F.wave * TR_SCR);
        const int gw = F.vcu * NWAVES + F.wave, NGW = F.G * NWAVES;
        constexpr int I_GIN = 16 * 48, I_GLR = 16, I_SQ = 16 * 16, I_W1 = 16 * 64, I_W2 = 64 * 16;
        constexpr int NITEMS = 2 * I_GIN + 2 * I_GLR + 2 * I_SQ + 2 * I_GIN + 2 * I_SQ + 4 * I_W1 + 4 * I_W2;
        auto decode = [&](int it) -> TrItem {
            int r = it;
            if (r < 2 * I_GIN) { const int j = r / I_GIN; return TrItem{a.in[7] + (size_t)j * D * GLA_IN, GLA_IN, 0, 3072, D, (bf16_t*)(ws + WS_WGIN) + (size_t)j * 3072 * D, r % I_GIN}; } r -= 2 * I_GIN;
            if (r < 2 * I_GLR) { const int j = r / I_GLR; return TrItem{a.in[7] + (size_t)j * D * GLA_IN, GLA_IN, 3072, 16, D, (bf16_t*)(ws + WS_WGLR) + (size_t)j * 16 * D, r % I_GLR}; } r -= 2 * I_GLR;
            if (r < 2 * I_SQ) { const int j = r / I_SQ; return TrItem{a.in[11] + (size_t)j * D * D, D, 0, D, D, (bf16_t*)(ws + WS_WGOUT) + (size_t)j * D * D, r % I_SQ}; } r -= 2 * I_SQ;
            if (r < 2 * I_GIN) { const int j = r / I_GIN; return TrItem{a.in[12] + (size_t)j * D * MB_IN, MB_IN, 0, 3072, D, (bf16_t*)(ws + WS_WMIN) + (size_t)j * 3072 * D, r % I_GIN}; } r -= 2 * I_GIN;
            if (r < 2 * I_SQ) { const int j = r / I_SQ; return TrItem{a.in[15] + (size_t)j * D * D, D, 0, D, D, (bf16_t*)(ws + WS_WMOUT) + (size_t)j * D * D, r % I_SQ}; } r -= 2 * I_SQ;
            if (r < 4 * I_W1) { const int j = r / I_W1; return TrItem{a.in[16] + (size_t)j * D * DFF, DFF, 0, DFF, D, (bf16_t*)(ws + WS_W1) + (size_t)j * DFF * D, r % I_W1}; } r -= 4 * I_W1;
            { const int j = r / I_W2; return TrItem{a.in[17] + (size_t)j * DFF * D, D, 0, D, DFF, (bf16_t*)(ws + WS_W2) + (size_t)j * D * DFF, r % I_W2}; }
        };
        f32x4 va[16], vb[16];
        int it = gw;
        if (it < NITEMS) { TrItem cur = decode(it); tr_load(cur, F.lane, va);
            for (;;) {
                const int itn = it + NGW; TrItem nx = cur; const bool more = itn < NITEMS;
                if (more) { nx = decode(itn); tr_load(nx, F.lane, vb); }
                tr_store(cur, F.lane, va, scr);
                if (!more) break;
                const int itn2 = itn + NGW; const bool more2 = itn2 < NITEMS; TrItem nx2 = nx;
                if (more2) { nx2 = decode(itn2); tr_load(nx2, F.lane, va); }
                tr_store(nx, F.lane, vb, scr);
                if (!more2) break;
                cur = nx2; it = itn2;
            }
        }
    }
    __syncthreads();
    {
        const float* c = a.in[1]; const float* ada_w = a.in[3]; const float* ada_b = a.in[4]; float* mod = (float*)(ws + WS_MOD);
        LAS float* sc = (LAS float*)F.lds;
        LAS float* red = (LAS float*)F.lds + 1024;
        for (int k = F.tid; k < D; k += NTHR) sc[k] = silu_f(c[k]);
        __syncthreads();
        const int kg = F.tid >> 5, cl = F.tid & 31;
        for (int chunk = F.vcu; chunk < 256; chunk += F.G) {
            float part[3];
#pragma unroll
            for (int cc = 0; cc < 3; ++cc) {
                const int col = chunk * 96 + cc * 32 + cl, i = col / (6 * D), n = col - i * 6 * D;
                const float* w = ada_w + (size_t)i * D * 6 * D + (size_t)(kg * 64) * 6 * D + n;
                float wv[64];
#pragma unroll
                for (int k = 0; k < 64; ++k) wv[k] = w[(size_t)k * 6 * D];
                float acc = 0.f;
#pragma unroll
                for (int k = 0; k < 64; ++k) acc += sc[kg * 64 + k] * wv[k];
                part[cc] = acc;
            }
#pragma unroll
            for (int cc = 0; cc < 3; ++cc) red[kg * 96 + cc * 32 + cl] = part[cc];
            __syncthreads();
            if (F.tid < 96) { float s = 0.f;
#pragma unroll
                for (int g = 0; g < 16; ++g) s += red[g * 96 + F.tid];
                mod[chunk * 96 + F.tid] = s + ada_b[chunk * 96 + F.tid]; }
            __syncthreads();
        }
    }
    {
        const int* pos = (const int*)a.in[2]; float* ct = (float*)(ws + WS_COS); float* st = (float*)(ws + WS_SIN);
        for (int idx = F.vcu * NTHR + F.tid; idx < S * 64; idx += F.G * NTHR) {
            const int t = idx >> 6, i = idx & 63;
            const float inv_freq = (float)exp2(-(double)i * (13.287712379549449 / 64.0));
            const float angf = (float)pos[t] * inv_freq;
            float sn, cs; sincos_acc((double)angf, sn, cs);
            ct[idx] = cs; st[idx] = sn;
        }
    }
}
__device__ __forceinline__ void norm_phase(const Frame& F0, const float* __restrict__ x, const float* __restrict__ g, const float* __restrict__ sc, const float* __restrict__ sh, bf16_t* __restrict__ h) {
    const Frame F = opaque(F0);
    f32x4 ga[4], gb[4];
#pragma unroll
    for (int j = 0; j < 4; ++j) { const f32x4 gg = ((const f32x4*)g)[F.lane + 64 * j], s1 = ((const f32x4*)sc)[F.lane + 64 * j]; ga[j] = gg * (s1 + 1.0f); gb[j] = ((const f32x4*)sh)[F.lane + 64 * j]; }
    const int gw = F.vcu * NWAVES + F.wave, NGW = F.G * NWAVES;
    for (int m = gw; m < S; m += NGW) {
        const f32x4* xr = (const f32x4*)(x + (size_t)m * D) + F.lane;
        f32x4 v[4]; float ss = 0.f;
#pragma unroll
        for (int j = 0; j < 4; ++j) { v[j] = xr[64 * j]; ss += (v[j].x * v[j].x + v[j].y * v[j].y) + (v[j].z * v[j].z + v[j].w * v[j].w); }
        const float r = 1.0f / sqrtf(wave_sum(ss) * (1.f / D) + EPS);
        u32x2* o8 = (u32x2*)(h + (size_t)m * D) + F.lane;
#pragma unroll
        for (int j = 0; j < 4; ++j) { const f32x4 y = v[j] * r * ga[j] + gb[j]; u32x2 w; w.x = cvtpk(y.x, y.y); w.y = cvtpk(y.z, y.w); o8[64 * j] = w; }
    }
}
__device__ __forceinline__ void glr_phase(const Frame& F0, const bf16_t* __restrict__ H, const bf16_t* __restrict__ WglrT, float* __restrict__ glr) {
    const Frame F = opaque(F0);
    if (F.wave >= 4) return;
    const int l15 = F.lane & 15, q = F.lane >> 4;
    for (int rb = F.vcu; rb < S / 64; rb += F.G) {
        const int row0 = rb * 64 + F.wave * 16;
        const bf16_t* ap = H + (size_t)(row0 + l15) * D + 8 * q;
        const bf16_t* bp = WglrT + (size_t)l15 * D + 8 * q;
        f32x4 acc = {0.f, 0.f, 0.f, 0.f};
#pragma unroll 8
        for (int ks = 0; ks < 32; ++ks) {
            const bf16x8 av = *(const bf16x8*)(ap + ks * 32), bv = *(const bf16x8*)(bp + ks * 32);
            acc = __builtin_amdgcn_mfma_f32_16x16x32_bf16(av, bv, acc, 0, 0, 0);
        }
#pragma unroll
        for (int r = 0; r < 4; ++r) glr[(size_t)(row0 + 4 * q + r) * 16 + l15] = acc[r];
    }
}
typedef short v4i16_t __attribute__((ext_vector_type(4)));
__device__ __forceinline__ s16x4 vtr(const LAS unsigned char* p) { return __builtin_bit_cast(s16x4, __builtin_amdgcn_ds_read_tr16_b64_v4i16((LAS v4i16_t*)p)); }
__device__ __forceinline__ int crow(int reg, int h) { return (reg & 3) + 8 * (reg >> 2) + 4 * h; }
__device__ __forceinline__ unsigned off_b(unsigned row, unsigned ch) { return 272u * row + 16u * ch; }
__device__ __forceinline__ unsigned tr_addr(unsigned lane, unsigned c, unsigned rowblk) {
    const unsigned blk = (lane >> 4) & 1, q = (lane & 15) >> 2, p = lane & 3;
    return off_b(rowblk + q, 4 * c + 2 * blk + (p >> 1)) + 8 * (p & 1);
}
constexpr int GL_IMG = 64 * 272, GL_PST = 144;
constexpr int GL_QD = 0, GL_KI = GL_IMG, GL_KT = 2 * GL_IMG, GL_V = 3 * GL_IMG, GL_P = 5 * GL_IMG, GL_GL = GL_P + 64 * GL_PST, GL_SEG = GL_GL + 4096, GL_DEC = GL_SEG + 2048, GL_RED = GL_DEC + 512;
static_assert(GL_RED + 2048 <= RING_BYTES, "gla lds");
#define MFMA32(a, b, c) __builtin_amdgcn_mfma_f32_32x32x16_bf16((a), (b), (c), 0, 0, 0)

struct GlaPre { f32x4 ga, gb; unsigned qk[16]; };
__device__ __forceinline__ void gla_prefetch_g(const Frame& F, const float* __restrict__ GLR, int t0, GlaPre& P) {
    const int ib = F.wave >> 2, l31 = F.lane & 31, h = F.lane >> 5;
    const float* gp = GLR + (size_t)(t0 + 32 * ib + l31) * 16 + 8 * h;
    P.ga = *(const f32x4*)gp; P.gb = *(const f32x4*)(gp + 4);
}
template <bool WITH_Q>
__device__ __forceinline__ void gla_prefetch(const Frame& F, const bf16_t* __restrict__ QKV, const float* __restrict__ GLR, int t0, int hd, GlaPre& P);
template <bool WITH_Q>
__device__ __forceinline__ void gla_prefetch_qk(const Frame& F, const bf16_t* __restrict__ QKV, int t0, int hd, GlaPre& P) {
    const int w = F.wave, ib = w >> 2, db = w & 3, l31 = F.lane & 31, h = F.lane >> 5;
#pragma unroll
    for (int r = 0; r < 16; ++r) {
        const bf16_t* row = QKV + (size_t)(t0 + 32 * ib + crow(r, h)) * 3072 + hd * 128 + 32 * db + l31;
        const unsigned kk = row[512]; const unsigned qq = WITH_Q ? (unsigned)row[0] : 0u;
        P.qk[r] = qq | (kk << 16);
    }
}
template <bool WITH_Q>
__device__ __forceinline__ void gla_prefetch(const Frame& F, const bf16_t* __restrict__ QKV, const float* __restrict__ GLR, int t0, int hd, GlaPre& P) {
    gla_prefetch_g(F, GLR, t0, P); gla_prefetch_qk<WITH_Q>(F, QKV, t0, hd, P);
}
struct GlaW { u32x4 bhi, blo; float bias; };
__device__ __forceinline__ void gla_load_w(const float* __restrict__ wupg, const float* __restrict__ bgg, int hd, const Frame& F, GlaW& W) {
    const int db = F.wave & 3, l31 = F.lane & 31, h = F.lane >> 5, d = hd * 128 + 32 * db + l31;
    float wv[8];
#pragma unroll
    for (int j = 0; j < 8; ++j) wv[j] = wupg[(8 * h + j) * 512 + d];
    W.bhi.x = cvtpk(wv[0], wv[1]); W.bhi.y = cvtpk(wv[2], wv[3]); W.bhi.z = cvtpk(wv[4], wv[5]); W.bhi.w = cvtpk(wv[6], wv[7]);
    W.blo.x = cvtpk(wv[0] - bflo(W.bhi.x), wv[1] - bfhi(W.bhi.x)); W.blo.y = cvtpk(wv[2] - bflo(W.bhi.y), wv[3] - bfhi(W.bhi.y));
    W.blo.z = cvtpk(wv[4] - bflo(W.bhi.z), wv[5] - bfhi(W.bhi.z)); W.blo.w = cvtpk(wv[6] - bflo(W.bhi.w), wv[7] - bfhi(W.bhi.w));
    W.bias = bgg[d];
}
template <bool WITH_Q>
__device__ __forceinline__ float gla_chunk_prep(const Frame& F, const GlaPre& P, const GlaW& W, const bf16_t* __restrict__ QKV, int t0, int hd) {
    LAS unsigned char* lds = F.lds;
    const int w = F.wave, ib = w >> 2, db = w & 3, l31 = F.lane & 31, h = F.lane >> 5, d = 32 * db + l31;
    u32x4 vv[4];
#pragma unroll
    for (int k = 0; k < 4; ++k) { const int c = F.tid + 512 * k, j = c >> 5, ch = c & 31; vv[k] = *(const u32x4*)(QKV + (size_t)(t0 + j) * 3072 + 1024 + hd * 256 + ch * 8); }
    u32x4 ahi, alo;
    ahi.x = cvtpk(P.ga.x, P.ga.y); ahi.y = cvtpk(P.ga.z, P.ga.w); ahi.z = cvtpk(P.gb.x, P.gb.y); ahi.w = cvtpk(P.gb.z, P.gb.w);
    alo.x = cvtpk(P.ga.x - bflo(ahi.x), P.ga.y - bfhi(ahi.x)); alo.y = cvtpk(P.ga.z - bflo(ahi.y), P.ga.w - bfhi(ahi.y));
    alo.z = cvtpk(P.gb.x - bflo(ahi.z), P.gb.y - bfhi(ahi.z)); alo.w = cvtpk(P.gb.z - bflo(ahi.w), P.gb.w - bfhi(ahi.w));
    f32x16 X;
#pragma unroll
    for (int r = 0; r < 16; ++r) X[r] = W.bias;
    X = MFMA32(__builtin_bit_cast(bf16x8, ahi), __builtin_bit_cast(bf16x8, W.bhi), X);
    X = MFMA32(__builtin_bit_cast(bf16x8, alo), __builtin_bit_cast(bf16x8, W.bhi), X);
    X = MFMA32(__builtin_bit_cast(bf16x8, ahi), __builtin_bit_cast(bf16x8, W.blo), X);
    float G[16], sk[4];
#pragma unroll
    for (int k = 0; k < 4; ++k) { float run = 0.f;
#pragma unroll
        for (int j = 0; j < 4; ++j) { const float x = X[4 * k + j]; const float ls = fminf(x, 0.f) - __logf(1.f + __expf(-fabsf(x))); run += ls * (1.f / 16.f); G[4 * k + j] = run; }
        sk[k] = run; }
    float base = 0.f, tot;
    {
        float ps[4];
#pragma unroll
        for (int k = 0; k < 4; ++k) ps[k] = __shfl_xor(sk[k], 32);
#pragma unroll
        for (int k = 0; k < 4; ++k) { const float bk = base + (h ? ps[k] : 0.f);
#pragma unroll
            for (int j = 0; j < 4; ++j) G[4 * k + j] += bk;
            base += sk[k] + ps[k]; }
        tot = base;
    }
    LAS float* HT = (LAS float*)(lds + GL_SEG);
    if (h == 0) HT[ib * 128 + d] = tot;
#pragma unroll
    for (int k = 0; k < 4; ++k) { const int c = F.tid + 512 * k, j = c >> 5, ch = c & 31; *(LAS u32x4*)(lds + GL_V + (ch >> 4) * GL_IMG + off_b(j, ch & 15)) = vv[k]; }
    __syncthreads();
    const float t0h = HT[d], t1h = HT[128 + d], glast = t0h + t1h;
    const float add = ib ? t0h : 0.f;
    const float qs = 0.08838834764831845f;
#pragma unroll
    for (int r = 0; r < 16; ++r) {
        const int i = 32 * ib + crow(r, h); const float Gv = G[r] + add;
        const unsigned a = off_b(i, d >> 3) + 2 * (d & 7);
        const float kf = bfhi(P.qk[r]);
        if (WITH_Q) {
            *(LAS unsigned short*)(lds + GL_QD + a) = (unsigned short)(cvtpk(bflo(P.qk[r]) * qs * __expf(Gv), 0.f) & 0xffffu);
            *(LAS unsigned short*)(lds + GL_KI + a) = (unsigned short)(cvtpk(kf * __expf(-Gv), 0.f) & 0xffffu);
        }
        *(LAS unsigned short*)(lds + GL_KT + a) = (unsigned short)(cvtpk(kf * __expf(glast - Gv), 0.f) & 0xffffu);
    }
    if (ib == 0 && h == 0) ((LAS float*)(lds + GL_DEC))[d] = __expf(glast);
    __syncthreads();
    return glast;
}
__device__ __forceinline__ void gla_state_update(const Frame& F, f32x16 (&St)[4]) {
    LAS unsigned char* lds = F.lds;
    const int h = F.lane >> 5, w = F.wave;
    const LAS float* dec = (const LAS float*)(lds + GL_DEC);
#pragma unroll
    for (int db = 0; db < 4; ++db)
#pragma unroll
        for (int r = 0; r < 16; ++r) St[db][r] *= dec[32 * db + crow(r, h)];
    const LAS unsigned char* vimg = lds + GL_V + (w >> 2) * GL_IMG;
#pragma unroll
    for (int ks = 0; ks < 4; ++ks) {
        const s16x4 vlo = vtr(vimg + tr_addr(F.lane, w & 3, 16 * ks + 8 * h)), vhi = vtr(vimg + tr_addr(F.lane, w & 3, 16 * ks + 8 * h + 4));
        const bf16x8 vb = __builtin_shufflevector(vlo, vhi, 0, 1, 2, 3, 4, 5, 6, 7);
#pragma unroll
        for (int db = 0; db < 4; ++db) {
            const s16x4 klo = vtr(lds + GL_KT + tr_addr(F.lane, db, 16 * ks + 8 * h)), khi = vtr(lds + GL_KT + tr_addr(F.lane, db, 16 * ks + 8 * h + 4));
            const bf16x8 ka = __builtin_shufflevector(klo, khi, 0, 1, 2, 3, 4, 5, 6, 7);
            St[db] = MFMA32(ka, vb, St[db]);
        }
    }
}
__device__ __forceinline__ void gla_g1(const Frame& F0, const bf16_t* __restrict__ QKV, const float* __restrict__ GLR, const float* __restrict__ wupg, const float* __restrict__ bgg, float* __restrict__ SBUF, float* __restrict__ DG) {
    const Frame F = opaque(F0);
    const int h = F.lane >> 5, w = F.wave;
    for (int u = F.vcu; u < 256; u += F.G) {
        const int gi = u >> 2, hd = u & 3;
        GlaW W; gla_load_w(wupg, bgg, hd, F, W);
        f32x16 St[4];
#pragma unroll
        for (int db = 0; db < 4; ++db)
#pragma unroll
            for (int r = 0; r < 16; ++r) St[db][r] = 0.f;
        float gsum = 0.f;
        GlaPre P; gla_prefetch<false>(F, QKV, GLR, gi * 256, hd, P);
#pragma unroll 1
        for (int c = 0; c < 4; ++c) {
            gsum += gla_chunk_prep<false>(F, P, W, QKV, gi * 256 + c * 64, hd);
            if (c < 3) gla_prefetch<false>(F, QKV, GLR, gi * 256 + (c + 1) * 64, hd, P);
            gla_state_update(F, St);
            __syncthreads();
        }
        float* sp = SBUF + ((size_t)u * 128) * 256 + 32 * w + (F.lane & 31);
#pragma unroll
        for (int db = 0; db < 4; ++db)
#pragma unroll
            for (int r = 0; r < 16; ++r) sp[(size_t)(32 * db + crow(r, h)) * 256] = St[db][r];
        if ((w >> 2) == 0 && h == 0) DG[u * 128 + 32 * (w & 3) + (F.lane & 31)] = __expf(gsum);
    }
}
__device__ __forceinline__ void gla_g2(const Frame& F0, float* __restrict__ SBUF, const float* __restrict__ DG) {
    const Frame F = opaque(F0);
    for (int e = F.vcu * NTHR + F.tid; e < 4 * 128 * 256; e += F.G * NTHR) {
        const int hd = e >> 15, d = (e >> 8) & 127;
        float run = 0.f;
#pragma unroll 1
        for (int g0 = 0; g0 < 64; g0 += 8) {
            float tmp[8], dec[8];
#pragma unroll
            for (int k = 0; k < 8; ++k) { const int g = g0 + k; tmp[k] = SBUF[(size_t)(g * 4 + hd) * 32768 + (e & 32767)]; dec[k] = DG[(g * 4 + hd) * 128 + d]; }
#pragma unroll
            for (int k = 0; k < 8; ++k) { const int g = g0 + k; SBUF[(size_t)(g * 4 + hd) * 32768 + (e & 32767)] = run; run = dec[k] * run + tmp[k]; }
        }
    }
}
__device__ __forceinline__ void gla_g3(const Frame& F0, const bf16_t* __restrict__ QKV, const float* __restrict__ GLR, const float* __restrict__ wupg, const float* __restrict__ bgg,
                                       const float* __restrict__ SBUF, const float* __restrict__ og, bf16_t* __restrict__ MIX) {
    const Frame F = opaque(F0);
    LAS unsigned char* lds = F.lds;
    const int h = F.lane >> 5, w = F.wave, l31 = F.lane & 31;
    for (int u = F.vcu; u < 256; u += F.G) {
        const int gi = u >> 2, hd = u & 3;
        GlaW W; gla_load_w(wupg, bgg, hd, F, W);
        f32x16 St[4];
        { const float* sp = SBUF + ((size_t)u * 128) * 256 + 32 * w + l31;
#pragma unroll
          for (int db = 0; db < 4; ++db)
#pragma unroll
              for (int r = 0; r < 16; ++r) St[db][r] = sp[(size_t)(32 * db + crow(r, h)) * 256]; }
#pragma unroll 1
        for (int c = 0; c < 4; ++c) {
            const int t0 = gi * 256 + c * 64;
            { GlaPre P; gla_prefetch<true>(F, QKV, GLR, t0, hd, P); (void)gla_chunk_prep<true>(F, P, W, QKV, t0, hd); }
            if (w < 3) {
                const int ib = (w >= 1), jb = (w == 2);
                f32x16 acc;
#pragma unroll
                for (int r = 0; r < 16; ++r) acc[r] = 0.f;
#pragma unroll
                for (int s = 0; s < 8; ++s) {
                    const bf16x8 a = *(const LAS bf16x8*)(lds + GL_QD + off_b(32 * ib + l31, 2 * s + h));
                    const bf16x8 b = *(const LAS bf16x8*)(lds + GL_KI + off_b(32 * jb + l31, 2 * s + h));
                    acc = MFMA32(a, b, acc);
                }
                const int jabs = 32 * jb + l31;
#pragma unroll
                for (int r = 0; r < 16; ++r) { const int iabs = 32 * ib + crow(r, h); const float pv = (jabs <= iabs) ? acc[r] : 0.f;
                    *(LAS unsigned short*)(lds + GL_P + iabs * GL_PST + 2 * jabs) = (unsigned short)(cvtpk(pv, 0.f) & 0xffffu); }
            }
            f32x16 oT[2];
#pragma unroll
            for (int ib = 0; ib < 2; ++ib)
#pragma unroll
                for (int r = 0; r < 16; ++r) oT[ib][r] = 0.f;
#pragma unroll
            for (int db = 0; db < 4; ++db)
#pragma unroll
                for (int s = 0; s < 2; ++s) {
                    u32x4 pk; pk.x = cvtpk(St[db][8 * s + 0], St[db][8 * s + 1]); pk.y = cvtpk(St[db][8 * s + 2], St[db][8 * s + 3]); pk.z = cvtpk(St[db][8 * s + 4], St[db][8 * s + 5]); pk.w = cvtpk(St[db][8 * s + 6], St[db][8 * s + 7]);
                    const bf16x8 xa = __builtin_bit_cast(bf16x8, pk);
#pragma unroll
                    for (int ib = 0; ib < 2; ++ib) {
                        const u32x2 qlo = *(const LAS u32x2*)(lds + GL_QD + off_b(32 * ib + l31, 4 * db + 2 * s + 0) + 8 * h);
                        const u32x2 qhi = *(const LAS u32x2*)(lds + GL_QD + off_b(32 * ib + l31, 4 * db + 2 * s + 1) + 8 * h);
                        u32x4 qq; qq.x = qlo.x; qq.y = qlo.y; qq.z = qhi.x; qq.w = qhi.y;
                        oT[ib] = MFMA32(xa, __builtin_bit_cast(bf16x8, qq), oT[ib]);
                    }
                }
            __syncthreads();
            {
                const LAS unsigned char* vimg = lds + GL_V + (w >> 2) * GL_IMG;
#pragma unroll
                for (int ks = 0; ks < 4; ++ks) {
                    const s16x4 vlo = vtr(vimg + tr_addr(F.lane, w & 3, 16 * ks + 8 * h)), vhi = vtr(vimg + tr_addr(F.lane, w & 3, 16 * ks + 8 * h + 4));
                    const bf16x8 va = __builtin_shufflevector(vlo, vhi, 0, 1, 2, 3, 4, 5, 6, 7);
#pragma unroll
                    for (int ib = 0; ib < 2; ++ib) {
                        if (ib == 0 && ks >= 2) continue;
                        const int irow = 32 * ib + l31;
                        const bf16x8 pb = *(const LAS bf16x8*)(lds + GL_P + irow * GL_PST + 16 * (2 * ks + h));
                        oT[ib] = MFMA32(va, pb, oT[ib]);
                    }
                }
            }
            float ssq[2];
#pragma unroll
            for (int ib = 0; ib < 2; ++ib) { float s = 0.f;
#pragma unroll
                for (int r = 0; r < 16; ++r) s += oT[ib][r] * oT[ib][r];
                s += __shfl_xor(s, 32); ssq[ib] = s; }
            if (h == 0) { ((LAS float*)(lds + GL_RED))[w * 64 + l31] = ssq[0]; ((LAS float*)(lds + GL_RED))[w * 64 + 32 + l31] = ssq[1]; }
            __syncthreads();
#pragma unroll
            for (int ib = 0; ib < 2; ++ib) {
                float tot = 0.f;
#pragma unroll
                for (int ww = 0; ww < 8; ++ww) tot += ((LAS float*)(lds + GL_RED))[ww * 64 + 32 * ib + l31];
                const float rn = 1.0f / sqrtf(tot * (1.f / 256.f) + EPS);
                const int t = t0 + 32 * ib + l31;
#pragma unroll
                for (int g = 0; g < 4; ++g) {
                    const int e0 = 32 * w + 8 * g + 4 * h;
                    const u32x2 rg = *(const u32x2*)(QKV + (size_t)t * 3072 + 2048 + hd * 256 + e0);
                    const f32x4 ogv = *(const f32x4*)(og + e0);
                    const float r0 = bflo(rg.x), r1 = bfhi(rg.x), r2 = bflo(rg.y), r3 = bfhi(rg.y);
                    const float y0 = oT[ib][4 * g + 0] * rn * ogv.x * (r0 / (1.f + __expf(-r0)));
                    const float y1 = oT[ib][4 * g + 1] * rn * ogv.y * (r1 / (1.f + __expf(-r1)));
                    const float y2 = oT[ib][4 * g + 2] * rn * ogv.z * (r2 / (1.f + __expf(-r2)));
                    const float y3 = oT[ib][4 * g + 3] * rn * ogv.w * (r3 / (1.f + __expf(-r3)));
                    u32x2 o; o.x = cvtpk(y0, y1); o.y = cvtpk(y2, y3);
                    *(u32x2*)(MIX + (size_t)t * D + hd * 256 + e0) = o;
                }
            }
            if (c < 3) gla_state_update(F, St);
            __syncthreads();
        }
    }
}
constexpr int MB_LIST_H = 516096;
__device__ __forceinline__ int mb_list_off(int n) { return 256 * (63 * n - (n * (n - 1)) / 2); }
constexpr int MB_OST = 2 * 128 * 256, MB_OSTW = 32 * 264;
constexpr int MB_PRE = MB_OST + 8 * MB_OSTW, MB_END = MB_PRE + 2064;
static_assert(MB_END <= MISC_OFF, "moba lds");

__device__ __forceinline__ void moba_m1_tile(const Frame& F, int pm, int pn, bf16_t* __restrict__ QKV, const float* __restrict__ COS, const float* __restrict__ SIN,
                                             const float* __restrict__ qg, const float* __restrict__ kg, float* __restrict__ KMEAN) {
    LAS unsigned char* lds = F.lds;
    const int which = (pn >= 4), h0 = 2 * (pn & 3);
    const int ts = F.lane >> 4, hs = (F.lane >> 3) & 1, j = F.lane & 7;
    const float* g = which ? kg : qg;
    const float gsc = which ? 1.0f : (0.08838834764831845f * 1.4426950408889634f);
    float g1[8], g2[8], a1[8], a2[8];
#pragma unroll
    for (int e = 0; e < 8; ++e) { g1[e] = g[8 * j + e] * gsc; g2[e] = g[64 + 8 * j + e] * gsc; a1[e] = 0.f; a2[e] = 0.f; }
#pragma unroll 2
    for (int it = 0; it < 8; ++it) {
        const int t = pm * 256 + (it * 8 + F.wave) * 4 + ts;
        bf16_t* p = QKV + (size_t)t * 3072 + which * 1024 + (h0 + hs) * 128 + 8 * j;
        const u32x4 ra = *(const u32x4*)p, rb = *(const u32x4*)(p + 64);
        const f32x4 c0 = *(const f32x4*)(COS + (size_t)t * 64 + 8 * j), c1 = *(const f32x4*)(COS + (size_t)t * 64 + 8 * j + 4);
        const f32x4 s0 = *(const f32x4*)(SIN + (size_t)t * 64 + 8 * j), s1 = *(const f32x4*)(SIN + (size_t)t * 64 + 8 * j + 4);
        float x1[8] = {bflo(ra.x), bfhi(ra.x), bflo(ra.y), bfhi(ra.y), bflo(ra.z), bfhi(ra.z), bflo(ra.w), bfhi(ra.w)};
        float x2[8] = {bflo(rb.x), bfhi(rb.x), bflo(rb.y), bfhi(rb.y), bflo(rb.z), bfhi(rb.z), bflo(rb.w), bfhi(rb.w)};
        const float cs[8] = {c0.x, c0.y, c0.z, c0.w, c1.x, c1.y, c1.z, c1.w};
        const float sn[8] = {s0.x, s0.y, s0.z, s0.w, s1.x, s1.y, s1.z, s1.w};
        float ss = 0.f;
#pragma unroll
        for (int e = 0; e < 8; ++e) ss += x1[e] * x1[e] + x2[e] * x2[e];
        ss += __shfl_xor(ss, 1); ss += __shfl_xor(ss, 2); ss += __shfl_xor(ss, 4);
        const float r = 1.0f / sqrtf(ss * (1.f / 128.f) + EPS);
        float o1[8], o2[8];
#pragma unroll
        for (int e = 0; e < 8; ++e) { const float y1 = x1[e] * r * g1[e], y2 = x2[e] * r * g2[e]; o1[e] = y1 * cs[e] - y2 * sn[e]; o2[e] = y2 * cs[e] + y1 * sn[e]; a1[e] += o1[e]; a2[e] += o2[e]; }
        u32x4 wa, wb;
        wa.x = cvtpk(o1[0], o1[1]); wa.y = cvtpk(o1[2], o1[3]); wa.z = cvtpk(o1[4], o1[5]); wa.w = cvtpk(o1[6], o1[7]);
        wb.x = cvtpk(o2[0], o2[1]); wb.y = cvtpk(o2[2], o2[3]); wb.z = cvtpk(o2[4], o2[5]); wb.w = cvtpk(o2[6], o2[7]);
        *(u32x4*)p = wa; *(u32x4*)(p + 64) = wb;
    }
    if (which) {
#pragma unroll
        for (int e = 0; e < 8; ++e) { a1[e] += __shfl_xor(a1[e], 16); a1[e] += __shfl_xor(a1[e], 32); a2[e] += __shfl_xor(a2[e], 16); a2[e] += __shfl_xor(a2[e], 32); }
        LAS float* red = (LAS float*)lds;
        if (ts == 0) {
#pragma unroll
            for (int e = 0; e < 8; ++e) { red[(F.wave * 2 + hs) * 128 + 8 * j + e] = a1[e]; red[(F.wave * 2 + hs) * 128 + 64 + 8 * j + e] = a2[e]; } }
        __syncthreads();
        if (F.tid < 256) { const int hh = F.tid >> 7, d = F.tid & 127; float s = 0.f;
#pragma unroll
            for (int w = 0; w < 8; ++w) s += red[(w * 2 + hh) * 128 + d];
            KMEAN[((size_t)(h0 + hh) * 64 + pm) * 128 + d] = s * (1.f / 256.f); }
        __syncthreads();
    }
}
__device__ __forceinline__ void moba_m1_tail(const Frame& F0, int G, int c, bf16_t* __restrict__ QKV, const float* __restrict__ COS, const float* __restrict__ SIN,
                                             const float* __restrict__ qg, const float* __restrict__ kg, float* __restrict__ KMEAN) {
    const Frame F = opaque(F0);
    pg8::StaticOrder So; So.init(S, 3072, G, c);
#pragma unroll 1
    for (int i = 0; i < 3; ++i) {
        pg8::Unit u; if (!So.next(i, u)) break;
        if (u.pn < 8) moba_m1_tile(F, u.pm, u.pn, QKV, COS, SIN, qg, kg, KMEAN);
    }
}
#define MB_INS(v, i) do { const float v_ = (v); const int i_ = (i); \
    const bool b0_ = v_ > v0 || (v_ == v0 && i_ < i0), b1_ = v_ > v1 || (v_ == v1 && i_ < i1), b2_ = v_ > v2 || (v_ == v2 && i_ < i2); \
    if (b0_) { v2 = v1; i2 = i1; v1 = v0; i1 = i0; v0 = v_; i0 = i_; } else if (b1_) { v2 = v1; i2 = i1; v1 = v_; i1 = i_; } else if (b2_) { v2 = v_; i2 = i_; } } while (0)
__device__ __forceinline__ void moba_m2(const Frame& F0, const bf16_t* __restrict__ QKV, const float* __restrict__ KMEAN, unsigned* __restrict__ gcnt, int* __restrict__ LIST) {
    const Frame F = opaque(F0);
    LAS unsigned char* lds = F.lds;
    LAS int* cntl = (LAS int*)lds;
    LAS float* kml = (LAS float*)(lds + 1024);
    const int h2 = F.lane >> 5, l31 = F.lane & 31, w = F.wave;
    for (int u = F.vcu; u < 512; u += F.G) {
        const int b = u >> 3, h = u & 7;
        if (b == 0) continue;
        if (F.tid < 64) cntl[F.tid] = 0;
#pragma unroll
        for (int k = 0; k < 4; ++k) { const int idx = F.tid + 512 * k, nr = idx >> 5, c4 = (idx & 31) * 4;
            if (nr < b) { const f32x4 v = *(const f32x4*)(KMEAN + ((size_t)h * 64 + nr) * 128 + c4); *(LAS f32x4*)(kml + nr * 132 + c4) = v; } }
        __syncthreads();
        const int t = b * 256 + 32 * w + l31;
        bf16x8 qf[8];
#pragma unroll
        for (int s = 0; s < 8; ++s) qf[s] = *(const bf16x8*)(QKV + (size_t)t * 3072 + h * 128 + 16 * s + 8 * h2);
        float v0 = -INFINITY, v1 = -INFINITY, v2 = -INFINITY; int i0 = 64, i1 = 64, i2 = 64;
#pragma unroll
        for (int nb = 0; nb < 2; ++nb) {
            if (nb == 1 && b <= 32) continue;
            f32x16 acc;
#pragma unroll
            for (int r = 0; r < 16; ++r) acc[r] = 0.f;
            const LAS float* kmp = kml + (32 * nb + l31) * 132 + 8 * h2;
#pragma unroll
            for (int s = 0; s < 8; ++s) {
                const f32x4 ka = *(const LAS f32x4*)(kmp + 16 * s), kb = *(const LAS f32x4*)(kmp + 16 * s + 4);
                u32x4 hi; hi.x = cvtpk(ka.x, ka.y); hi.y = cvtpk(ka.z, ka.w); hi.z = cvtpk(kb.x, kb.y); hi.w = cvtpk(kb.z, kb.w);
                u32x4 lo; lo.x = cvtpk(ka.x - bflo(hi.x), ka.y - bfhi(hi.x)); lo.y = cvtpk(ka.z - bflo(hi.y), ka.w - bfhi(hi.y));
                lo.z = cvtpk(kb.x - bflo(hi.z), kb.y - bfhi(hi.z)); lo.w = cvtpk(kb.z - bflo(hi.w), kb.w - bfhi(hi.w));
                acc = MFMA32(__builtin_bit_cast(bf16x8, hi), qf[s], acc);
                acc = MFMA32(__builtin_bit_cast(bf16x8, lo), qf[s], acc);
            }
#pragma unroll
            for (int r = 0; r < 16; ++r) { const int n = 32 * nb + crow(r, h2); const float gv = (n < b) ? acc[r] : -INFINITY; MB_INS(gv, n); }
        }
        { const float p0 = __shfl_xor(v0, 32), p1 = __shfl_xor(v1, 32), p2 = __shfl_xor(v2, 32); const int q0 = __shfl_xor(i0, 32), q1 = __shfl_xor(i1, 32), q2 = __shfl_xor(i2, 32);
          MB_INS(p0, q0); MB_INS(p1, q1); MB_INS(p2, q2); }
        int pos0 = 0, pos1 = 0, pos2 = 0;
        const bool e0 = (h2 == 0) && (v0 > -INFINITY), e1 = (h2 == 0) && (v1 > -INFINITY), e2 = (h2 == 0) && (v2 > -INFINITY);
        if (e0) pos0 = __hip_atomic_fetch_add(cntl + i0, 1, __ATOMIC_RELAXED, __HIP_MEMORY_SCOPE_WORKGROUP);
        if (e1) pos1 = __hip_atomic_fetch_add(cntl + i1, 1, __ATOMIC_RELAXED, __HIP_MEMORY_SCOPE_WORKGROUP);
        if (e2) pos2 = __hip_atomic_fetch_add(cntl + i2, 1, __ATOMIC_RELAXED, __HIP_MEMORY_SCOPE_WORKGROUP);
        __syncthreads();
        if (F.tid < 64) { const int c = cntl[F.tid]; int base = 0; if (c > 0) base = (int)__hip_atomic_fetch_add(gcnt + h * 64 + F.tid, (unsigned)c, __ATOMIC_RELAXED, __HIP_MEMORY_SCOPE_AGENT); cntl[64 + F.tid] = base; }
        __syncthreads();
        int* lst = LIST + (size_t)h * MB_LIST_H;
        if (e0) lst[mb_list_off(i0) + cntl[64 + i0] + pos0] = (t << 2) | 0;
        if (e1) lst[mb_list_off(i1) + cntl[64 + i1] + pos1] = (t << 2) | 1;
        if (e2) lst[mb_list_off(i2) + cntl[64 + i2] + pos2] = (t << 2) | 2;
        __syncthreads();
    }
}
constexpr int MB_HALF = 128 * 256;
__device__ __forceinline__ unsigned off_x(unsigned row, unsigned ch) { return 256u * row + 16u * (ch ^ (((row & 3) << 2) | ((row >> 2) & 3))); }
__device__ __forceinline__ void mb_decode(int v, const LAS int* pre, const unsigned* __restrict__ gcnt, int& h, int& n, int& count, int& lbase, bool& own) {
    if (v < 512) { n = v >> 3; h = v & 7; count = 256; lbase = 0; own = true; return; }
    const int x = v - 512; int lo_ = 0, hi_ = 511;
    while (lo_ < hi_) { const int mid = (lo_ + hi_) >> 1; if (pre[mid] > x) hi_ = mid; else lo_ = mid + 1; }
    const int hn = lo_; h = hn >> 6; n = hn & 63;
    const int tile = x - (hn ? pre[hn - 1] : 0);
    count = (int)gcnt[hn] - tile * 256; if (count > 256) count = 256;
    lbase = h * MB_LIST_H + mb_list_off(n) + tile * 256; own = false;
}
#define MB_STAGE(hh_, nn_, hf_, buf_) do { _Pragma("unroll") for (int k_ = 0; k_ < 4; ++k_) { const int pc_ = w * 4 + k_;               \
        const int r_ = 4 * pc_ + (F.lane >> 4); const int ch_ = (F.lane & 15) ^ (((r_ & 3) << 2) | ((r_ >> 2) & 3)); \
        const bf16_t* src_ = QKV + (size_t)((nn_) * 256 + (hf_) * 128 + r_) * 3072 + 1024 + (hh_) * 128 + 8 * ch_; \
        __builtin_amdgcn_global_load_lds((const unsigned*)src_, (LAS unsigned*)(lds + (buf_) * 2 * MB_HALF + pc_ * 1024), 16, 0, 0); \
        __builtin_amdgcn_global_load_lds((const unsigned*)(src_ + 1024), (LAS unsigned*)(lds + (buf_) * 2 * MB_HALF + MB_HALF + pc_ * 1024), 16, 0, 0); } } while (0)
#define MB_VMWAIT() asm volatile("s_waitcnt vmcnt(0)" ::: "memory")
#define MB_ENT(entv_, own_, nn_, cnt_, lb_) do { const int qi_ = 32 * w + l31; \
        if (own_) entv_ = (((nn_) * 256 + qi_) << 2) | 3; else entv_ = (qi_ < (cnt_)) ? LIST[(lb_) + qi_] : -1; } while (0)
#define MB_GATHER(entv_, qv_, nn_, hh_) do { \
        const int tq_ = (entv_ >= 0) ? (entv_ >> 2) : ((nn_) * 256); \
        _Pragma("unroll") for (int s_ = 0; s_ < 8; ++s_) qv_[s_] = *(const bf16x8*)(QKV + (size_t)tq_ * 3072 + (hh_) * 128 + 16 * s_ + 8 * h2); } while (0)
#define MB_COMPUTE(buf_, hf_, nkt_, own_) do { \
        const LAS unsigned char* kb_ = lds + (buf_) * 2 * MB_HALF + 256 * l31; \
        const LAS unsigned char* vb_ = lds + (buf_) * 2 * MB_HALF + MB_HALF + 256 * (4 * h2 + vq) + 8 * (vp & 1); \
        _Pragma("unroll 1") for (int kt_ = 0; kt_ < (nkt_); ++kt_) { \
            bf16x8 ka_[4]; \
            _Pragma("unroll") for (int s_ = 0; s_ < 4; ++s_) ka_[s_] = *(const LAS bf16x8*)(kb_ + kt_ * (32 * 256) + 16 * ((2 * s_ + h2) ^ fK)); \
            f32x16 acc_; _Pragma("unroll") for (int r_ = 0; r_ < 16; ++r_) acc_[r_] = 0.f; \
            _Pragma("unroll") for (int s_ = 0; s_ < 4; ++s_) acc_ = MFMA32(ka_[s_], qf[s_], acc_); \
            _Pragma("unroll") for (int s_ = 0; s_ < 4; ++s_) ka_[s_] = *(const LAS bf16x8*)(kb_ + kt_ * (32 * 256) + 16 * ((2 * (s_ + 4) + h2) ^ fK)); \
            _Pragma("unroll") for (int s_ = 0; s_ < 4; ++s_) acc_ = MFMA32(ka_[s_], qf[s_ + 4], acc_); \
            s16x4 vl0_[4], vh0_[4]; \
            _Pragma("unroll") for (int db_ = 0; db_ < 4; ++db_) { const LAS unsigned char* vp_ = vb_ + (kt_ * 32) * 256 + 64 * (db_ ^ vq); \
                vl0_[db_] = vtr(vp_ + 16 * (vj ^ h2)); vh0_[db_] = vtr(vp_ + 8 * 256 + 16 * (vj ^ (2 + h2))); } \
            float pr_[16]; \
            _Pragma("unroll") for (int r_ = 0; r_ < 16; ++r_) { float p_ = __builtin_amdgcn_exp2f(acc_[r_]); if ((own_) && (128 * (hf_) + 32 * kt_ + crow(r_, h2) > 32 * w + l31)) p_ = 0.f; pr_[r_] = p_; lsum += p_; } \
            { u32x4 pk_; pk_.x = cvtpk(pr_[0], pr_[1]); pk_.y = cvtpk(pr_[2], pr_[3]); pk_.z = cvtpk(pr_[4], pr_[5]); pk_.w = cvtpk(pr_[6], pr_[7]); \
              const bf16x8 pb_ = __builtin_bit_cast(bf16x8, pk_); \
              _Pragma("unroll") for (int db_ = 0; db_ < 4; ++db_) O[db_] = MFMA32(__builtin_shufflevector(vl0_[db_], vh0_[db_], 0, 1, 2, 3, 4, 5, 6, 7), pb_, O[db_]); } \
            _Pragma("unroll") for (int db_ = 0; db_ < 4; ++db_) { const LAS unsigned char* vp_ = vb_ + (kt_ * 32 + 16) * 256 + 64 * (db_ ^ vq); \
                vl0_[db_] = vtr(vp_ + 16 * (vj ^ h2)); vh0_[db_] = vtr(vp_ + 8 * 256 + 16 * (vj ^ (2 + h2))); } \
            { u32x4 pk_; pk_.x = cvtpk(pr_[8], pr_[9]); pk_.y = cvtpk(pr_[10], pr_[11]); pk_.z = cvtpk(pr_[12], pr_[13]); pk_.w = cvtpk(pr_[14], pr_[15]); \
              const bf16x8 pb_ = __builtin_bit_cast(bf16x8, pk_); \
              _Pragma("unroll") for (int db_ = 0; db_ < 4; ++db_) O[db_] = MFMA32(__builtin_shufflevector(vl0_[db_], vh0_[db_], 0, 1, 2, 3, 4, 5, 6, 7), pb_, O[db_]); } } } while (0)
__device__ __forceinline__ void moba_m3(const Frame& F0, const bf16_t* __restrict__ QKV, const unsigned* __restrict__ gcnt, const int* __restrict__ LIST,
                                        bf16_t* __restrict__ OPART01, bf16_t* __restrict__ OPART2, bf16_t* __restrict__ MIX, float* __restrict__ LPART) {
    const Frame F = opaque(F0);
    LAS unsigned char* lds = F.lds;
    LAS int* pre = (LAS int*)(lds + MB_PRE);
    const int h2 = F.lane >> 5, l31 = F.lane & 31, w = F.wave;
    const int fK = ((l31 & 3) << 2) | ((l31 >> 2) & 3);
    const int vq = (F.lane & 15) >> 2, vp = F.lane & 3, vj = 2 * ((F.lane >> 4) & 1) + (vp >> 1);
    { int v = ((int)gcnt[F.tid] + 255) >> 8; pre[F.tid] = v; __syncthreads();
#pragma unroll 1
      for (int o = 1; o < 512; o <<= 1) { const int add = (F.tid >= o) ? pre[F.tid - o] : 0; __syncthreads(); pre[F.tid] += add; __syncthreads(); } }
    const int total = 512 + pre[511];
    const int n_units = (total - F.vcu + F.G - 1) / F.G;
    if (n_units == 0) return;
#define MB_UNIT_V(it_) (F.vcu + (it_) * F.G)
    int h, n, count, lbase; bool own;
    mb_decode(MB_UNIT_V(0), pre, gcnt, h, n, count, lbase, own);
    int ent; bf16x8 qf[8];
    MB_ENT(ent, own, n, count, lbase);
    MB_GATHER(ent, qf, n, h);
    MB_STAGE(h, n, 0, 0);
    MB_VMWAIT();
    __syncthreads();
#pragma unroll 1
    for (int it = 0; it < n_units; ++it) {
        f32x16 O[4];
#pragma unroll
        for (int db = 0; db < 4; ++db)
#pragma unroll
            for (int r = 0; r < 16; ++r) O[db][r] = 0.f;
        float lsum = 0.f;
        MB_STAGE(h, n, 1, 1);
        { const int nkt = own ? ((w + 1 < 4) ? (w + 1) : 4) : 4; MB_COMPUTE(0, 0, nkt, own); }
        const bool more = (it + 1 < n_units);
        int h_n = h, n_n = n, count_n = count, lbase_n = lbase; bool own_n = own;
        int ent_n = -1;
        if (more) { mb_decode(MB_UNIT_V(it + 1), pre, gcnt, h_n, n_n, count_n, lbase_n, own_n); MB_ENT(ent_n, own_n, n_n, count_n, lbase_n); }
        MB_VMWAIT();
        __syncthreads();
        if (more) MB_STAGE(h_n, n_n, 0, 0);
        { const int nkt = own ? ((w >= 4) ? (w - 3) : 0) : 4; MB_COMPUTE(1, 1, nkt, own); }
        const int ent_c = ent, h_c = h;
        if (more) MB_GATHER(ent_n, qf, n_n, h_n);
        lsum += __shfl_xor(lsum, 32);
        if (ent_c >= 0 && h2 == 0) LPART[((size_t)(ent_c & 3) * S + (ent_c >> 2)) * 8 + h_c] = lsum;
        __syncthreads();
        {
            LAS unsigned char* ost = lds + MB_OST + w * MB_OSTW;
#pragma unroll
            for (int db = 0; db < 4; ++db)
#pragma unroll
                for (int g = 0; g < 4; ++g) { u32x2 o; o.x = cvtpk(O[db][4 * g + 0], O[db][4 * g + 1]); o.y = cvtpk(O[db][4 * g + 2], O[db][4 * g + 3]);
                    *(LAS u32x2*)(ost + l31 * 264 + 2 * (32 * db + 8 * g + 4 * h2)) = o; }
            asm volatile("s_waitcnt lgkmcnt(0)" ::: "memory");
#pragma unroll
            for (int i = 0; i < 8; ++i) {
                const int row = 4 * i + (F.lane >> 4), ch = F.lane & 15;
                const int er = __shfl(ent_c, row);
                const u32x4 v = *(const LAS u32x4*)(ost + row * 264 + 16 * ch);
                if (er >= 0) { const int sl = er & 3, tq = er >> 2;
                    bf16_t* dst = ((sl == 3) ? (MIX + (size_t)tq * D) : (sl == 2) ? (OPART2 + (size_t)tq * D) : (OPART01 + ((size_t)sl * S + tq) * D)) + h_c * 128 + 8 * ch;
                    *(u32x4*)dst = v; }
            }
        }
        if (more) { h = h_n; n = n_n; count = count_n; lbase = lbase_n; own = own_n; ent = ent_n; }
        MB_VMWAIT();
        __syncthreads();
    }
#undef MB_UNIT_V
}
__device__ __forceinline__ void moba_m4(const Frame& F0, const bf16_t* __restrict__ OPART01, const bf16_t* __restrict__ OPART2, const float* __restrict__ LPART, bf16_t* __restrict__ MIX) {
    const Frame F = opaque(F0);
    for (int it = F.vcu * NTHR + F.tid; it < S * 128; it += F.G * NTHR) {
        const int t = it >> 7, c8 = it & 127, h = c8 >> 4;
        const int nsel = (t >> 8) < 3 ? (t >> 8) : 3;
        const u32x4 m = *(const u32x4*)(MIX + (size_t)t * D + c8 * 8);
        float o[8] = {bflo(m.x), bfhi(m.x), bflo(m.y), bfhi(m.y), bflo(m.z), bfhi(m.z), bflo(m.w), bfhi(m.w)};
        float l = LPART[((size_t)3 * S + t) * 8 + h];
#pragma unroll
        for (int sl = 0; sl < 3; ++sl) {
            if (sl < nsel) {
                const u32x4 p = *(const u32x4*)(((sl == 2) ? (OPART2 + (size_t)t * D) : (OPART01 + ((size_t)sl * S + t) * D)) + c8 * 8);
                o[0] += bflo(p.x); o[1] += bfhi(p.x); o[2] += bflo(p.y); o[3] += bfhi(p.y); o[4] += bflo(p.z); o[5] += bfhi(p.z); o[6] += bflo(p.w); o[7] += bfhi(p.w);
                l += LPART[((size_t)sl * S + t) * 8 + h];
            }
        }
        const float inv = 1.f / l;
        u32x4 r; r.x = cvtpk(o[0] * inv, o[1] * inv); r.y = cvtpk(o[2] * inv, o[3] * inv); r.z = cvtpk(o[4] * inv, o[5] * inv); r.w = cvtpk(o[6] * inv, o[7] * inv);
        *(u32x4*)(MIX + (size_t)t * D + c8 * 8) = r;
    }
}
__device__ __forceinline__ float wave_max(float v) {
#pragma unroll
    for (int o = 1; o < 64; o <<= 1) v = fmaxf(v, __shfl_xor(v, o));
    return v;
}
__device__ __forceinline__ float logsigmoid_f(float x) { return fminf(x, 0.f) - log1pf(expf(-fabsf(x))); }
__global__ void nk_gla_gate(const float* __restrict__ glr, const float* __restrict__ wup, const float* __restrict__ bg, float* __restrict__ g) {
    const size_t idx = (size_t)blockIdx.x * blockDim.x + threadIdx.x;
    const int t = (int)(idx >> 9), j = (int)(idx & 511);
    float acc = bg[j];
#pragma unroll
    for (int r = 0; r < 16; ++r) acc += glr[(size_t)t * 16 + r] * wup[r * 512 + j];
    g[idx] = logsigmoid_f(acc) * (1.f / 16.f);
}
__global__ __launch_bounds__(256) void nk_gla_recur(const bf16_t* __restrict__ qkv, const float* __restrict__ g, float* __restrict__ o) {
    __shared__ float sq[16][128], sk[16][128], sa[16][128];
    const int h = blockIdx.x, tid = threadIdx.x;
    float St[128];
#pragma unroll
    for (int d = 0; d < 128; ++d) St[d] = 0.f;
    const float qs = 0.08838834764831845f;
    for (int t0 = 0; t0 < S; t0 += 16) {
        float vv[16];
#pragma unroll
        for (int tt = 0; tt < 16; ++tt) vv[tt] = bf2f(qkv[(size_t)(t0 + tt) * 3072 + 1024 + h * 256 + tid]);
#pragma unroll
        for (int i = 0; i < 8; ++i) {
            const int e = tid + i * 256, tok = e >> 7, d = e & 127;
            const bf16_t* row = qkv + (size_t)(t0 + tok) * 3072;
            sq[tok][d] = bf2f(row[h * 128 + d]) * qs;
            sk[tok][d] = bf2f(row[512 + h * 128 + d]);
            sa[tok][d] = expf(g[(size_t)(t0 + tok) * 512 + h * 128 + d]);
        }
        __syncthreads();
#pragma unroll 1
        for (int tt = 0; tt < 16; ++tt) {
            const float v = vv[0];
#pragma unroll
            for (int i = 0; i < 15; ++i) vv[i] = vv[i + 1];
            float acc = 0.f;
#pragma unroll
            for (int d = 0; d < 128; ++d) { St[d] = sa[tt][d] * St[d] + sk[tt][d] * v; acc += sq[tt][d] * St[d]; }
            o[(size_t)(t0 + tt) * D + h * 256 + tid] = acc;
        }
        __syncthreads();
    }
}
__global__ __launch_bounds__(256) void nk_gla_post(const float* __restrict__ o, const bf16_t* __restrict__ qkv, const float* __restrict__ og, bf16_t* __restrict__ mix) {
    const int w = blockIdx.x * 4 + (threadIdx.x >> 6), lane = threadIdx.x & 63;
    const int t = w >> 2, h = w & 3;
    f32x4 v = *(const f32x4*)(o + (size_t)t * D + h * 256 + lane * 4);
    const float ss = wave_sum(v.x * v.x + v.y * v.y + v.z * v.z + v.w * v.w);
    const float r = 1.0f / sqrtf(ss * (1.f / 256.f) + EPS);
    const f32x4 gg = *(const f32x4*)(og + lane * 4);
    const bf16_t* rp = qkv + (size_t)t * 3072 + 2048 + h * 256 + lane * 4;
    bf16_t* mp = mix + (size_t)t * D + h * 256 + lane * 4;
#pragma unroll
    for (int e = 0; e < 4; ++e) { const float rr = bf2f(rp[e]); const float y = v[e] * r * gg[e] * (rr / (1.f + expf(-rr))); mp[e] = (bf16_t)(cvtpk(y, 0.f) & 0xffffu); }
}
__global__ __launch_bounds__(256) void nk_moba_qk(bf16_t* __restrict__ qkv, const int* __restrict__ pos, const float* __restrict__ qg, const float* __restrict__ kg) {
    const int w = blockIdx.x * 4 + (threadIdx.x >> 6), lane = threadIdx.x & 63;
    const int t = w >> 4, which = (w >> 3) & 1, h = w & 7;
    bf16_t* p = qkv + (size_t)t * 3072 + which * 1024 + h * 128;
    const float* g = which ? kg : qg;
    float t1 = bf2f(p[lane]), t2 = bf2f(p[lane + 64]);
    const float ss = wave_sum(t1 * t1 + t2 * t2);
    const float r = 1.0f / sqrtf(ss * (1.f / 128.f) + EPS);
    t1 = t1 * r * g[lane]; t2 = t2 * r * g[lane + 64];
    const float inv_freq = (float)exp2(-(double)lane * (13.287712379549449 / 64.0));
    const float angf = (float)pos[t] * inv_freq;
    float cs, sn; sincos_acc((double)angf, sn, cs);
    p[lane] = (bf16_t)(cvtpk(t1 * cs - t2 * sn, 0.f) & 0xffffu);
    p[lane + 64] = (bf16_t)(cvtpk(t2 * cs + t1 * sn, 0.f) & 0xffffu);
}
__global__ __launch_bounds__(128) void nk_moba_kmean(const bf16_t* __restrict__ qkv, float* __restrict__ kmean) {
    const int h = blockIdx.x >> 6, n = blockIdx.x & 63, d = threadIdx.x;
    float acc = 0.f;
    for (int j = 0; j < 256; ++j) acc += bf2f(qkv[(size_t)(n * 256 + j) * 3072 + 1024 + h * 128 + d]);
    kmean[(size_t)blockIdx.x * 128 + d] = acc * (1.f / 256.f);
}
__global__ __launch_bounds__(64) void nk_moba_attn(const bf16_t* __restrict__ qkv, const float* __restrict__ kmean, bf16_t* __restrict__ out) {
    __shared__ float sq[128];
    __shared__ float sp[1024];
    __shared__ int skey[1024];
    const int t = blockIdx.x >> 3, h = blockIdx.x & 7, lane = threadIdx.x;
    const bf16_t* qp = qkv + (size_t)t * 3072 + h * 128;
    sq[lane] = bf2f(qp[lane]); sq[lane + 64] = bf2f(qp[lane + 64]);
    __syncthreads();
    const int own = t >> 8;
    float gate = -INFINITY;
    if (lane < own) {
        const float* km = kmean + ((size_t)h * 64 + lane) * 128;
        float a = 0.f;
        for (int d = 0; d < 128; ++d) a += sq[d] * km[d];
        gate = a;
    }
    int s0 = -1, s1 = -1, s2 = -1;
#pragma unroll
    for (int j = 0; j < 3; ++j) {
        const float m = wave_max(gate);
        int idx = -1;
        if (m > -INFINITY) { const unsigned long long b = __ballot(gate == m); idx = __ffsll((long long)b) - 1; }
        if (j == 0) s0 = idx; else if (j == 1) s1 = idx; else s2 = idx;
        if (lane == idx) gate = -INFINITY;
    }
    int nk = 0;
    if (s0 >= 0) { for (int i = lane; i < 256; i += 64) skey[nk + i] = s0 * 256 + i; nk += 256; }
    if (s1 >= 0) { for (int i = lane; i < 256; i += 64) skey[nk + i] = s1 * 256 + i; nk += 256; }
    if (s2 >= 0) { for (int i = lane; i < 256; i += 64) skey[nk + i] = s2 * 256 + i; nk += 256; }
    const int nown = t - own * 256 + 1;
    for (int i = lane; i < nown; i += 64) skey[nk + i] = own * 256 + i;
    nk += nown;
    __syncthreads();
    const float scale = 0.08838834764831845f;
    float mx = -INFINITY;
    for (int i = lane; i < nk; i += 64) {
        const bf16_t* kp = qkv + (size_t)skey[i] * 3072 + 1024 + h * 128;
        float a = 0.f;
        for (int d = 0; d < 128; d += 8) { const u32x4 kk = *(const u32x4*)(kp + d);
            a += sq[d] * bflo(kk.x) + sq[d + 1] * bfhi(kk.x) + sq[d + 2] * bflo(kk.y) + sq[d + 3] * bfhi(kk.y) + sq[d + 4] * bflo(kk.z) + sq[d + 5] * bfhi(kk.z) + sq[d + 6] * bflo(kk.w) + sq[d + 7] * bfhi(kk.w); }
        a *= scale; sp[i] = a; mx = fmaxf(mx, a);
    }
    mx = wave_max(mx);
    float sum = 0.f;
    for (int i = lane; i < nk; i += 64) { const float p = expf(sp[i] - mx); sp[i] = p; sum += p; }
    sum = wave_sum(sum);
    __syncthreads();
    float o0 = 0.f, o1 = 0.f;
    for (int i = 0; i < nk; ++i) {
        const bf16_t* vp = qkv + (size_t)skey[i] * 3072 + 2048 + h * 128;
        const float p = sp[i];
        o0 += p * bf2f(vp[lane]); o1 += p * bf2f(vp[lane + 64]);
    }
    const float inv = 1.f / sum;
    out[(size_t)t * D + h * 128 + lane] = (bf16_t)(cvtpk(o0 * inv, 0.f) & 0xffffu);
    out[(size_t)t * D + h * 128 + lane + 64] = (bf16_t)(cvtpk(o1 * inv, 0.f) & 0xffffu);
}
constexpr int PH_PER_LAYER = 10, PH_L0 = 2, N_PHASES = PH_L0 + DEPTH * PH_PER_LAYER;
__global__ void __launch_bounds__(NTHR, 2) mega(MegaArgs args) {
    extern __shared__ __attribute__((aligned(16))) unsigned char lds_raw[];
    Frame F;
    F.lds = (LAS unsigned char*)lds_raw;
    F.tid = threadIdx.x; F.lane = F.tid & 63; F.wave = __builtin_amdgcn_readfirstlane(F.tid >> 6);
    F.G = gridDim.x; { const int bx = blockIdx.x; F.vcu = (F.G % 8 == 0) ? (bx % 8) * (F.G / 8) + bx / 8 : bx; }
    volatile LAS unsigned* MISC = (volatile LAS unsigned*)(F.lds + MISC_OFF);
    unsigned char* ws = args.ws;
    unsigned* ctl = (unsigned*)(ws + WS_CTL);
    for (int u = F.tid; u < (LDS_BYTES - MISC_OFF) / 4; u += NTHR) ((LAS unsigned*)(F.lds + MISC_OFF))[u] = 0u;
    __syncthreads();
    XcdBarrier bar = xcd_barrier_post(ctl + CW_BAR, MISC + 8);
    const int lo = args.ph_lo, hi = args.ph_hi;
#define IN(k) (lo <= (k) && (k) < hi)
#define SEAM(k) do { if (lo <= (k) && (k) + 1 < hi) xcd_barrier(bar); } while (0)
    const float* mod = (const float*)(ws + WS_MOD);
    bf16_t* H = (bf16_t*)(ws + WS_H); bf16_t* MIX = (bf16_t*)(ws + WS_MIX); bf16_t* QKV = (bf16_t*)(ws + WS_QKV); bf16_t* HID = (bf16_t*)(ws + WS_HID);
    float* xout = args.out;
    bf16_t* XB = (bf16_t*)(ws + WS_XB);

    if (IN(0)) { p0_prologue(F, args); }
    if (lo < 0) cg::this_grid().sync();
    if (lo <= 0 && 1 < hi) xcd_barrier(bar);
    if (IN(1)) { norm_phase(F, args.in[0], args.in[5], mod + D, mod, H); }
    SEAM(1);
#pragma unroll 1
    for (int L = 0; L < DEPTH; ++L) {
        const int pb = PH_L0 + L * PH_PER_LAYER, j = L >> 1;
        const float* m = mod + (size_t)L * 6 * D;
        if (pb + PH_PER_LAYER <= lo || pb >= hi) continue;
        if ((L & 1) == 0) {
            if (IN(pb + 0)) {
                pg8::Gemm g{H, (const bf16_t*)(ws + WS_WGIN) + (size_t)j * 3072 * D, S, 3072, D}; pg8::StaticOrder So; So.init(S, 3072, F.G, (int)blockIdx.x);
                pg8::EpiBf16<0> E{QKV, 3072};
                pg8::gemm_phase<pg8::EpiBf16<0>, pg8::StaticOrder, true, true>(F.lds, g, So, E);
                glr_phase(F, H, (const bf16_t*)(ws + WS_WGLR) + (size_t)j * 16 * D, (float*)(ws + WS_GLR));
            }
            SEAM(pb + 0);
        } else {
            if (IN(pb + 0)) {
                pg8::Gemm g{H, (const bf16_t*)(ws + WS_WMIN) + (size_t)j * 3072 * D, S, 3072, D}; pg8::StaticOrder So; So.init(S, 3072, F.G, (int)blockIdx.x);
                pg8::EpiBf16<0> E{QKV, 3072};
                pg8::gemm_phase<pg8::EpiBf16<0>, pg8::StaticOrder, true, true>(F.lds, g, So, E);
                asm volatile("s_waitcnt vmcnt(0)" ::: "memory"); __syncthreads();
                moba_m1_tail(F, F.G, (int)blockIdx.x, QKV, (const float*)(args.ws + WS_COS), (const float*)(args.ws + WS_SIN), args.in[13] + (size_t)j * 128, args.in[14] + (size_t)j * 128, (float*)(args.ws + WS_KMEAN));
            }
            SEAM(pb + 0);
        }
        if ((L & 1) == 0) {
            unsigned char* ws = args.ws; asm volatile("" : "+s"(ws));
            const float* wupg = args.in[8] + (size_t)j * 16 * 512; const float* bgg = args.in[9] + (size_t)j * 512;
            if (IN(pb + 1)) gla_g1(F, QKV, (const float*)(ws + WS_GLR), wupg, bgg, (float*)(ws + WS_SBUF), (float*)(ws + WS_DG));
            SEAM(pb + 1);
            if (IN(pb + 2)) gla_g2(F, (float*)(ws + WS_SBUF), (const float*)(ws + WS_DG));
            SEAM(pb + 2);
            if (IN(pb + 3)) gla_g3(F, QKV, (const float*)(ws + WS_GLR), wupg, bgg, (const float*)(ws + WS_SBUF), args.in[10] + (size_t)j * 256, MIX);
            if (lo <= pb + 3 && pb + 5 < hi) xcd_barrier(bar);
        } else {
            unsigned char* ws = args.ws; asm volatile("" : "+s"(ws));
            unsigned* gcnt = (unsigned*)(ws + WS_CTL) + CW_MCNT + j * 512;
            if (IN(pb + 2)) moba_m2(F, QKV, (const float*)(ws + WS_KMEAN), gcnt, (int*)(ws + WS_LIST));
            SEAM(pb + 2);
            if (IN(pb + 3)) moba_m3(F, QKV, gcnt, (const int*)(ws + WS_LIST), (bf16_t*)xout, (bf16_t*)(ws + WS_AUX), MIX, (float*)(ws + WS_LPART));
            SEAM(pb + 3);
            if (IN(pb + 4)) moba_m4(F, (const bf16_t*)xout, (const bf16_t*)(ws + WS_AUX), (const float*)(ws + WS_LPART), MIX);
            SEAM(pb + 4);
        }
        if (IN(pb + 5)) {
            const bf16_t* wo = ((L & 1) == 0) ? (const bf16_t*)(ws + WS_WGOUT) + (size_t)j * D * D : (const bf16_t*)(ws + WS_WMOUT) + (size_t)j * D * D;
            pg8::Gemm g{MIX, wo, S, D, D}; pg8::StaticOrder So; So.init(S, D, F.G, (int)blockIdx.x);
            if (L == 0) {
                pg8::EpiResidNorm<true> E{args.in[0], XB, D, m + 2 * D, args.in[6] + (size_t)L * D, m + 4 * D, m + 3 * D, H, (float*)(ws + WS_XBUF), ctl + CW_SEAM + (2 * L) * SEAM_BANK, ctl + CW_TMO, EPS};
                pg8::gemm_phase<pg8::EpiResidNorm<true>, pg8::StaticOrder, false, true>(F.lds, g, So, E);
            } else {
                pg8::EpiResidNorm<false> E{XB, XB, D, m + 2 * D, args.in[6] + (size_t)L * D, m + 4 * D, m + 3 * D, H, (float*)(ws + WS_XBUF), ctl + CW_SEAM + (2 * L) * SEAM_BANK, ctl + CW_TMO, EPS};
                pg8::gemm_phase<pg8::EpiResidNorm<false>, pg8::StaticOrder, false, true>(F.lds, g, So, E);
            }
        }
        SEAM(pb + 5);
        if (IN(pb + 7)) {
            pg8::Gemm g{H, (const bf16_t*)(ws + WS_W1) + (size_t)L * DFF * D, S, DFF, D}; pg8::StaticOrder So; So.init(S, DFF, F.G, (int)blockIdx.x);
            pg8::EpiBf16<1> E{HID, DFF};
            pg8::gemm_phase<pg8::EpiBf16<1>, pg8::StaticOrder, true, true>(F.lds, g, So, E);
        }
        SEAM(pb + 7);
        if (IN(pb + 8)) {
            pg8::Gemm g{HID, (const bf16_t*)(ws + WS_W2) + (size_t)L * D * DFF, S, D, DFF}; pg8::StaticOrder So; So.init(S, D, F.G, (int)blockIdx.x);
            pg8::EpiResid E{XB, xout, D, m + 5 * D};
            if (L + 1 < DEPTH) {
                const float* mn = mod + (size_t)(L + 1) * 6 * D;
                pg8::EpiResidNorm<false> EN{XB, XB, D, m + 5 * D, args.in[5] + (size_t)(L + 1) * D, mn + D, mn, H, (float*)(ws + WS_XBUF), ctl + CW_SEAM + (2 * L + 1) * SEAM_BANK, ctl + CW_TMO, EPS};
                pg8::gemm_phase<pg8::EpiResidNorm<false>, pg8::StaticOrder, false, true>(F.lds, g, So, EN);
            } else
            pg8::gemm_phase<pg8::EpiResid, pg8::StaticOrder, false, true>(F.lds, g, So, E);
        }
        if (L + 1 < DEPTH) SEAM(pb + 8);
    }
#undef IN
#undef SEAM
}
static int g_grid = 0;
static void launch_mega(MegaArgs a, int lo, int hi, hipStream_t stream) {
    a.ph_lo = lo; a.ph_hi = hi;
    (void)hipMemsetAsync((char*)a.ws + WS_CTL + CW_BAR * 4, 0, XCD_BAR_WORDS * 4, stream);
    void* params[] = {&a};
    hipError_t e = hipLaunchCooperativeKernel((const void*)mega, dim3(g_grid), dim3(NTHR), params, LDS_BYTES, stream);
    if (e != hipSuccess) fprintf(stderr, "cooperative launch failed: %s (grid %d)\n", hipGetErrorString(e), g_grid);
}
extern "C" void kernel_launch(void* const* d_in, const int* in_sizes, int n_in, void* d_out, int out_size, void* d_ws, size_t ws_size, hipStream_t stream) {
    if (g_grid == 0) {
        int dev = 0, cus = 0, per_cu = 0;
        (void)hipGetDevice(&dev);
        (void)hipDeviceGetAttribute(&cus, hipDeviceAttributeMultiprocessorCount, dev);
        (void)hipFuncSetAttribute((const void*)mega, hipFuncAttributeMaxDynamicSharedMemorySize, LDS_BYTES);
        (void)hipOccupancyMaxActiveBlocksPerMultiprocessor(&per_cu, (const void*)mega, NTHR, LDS_BYTES);
        if (per_cu < 1) { fprintf(stderr, "occupancy query says %d blocks/CU\n", per_cu); per_cu = 1; }
        g_grid = cus;
        if (ws_size < WS_END || n_in != 18) { fprintf(stderr, "bad ws_size %zu / n_in %d\n", ws_size, n_in); g_grid = -1; }
    }
    if (g_grid < 0) return;
    (void)hipMemsetAsync((char*)d_ws + WS_CTL, 0, CTL_ZERO_BYTES, stream);
    MegaArgs a{};
    for (int i = 0; i < 18; ++i) a.in[i] = (const float*)d_in[i];
    a.out = (float*)d_out; a.ws = (unsigned char*)d_ws;
    launch_mega(a, 0, N_PHASES, stream);
}
```

```cpp
#include <hip/hip_runtime.h>
#include <hip/hip_cooperative_groups.h>
#include <cstdio>
#include <cstdint>
#include <cmath>
namespace cg = cooperative_groups;
constexpr int D = 1024, S = 16384, DEPTH = 4, DFF = 4096;
constexpr int GLA_IN = 3088, MB_IN = 3072;
constexpr float EPS = 1e-6f;
#ifndef PROBE
#define PROBE 0
#endif
#ifndef TCAT
#define TCAT 0
#endif
#ifndef TBLK
#define TBLK 0
#endif
#define LAS __attribute__((address_space(3)))
#define GAS __attribute__((address_space(1)))
typedef unsigned short bf16_t;
typedef short bf16x8 __attribute__((ext_vector_type(8)));
typedef short s16x4 __attribute__((ext_vector_type(4)));
typedef float f32x4 __attribute__((ext_vector_type(4)));
typedef float f32x16 __attribute__((ext_vector_type(16)));
typedef float f32x2 __attribute__((ext_vector_type(2)));
typedef unsigned u32x4 __attribute__((ext_vector_type(4)));
typedef unsigned u32x2 __attribute__((ext_vector_type(2)));
typedef __bf16 bf16x2_t __attribute__((ext_vector_type(2)));

__device__ __forceinline__ unsigned cvtpk(float lo, float hi) { f32x2 v = {lo, hi}; bf16x2_t b = __builtin_convertvector(v, bf16x2_t); return __builtin_bit_cast(unsigned, b); }
__device__ __forceinline__ float bf2f(unsigned short b) { return __uint_as_float((unsigned)b << 16); }
__device__ __forceinline__ float bflo(unsigned w) { return __uint_as_float(w << 16); }
__device__ __forceinline__ float bfhi(unsigned w) { return __uint_as_float(w & 0xffff0000u); }

#ifndef WT_STORES
#define WT_STORES 0
#endif
__device__ __forceinline__ void st16_wt(void* p, u32x4 v) {
#if WT_STORES
    asm volatile("global_store_dwordx4 %0, %1, off sc1\n\ts_nop 1" :: "v"(p), "v"(v) : "memory");
#else
    *(u32x4*)p = v;
#endif
}
__device__ __forceinline__ void st16_wt(void* p, f32x4 v) { st16_wt(p, __builtin_bit_cast(u32x4, v)); }
namespace pg8 {
constexpr int BM = 256, BK = 64, HALF = 128, HTB = HALF * BK * 2, STAGE_BYTES = 8 * HTB, NXCD = 8, WGM = 8;
__host__ __device__ __forceinline__ int lds_byte(int r, int c) { const int st = (r >> 4) * 2 + (c >> 5), rr = r & 15, cc = c & 31, ob = rr * 64 + cc * 2; return st * 1024 + (ob ^ (((ob >> 9) & 1) << 5)); }
__host__ __device__ __forceinline__ void stage_rc(int b, int& R, int& C) { const int st = b / 1024, sb = b % 1024, swz = sb ^ (((sb >> 9) & 1) << 5); R = (st >> 1) * 16 + swz / 64; C = (st & 1) * 32 + (swz % 64) / 2; }
__host__ __device__ __forceinline__ int perm32(int rho) { const int n = rho >> 4, i = rho & 15; return 8 * (i >> 2) + 4 * n + (i & 3); }
struct Unit { int pm, pn; };
struct Gemm { const bf16_t* A; const bf16_t* Bt; int M, N, K; };
struct StaticOrder {
    int nM, nN, nwg, G, c;
    __host__ __device__ void init(int M, int N, int G_, int c_) { nM = M / BM; nN = N / BM; nwg = nM * nN; G = G_; c = c_; }
    __host__ __device__ bool next(int i, Unit& u) const {
        const long L = (long)i * G + c; if (L >= nwg) return false;
        int wgid = (int)L; { const int q = nwg / NXCD, r = nwg % NXCD, xcd = wgid % NXCD, off = wgid / NXCD; wgid = (xcd < r ? xcd * (q + 1) : r * (q + 1) + (xcd - r) * q) + off; }
        const int nig = WGM * nN, gid = wgid / nig, fm = gid * WGM, gsz = (nM - fm) < WGM ? (nM - fm) : WGM;
        u.pm = fm + ((wgid % nig) % gsz); u.pn = (wgid % nig) / gsz; return true;
    }
    __device__ __forceinline__ void a_ready(const Unit&) const {}
    __device__ __forceinline__ void done(const Unit&) const {}
};
struct MaskOrder : StaticOrder {
    __device__ bool next(int i, Unit& u) const { const bool ok = StaticOrder::next(i, u); u.pm &= 7; u.pn &= 3; return ok; }
};
template <int ACT  > struct EpiBf16 {
    static constexpr bool PERM = true, AFTER_DRAIN = false;
    bf16_t* O; int ldc;
    __device__ __forceinline__ void operator()(const f32x4 (&acc)[2][2][4][2], const Unit& u, int wr, int wc, int fr, int fq) const {
        const int row0 = u.pm * BM + wr * 64 + fr; const int col0 = u.pn * BM + wc * 32 + 8 * fq;
#pragma unroll
        for (int ai = 0; ai < 2; ++ai)
#pragma unroll
            for (int m = 0; m < 4; ++m) { bf16_t* rowp = O + (size_t)(row0 + ai * HALF + m * 16) * ldc + col0;
#pragma unroll
                for (int bj = 0; bj < 2; ++bj) { f32x4 v0 = acc[ai][bj][m][0], v1 = acc[ai][bj][m][1];
                    if (ACT == 1) {
#pragma unroll
                        for (int e = 0; e < 4; ++e) { float a = fmaxf(v0[e], 0.f); v0[e] = a * a; float b = fmaxf(v1[e], 0.f); v1[e] = b * b; } }
                    u32x4 w; w.x = cvtpk(v0[0], v0[1]); w.y = cvtpk(v0[2], v0[3]); w.z = cvtpk(v1[0], v1[1]); w.w = cvtpk(v1[2], v1[3]);
                    st16_wt(rowp + bj * HALF, w); } }
    }
};
struct EpiResid {
    static constexpr bool PERM = false, AFTER_DRAIN = false;
    const bf16_t* base; float* out; int ldc; const float* gate;
    __device__ __forceinline__ void operator()(const f32x4 (&acc)[2][2][4][2], const Unit& u, int wr, int wc, int fr, int fq) const {
        const int row0 = u.pm * BM + wr * 64 + fr, col0 = u.pn * BM + wc * 32 + 4 * fq;
        f32x4 gv[2][2];
#pragma unroll
        for (int bj = 0; bj < 2; ++bj)
#pragma unroll
            for (int n = 0; n < 2; ++n) gv[bj][n] = *(const f32x4*)(gate + col0 + bj * HALF + n * 16);
#pragma unroll
        for (int ai = 0; ai < 2; ++ai)
#pragma unroll
            for (int m = 0; m < 4; ++m) { const size_t off = (size_t)(row0 + ai * HALF + m * 16) * ldc + col0;
#pragma unroll
                for (int bj = 0; bj < 2; ++bj)
#pragma unroll
                    for (int n = 0; n < 2; ++n) { const u32x2 bb = *(const u32x2*)(base + off + bj * HALF + n * 16); const f32x4 b = {bflo(bb.x), bfhi(bb.x), bflo(bb.y), bfhi(bb.y)};
                        st16_wt(out + off + bj * HALF + n * 16, b + gv[bj][n] * acc[ai][bj][m][n]); } }
    }
};

template <bool BASE_F32> struct EpiResidNorm {
    static constexpr bool PERM = false, AFTER_DRAIN = true;
    const void* base; bf16_t* out; int ldc; const float* gate;
    const float* ng; const float* sc; const float* sh; bf16_t* H;
    float* xbuf; unsigned* cnt; unsigned* tmo; float eps;
    __device__ __forceinline__ void operator()(const f32x4 (&)[2][2][4][2], const Unit&, int, int, int, int) const {}
    __device__ __forceinline__ void fused(f32x4 (&acc)[2][2][4][2], const Unit& u, int wr, int wc, int fr, int fq, LAS unsigned char* lds, int wid, int lane) const {
        LAS float* P = (LAS float*)lds;
        LAS float* Sr = (LAS float*)(lds + 4096);
        LAS unsigned* flag = (LAS unsigned*)(lds + 4096 + 1024);
        const int row0 = u.pm * BM + wr * 64 + fr, col0 = u.pn * BM + wc * 32 + 4 * fq;
        {
            f32x4 gv[2][2];
#pragma unroll
            for (int bj = 0; bj < 2; ++bj)
#pragma unroll
                for (int n = 0; n < 2; ++n) gv[bj][n] = *(const f32x4*)(gate + col0 + bj * HALF + n * 16);
#pragma unroll
            for (int ai = 0; ai < 2; ++ai)
#pragma unroll
                for (int m = 0; m < 4; ++m) { const size_t off = (size_t)(row0 + ai * HALF + m * 16) * ldc + col0;
                    float s = 0.f;
#pragma unroll
                    for (int bj = 0; bj < 2; ++bj)
#pragma unroll
                        for (int n = 0; n < 2; ++n) { f32x4 b;
                            if constexpr (BASE_F32) b = *(const f32x4*)((const float*)base + off + bj * HALF + n * 16);
                            else { const u32x2 bb = *(const u32x2*)((const bf16_t*)base + off + bj * HALF + n * 16); b = (f32x4){bflo(bb.x), bfhi(bb.x), bflo(bb.y), bfhi(bb.y)}; }
                            const f32x4 x = b + gv[bj][n] * acc[ai][bj][m][n]; acc[ai][bj][m][n] = x;
                            { u32x2 xw; xw.x = cvtpk(x[0], x[1]); xw.y = cvtpk(x[2], x[3]); *(u32x2*)(out + off + bj * HALF + n * 16) = xw; } s += (x[0] * x[0] + x[1] * x[1]) + (x[2] * x[2] + x[3] * x[3]); }
                    s += __shfl_xor(s, 16); s += __shfl_xor(s, 32);
                    if (fq == 0) P[(ai * HALF + wr * 64 + m * 16 + fr) * 4 + wc] = s;
                    if (m & 1) asm volatile("" ::: "memory"); }
        }
        asm volatile("s_waitcnt lgkmcnt(0)" ::: "memory"); __builtin_amdgcn_s_barrier(); asm volatile("" ::: "memory");
        const int row = wid * 32 + (lane & 31);
        if (lane < 32) {
            const float tot = (P[row * 4 + 0] + P[row * 4 + 1]) + (P[row * 4 + 2] + P[row * 4 + 3]);
            __hip_atomic_store((unsigned*)xbuf + ((size_t)(u.pm * BM + row) * 4 + u.pn), __float_as_uint(tot), __ATOMIC_RELAXED, __HIP_MEMORY_SCOPE_AGENT);
        }
        asm volatile("s_waitcnt vmcnt(0)" ::: "memory");
        if (lane == 0) __hip_atomic_fetch_add(cnt + 64 * u.pm, 1u, __ATOMIC_RELAXED, __HIP_MEMORY_SCOPE_AGENT);
        if (wid == 0) {
            unsigned sp = 0; bool dead = false;
            for (;;) {
                if ((unsigned)__builtin_amdgcn_readfirstlane(__hip_atomic_load(cnt + 64 * u.pm, __ATOMIC_RELAXED, __HIP_MEMORY_SCOPE_AGENT)) >= 32u) break;
                __builtin_amdgcn_s_sleep(2);
                if (++sp > (1u << 20)) { if (lane == 0) __hip_atomic_store(tmo, 1u, __ATOMIC_RELAXED, __HIP_MEMORY_SCOPE_AGENT); dead = true; break; }
            }
            __builtin_amdgcn_fence(__ATOMIC_ACQUIRE, "agent");
            if (lane == 0) flag[0] = dead ? 1u : 0u;
        }
        asm volatile("s_waitcnt vmcnt(0) lgkmcnt(0)" ::: "memory"); __builtin_amdgcn_s_barrier(); asm volatile("" ::: "memory");
        if (lane < 32) {
            const unsigned* slot = (const unsigned*)xbuf + (size_t)(u.pm * BM + row) * 4; float t = 0.f;
#pragma unroll
            for (int k = 0; k < 4; ++k) t += __uint_as_float(__hip_atomic_load(slot + k, __ATOMIC_RELAXED, __HIP_MEMORY_SCOPE_AGENT));
            Sr[row] = 1.0f / sqrtf(t * (1.0f / 1024.0f) + eps);
        }
        asm volatile("s_waitcnt lgkmcnt(0)" ::: "memory"); __builtin_amdgcn_s_barrier(); asm volatile("" ::: "memory");
        float rs[2][4];
#pragma unroll
        for (int ai = 0; ai < 2; ++ai)
#pragma unroll
            for (int m = 0; m < 4; ++m) rs[ai][m] = Sr[ai * HALF + wr * 64 + m * 16 + fr];
#pragma unroll
        for (int bj = 0; bj < 2; ++bj)
#pragma unroll
            for (int n = 0; n < 2; ++n) { const int c = col0 + bj * HALF + n * 16;
                const f32x4 ga = *(const f32x4*)(ng + c) * (*(const f32x4*)(sc + c) + 1.0f), gb = *(const f32x4*)(sh + c);
#pragma unroll
                for (int ai = 0; ai < 2; ++ai)
#pragma unroll
                    for (int m = 0; m < 4; ++m) { const int r = ai * HALF + wr * 64 + m * 16 + fr; const size_t off = (size_t)(u.pm * BM + r) * ldc + c;
                        const f32x4 y = acc[ai][bj][m][n] * rs[ai][m] * ga + gb; u32x2 w; w.x = cvtpk(y[0], y[1]); w.y = cvtpk(y[2], y[3]);
                        *(u32x2*)(H + off) = w; } }
    }
};

template <class Epi, class Sched, bool ALIGN_EPI = false, bool SP2 = false>
__device__ __forceinline__ void gemm_phase(LAS unsigned char* lds, const Gemm g, const Sched& S, const Epi& E) {
    int tid_ = threadIdx.x; asm volatile("" : "+v"(tid_));
    const int tid = tid_, wid = __builtin_amdgcn_readfirstlane(tid >> 6), lane = tid & 63, wr = wid >> 2, wc = wid & 3, fr = lane & 15, fq = lane >> 4;
    const int K = g.K, nt = K / BK;
    unsigned voffA[2], voffB[2];
#pragma unroll
    for (int i = 0; i < 2; ++i) { int R, C; stage_rc(tid * 16 + i * 8192, R, C); const int Rb = Epi::PERM ? ((R & ~31) + perm32(R & 31)) : R;
        voffA[i] = (unsigned)(R * K + C) * 2u; voffB[i] = (unsigned)(Rb * K + C) * 2u; }
    const size_t kstep = (size_t)(BK * 2);
    const size_t hstep = (size_t)HALF * K * 2;
    const size_t tstep = 2 * hstep;
    const unsigned ldsw = (unsigned)wid * 1024u;
    const int aoff = lds_byte(wr * 64 + fr, fq * 8), boff = lds_byte(wc * 32 + fr, fq * 8);
#define PG8_SA(b, h) (((b) * 2 + (h)) * HTB)
#define PG8_SB(b, h) ((4 + (b) * 2 + (h)) * HTB)
#define PG8_STAGE(bufoff, gbase, voff) do { _Pragma("unroll") for (int _i = 0; _i < 2; ++_i) \
        __builtin_amdgcn_global_load_lds((const unsigned*)((const char*)(gbase) + (voff)[_i]), (LAS unsigned*)(lds + (bufoff) + ldsw + _i * 8192), 16, 0, 0); } while (0)
#define PG8_LDA(dst, b, h) do { _Pragma("unroll") for (int m = 0; m < 4; ++m) _Pragma("unroll") for (int k = 0; k < 2; ++k) dst[m][k] = *(const LAS bf16x8*)(lds + PG8_SA(b, h) + aoff + m * 2048 + k * 1024); } while (0)
#define PG8_LDB(dst, b, h) do { _Pragma("unroll") for (int n = 0; n < 2; ++n) _Pragma("unroll") for (int k = 0; k < 2; ++k) dst[n][k] = *(const LAS bf16x8*)(lds + PG8_SB(b, h) + boff + n * 2048 + k * 1024); } while (0)
#define PG8_MMA(ai, bj, At, Bt) do { __builtin_amdgcn_s_setprio(1); _Pragma("unroll") for (int m = 0; m < 4; ++m) _Pragma("unroll") for (int n = 0; n < 2; ++n) _Pragma("unroll") for (int k = 0; k < 2; ++k) \
        acc[ai][bj][m][n] = __builtin_amdgcn_mfma_f32_16x16x32_bf16(Bt[n][k], At[m][k], acc[ai][bj][m][n], 0, 0, 0); __builtin_amdgcn_s_setprio(0); } while (0)
#define PG8_WAIT_V(n) asm volatile("s_waitcnt vmcnt(" #n ")" ::: "memory")
#define PG8_WAIT_L(n) asm volatile("s_waitcnt lgkmcnt(" #n ")" ::: "memory")
#define PG8_BAR __builtin_amdgcn_s_barrier()
#define PG8_SCHED __builtin_amdgcn_sched_barrier(0)
    Unit cur, nxt; int ui = 0;
    if (!S.next(0, cur)) return;
    f32x4 acc[2][2][4][2];
#pragma unroll
    for (int a = 0; a < 2; ++a)
#pragma unroll
        for (int b = 0; b < 2; ++b)
#pragma unroll
            for (int m = 0; m < 4; ++m)
#pragma unroll
                for (int n = 0; n < 2; ++n) acc[a][b][m][n] = (f32x4){0.f, 0.f, 0.f, 0.f};
    bf16x8 At[4][2], B0[2][2], B1[2][2];
    const char* cA = (const char*)g.A + (size_t)cur.pm * tstep; const char* cB = (const char*)g.Bt + (size_t)cur.pn * tstep;
    S.a_ready(cur);
    if constexpr (SP2) {
        PG8_STAGE(PG8_SB(0, 0), cB, voffB); PG8_STAGE(PG8_SB(0, 1), cB + hstep, voffB); PG8_STAGE(PG8_SA(0, 0), cA, voffA); PG8_STAGE(PG8_SA(0, 1), cA + hstep, voffA);
        if (wr == 1) PG8_BAR;
        PG8_WAIT_V(2); PG8_BAR;
        PG8_STAGE(PG8_SB(1, 0), cB + kstep, voffB); PG8_STAGE(PG8_SA(1, 0), cA + kstep, voffA); PG8_STAGE(PG8_SB(1, 1), cB + hstep + kstep, voffB);
        PG8_WAIT_V(6); PG8_BAR;
    } else {
        PG8_STAGE(PG8_SB(0, 0), cB, voffB); PG8_STAGE(PG8_SA(0, 0), cA, voffA); PG8_STAGE(PG8_SB(0, 1), cB + hstep, voffB); PG8_STAGE(PG8_SA(0, 1), cA + hstep, voffA);
        if (wr == 1) PG8_BAR;
        PG8_WAIT_V(4); PG8_BAR;
        PG8_STAGE(PG8_SB(1, 0), cB + kstep, voffB); PG8_STAGE(PG8_SA(1, 0), cA + kstep, voffA); PG8_STAGE(PG8_SB(1, 1), cB + hstep + kstep, voffB);
        PG8_WAIT_V(6); PG8_BAR;
    }
    for (;;) {
        const bool has_next = S.next(ui + 1, nxt);
        const char* nA = has_next ? (const char*)g.A + (size_t)nxt.pm * tstep : cA; const char* nB = has_next ? (const char*)g.Bt + (size_t)nxt.pn * tstep : cB;
        for (int t = 0; t < nt; t += 2) {
            const bool last = (t == nt - 2);
            const char* a1 = cA + (size_t)(t + 1) * kstep;
            const char* a2 = last ? nA : cA + (size_t)(t + 2) * kstep; const char* b2 = last ? nB : cB + (size_t)(t + 2) * kstep;
            const char* a3 = a2 + kstep; const char* b3 = b2 + kstep;
            if (last && has_next) S.a_ready(nxt);
            if constexpr (SP2) {
            PG8_LDB(B0, 0, 0); PG8_LDB(B1, 0, 1); PG8_SCHED; PG8_LDA(At, 0, 0); PG8_STAGE(PG8_SA(1, 1), a1 + hstep, voffA);
            PG8_WAIT_V(8); PG8_WAIT_L(0); PG8_BAR; PG8_MMA(0, 0, At, B0); PG8_MMA(0, 1, At, B1); PG8_BAR; PG8_SCHED;
            PG8_LDA(At, 0, 1); PG8_STAGE(PG8_SB(0, 0), b2, voffB); PG8_STAGE(PG8_SB(0, 1), b2 + hstep, voffB); PG8_STAGE(PG8_SA(0, 0), a2, voffA);
            PG8_WAIT_V(8); PG8_WAIT_L(0); PG8_BAR; PG8_MMA(1, 0, At, B0); PG8_MMA(1, 1, At, B1); PG8_BAR; PG8_SCHED;
            PG8_LDB(B0, 1, 0); PG8_LDB(B1, 1, 1); PG8_SCHED; PG8_LDA(At, 1, 0); PG8_STAGE(PG8_SA(0, 1), a2 + hstep, voffA);
            PG8_WAIT_V(8); PG8_WAIT_L(0); PG8_BAR; PG8_MMA(0, 0, At, B0); PG8_MMA(0, 1, At, B1); PG8_BAR; PG8_SCHED;
            PG8_LDA(At, 1, 1); PG8_STAGE(PG8_SB(1, 0), b3, voffB); PG8_STAGE(PG8_SB(1, 1), b3 + hstep, voffB); PG8_STAGE(PG8_SA(1, 0), a3, voffA);
            PG8_WAIT_V(8); PG8_WAIT_L(0); PG8_BAR; PG8_MMA(1, 0, At, B0); PG8_MMA(1, 1, At, B1); PG8_BAR; PG8_SCHED;
            } else {
            PG8_LDB(B0, 0, 0); PG8_SCHED; PG8_LDA(At, 0, 0); PG8_STAGE(PG8_SA(1, 1), a1 + hstep, voffA);
            PG8_WAIT_L(8); PG8_BAR; PG8_WAIT_L(0); PG8_MMA(0, 0, At, B0); PG8_BAR; PG8_SCHED;
            PG8_LDB(B1, 0, 1); PG8_STAGE(PG8_SB(0, 0), b2, voffB);
            PG8_BAR; PG8_WAIT_L(0); PG8_MMA(0, 1, At, B1); PG8_BAR;
            PG8_LDA(At, 0, 1); PG8_STAGE(PG8_SA(0, 0), a2, voffA);
            PG8_BAR; PG8_WAIT_L(0); PG8_MMA(1, 0, At, B0); PG8_BAR; PG8_SCHED;
            PG8_STAGE(PG8_SB(0, 1), b2 + hstep, voffB);
            PG8_WAIT_V(6); PG8_BAR; PG8_MMA(1, 1, At, B1); PG8_BAR;
            PG8_LDB(B0, 1, 0); PG8_SCHED; PG8_LDA(At, 1, 0); PG8_STAGE(PG8_SA(0, 1), a2 + hstep, voffA);
            PG8_WAIT_L(8); PG8_BAR; PG8_WAIT_L(0); PG8_MMA(0, 0, At, B0); PG8_BAR; PG8_SCHED;
            PG8_LDB(B1, 1, 1); PG8_STAGE(PG8_SB(1, 0), b3, voffB);
            PG8_BAR; PG8_WAIT_L(0); PG8_MMA(0, 1, At, B1); PG8_BAR;
            PG8_LDA(At, 1, 1); PG8_STAGE(PG8_SA(1, 0), a3, voffA);
            PG8_BAR; PG8_WAIT_L(0); PG8_MMA(1, 0, At, B0); PG8_BAR; PG8_SCHED;
            PG8_STAGE(PG8_SB(1, 1), b3 + hstep, voffB);
            PG8_WAIT_V(6); PG8_BAR; PG8_MMA(1, 1, At, B1); PG8_BAR;
            }
        }
        if constexpr (ALIGN_EPI) { if (wr == 0) PG8_BAR; }
        if constexpr (!Epi::AFTER_DRAIN) { E(acc, cur, wr, wc, fr, fq); S.done(cur); }
        if (!has_next) break;
#pragma unroll
        for (int a = 0; a < 2; ++a)
#pragma unroll
            for (int b = 0; b < 2; ++b)
#pragma unroll
                for (int m = 0; m < 4; ++m)
#pragma unroll
                    for (int n = 0; n < 2; ++n) acc[a][b][m][n] = (f32x4){0.f, 0.f, 0.f, 0.f};
        cur = nxt; cA = nA; cB = nB; ++ui;
        if constexpr (ALIGN_EPI) { if (wr == 1) PG8_BAR; }
    }
    PG8_WAIT_V(0);
    if constexpr (!ALIGN_EPI) { if (wr == 0) PG8_BAR; }
    PG8_BAR;
    if constexpr (Epi::AFTER_DRAIN) { E.fused(acc, cur, wr, wc, fr, fq, lds, wid, lane); }
#undef PG8_SA
#undef PG8_SB
#undef PG8_STAGE
#undef PG8_LDA
#undef PG8_LDB
#undef PG8_MMA
#undef PG8_WAIT_V
#undef PG8_WAIT_L
#undef PG8_BAR
#undef PG8_SCHED
}
}

#define XB_TMO      128
#define XB_XCNT(j)  (256  + 64 * (j))
#define XB_XSUB(j)  (1280 + 64 * (j))
#define XB_XGEN(j)  (2304 + 64 * (j))
#define XB_TOP      3328
#define XB_TOPGEN   3392
#define XCD_BAR_WORDS 3456
#define XB_SPIN_CAP (1u << 18)
__device__ __forceinline__ unsigned xb_ld(unsigned* p)              { return __hip_atomic_load(p, __ATOMIC_RELAXED, __HIP_MEMORY_SCOPE_AGENT); }
__device__ __forceinline__ unsigned xb_add(unsigned* p, unsigned v) { return __hip_atomic_fetch_add(p, v, __ATOMIC_RELAXED, __HIP_MEMORY_SCOPE_AGENT); }
__device__ __forceinline__ unsigned xb_xcc_id() { return (unsigned)__builtin_amdgcn_s_getreg((3 << 11) | 20) & 0xFu; }
#define XB_SPIN(cond, bar) do { unsigned _sp = 0; while (cond) { __builtin_amdgcn_s_sleep(1); \
    if ((++_sp & 255u) == 0u) { if (xb_ld(&(bar)[XB_TMO])) break; if (_sp > XB_SPIN_CAP) { atomicAdd(&(bar)[XB_TMO], 1u); break; } } } } while (0)
struct XcdBarrier { unsigned* bar; unsigned x; volatile LAS unsigned* st; };
__device__ __forceinline__ XcdBarrier xcd_barrier_post(unsigned* bar, volatile LAS unsigned* st) {
    XcdBarrier b; b.bar = bar; b.x = xb_xcc_id(); b.st = st;
    if (threadIdx.x == 0) (void)xb_add(&bar[XB_XCNT(b.x)], 1u);
    return b;
}
__device__ __forceinline__ void xcd_barrier_complete(unsigned* bar, unsigned x, unsigned& nloc, unsigned& nx) {
    const unsigned G = gridDim.x * gridDim.y * gridDim.z;
    unsigned sum, cnt, mine, sp = 0u;
    for (;;) {
        sum = 0u; cnt = 0u; mine = 0u;
#pragma unroll
        for (unsigned j = 0; j < 16; ++j) { const unsigned c = xb_ld(&bar[XB_XCNT(j)]); sum += c; cnt += (c > 0u) ? 1u : 0u; }
        mine = xb_ld(&bar[XB_XCNT(x)]);
        if (sum == G) break;
        __builtin_amdgcn_s_sleep(1);
        if ((++sp & 255u) == 0u) { if (xb_ld(&bar[XB_TMO])) break; if (sp > XB_SPIN_CAP) { atomicAdd(&bar[XB_TMO], 1u); break; } }
    }
    nloc = mine > 0u ? mine : 1u; nx = cnt > 0u ? cnt : 1u;
}
__device__ __forceinline__ void xcd_barrier(const XcdBarrier& b) {
    asm volatile("s_waitcnt vmcnt(0)" ::: "memory");
    __syncthreads();
    if (threadIdx.x == 0) {
        unsigned* bar = b.bar; asm volatile("" : "+s"(bar));
        __builtin_amdgcn_s_waitcnt(0);
        unsigned nloc = b.st[0], nx = b.st[1];
        if (nloc == 0u) { xcd_barrier_complete(bar, b.x, nloc, nx); b.st[0] = nloc; b.st[1] = nx; }
        const unsigned old = xb_add(&bar[XB_XSUB(b.x)], 1u);
        const unsigned gen = old / nloc;
        if (old + 1u == (gen + 1u) * nloc) {
            __builtin_amdgcn_fence(__ATOMIC_RELEASE, "agent");
            asm volatile("s_waitcnt vmcnt(0)" ::: "memory");
            const unsigned og = xb_add(&bar[XB_TOP], 1u);
            const unsigned tg = og / nx;
            if (og + 1u == (tg + 1u) * nx) xb_add(&bar[XB_TOPGEN], 1u);
            else XB_SPIN(xb_ld(&bar[XB_TOPGEN]) == tg, bar);
            __builtin_amdgcn_fence(__ATOMIC_ACQUIRE, "agent");
            xb_add(&bar[XB_XGEN(b.x)], 1u);
            asm volatile("s_waitcnt vmcnt(0)" ::: "memory");
        } else {
            XB_SPIN(xb_ld(&bar[XB_XGEN(b.x)]) == gen, bar);
            __builtin_amdgcn_fence(__ATOMIC_ACQUIRE, "agent");
            asm volatile("s_waitcnt vmcnt(0)" ::: "memory");
        }
    }
    __syncthreads();
}
constexpr int NWAVES = 8, NTHR = 512;
constexpr int LDS_BYTES = 147456;
constexpr int RING_BYTES = 131072;
constexpr int MISC_OFF = LDS_BYTES - 256;
constexpr size_t MiB = 1u << 20;
constexpr size_t WS_CTL = 0, CTL_ZERO_BYTES = 1 * MiB;
constexpr size_t WS_MOD = 1 * MiB;
constexpr size_t WS_COS = 2 * MiB, WS_SIN = 6 * MiB;
constexpr size_t WS_WGIN = 10 * MiB;
constexpr size_t WS_WGLR = 22 * MiB;
constexpr size_t WS_WGOUT = 23 * MiB;
constexpr size_t WS_WMIN = 27 * MiB;
constexpr size_t WS_WMOUT = 39 * MiB;
constexpr size_t WS_W1 = 43 * MiB;
constexpr size_t WS_W2 = 75 * MiB;
constexpr size_t WS_H = 107 * MiB;
constexpr size_t WS_MIX = 139 * MiB;
constexpr size_t WS_QKV = 171 * MiB;
constexpr size_t WS_AUX = 267 * MiB;
constexpr size_t WS_HID = 171 * MiB;
constexpr size_t WS_END = 363 * MiB;
constexpr size_t WS_SBUF = WS_AUX;
constexpr size_t WS_GLR = WS_AUX + 32 * MiB;
constexpr size_t WS_DG = WS_AUX + 33 * MiB;
constexpr size_t WS_XB = WS_AUX + 64 * MiB;
constexpr size_t WS_KMEAN = WS_MOD + 128 * 1024;
constexpr size_t WS_LPART = WS_H + 1 * MiB;
constexpr size_t WS_LIST = WS_H + 4 * MiB;
constexpr int CW_BAR = 4096;
constexpr int CW_MCNT = 16384;
constexpr int CW_TMO = 0;
constexpr int CW_SEAM = 32768, SEAM_BANK = 64 * 64;
constexpr size_t WS_XBUF = WS_MOD + 512 * 1024;
struct Frame {
    LAS unsigned char* lds;
    int tid, lane, wave, vcu, G;
};
__device__ __forceinline__ Frame opaque(const Frame& F0) { Frame F = F0; int t = F0.tid; asm volatile("" : "+v"(t)); F.tid = t; F.lane = t & 63; F.wave = __builtin_amdgcn_readfirstlane(t >> 6); return F; }
__device__ __forceinline__ float wave_sum(float v) {
#pragma unroll
    for (int o = 1; o < 64; o <<= 1) v += __shfl_xor(v, o);
    return v;
}
__device__ __forceinline__ float silu_f(float x) { return x / (1.f + __expf(-x)); }
__device__ __forceinline__ void sincos_acc(double ang, float& s, float& c) {
    const double n = rint(ang * 0.15915494309189535);
    double r = fma(-n, 6.283185307179586, ang); r = fma(-n, 2.4492935982947064e-16, r);
    const double x = r * 0.25, x2 = x * x;
    const double sn = x * (1.0 + x2 * (-1.0 / 6 + x2 * (1.0 / 120 + x2 * (-1.0 / 5040 + x2 * (1.0 / 362880 + x2 * (-1.0 / 39916800 + x2 * (1.0 / 6227020800.0)))))));
    const double cs = 1.0 + x2 * (-0.5 + x2 * (1.0 / 24 + x2 * (-1.0 / 720 + x2 * (1.0 / 40320 + x2 * (-1.0 / 3628800 + x2 * (1.0 / 479001600 + x2 * (-1.0 / 87178291200.0)))))));
    const double s2 = 2 * sn * cs, c2 = 1 - 2 * sn * sn;
    s = (float)(2 * s2 * c2); c = (float)(1 - 2 * s2 * s2);
}
constexpr int TR_SCR = 64 * 65 * 4;
struct TrItem { const float* W; int ld, n_off, n_cnt, K; bf16_t* WT; int item; };
__device__ __forceinline__ void tr_load(const TrItem& t, int lane, f32x4 (&v)[16]) {
    const int nblk = (t.n_cnt + 63) >> 6, kb = t.item / nblk, nb = t.item - kb * nblk, k0 = 64 * kb, n0 = 64 * nb;
    const int c4 = (lane & 15) * 4, kr = lane >> 4;
    const bool ok = (n0 + c4) < t.n_cnt;
#pragma unroll
    for (int i = 0; i < 16; ++i) v[i] = ok ? *(const f32x4*)(t.W + (size_t)(k0 + 4 * i + kr) * t.ld + t.n_off + n0 + c4) : (f32x4){0.f, 0.f, 0.f, 0.f};
}
__device__ __forceinline__ void tr_store(const TrItem& t, int lane, const f32x4 (&v)[16], LAS float* scr) {
    const int nblk = (t.n_cnt + 63) >> 6, kb = t.item / nblk, nb = t.item - kb * nblk, k0 = 64 * kb, n0 = 64 * nb;
    const int c4 = (lane & 15) * 4, kr = lane >> 4;
#pragma unroll
    for (int i = 0; i < 16; ++i) { LAS float* s = scr + (4 * i + kr) * 65 + c4; s[0] = v[i].x; s[1] = v[i].y; s[2] = v[i].z; s[3] = v[i].w; }
    asm volatile("s_waitcnt lgkmcnt(0)" ::: "memory");
    const int c = lane & 7;
#pragma unroll
    for (int j = 0; j < 8; ++j) { const int n = (lane >> 3) + 8 * j; const LAS float* s = scr + (8 * c) * 65 + n;
        u32x4 o; o.x = cvtpk(s[0 * 65], s[1 * 65]); o.y = cvtpk(s[2 * 65], s[3 * 65]); o.z = cvtpk(s[4 * 65], s[5 * 65]); o.w = cvtpk(s[6 * 65], s[7 * 65]);
        if (n0 + n < t.n_cnt) *(u32x4*)(t.WT + (size_t)(n0 + n) * t.K + k0 + 8 * c) = o; }
    asm volatile("s_waitcnt lgkmcnt(0)" ::: "memory");
}
struct MegaArgs {
    const float* in[18]; float* out; unsigned char* ws; int ph_lo, ph_hi;
};
__device__ __forceinline__ void p0_prologue(const Frame& F0, const MegaArgs& a) {
    const Frame F = opaque(F0);
    unsigned char* ws = a.ws;
    {
        LAS float* scr = (LAS float*)(F.lds + F.wave * TR_SCR);
        const int gw = F.vcu * NWAVES + F.wave, NGW = F.G * NWAVES;
        constexpr int I_GIN = 16 * 48, I_GLR = 16, I_SQ = 16 * 16, I_W1 = 16 * 64, I_W2 = 64 * 16;
        constexpr int NITEMS = 2 * I_GIN + 2 * I_GLR + 2 * I_SQ + 2 * I_GIN + 2 * I_SQ + 4 * I_W1 + 4 * I_W2;
        auto decode = [&](int it) -> TrItem {
            int r = it;
            if (r < 2 * I_GIN) { const int j = r / I_GIN; return TrItem{a.in[7] + (size_t)j * D * GLA_IN, GLA_IN, 0, 3072, D, (bf16_t*)(ws + WS_WGIN) + (size_t)j * 3072 * D, r % I_GIN}; } r -= 2 * I_GIN;
            if (r < 2 * I_GLR) { const int j = r / I_GLR; return TrItem{a.in[7] + (size_t)j * D * GLA_IN, GLA_IN, 3072, 16, D, (bf16_t*)(ws + WS_WGLR) + (size_t)j * 16 * D, r % I_GLR}; } r -= 2 * I_GLR;
            if (r < 2 * I_SQ) { const int j = r / I_SQ; return TrItem{a.in[11] + (size_t)j * D * D, D, 0, D, D, (bf16_t*)(ws + WS_WGOUT) + (size_t)j * D * D, r % I_SQ}; } r -= 2 * I_SQ;
            if (r < 2 * I_GIN) { const int j = r / I_GIN; return TrItem{a.in[12] + (size_t)j * D * MB_IN, MB_IN, 0, 3072, D, (bf16_t*)(ws + WS_WMIN) + (size_t)j * 3072 * D, r % I_GIN}; } r -= 2 * I_GIN;
            if (r < 2 * I_SQ) { const int j = r / I_SQ; return TrItem{a.in[15] + (size_t)j * D * D, D, 0, D, D, (bf16_t*)(ws + WS_WMOUT) + (size_t)j * D * D, r % I_SQ}; } r -= 2 * I_SQ;
            if (r < 4 * I_W1) { const int j = r / I_W1; return TrItem{a.in[16] + (size_t)j * D * DFF, DFF, 0, DFF, D, (bf16_t*)(ws + WS_W1) + (size_t)j * DFF * D, r % I_W1}; } r -= 4 * I_W1;
            { const int j = r / I_W2; return TrItem{a.in[17] + (size_t)j * DFF * D, D, 0, D, DFF, (bf16_t*)(ws + WS_W2) + (size_t)j * D * DFF, r % I_W2}; }
        };
        f32x4 va[16], vb[16];
        int it = gw;
        if (it < NITEMS) { TrItem cur = decode(it); tr_load(cur, F.lane, va);
            for (;;) {
                const int itn = it + NGW; TrItem nx = cur; const bool more = itn < NITEMS;
                if (more) { nx = decode(itn); tr_load(nx, F.lane, vb); }
                tr_store(cur, F.lane, va, scr);
                if (!more) break;
                const int itn2 = itn + NGW; const bool more2 = itn2 < NITEMS; TrItem nx2 = nx;
                if (more2) { nx2 = decode(itn2); tr_load(nx2, F.lane, va); }
                tr_store(nx, F.lane, vb, scr);
                if (!more2) break;
                cur = nx2; it = itn2;
            }
        }
    }
    __syncthreads();
    {
        const float* c = a.in[1]; const float* ada_w = a.in[3]; const float* ada_b = a.in[4]; float* mod = (float*)(ws + WS_MOD);
        LAS float* sc = (LAS float*)F.lds;
        LAS float* red = (LAS float*)F.lds + 1024;
        for (int k = F.tid; k < D; k += NTHR) sc[k] = silu_f(c[k]);
        __syncthreads();
        const int kg = F.tid >> 5, cl = F.tid & 31;
        for (int chunk = F.vcu; chunk < 256; chunk += F.G) {
            float part[3];
#pragma unroll
            for (int cc = 0; cc < 3; ++cc) {
                const int col = chunk * 96 + cc * 32 + cl, i = col / (6 * D), n = col - i * 6 * D;
                const float* w = ada_w + (size_t)i * D * 6 * D + (size_t)(kg * 64) * 6 * D + n;
                float wv[64];
#pragma unroll
                for (int k = 0; k < 64; ++k) wv[k] = w[(size_t)k * 6 * D];
                float acc = 0.f;
#pragma unroll
                for (int k = 0; k < 64; ++k) acc += sc[kg * 64 + k] * wv[k];
                part[cc] = acc;
            }
#pragma unroll
            for (int cc = 0; cc < 3; ++cc) red[kg * 96 + cc * 32 + cl] = part[cc];
            __syncthreads();
            if (F.tid < 96) { float s = 0.f;
#pragma unroll
                for (int g = 0; g < 16; ++g) s += red[g * 96 + F.tid];
                mod[chunk * 96 + F.tid] = s + ada_b[chunk * 96 + F.tid]; }
            __syncthreads();
        }
    }
    {
        const int* pos = (const int*)a.in[2]; float* ct = (float*)(ws + WS_COS); float* st = (float*)(ws + WS_SIN);
        for (int idx = F.vcu * NTHR + F.tid; idx < S * 64; idx += F.G * NTHR) {
            const int t = idx >> 6, i = idx & 63;
            const float inv_freq = (float)exp2(-(double)i * (13.287712379549449 / 64.0));
            const float angf = (float)pos[t] * inv_freq;
            float sn, cs; sincos_acc((double)angf, sn, cs);
            ct[idx] = cs; st[idx] = sn;
        }
    }
}
__device__ __forceinline__ void norm_phase(const Frame& F0, const float* __restrict__ x, const float* __restrict__ g, const float* __restrict__ sc, const float* __restrict__ sh, bf16_t* __restrict__ h) {
    const Frame F = opaque(F0);
    f32x4 ga[4], gb[4];
#pragma unroll
    for (int j = 0; j < 4; ++j) { const f32x4 gg = ((const f32x4*)g)[F.lane + 64 * j], s1 = ((const f32x4*)sc)[F.lane + 64 * j]; ga[j] = gg * (s1 + 1.0f); gb[j] = ((const f32x4*)sh)[F.lane + 64 * j]; }
    const int gw = F.vcu * NWAVES + F.wave, NGW = F.G * NWAVES;
    for (int m = gw; m < S; m += NGW) {
        const f32x4* xr = (const f32x4*)(x + (size_t)m * D) + F.lane;
        f32x4 v[4]; float ss = 0.f;
#pragma unroll
        for (int j = 0; j < 4; ++j) { v[j] = xr[64 * j]; ss += (v[j].x * v[j].x + v[j].y * v[j].y) + (v[j].z * v[j].z + v[j].w * v[j].w); }
        const float r = 1.0f / sqrtf(wave_sum(ss) * (1.f / D) + EPS);
        u32x2* o8 = (u32x2*)(h + (size_t)m * D) + F.lane;
#pragma unroll
        for (int j = 0; j < 4; ++j) { const f32x4 y = v[j] * r * ga[j] + gb[j]; u32x2 w; w.x = cvtpk(y.x, y.y); w.y = cvtpk(y.z, y.w); o8[64 * j] = w; }
    }
}
__device__ __forceinline__ void glr_phase(const Frame& F0, const bf16_t* __restrict__ H, const bf16_t* __restrict__ WglrT, float* __restrict__ glr) {
    const Frame F = opaque(F0);
    if (F.wave >= 4) return;
    const int l15 = F.lane & 15, q = F.lane >> 4;
    for (int rb = F.vcu; rb < S / 64; rb += F.G) {
        const int row0 = rb * 64 + F.wave * 16;
        const bf16_t* ap = H + (size_t)(row0 + l15) * D + 8 * q;
        const bf16_t* bp = WglrT + (size_t)l15 * D + 8 * q;
        f32x4 acc = {0.f, 0.f, 0.f, 0.f};
#pragma unroll 8
        for (int ks = 0; ks < 32; ++ks) {
            const bf16x8 av = *(const bf16x8*)(ap + ks * 32), bv = *(const bf16x8*)(bp + ks * 32);
            acc = __builtin_amdgcn_mfma_f32_16x16x32_bf16(av, bv, acc, 0, 0, 0);
        }
#pragma unroll
        for (int r = 0; r < 4; ++r) glr[(size_t)(row0 + 4 * q + r) * 16 + l15] = acc[r];
    }
}
typedef short v4i16_t __attribute__((ext_vector_type(4)));
__device__ __forceinline__ s16x4 vtr(const LAS unsigned char* p) { return __builtin_bit_cast(s16x4, __builtin_amdgcn_ds_read_tr16_b64_v4i16((LAS v4i16_t*)p)); }
__device__ __forceinline__ int crow(int reg, int h) { return (reg & 3) + 8 * (reg >> 2) + 4 * h; }
__device__ __forceinline__ unsigned off_b(unsigned row, unsigned ch) { return 272u * row + 16u * ch; }
__device__ __forceinline__ unsigned tr_addr(unsigned lane, unsigned c, unsigned rowblk) {
    const unsigned blk = (lane >> 4) & 1, q = (lane & 15) >> 2, p = lane & 3;
    return off_b(rowblk + q, 4 * c + 2 * blk + (p >> 1)) + 8 * (p & 1);
}
constexpr int GL_IMG = 64 * 272, GL_PST = 144;
constexpr int GL_QD = 0, GL_KI = GL_IMG, GL_KT = 2 * GL_IMG, GL_V = 3 * GL_IMG, GL_P = 5 * GL_IMG, GL_GL = GL_P + 64 * GL_PST, GL_SEG = GL_GL + 4096, GL_DEC = GL_SEG + 2048, GL_RED = GL_DEC + 512;
static_assert(GL_RED + 2048 <= RING_BYTES, "gla lds");
#define MFMA32(a, b, c) __builtin_amdgcn_mfma_f32_32x32x16_bf16((a), (b), (c), 0, 0, 0)

struct GlaPre { f32x4 ga, gb; unsigned qk[16]; };
__device__ __forceinline__ void gla_prefetch_g(const Frame& F, const float* __restrict__ GLR, int t0, GlaPre& P) {
    const int ib = F.wave >> 2, l31 = F.lane & 31, h = F.lane >> 5;
    const float* gp = GLR + (size_t)(t0 + 32 * ib + l31) * 16 + 8 * h;
    P.ga = *(const f32x4*)gp; P.gb = *(const f32x4*)(gp + 4);
}
template <bool WITH_Q>
__device__ __forceinline__ void gla_prefetch(const Frame& F, const bf16_t* __restrict__ QKV, const float* __restrict__ GLR, int t0, int hd, GlaPre& P);
template <bool WITH_Q>
__device__ __forceinline__ void gla_prefetch_qk(const Frame& F, const bf16_t* __restrict__ QKV, int t0, int hd, GlaPre& P) {
    const int w = F.wave, ib = w >> 2, db = w & 3, l31 = F.lane & 31, h = F.lane >> 5;
#pragma unroll
    for (int r = 0; r < 16; ++r) {
        const bf16_t* row = QKV + (size_t)(t0 + 32 * ib + crow(r, h)) * 3072 + hd * 128 + 32 * db + l31;
        const unsigned kk = row[512]; const unsigned qq = WITH_Q ? (unsigned)row[0] : 0u;
        P.qk[r] = qq | (kk << 16);
    }
}
template <bool WITH_Q>
__device__ __forceinline__ void gla_prefetch(const Frame& F, const bf16_t* __restrict__ QKV, const float* __restrict__ GLR, int t0, int hd, GlaPre& P) {
    gla_prefetch_g(F, GLR, t0, P); gla_prefetch_qk<WITH_Q>(F, QKV, t0, hd, P);
}
struct GlaW { u32x4 bhi, blo; float bias; };
__device__ __forceinline__ void gla_load_w(const float* __restrict__ wupg, const float* __restrict__ bgg, int hd, const Frame& F, GlaW& W) {
    const int db = F.wave & 3, l31 = F.lane & 31, h = F.lane >> 5, d = hd * 128 + 32 * db + l31;
    float wv[8];
#pragma unroll
    for (int j = 0; j < 8; ++j) wv[j] = wupg[(8 * h + j) * 512 + d];
    W.bhi.x = cvtpk(wv[0], wv[1]); W.bhi.y = cvtpk(wv[2], wv[3]); W.bhi.z = cvtpk(wv[4], wv[5]); W.bhi.w = cvtpk(wv[6], wv[7]);
    W.blo.x = cvtpk(wv[0] - bflo(W.bhi.x), wv[1] - bfhi(W.bhi.x)); W.blo.y = cvtpk(wv[2] - bflo(W.bhi.y), wv[3] - bfhi(W.bhi.y));
    W.blo.z = cvtpk(wv[4] - bflo(W.bhi.z), wv[5] - bfhi(W.bhi.z)); W.blo.w = cvtpk(wv[6] - bflo(W.bhi.w), wv[7] - bfhi(W.bhi.w));
    W.bias = bgg[d];
}
template <bool WITH_Q>
__device__ __forceinline__ float gla_chunk_prep(const Frame& F, const GlaPre& P, const GlaW& W, const bf16_t* __restrict__ QKV, int t0, int hd) {
    LAS unsigned char* lds = F.lds;
    const int w = F.wave, ib = w >> 2, db = w & 3, l31 = F.lane & 31, h = F.lane >> 5, d = 32 * db + l31;
    u32x4 vv[4];
#pragma unroll
    for (int k = 0; k < 4; ++k) { const int c = F.tid + 512 * k, j = c >> 5, ch = c & 31; vv[k] = *(const u32x4*)(QKV + (size_t)(t0 + j) * 3072 + 1024 + hd * 256 + ch * 8); }
    u32x4 ahi, alo;
    ahi.x = cvtpk(P.ga.x, P.ga.y); ahi.y = cvtpk(P.ga.z, P.ga.w); ahi.z = cvtpk(P.gb.x, P.gb.y); ahi.w = cvtpk(P.gb.z, P.gb.w);
    alo.x = cvtpk(P.ga.x - bflo(ahi.x), P.ga.y - bfhi(ahi.x)); alo.y = cvtpk(P.ga.z - bflo(ahi.y), P.ga.w - bfhi(ahi.y));
    alo.z = cvtpk(P.gb.x - bflo(ahi.z), P.gb.y - bfhi(ahi.z)); alo.w = cvtpk(P.gb.z - bflo(ahi.w), P.gb.w - bfhi(ahi.w));
    f32x16 X;
#pragma unroll
    for (int r = 0; r < 16; ++r) X[r] = W.bias;
    X = MFMA32(__builtin_bit_cast(bf16x8, ahi), __builtin_bit_cast(bf16x8, W.bhi), X);
    X = MFMA32(__builtin_bit_cast(bf16x8, alo), __builtin_bit_cast(bf16x8, W.bhi), X);
    X = MFMA32(__builtin_bit_cast(bf16x8, ahi), __builtin_bit_cast(bf16x8, W.blo), X);
    float G[16], sk[4];
#pragma unroll
    for (int k = 0; k < 4; ++k) { float run = 0.f;
#pragma unroll
        for (int j = 0; j < 4; ++j) { const float x = X[4 * k + j]; const float ls = fminf(x, 0.f) - __logf(1.f + __expf(-fabsf(x))); run += ls * (1.f / 16.f); G[4 * k + j] = run; }
        sk[k] = run; }
    float base = 0.f, tot;
    {
        float ps[4];
#pragma unroll
        for (int k = 0; k < 4; ++k) ps[k] = __shfl_xor(sk[k], 32);
#pragma unroll
        for (int k = 0; k < 4; ++k) { const float bk = base + (h ? ps[k] : 0.f);
#pragma unroll
            for (int j = 0; j < 4; ++j) G[4 * k + j] += bk;
            base += sk[k] + ps[k]; }
        tot = base;
    }
    LAS float* HT = (LAS float*)(lds + GL_SEG);
    if (h == 0) HT[ib * 128 + d] = tot;
#pragma unroll
    for (int k = 0; k < 4; ++k) { const int c = F.tid + 512 * k, j = c >> 5, ch = c & 31; *(LAS u32x4*)(lds + GL_V + (ch >> 4) * GL_IMG + off_b(j, ch & 15)) = vv[k]; }
    __syncthreads();
    const float t0h = HT[d], t1h = HT[128 + d], glast = t0h + t1h;
    const float add = ib ? t0h : 0.f;
    const float qs = 0.08838834764831845f;
#pragma unroll
    for (int r = 0; r < 16; ++r) {
        const int i = 32 * ib + crow(r, h); const float Gv = G[r] + add;
        const unsigned a = off_b(i, d >> 3) + 2 * (d & 7);
        const float kf = bfhi(P.qk[r]);
        if (WITH_Q) {
            *(LAS unsigned short*)(lds + GL_QD + a) = (unsigned short)(cvtpk(bflo(P.qk[r]) * qs * __expf(Gv), 0.f) & 0xffffu);
            *(LAS unsigned short*)(lds + GL_KI + a) = (unsigned short)(cvtpk(kf * __expf(-Gv), 0.f) & 0xffffu);
        }
        *(LAS unsigned short*)(lds + GL_KT + a) = (unsigned short)(cvtpk(kf * __expf(glast - Gv), 0.f) & 0xffffu);
    }
    if (ib == 0 && h == 0) ((LAS float*)(lds + GL_DEC))[d] = __expf(glast);
    __syncthreads();
    return glast;
}
__device__ __forceinline__ void gla_state_update(const Frame& F, f32x16 (&St)[4]) {
    LAS unsigned char* lds = F.lds;
    const int h = F.lane >> 5, w = F.wave;
    const LAS float* dec = (const LAS float*)(lds + GL_DEC);
#pragma unroll
    for (int db = 0; db < 4; ++db)
#pragma unroll
        for (int r = 0; r < 16; ++r) St[db][r] *= dec[32 * db + crow(r, h)];
    const LAS unsigned char* vimg = lds + GL_V + (w >> 2) * GL_IMG;
#pragma unroll
    for (int ks = 0; ks < 4; ++ks) {
        const s16x4 vlo = vtr(vimg + tr_addr(F.lane, w & 3, 16 * ks + 8 * h)), vhi = vtr(vimg + tr_addr(F.lane, w & 3, 16 * ks + 8 * h + 4));
        const bf16x8 vb = __builtin_shufflevector(vlo, vhi, 0, 1, 2, 3, 4, 5, 6, 7);
#pragma unroll
        for (int db = 0; db < 4; ++db) {
            const s16x4 klo = vtr(lds + GL_KT + tr_addr(F.lane, db, 16 * ks + 8 * h)), khi = vtr(lds + GL_KT + tr_addr(F.lane, db, 16 * ks + 8 * h + 4));
            const bf16x8 ka = __builtin_shufflevector(klo, khi, 0, 1, 2, 3, 4, 5, 6, 7);
            St[db] = MFMA32(ka, vb, St[db]);
        }
    }
}
__device__ __forceinline__ void gla_g1(const Frame& F0, const bf16_t* __restrict__ QKV, const float* __restrict__ GLR, const float* __restrict__ wupg, const float* __restrict__ bgg, float* __restrict__ SBUF, float* __restrict__ DG) {
    const Frame F = opaque(F0);
    const int h = F.lane >> 5, w = F.wave;
    for (int u = F.vcu; u < 256; u += F.G) {
        const int gi = u >> 2, hd = u & 3;
        GlaW W; gla_load_w(wupg, bgg, hd, F, W);
        f32x16 St[4];
#pragma unroll
        for (int db = 0; db < 4; ++db)
#pragma unroll
            for (int r = 0; r < 16; ++r) St[db][r] = 0.f;
        float gsum = 0.f;
        GlaPre P; gla_prefetch<false>(F, QKV, GLR, gi * 256, hd, P);
#pragma unroll 1
        for (int c = 0; c < 4; ++c) {
            gsum += gla_chunk_prep<false>(F, P, W, QKV, gi * 256 + c * 64, hd);
            if (c < 3) gla_prefetch<false>(F, QKV, GLR, gi * 256 + (c + 1) * 64, hd, P);
            gla_state_update(F, St);
            __syncthreads();
        }
        float* sp = SBUF + ((size_t)u * 128) * 256 + 32 * w + (F.lane & 31);
#pragma unroll
        for (int db = 0; db < 4; ++db)
#pragma unroll
            for (int r = 0; r < 16; ++r) sp[(size_t)(32 * db + crow(r, h)) * 256] = St[db][r];
        if ((w >> 2) == 0 && h == 0) DG[u * 128 + 32 * (w & 3) + (F.lane & 31)] = __expf(gsum);
    }
}
__device__ __forceinline__ void gla_g2(const Frame& F0, float* __restrict__ SBUF, const float* __restrict__ DG) {
    const Frame F = opaque(F0);
    for (int e = F.vcu * NTHR + F.tid; e < 4 * 128 * 256; e += F.G * NTHR) {
        const int hd = e >> 15, d = (e >> 8) & 127;
        float run = 0.f;
#pragma unroll 1
        for (int g0 = 0; g0 < 64; g0 += 8) {
            float tmp[8], dec[8];
#pragma unroll
            for (int k = 0; k < 8; ++k) { const int g = g0 + k; tmp[k] = SBUF[(size_t)(g * 4 + hd) * 32768 + (e & 32767)]; dec[k] = DG[(g * 4 + hd) * 128 + d]; }
#pragma unroll
            for (int k = 0; k < 8; ++k) { const int g = g0 + k; SBUF[(size_t)(g * 4 + hd) * 32768 + (e & 32767)] = run; run = dec[k] * run + tmp[k]; }
        }
    }
}
__device__ __forceinline__ void gla_g3(const Frame& F0, const bf16_t* __restrict__ QKV, const float* __restrict__ GLR, const float* __restrict__ wupg, const float* __restrict__ bgg,
                                       const float* __restrict__ SBUF, const float* __restrict__ og, bf16_t* __restrict__ MIX) {
    const Frame F = opaque(F0);
    LAS unsigned char* lds = F.lds;
    const int h = F.lane >> 5, w = F.wave, l31 = F.lane & 31;
    for (int u = F.vcu; u < 256; u += F.G) {
        const int gi = u >> 2, hd = u & 3;
        GlaW W; gla_load_w(wupg, bgg, hd, F, W);
        f32x16 St[4];
        { const float* sp = SBUF + ((size_t)u * 128) * 256 + 32 * w + l31;
#pragma unroll
          for (int db = 0; db < 4; ++db)
#pragma unroll
              for (int r = 0; r < 16; ++r) St[db][r] = sp[(size_t)(32 * db + crow(r, h)) * 256]; }
#pragma unroll 1
        for (int c = 0; c < 4; ++c) {
            const int t0 = gi * 256 + c * 64;
            { GlaPre P; gla_prefetch<true>(F, QKV, GLR, t0, hd, P); (void)gla_chunk_prep<true>(F, P, W, QKV, t0, hd); }
            if (w < 3) {
                const int ib = (w >= 1), jb = (w == 2);
                f32x16 acc;
#pragma unroll
                for (int r = 0; r < 16; ++r) acc[r] = 0.f;
#pragma unroll
                for (int s = 0; s < 8; ++s) {
                    const bf16x8 a = *(const LAS bf16x8*)(lds + GL_QD + off_b(32 * ib + l31, 2 * s + h));
                    const bf16x8 b = *(const LAS bf16x8*)(lds + GL_KI + off_b(32 * jb + l31, 2 * s + h));
                    acc = MFMA32(a, b, acc);
                }
                const int jabs = 32 * jb + l31;
#pragma unroll
                for (int r = 0; r < 16; ++r) { const int iabs = 32 * ib + crow(r, h); const float pv = (jabs <= iabs) ? acc[r] : 0.f;
                    *(LAS unsigned short*)(lds + GL_P + iabs * GL_PST + 2 * jabs) = (unsigned short)(cvtpk(pv, 0.f) & 0xffffu); }
            }
            f32x16 oT[2];
#pragma unroll
            for (int ib = 0; ib < 2; ++ib)
#pragma unroll
                for (int r = 0; r < 16; ++r) oT[ib][r] = 0.f;
#pragma unroll
            for (int db = 0; db < 4; ++db)
#pragma unroll
                for (int s = 0; s < 2; ++s) {
                    u32x4 pk; pk.x = cvtpk(St[db][8 * s + 0], St[db][8 * s + 1]); pk.y = cvtpk(St[db][8 * s + 2], St[db][8 * s + 3]); pk.z = cvtpk(St[db][8 * s + 4], St[db][8 * s + 5]); pk.w = cvtpk(St[db][8 * s + 6], St[db][8 * s + 7]);
                    const bf16x8 xa = __builtin_bit_cast(bf16x8, pk);
#pragma unroll
                    for (int ib = 0; ib < 2; ++ib) {
                        const u32x2 qlo = *(const LAS u32x2*)(lds + GL_QD + off_b(32 * ib + l31, 4 * db + 2 * s + 0) + 8 * h);
                        const u32x2 qhi = *(const LAS u32x2*)(lds + GL_QD + off_b(32 * ib + l31, 4 * db + 2 * s + 1) + 8 * h);
                        u32x4 qq; qq.x = qlo.x; qq.y = qlo.y; qq.z = qhi.x; qq.w = qhi.y;
                        oT[ib] = MFMA32(xa, __builtin_bit_cast(bf16x8, qq), oT[ib]);
                    }
                }
            __syncthreads();
            {
                const LAS unsigned char* vimg = lds + GL_V + (w >> 2) * GL_IMG;
#pragma unroll
                for (int ks = 0; ks < 4; ++ks) {
                    const s16x4 vlo = vtr(vimg + tr_addr(F.lane, w & 3, 16 * ks + 8 * h)), vhi = vtr(vimg + tr_addr(F.lane, w & 3, 16 * ks + 8 * h + 4));
                    const bf16x8 va = __builtin_shufflevector(vlo, vhi, 0, 1, 2, 3, 4, 5, 6, 7);
#pragma unroll
                    for (int ib = 0; ib < 2; ++ib) {
                        if (ib == 0 && ks >= 2) continue;
                        const int irow = 32 * ib + l31;
                        const bf16x8 pb = *(const LAS bf16x8*)(lds + GL_P + irow * GL_PST + 16 * (2 * ks + h));
                        oT[ib] = MFMA32(va, pb, oT[ib]);
                    }
                }
            }
            float ssq[2];
#pragma unroll
            for (int ib = 0; ib < 2; ++ib) { float s = 0.f;
#pragma unroll
                for (int r = 0; r < 16; ++r) s += oT[ib][r] * oT[ib][r];
                s += __shfl_xor(s, 32); ssq[ib] = s; }
            if (h == 0) { ((LAS float*)(lds + GL_RED))[w * 64 + l31] = ssq[0]; ((LAS float*)(lds + GL_RED))[w * 64 + 32 + l31] = ssq[1]; }
            __syncthreads();
#pragma unroll
            for (int ib = 0; ib < 2; ++ib) {
                float tot = 0.f;
#pragma unroll
                for (int ww = 0; ww < 8; ++ww) tot += ((LAS float*)(lds + GL_RED))[ww * 64 + 32 * ib + l31];
                const float rn = 1.0f / sqrtf(tot * (1.f / 256.f) + EPS);
                const int t = t0 + 32 * ib + l31;
#pragma unroll
                for (int g = 0; g < 4; ++g) {
                    const int e0 = 32 * w + 8 * g + 4 * h;
                    const u32x2 rg = *(const u32x2*)(QKV + (size_t)t * 3072 + 2048 + hd * 256 + e0);
                    const f32x4 ogv = *(const f32x4*)(og + e0);
                    const float r0 = bflo(rg.x), r1 = bfhi(rg.x), r2 = bflo(rg.y), r3 = bfhi(rg.y);
                    const float y0 = oT[ib][4 * g + 0] * rn * ogv.x * (r0 / (1.f + __expf(-r0)));
                    const float y1 = oT[ib][4 * g + 1] * rn * ogv.y * (r1 / (1.f + __expf(-r1)));
                    const float y2 = oT[ib][4 * g + 2] * rn * ogv.z * (r2 / (1.f + __expf(-r2)));
                    const float y3 = oT[ib][4 * g + 3] * rn * ogv.w * (r3 / (1.f + __expf(-r3)));
                    u32x2 o; o.x = cvtpk(y0, y1); o.y = cvtpk(y2, y3);
                    *(u32x2*)(MIX + (size_t)t * D + hd * 256 + e0) = o;
                }
            }
            if (c < 3) gla_state_update(F, St);
            __syncthreads();
        }
    }
}
constexpr int MB_LIST_H = 516096;
__device__ __forceinline__ int mb_list_off(int n) { return 256 * (63 * n - (n * (n - 1)) / 2); }
constexpr int MB_OST = 2 * 128 * 256, MB_OSTW = 32 * 264;
constexpr int MB_PRE = MB_OST + 8 * MB_OSTW, MB_END = MB_PRE + 2064;
static_assert(MB_END <= MISC_OFF, "moba lds");

__device__ __forceinline__ void moba_m1_tile(const Frame& F, int pm, int pn, bf16_t* __restrict__ QKV, const float* __restrict__ COS, const float* __restrict__ SIN,
                                             const float* __restrict__ qg, const float* __restrict__ kg, float* __restrict__ KMEAN) {
    LAS unsigned char* lds = F.lds;
    const int which = (pn >= 4), h0 = 2 * (pn & 3);
    const int ts = F.lane >> 4, hs = (F.lane >> 3) & 1, j = F.lane & 7;
    const float* g = which ? kg : qg;
    const float gsc = which ? 1.0f : (0.08838834764831845f * 1.4426950408889634f);
    float g1[8], g2[8], a1[8], a2[8];
#pragma unroll
    for (int e = 0; e < 8; ++e) { g1[e] = g[8 * j + e] * gsc; g2[e] = g[64 + 8 * j + e] * gsc; a1[e] = 0.f; a2[e] = 0.f; }
#pragma unroll 2
    for (int it = 0; it < 8; ++it) {
        const int t = pm * 256 + (it * 8 + F.wave) * 4 + ts;
        bf16_t* p = QKV + (size_t)t * 3072 + which * 1024 + (h0 + hs) * 128 + 8 * j;
        const u32x4 ra = *(const u32x4*)p, rb = *(const u32x4*)(p + 64);
        const f32x4 c0 = *(const f32x4*)(COS + (size_t)t * 64 + 8 * j), c1 = *(const f32x4*)(COS + (size_t)t * 64 + 8 * j + 4);
        const f32x4 s0 = *(const f32x4*)(SIN + (size_t)t * 64 + 8 * j), s1 = *(const f32x4*)(SIN + (size_t)t * 64 + 8 * j + 4);
        float x1[8] = {bflo(ra.x), bfhi(ra.x), bflo(ra.y), bfhi(ra.y), bflo(ra.z), bfhi(ra.z), bflo(ra.w), bfhi(ra.w)};
        float x2[8] = {bflo(rb.x), bfhi(rb.x), bflo(rb.y), bfhi(rb.y), bflo(rb.z), bfhi(rb.z), bflo(rb.w), bfhi(rb.w)};
        const float cs[8] = {c0.x, c0.y, c0.z, c0.w, c1.x, c1.y, c1.z, c1.w};
        const float sn[8] = {s0.x, s0.y, s0.z, s0.w, s1.x, s1.y, s1.z, s1.w};
        float ss = 0.f;
#pragma unroll
        for (int e = 0; e < 8; ++e) ss += x1[e] * x1[e] + x2[e] * x2[e];
        ss += __shfl_xor(ss, 1); ss += __shfl_xor(ss, 2); ss += __shfl_xor(ss, 4);
        const float r = 1.0f / sqrtf(ss * (1.f / 128.f) + EPS);
        float o1[8], o2[8];
#pragma unroll
        for (int e = 0; e < 8; ++e) { const float y1 = x1[e] * r * g1[e], y2 = x2[e] * r * g2[e]; o1[e] = y1 * cs[e] - y2 * sn[e]; o2[e] = y2 * cs[e] + y1 * sn[e]; a1[e] += o1[e]; a2[e] += o2[e]; }
        u32x4 wa, wb;
        wa.x = cvtpk(o1[0], o1[1]); wa.y = cvtpk(o1[2], o1[3]); wa.z = cvtpk(o1[4], o1[5]); wa.w = cvtpk(o1[6], o1[7]);
        wb.x = cvtpk(o2[0], o2[1]); wb.y = cvtpk(o2[2], o2[3]); wb.z = cvtpk(o2[4], o2[5]); wb.w = cvtpk(o2[6], o2[7]);
        *(u32x4*)p = wa; *(u32x4*)(p + 64) = wb;
    }
    if (which) {
#pragma unroll
        for (int e = 0; e < 8; ++e) { a1[e] += __shfl_xor(a1[e], 16); a1[e] += __shfl_xor(a1[e], 32); a2[e] += __shfl_xor(a2[e], 16); a2[e] += __shfl_xor(a2[e], 32); }
        LAS float* red = (LAS float*)lds;
        if (ts == 0) {
#pragma unroll
            for (int e = 0; e < 8; ++e) { red[(F.wave * 2 + hs) * 128 + 8 * j + e] = a1[e]; red[(F.wave * 2 + hs) * 128 + 64 + 8 * j + e] = a2[e]; } }
        __syncthreads();
        if (F.tid < 256) { const int hh = F.tid >> 7, d = F.tid & 127; float s = 0.f;
#pragma unroll
            for (int w = 0; w < 8; ++w) s += red[(w * 2 + hh) * 128 + d];
            KMEAN[((size_t)(h0 + hh) * 64 + pm) * 128 + d] = s * (1.f / 256.f); }
        __syncthreads();
    }
}
__device__ __forceinline__ void moba_m1_tail(const Frame& F0, int G, int c, bf16_t* __restrict__ QKV, const float* __restrict__ COS, const float* __restrict__ SIN,
                                             const float* __restrict__ qg, const float* __restrict__ kg, float* __restrict__ KMEAN) {
    const Frame F = opaque(F0);
    pg8::StaticOrder So; So.init(S, 3072, G, c);
#pragma unroll 1
    for (int i = 0; i < 3; ++i) {
        pg8::Unit u; if (!So.next(i, u)) break;
        if (u.pn < 8) moba_m1_tile(F, u.pm, u.pn, QKV, COS, SIN, qg, kg, KMEAN);
    }
}
#define MB_INS(v, i) do { const float v_ = (v); const int i_ = (i); \
    const bool b0_ = v_ > v0 || (v_ == v0 && i_ < i0), b1_ = v_ > v1 || (v_ == v1 && i_ < i1), b2_ = v_ > v2 || (v_ == v2 && i_ < i2); \
    if (b0_) { v2 = v1; i2 = i1; v1 = v0; i1 = i0; v0 = v_; i0 = i_; } else if (b1_) { v2 = v1; i2 = i1; v1 = v_; i1 = i_; } else if (b2_) { v2 = v_; i2 = i_; } } while (0)
__device__ __forceinline__ void moba_m2(const Frame& F0, const bf16_t* __restrict__ QKV, const float* __restrict__ KMEAN, unsigned* __restrict__ gcnt, int* __restrict__ LIST) {
    const Frame F = opaque(F0);
    LAS unsigned char* lds = F.lds;
    LAS int* cntl = (LAS int*)lds;
    LAS float* kml = (LAS float*)(lds + 1024);
    const int h2 = F.lane >> 5, l31 = F.lane & 31, w = F.wave;
    for (int u = F.vcu; u < 512; u += F.G) {
        const int b = u >> 3, h = u & 7;
        if (b == 0) continue;
        if (F.tid < 64) cntl[F.tid] = 0;
#pragma unroll
        for (int k = 0; k < 4; ++k) { const int idx = F.tid + 512 * k, nr = idx >> 5, c4 = (idx & 31) * 4;
            if (nr < b) { const f32x4 v = *(const f32x4*)(KMEAN + ((size_t)h * 64 + nr) * 128 + c4); *(LAS f32x4*)(kml + nr * 132 + c4) = v; } }
        __syncthreads();
        const int t = b * 256 + 32 * w + l31;
        bf16x8 qf[8];
#pragma unroll
        for (int s = 0; s < 8; ++s) qf[s] = *(const bf16x8*)(QKV + (size_t)t * 3072 + h * 128 + 16 * s + 8 * h2);
        float v0 = -INFINITY, v1 = -INFINITY, v2 = -INFINITY; int i0 = 64, i1 = 64, i2 = 64;
#pragma unroll
        for (int nb = 0; nb < 2; ++nb) {
            if (nb == 1 && b <= 32) continue;
            f32x16 acc;
#pragma unroll
            for (int r = 0; r < 16; ++r) acc[r] = 0.f;
            const LAS float* kmp = kml + (32 * nb + l31) * 132 + 8 * h2;
#pragma unroll
            for (int s = 0; s < 8; ++s) {
                const f32x4 ka = *(const LAS f32x4*)(kmp + 16 * s), kb = *(const LAS f32x4*)(kmp + 16 * s + 4);
                u32x4 hi; hi.x = cvtpk(ka.x, ka.y); hi.y = cvtpk(ka.z, ka.w); hi.z = cvtpk(kb.x, kb.y); hi.w = cvtpk(kb.z, kb.w);
                u32x4 lo; lo.x = cvtpk(ka.x - bflo(hi.x), ka.y - bfhi(hi.x)); lo.y = cvtpk(ka.z - bflo(hi.y), ka.w - bfhi(hi.y));
                lo.z = cvtpk(kb.x - bflo(hi.z), kb.y - bfhi(hi.z)); lo.w = cvtpk(kb.z - bflo(hi.w), kb.w - bfhi(hi.w));
                acc = MFMA32(__builtin_bit_cast(bf16x8, hi), qf[s], acc);
                acc = MFMA32(__builtin_bit_cast(bf16x8, lo), qf[s], acc);
            }
#pragma unroll
            for (int r = 0; r < 16; ++r) { const int n = 32 * nb + crow(r, h2); const float gv = (n < b) ? acc[r] : -INFINITY; MB_INS(gv, n); }
        }
        { const float p0 = __shfl_xor(v0, 32), p1 = __shfl_xor(v1, 32), p2 = __shfl_xor(v2, 32); const int q0 = __shfl_xor(i0, 32), q1 = __shfl_xor(i1, 32), q2 = __shfl_xor(i2, 32);
          MB_INS(p0, q0); MB_INS(p1, q1); MB_INS(p2, q2); }
        int pos0 = 0, pos1 = 0, pos2 = 0;
        const bool e0 = (h2 == 0) && (v0 > -INFINITY), e1 = (h2 == 0) && (v1 > -INFINITY), e2 = (h2 == 0) && (v2 > -INFINITY);
        if (e0) pos0 = __hip_atomic_fetch_add(cntl + i0, 1, __ATOMIC_RELAXED, __HIP_MEMORY_SCOPE_WORKGROUP);
        if (e1) pos1 = __hip_atomic_fetch_add(cntl + i1, 1, __ATOMIC_RELAXED, __HIP_MEMORY_SCOPE_WORKGROUP);
        if (e2) pos2 = __hip_atomic_fetch_add(cntl + i2, 1, __ATOMIC_RELAXED, __HIP_MEMORY_SCOPE_WORKGROUP);
        __syncthreads();
        if (F.tid < 64) { const int c = cntl[F.tid]; int base = 0; if (c > 0) base = (int)__hip_atomic_fetch_add(gcnt + h * 64 + F.tid, (unsigned)c, __ATOMIC_RELAXED, __HIP_MEMORY_SCOPE_AGENT); cntl[64 + F.tid] = base; }
        __syncthreads();
        int* lst = LIST + (size_t)h * MB_LIST_H;
        if (e0) lst[mb_list_off(i0) + cntl[64 + i0] + pos0] = (t << 2) | 0;
        if (e1) lst[mb_list_off(i1) + cntl[64 + i1] + pos1] = (t << 2) | 1;
        if (e2) lst[mb_list_off(i2) + cntl[64 + i2] + pos2] = (t << 2) | 2;
        __syncthreads();
    }
}
constexpr int MB_HALF = 128 * 256;
__device__ __forceinline__ unsigned off_x(unsigned row, unsigned ch) { return 256u * row + 16u * (ch ^ (((row & 3) << 2) | ((row >> 2) & 3))); }
__device__ __forceinline__ void mb_decode(int v, const LAS int* pre, const unsigned* __restrict__ gcnt, int& h, int& n, int& count, int& lbase, bool& own) {
    if (v < 512) { n = v >> 3; h = v & 7; count = 256; lbase = 0; own = true; return; }
    const int x = v - 512; int lo_ = 0, hi_ = 511;
    while (lo_ < hi_) { const int mid = (lo_ + hi_) >> 1; if (pre[mid] > x) hi_ = mid; else lo_ = mid + 1; }
    const int hn = lo_; h = hn >> 6; n = hn & 63;
    const int tile = x - (hn ? pre[hn - 1] : 0);
    count = (int)gcnt[hn] - tile * 256; if (count > 256) count = 256;
    lbase = h * MB_LIST_H + mb_list_off(n) + tile * 256; own = false;
}
#define MB_STAGE(hh_, nn_, hf_, buf_) do { _Pragma("unroll") for (int k_ = 0; k_ < 4; ++k_) { const int pc_ = w * 4 + k_;               \
        const int r_ = 4 * pc_ + (F.lane >> 4); const int ch_ = (F.lane & 15) ^ (((r_ & 3) << 2) | ((r_ >> 2) & 3)); \
        const bf16_t* src_ = QKV + (size_t)((nn_) * 256 + (hf_) * 128 + r_) * 3072 + 1024 + (hh_) * 128 + 8 * ch_; \
        __builtin_amdgcn_global_load_lds((const unsigned*)src_, (LAS unsigned*)(lds + (buf_) * 2 * MB_HALF + pc_ * 1024), 16, 0, 0); \
        __builtin_amdgcn_global_load_lds((const unsigned*)(src_ + 1024), (LAS unsigned*)(lds + (buf_) * 2 * MB_HALF + MB_HALF + pc_ * 1024), 16, 0, 0); } } while (0)
#define MB_VMWAIT() asm volatile("s_waitcnt vmcnt(0)" ::: "memory")
#define MB_ENT(entv_, own_, nn_, cnt_, lb_) do { const int qi_ = 32 * w + l31; \
        if (own_) entv_ = (((nn_) * 256 + qi_) << 2) | 3; else entv_ = (qi_ < (cnt_)) ? LIST[(lb_) + qi_] : -1; } while (0)
#define MB_GATHER(entv_, qv_, nn_, hh_) do { \
        const int tq_ = (entv_ >= 0) ? (entv_ >> 2) : ((nn_) * 256); \
        _Pragma("unroll") for (int s_ = 0; s_ < 8; ++s_) qv_[s_] = *(const bf16x8*)(QKV + (size_t)tq_ * 3072 + (hh_) * 128 + 16 * s_ + 8 * h2); } while (0)
#define MB_COMPUTE(buf_, hf_, nkt_, own_) do { \
        const LAS unsigned char* kb_ = lds + (buf_) * 2 * MB_HALF + 256 * l31; \
        const LAS unsigned char* vb_ = lds + (buf_) * 2 * MB_HALF + MB_HALF + 256 * (4 * h2 + vq) + 8 * (vp & 1); \
        _Pragma("unroll 1") for (int kt_ = 0; kt_ < (nkt_); ++kt_) { \
            bf16x8 ka_[4]; \
            _Pragma("unroll") for (int s_ = 0; s_ < 4; ++s_) ka_[s_] = *(const LAS bf16x8*)(kb_ + kt_ * (32 * 256) + 16 * ((2 * s_ + h2) ^ fK)); \
            f32x16 acc_; _Pragma("unroll") for (int r_ = 0; r_ < 16; ++r_) acc_[r_] = 0.f; \
            _Pragma("unroll") for (int s_ = 0; s_ < 4; ++s_) acc_ = MFMA32(ka_[s_], qf[s_], acc_); \
            _Pragma("unroll") for (int s_ = 0; s_ < 4; ++s_) ka_[s_] = *(const LAS bf16x8*)(kb_ + kt_ * (32 * 256) + 16 * ((2 * (s_ + 4) + h2) ^ fK)); \
            _Pragma("unroll") for (int s_ = 0; s_ < 4; ++s_) acc_ = MFMA32(ka_[s_], qf[s_ + 4], acc_); \
            s16x4 vl0_[4], vh0_[4]; \
            _Pragma("unroll") for (int db_ = 0; db_ < 4; ++db_) { const LAS unsigned char* vp_ = vb_ + (kt_ * 32) * 256 + 64 * (db_ ^ vq); \
                vl0_[db_] = vtr(vp_ + 16 * (vj ^ h2)); vh0_[db_] = vtr(vp_ + 8 * 256 + 16 * (vj ^ (2 + h2))); } \
            float pr_[16]; \
            _Pragma("unroll") for (int r_ = 0; r_ < 16; ++r_) { float p_ = __builtin_amdgcn_exp2f(acc_[r_]); if ((own_) && (128 * (hf_) + 32 * kt_ + crow(r_, h2) > 32 * w + l31)) p_ = 0.f; pr_[r_] = p_; lsum += p_; } \
            { u32x4 pk_; pk_.x = cvtpk(pr_[0], pr_[1]); pk_.y = cvtpk(pr_[2], pr_[3]); pk_.z = cvtpk(pr_[4], pr_[5]); pk_.w = cvtpk(pr_[6], pr_[7]); \
              const bf16x8 pb_ = __builtin_bit_cast(bf16x8, pk_); \
              _Pragma("unroll") for (int db_ = 0; db_ < 4; ++db_) O[db_] = MFMA32(__builtin_shufflevector(vl0_[db_], vh0_[db_], 0, 1, 2, 3, 4, 5, 6, 7), pb_, O[db_]); } \
            _Pragma("unroll") for (int db_ = 0; db_ < 4; ++db_) { const LAS unsigned char* vp_ = vb_ + (kt_ * 32 + 16) * 256 + 64 * (db_ ^ vq); \
                vl0_[db_] = vtr(vp_ + 16 * (vj ^ h2)); vh0_[db_] = vtr(vp_ + 8 * 256 + 16 * (vj ^ (2 + h2))); } \
            { u32x4 pk_; pk_.x = cvtpk(pr_[8], pr_[9]); pk_.y = cvtpk(pr_[10], pr_[11]); pk_.z = cvtpk(pr_[12], pr_[13]); pk_.w = cvtpk(pr_[14], pr_[15]); \
              const bf16x8 pb_ = __builtin_bit_cast(bf16x8, pk_); \
              _Pragma("unroll") for (int db_ = 0; db_ < 4; ++db_) O[db_] = MFMA32(__builtin_shufflevector(vl0_[db_], vh0_[db_], 0, 1, 2, 3, 4, 5, 6, 7), pb_, O[db_]); } } } while (0)
template <int MODE  >
__device__ __forceinline__ void moba_m3(const Frame& F0, const bf16_t* __restrict__ QKV, const unsigned* __restrict__ gcnt, const int* __restrict__ LIST,
                                        bf16_t* __restrict__ OPART01, bf16_t* __restrict__ OPART2, bf16_t* __restrict__ MIX, float* __restrict__ LPART) {
    const Frame F = opaque(F0);
    LAS unsigned char* lds = F.lds;
    LAS int* pre = (LAS int*)(lds + MB_PRE);
    const int h2 = F.lane >> 5, l31 = F.lane & 31, w = F.wave;
    const int fK = ((l31 & 3) << 2) | ((l31 >> 2) & 3);
    const int vq = (F.lane & 15) >> 2, vp = F.lane & 3, vj = 2 * ((F.lane >> 4) & 1) + (vp >> 1);
    { int v = ((int)gcnt[F.tid] + 255) >> 8; pre[F.tid] = v; __syncthreads();
#pragma unroll 1
      for (int o = 1; o < 512; o <<= 1) { const int add = (F.tid >= o) ? pre[F.tid - o] : 0; __syncthreads(); pre[F.tid] += add; __syncthreads(); } }
    const int total = 512 + pre[511];
    const int u_lo = MODE ? 0 : 512, u_hi = MODE ? 512 : total;
    const int n_units = (u_hi - u_lo - F.vcu + F.G - 1) / F.G;
    if (n_units <= 0) return;
#define MB_UNIT_V(it_) (u_lo + F.vcu + (it_) * F.G)
    int h, n, count, lbase; bool own;
    mb_decode(MB_UNIT_V(0), pre, gcnt, h, n, count, lbase, own);
    int ent; bf16x8 qf[8];
    MB_ENT(ent, own, n, count, lbase);
    MB_GATHER(ent, qf, n, h);
    MB_STAGE(h, n, 0, 0);
    MB_VMWAIT();
    __syncthreads();
#pragma unroll 1
    for (int it = 0; it < n_units; ++it) {
        f32x16 O[4];
#pragma unroll
        for (int db = 0; db < 4; ++db)
#pragma unroll
            for (int r = 0; r < 16; ++r) O[db][r] = 0.f;
        float lsum = 0.f;
        MB_STAGE(h, n, 1, 1);
        { const int nkt = own ? ((w + 1 < 4) ? (w + 1) : 4) : 4; MB_COMPUTE(0, 0, nkt, own); }
        const bool more = (it + 1 < n_units);
        int h_n = h, n_n = n, count_n = count, lbase_n = lbase; bool own_n = own;
        int ent_n = -1;
        if (more) { mb_decode(MB_UNIT_V(it + 1), pre, gcnt, h_n, n_n, count_n, lbase_n, own_n); MB_ENT(ent_n, own_n, n_n, count_n, lbase_n); }
        MB_VMWAIT();
        __syncthreads();
        if (more) MB_STAGE(h_n, n_n, 0, 0);
        { const int nkt = own ? ((w >= 4) ? (w - 3) : 0) : 4; MB_COMPUTE(1, 1, nkt, own); }
        const int ent_c = ent, h_c = h;
        if (more) MB_GATHER(ent_n, qf, n_n, h_n);
        lsum += __shfl_xor(lsum, 32);
        if (MODE == 0) { if (ent_c >= 0 && h2 == 0) LPART[((size_t)(ent_c & 3) * S + (ent_c >> 2)) * 8 + h_c] = lsum; }
        float linv = 0.f;
        if (MODE == 1) {
            const int tq = ent_c >> 2, nsel = (tq >> 8) < 3 ? (tq >> 8) : 3; float lt = lsum;
#pragma unroll
            for (int sl = 0; sl < 3; ++sl) if (sl < nsel) lt += LPART[((size_t)sl * S + tq) * 8 + h_c];
            linv = 1.f / lt;
        }
        __syncthreads();
        {
            LAS unsigned char* ost = lds + MB_OST + w * MB_OSTW;
#pragma unroll
            for (int db = 0; db < 4; ++db)
#pragma unroll
                for (int g = 0; g < 4; ++g) { u32x2 o; o.x = cvtpk(O[db][4 * g + 0], O[db][4 * g + 1]); o.y = cvtpk(O[db][4 * g + 2], O[db][4 * g + 3]);
                    *(LAS u32x2*)(ost + l31 * 264 + 2 * (32 * db + 8 * g + 4 * h2)) = o; }
            asm volatile("s_waitcnt lgkmcnt(0)" ::: "memory");
#pragma unroll
            for (int i = 0; i < 8; ++i) {
                const int row = 4 * i + (F.lane >> 4), ch = F.lane & 15;
                const int er = __shfl(ent_c, row);
                const u32x4 v = *(const LAS u32x4*)(ost + row * 264 + 16 * ch);
                if (MODE == 0) {
                    if (er >= 0) { const int sl = er & 3, tq = er >> 2;
                        bf16_t* dst = ((sl == 2) ? (OPART2 + (size_t)tq * D) : (OPART01 + ((size_t)sl * S + tq) * D)) + h_c * 128 + 8 * ch;
                        *(u32x4*)dst = v; }
                } else {
                    const float li = __shfl(linv, row);
                    const int tq = er >> 2, nsel = (tq >> 8) < 3 ? (tq >> 8) : 3;
                    float o[8] = {bflo(v.x), bfhi(v.x), bflo(v.y), bfhi(v.y), bflo(v.z), bfhi(v.z), bflo(v.w), bfhi(v.w)};
#pragma unroll
                    for (int sl = 0; sl < 3; ++sl) if (sl < nsel) {
                        const u32x4 p = *(const u32x4*)(((sl == 2) ? (OPART2 + (size_t)tq * D) : (OPART01 + ((size_t)sl * S + tq) * D)) + h_c * 128 + 8 * ch);
                        o[0] += bflo(p.x); o[1] += bfhi(p.x); o[2] += bflo(p.y); o[3] += bfhi(p.y); o[4] += bflo(p.z); o[5] += bfhi(p.z); o[6] += bflo(p.w); o[7] += bfhi(p.w); }
                    u32x4 r; r.x = cvtpk(o[0] * li, o[1] * li); r.y = cvtpk(o[2] * li, o[3] * li); r.z = cvtpk(o[4] * li, o[5] * li); r.w = cvtpk(o[6] * li, o[7] * li);
                    *(u32x4*)(MIX + (size_t)tq * D + h_c * 128 + 8 * ch) = r;
                }
            }
        }
        if (more) { h = h_n; n = n_n; count = count_n; lbase = lbase_n; own = own_n; ent = ent_n; }
        MB_VMWAIT();
        __syncthreads();
    }
#undef MB_UNIT_V
}
__device__ __forceinline__ float wave_max(float v) {
#pragma unroll
    for (int o = 1; o < 64; o <<= 1) v = fmaxf(v, __shfl_xor(v, o));
    return v;
}
__device__ __forceinline__ float logsigmoid_f(float x) { return fminf(x, 0.f) - log1pf(expf(-fabsf(x))); }
__global__ void nk_gla_gate(const float* __restrict__ glr, const float* __restrict__ wup, const float* __restrict__ bg, float* __restrict__ g) {
    const size_t idx = (size_t)blockIdx.x * blockDim.x + threadIdx.x;
    const int t = (int)(idx >> 9), j = (int)(idx & 511);
    float acc = bg[j];
#pragma unroll
    for (int r = 0; r < 16; ++r) acc += glr[(size_t)t * 16 + r] * wup[r * 512 + j];
    g[idx] = logsigmoid_f(acc) * (1.f / 16.f);
}
__global__ __launch_bounds__(256) void nk_gla_recur(const bf16_t* __restrict__ qkv, const float* __restrict__ g, float* __restrict__ o) {
    __shared__ float sq[16][128], sk[16][128], sa[16][128];
    const int h = blockIdx.x, tid = threadIdx.x;
    float St[128];
#pragma unroll
    for (int d = 0; d < 128; ++d) St[d] = 0.f;
    const float qs = 0.08838834764831845f;
    for (int t0 = 0; t0 < S; t0 += 16) {
        float vv[16];
#pragma unroll
        for (int tt = 0; tt < 16; ++tt) vv[tt] = bf2f(qkv[(size_t)(t0 + tt) * 3072 + 1024 + h * 256 + tid]);
#pragma unroll
        for (int i = 0; i < 8; ++i) {
            const int e = tid + i * 256, tok = e >> 7, d = e & 127;
            const bf16_t* row = qkv + (size_t)(t0 + tok) * 3072;
            sq[tok][d] = bf2f(row[h * 128 + d]) * qs;
            sk[tok][d] = bf2f(row[512 + h * 128 + d]);
            sa[tok][d] = expf(g[(size_t)(t0 + tok) * 512 + h * 128 + d]);
        }
        __syncthreads();
#pragma unroll 1
        for (int tt = 0; tt < 16; ++tt) {
            const float v = vv[0];
#pragma unroll
            for (int i = 0; i < 15; ++i) vv[i] = vv[i + 1];
            float acc = 0.f;
#pragma unroll
            for (int d = 0; d < 128; ++d) { St[d] = sa[tt][d] * St[d] + sk[tt][d] * v; acc += sq[tt][d] * St[d]; }
            o[(size_t)(t0 + tt) * D + h * 256 + tid] = acc;
        }
        __syncthreads();
    }
}
__global__ __launch_bounds__(256) void nk_gla_post(const float* __restrict__ o, const bf16_t* __restrict__ qkv, const float* __restrict__ og, bf16_t* __restrict__ mix) {
    const int w = blockIdx.x * 4 + (threadIdx.x >> 6), lane = threadIdx.x & 63;
    const int t = w >> 2, h = w & 3;
    f32x4 v = *(const f32x4*)(o + (size_t)t * D + h * 256 + lane * 4);
    const float ss = wave_sum(v.x * v.x + v.y * v.y + v.z * v.z + v.w * v.w);
    const float r = 1.0f / sqrtf(ss * (1.f / 256.f) + EPS);
    const f32x4 gg = *(const f32x4*)(og + lane * 4);
    const bf16_t* rp = qkv + (size_t)t * 3072 + 2048 + h * 256 + lane * 4;
    bf16_t* mp = mix + (size_t)t * D + h * 256 + lane * 4;
#pragma unroll
    for (int e = 0; e < 4; ++e) { const float rr = bf2f(rp[e]); const float y = v[e] * r * gg[e] * (rr / (1.f + expf(-rr))); mp[e] = (bf16_t)(cvtpk(y, 0.f) & 0xffffu); }
}
__global__ __launch_bounds__(256) void nk_moba_qk(bf16_t* __restrict__ qkv, const int* __restrict__ pos, const float* __restrict__ qg, const float* __restrict__ kg) {
    const int w = blockIdx.x * 4 + (threadIdx.x >> 6), lane = threadIdx.x & 63;
    const int t = w >> 4, which = (w >> 3) & 1, h = w & 7;
    bf16_t* p = qkv + (size_t)t * 3072 + which * 1024 + h * 128;
    const float* g = which ? kg : qg;
    float t1 = bf2f(p[lane]), t2 = bf2f(p[lane + 64]);
    const float ss = wave_sum(t1 * t1 + t2 * t2);
    const float r = 1.0f / sqrtf(ss * (1.f / 128.f) + EPS);
    t1 = t1 * r * g[lane]; t2 = t2 * r * g[lane + 64];
    const float inv_freq = (float)exp2(-(double)lane * (13.287712379549449 / 64.0));
    const float angf = (float)pos[t] * inv_freq;
    float cs, sn; sincos_acc((double)angf, sn, cs);
    p[lane] = (bf16_t)(cvtpk(t1 * cs - t2 * sn, 0.f) & 0xffffu);
    p[lane + 64] = (bf16_t)(cvtpk(t2 * cs + t1 * sn, 0.f) & 0xffffu);
}
__global__ __launch_bounds__(128) void nk_moba_kmean(const bf16_t* __restrict__ qkv, float* __restrict__ kmean) {
    const int h = blockIdx.x >> 6, n = blockIdx.x & 63, d = threadIdx.x;
    float acc = 0.f;
    for (int j = 0; j < 256; ++j) acc += bf2f(qkv[(size_t)(n * 256 + j) * 3072 + 1024 + h * 128 + d]);
    kmean[(size_t)blockIdx.x * 128 + d] = acc * (1.f / 256.f);
}
__global__ __launch_bounds__(64) void nk_moba_attn(const bf16_t* __restrict__ qkv, const float* __restrict__ kmean, bf16_t* __restrict__ out) {
    __shared__ float sq[128];
    __shared__ float sp[1024];
    __shared__ int skey[1024];
    const int t = blockIdx.x >> 3, h = blockIdx.x & 7, lane = threadIdx.x;
    const bf16_t* qp = qkv + (size_t)t * 3072 + h * 128;
    sq[lane] = bf2f(qp[lane]); sq[lane + 64] = bf2f(qp[lane + 64]);
    __syncthreads();
    const int own = t >> 8;
    float gate = -INFINITY;
    if (lane < own) {
        const float* km = kmean + ((size_t)h * 64 + lane) * 128;
        float a = 0.f;
        for (int d = 0; d < 128; ++d) a += sq[d] * km[d];
        gate = a;
    }
    int s0 = -1, s1 = -1, s2 = -1;
#pragma unroll
    for (int j = 0; j < 3; ++j) {
        const float m = wave_max(gate);
        int idx = -1;
        if (m > -INFINITY) { const unsigned long long b = __ballot(gate == m); idx = __ffsll((long long)b) - 1; }
        if (j == 0) s0 = idx; else if (j == 1) s1 = idx; else s2 = idx;
        if (lane == idx) gate = -INFINITY;
    }
    int nk = 0;
    if (s0 >= 0) { for (int i = lane; i < 256; i += 64) skey[nk + i] = s0 * 256 + i; nk += 256; }
    if (s1 >= 0) { for (int i = lane; i < 256; i += 64) skey[nk + i] = s1 * 256 + i; nk += 256; }
    if (s2 >= 0) { for (int i = lane; i < 256; i += 64) skey[nk + i] = s2 * 256 + i; nk += 256; }
    const int nown = t - own * 256 + 1;
    for (int i = lane; i < nown; i += 64) skey[nk + i] = own * 256 + i;
    nk += nown;
    __syncthreads();
    const float scale = 0.08838834764831845f;
    float mx = -INFINITY;
    for (int i = lane; i < nk; i += 64) {
        const bf16_t* kp = qkv + (size_t)skey[i] * 3072 + 1024 + h * 128;
        float a = 0.f;
        for (int d = 0; d < 128; d += 8) { const u32x4 kk = *(const u32x4*)(kp + d);
            a += sq[d] * bflo(kk.x) + sq[d + 1] * bfhi(kk.x) + sq[d + 2] * bflo(kk.y) + sq[d + 3] * bfhi(kk.y) + sq[d + 4] * bflo(kk.z) + sq[d + 5] * bfhi(kk.z) + sq[d + 6] * bflo(kk.w) + sq[d + 7] * bfhi(kk.w); }
        a *= scale; sp[i] = a; mx = fmaxf(mx, a);
    }
    mx = wave_max(mx);
    float sum = 0.f;
    for (int i = lane; i < nk; i += 64) { const float p = expf(sp[i] - mx); sp[i] = p; sum += p; }
    sum = wave_sum(sum);
    __syncthreads();
    float o0 = 0.f, o1 = 0.f;
    for (int i = 0; i < nk; ++i) {
        const bf16_t* vp = qkv + (size_t)skey[i] * 3072 + 2048 + h * 128;
        const float p = sp[i];
        o0 += p * bf2f(vp[lane]); o1 += p * bf2f(vp[lane + 64]);
    }
    const float inv = 1.f / sum;
    out[(size_t)t * D + h * 128 + lane] = (bf16_t)(cvtpk(o0 * inv, 0.f) & 0xffffu);
    out[(size_t)t * D + h * 128 + lane + 64] = (bf16_t)(cvtpk(o1 * inv, 0.f) & 0xffffu);
}
constexpr int PH_PER_LAYER = 10, PH_L0 = 2, N_PHASES = PH_L0 + DEPTH * PH_PER_LAYER;
__global__ void __launch_bounds__(NTHR, 2) mega(MegaArgs args) {
    extern __shared__ __attribute__((aligned(16))) unsigned char lds_raw[];
    Frame F;
    F.lds = (LAS unsigned char*)lds_raw;
    F.tid = threadIdx.x; F.lane = F.tid & 63; F.wave = __builtin_amdgcn_readfirstlane(F.tid >> 6);
    F.G = gridDim.x; { const int bx = blockIdx.x; F.vcu = (F.G % 8 == 0) ? (bx % 8) * (F.G / 8) + bx / 8 : bx; }
    volatile LAS unsigned* MISC = (volatile LAS unsigned*)(F.lds + MISC_OFF);
    unsigned char* ws = args.ws;
    unsigned* ctl = (unsigned*)(ws + WS_CTL);
    for (int u = F.tid; u < (LDS_BYTES - MISC_OFF) / 4; u += NTHR) ((LAS unsigned*)(F.lds + MISC_OFF))[u] = 0u;
    __syncthreads();
    XcdBarrier bar = xcd_barrier_post(ctl + CW_BAR, MISC + 8);
    const int lo = args.ph_lo, hi = args.ph_hi;
#define IN(k) (lo <= (k) && (k) < hi)
#define SEAM(k) do { if (lo <= (k) && (k) + 1 < hi) xcd_barrier(bar); } while (0)
    const float* mod = (const float*)(ws + WS_MOD);
    bf16_t* H = (bf16_t*)(ws + WS_H); bf16_t* MIX = (bf16_t*)(ws + WS_MIX); bf16_t* QKV = (bf16_t*)(ws + WS_QKV); bf16_t* HID = (bf16_t*)(ws + WS_HID);
    float* xout = args.out;
    bf16_t* XB = (bf16_t*)(ws + WS_XB);

    if (IN(0)) { p0_prologue(F, args); }
    if (lo < 0) cg::this_grid().sync();
    if (lo <= 0 && 1 < hi) xcd_barrier(bar);
    if (IN(1)) { norm_phase(F, args.in[0], args.in[5], mod + D, mod, H); }
    SEAM(1);
#pragma unroll 1
    for (int L = 0; L < DEPTH; ++L) {
        const int pb = PH_L0 + L * PH_PER_LAYER, j = L >> 1;
        const float* m = mod + (size_t)L * 6 * D;
        if (pb + PH_PER_LAYER <= lo || pb >= hi) continue;
        if ((L & 1) == 0) {
            if (IN(pb + 0)) {
                pg8::Gemm g{H, (const bf16_t*)(ws + WS_WGIN) + (size_t)j * 3072 * D, S, 3072, D}; pg8::StaticOrder So; So.init(S, 3072, F.G, (int)blockIdx.x);
                pg8::EpiBf16<0> E{QKV, 3072};
                pg8::gemm_phase<pg8::EpiBf16<0>, pg8::StaticOrder, true, true>(F.lds, g, So, E);
                glr_phase(F, H, (const bf16_t*)(ws + WS_WGLR) + (size_t)j * 16 * D, (float*)(ws + WS_GLR));
            }
            SEAM(pb + 0);
        } else {
            if (IN(pb + 0)) {
                pg8::Gemm g{H, (const bf16_t*)(ws + WS_WMIN) + (size_t)j * 3072 * D, S, 3072, D}; pg8::StaticOrder So; So.init(S, 3072, F.G, (int)blockIdx.x);
                pg8::EpiBf16<0> E{QKV, 3072};
                pg8::gemm_phase<pg8::EpiBf16<0>, pg8::StaticOrder, true, true>(F.lds, g, So, E);
                asm volatile("s_waitcnt vmcnt(0)" ::: "memory"); __syncthreads();
                moba_m1_tail(F, F.G, (int)blockIdx.x, QKV, (const float*)(args.ws + WS_COS), (const float*)(args.ws + WS_SIN), args.in[13] + (size_t)j * 128, args.in[14] + (size_t)j * 128, (float*)(args.ws + WS_KMEAN));
            }
            SEAM(pb + 0);
        }
        if ((L & 1) == 0) {
            unsigned char* ws = args.ws; asm volatile("" : "+s"(ws));
            const float* wupg = args.in[8] + (size_t)j * 16 * 512; const float* bgg = args.in[9] + (size_t)j * 512;
            if (IN(pb + 1)) gla_g1(F, QKV, (const float*)(ws + WS_GLR), wupg, bgg, (float*)(ws + WS_SBUF), (float*)(ws + WS_DG));
            SEAM(pb + 1);
            if (IN(pb + 2)) gla_g2(F, (float*)(ws + WS_SBUF), (const float*)(ws + WS_DG));
            SEAM(pb + 2);
            if (IN(pb + 3)) gla_g3(F, QKV, (const float*)(ws + WS_GLR), wupg, bgg, (const float*)(ws + WS_SBUF), args.in[10] + (size_t)j * 256, MIX);
            if (lo <= pb + 3 && pb + 5 < hi) xcd_barrier(bar);
        } else {
            unsigned char* ws = args.ws; asm volatile("" : "+s"(ws));
            unsigned* gcnt = (unsigned*)(ws + WS_CTL) + CW_MCNT + j * 512;
            if (IN(pb + 2)) moba_m2(F, QKV, (const float*)(ws + WS_KMEAN), gcnt, (int*)(ws + WS_LIST));
            SEAM(pb + 2);
            if (IN(pb + 3)) moba_m3<0>(F, QKV, gcnt, (const int*)(ws + WS_LIST), (bf16_t*)xout, (bf16_t*)(ws + WS_AUX), MIX, (float*)(ws + WS_LPART));
            SEAM(pb + 3);
            if (IN(pb + 4)) moba_m3<1>(F, QKV, gcnt, (const int*)(ws + WS_LIST), (bf16_t*)xout, (bf16_t*)(ws + WS_AUX), MIX, (float*)(ws + WS_LPART));
            SEAM(pb + 4);
        }
        if (IN(pb + 5)) {
            const bf16_t* wo = ((L & 1) == 0) ? (const bf16_t*)(ws + WS_WGOUT) + (size_t)j * D * D : (const bf16_t*)(ws + WS_WMOUT) + (size_t)j * D * D;
            pg8::Gemm g{MIX, wo, S, D, D}; pg8::StaticOrder So; So.init(S, D, F.G, (int)blockIdx.x);
            if (L == 0) {
                pg8::EpiResidNorm<true> E{args.in[0], XB, D, m + 2 * D, args.in[6] + (size_t)L * D, m + 4 * D, m + 3 * D, H, (float*)(ws + WS_XBUF), ctl + CW_SEAM + (2 * L) * SEAM_BANK, ctl + CW_TMO, EPS};
                pg8::gemm_phase<pg8::EpiResidNorm<true>, pg8::StaticOrder, false, true>(F.lds, g, So, E);
            } else {
                pg8::EpiResidNorm<false> E{XB, XB, D, m + 2 * D, args.in[6] + (size_t)L * D, m + 4 * D, m + 3 * D, H, (float*)(ws + WS_XBUF), ctl + CW_SEAM + (2 * L) * SEAM_BANK, ctl + CW_TMO, EPS};
                pg8::gemm_phase<pg8::EpiResidNorm<false>, pg8::StaticOrder, false, true>(F.lds, g, So, E);
            }
        }
        SEAM(pb + 5);
        if (IN(pb + 7)) {
            pg8::Gemm g{H, (const bf16_t*)(ws + WS_W1) + (size_t)L * DFF * D, S, DFF, D}; pg8::StaticOrder So; So.init(S, DFF, F.G, (int)blockIdx.x);
            pg8::EpiBf16<1> E{HID, DFF};
            pg8::gemm_phase<pg8::EpiBf16<1>, pg8::StaticOrder, true, true>(F.lds, g, So, E);
        }
        SEAM(pb + 7);
        if (IN(pb + 8)) {
            pg8::Gemm g{HID, (const bf16_t*)(ws + WS_W2) + (size_t)L * D * DFF, S, D, DFF}; pg8::StaticOrder So; So.init(S, D, F.G, (int)blockIdx.x);
            pg8::EpiResid E{XB, xout, D, m + 5 * D};
            if (L + 1 < DEPTH) {
                const float* mn = mod + (size_t)(L + 1) * 6 * D;
                pg8::EpiResidNorm<false> EN{XB, XB, D, m + 5 * D, args.in[5] + (size_t)(L + 1) * D, mn + D, mn, H, (float*)(ws + WS_XBUF), ctl + CW_SEAM + (2 * L + 1) * SEAM_BANK, ctl + CW_TMO, EPS};
                pg8::gemm_phase<pg8::EpiResidNorm<false>, pg8::StaticOrder, false, true>(F.lds, g, So, EN);
            } else
            pg8::gemm_phase<pg8::EpiResid, pg8::StaticOrder, false, true>(F.lds, g, So, E);
        }
        if (L + 1 < DEPTH) SEAM(pb + 8);
    }
#undef IN
#undef SEAM
}
static int g_grid = 0;
static void launch_mega(MegaArgs a, int lo, int hi, hipStream_t stream) {
    a.ph_lo = lo; a.ph_hi = hi;
    (void)hipMemsetAsync((char*)a.ws + WS_CTL + CW_BAR * 4, 0, XCD_BAR_WORDS * 4, stream);
    void* params[] = {&a};
    hipError_t e = hipLaunchCooperativeKernel((const void*)mega, dim3(g_grid), dim3(NTHR), params, LDS_BYTES, stream);
    if (e != hipSuccess) fprintf(stderr, "cooperative launch failed: %s (grid %d)\n", hipGetErrorString(e), g_grid);
}
extern "C" void kernel_launch(void* const* d_in, const int* in_sizes, int n_in, void* d_out, int out_size, void* d_ws, size_t ws_size, hipStream_t stream) {
    if (g_grid == 0) {
        int dev = 0, cus = 0, per_cu = 0;
        (void)hipGetDevice(&dev);
        (void)hipDeviceGetAttribute(&cus, hipDeviceAttributeMultiprocessorCount, dev);
        (void)hipFuncSetAttribute((const void*)mega, hipFuncAttributeMaxDynamicSharedMemorySize, LDS_BYTES);
        (void)hipOccupancyMaxActiveBlocksPerMultiprocessor(&per_cu, (const void*)mega, NTHR, LDS_BYTES);
        if (per_cu < 1) { fprintf(stderr, "occupancy query says %d blocks/CU\n", per_cu); per_cu = 1; }
        g_grid = cus;
        if (ws_size < WS_END || n_in != 18) { fprintf(stderr, "bad ws_size %zu / n_in %d\n", ws_size, n_in); g_grid = -1; }
    }
    if (g_grid < 0) return;
    (void)hipMemsetAsync((char*)d_ws + WS_CTL, 0, CTL_ZERO_BYTES, stream);
    MegaArgs a{};
    for (int i = 0; i < 18; ++i) a.in[i] = (const float*)d_in[i];
    a.out = (float*)d_out; a.ws = (unsigned char*)d_ws;
    launch_mega(a, 0, N_PHASES, stream);
}
```

```cpp
#include <hip/hip_runtime.h>
#include <hip/hip_cooperative_groups.h>
#include <cstdio>
#include <cstdint>
#include <cmath>
namespace cg = cooperative_groups;
constexpr int D = 1024, S = 16384, DEPTH = 4, DFF = 4096;
constexpr int GLA_IN = 3088, MB_IN = 3072;
constexpr float EPS = 1e-6f;
#ifndef PROBE
#define PROBE 0
#endif
#ifndef TCAT
#define TCAT 0
#endif
#ifndef TBLK
#define TBLK 0
#endif
#define LAS __attribute__((address_space(3)))
#define GAS __attribute__((address_space(1)))
typedef unsigned short bf16_t;
typedef short bf16x8 __attribute__((ext_vector_type(8)));
typedef short s16x4 __attribute__((ext_vector_type(4)));
typedef float f32x4 __attribute__((ext_vector_type(4)));
typedef float f32x16 __attribute__((ext_vector_type(16)));
typedef float f32x2 __attribute__((ext_vector_type(2)));
typedef unsigned u32x4 __attribute__((ext_vector_type(4)));
typedef unsigned u32x2 __attribute__((ext_vector_type(2)));
typedef __bf16 bf16x2_t __attribute__((ext_vector_type(2)));

__device__ __forceinline__ unsigned cvtpk(float lo, float hi) { f32x2 v = {lo, hi}; bf16x2_t b = __builtin_convertvector(v, bf16x2_t); return __builtin_bit_cast(unsigned, b); }
__device__ __forceinline__ float bf2f(unsigned short b) { return __uint_as_float((unsigned)b << 16); }
__device__ __forceinline__ float bflo(unsigned w) { return __uint_as_float(w << 16); }
__device__ __forceinline__ float bfhi(unsigned w) { return __uint_as_float(w & 0xffff0000u); }

#ifndef WT_STORES
#define WT_STORES 0
#endif
__device__ __forceinline__ void st16_wt(void* p, u32x4 v) {
#if WT_STORES
    asm volatile("global_store_dwordx4 %0, %1, off sc1\n\ts_nop 1" :: "v"(p), "v"(v) : "memory");
#else
    *(u32x4*)p = v;
#endif
}
__device__ __forceinline__ void st16_wt(void* p, f32x4 v) { st16_wt(p, __builtin_bit_cast(u32x4, v)); }
namespace pg8 {
constexpr int BM = 256, BK = 64, HALF = 128, HTB = HALF * BK * 2, STAGE_BYTES = 8 * HTB, NXCD = 8, WGM = 8;
__host__ __device__ __forceinline__ int lds_byte(int r, int c) { const int st = (r >> 4) * 2 + (c >> 5), rr = r & 15, cc = c & 31, ob = rr * 64 + cc * 2; return st * 1024 + (ob ^ (((ob >> 9) & 1) << 5)); }
__host__ __device__ __forceinline__ void stage_rc(int b, int& R, int& C) { const int st = b / 1024, sb = b % 1024, swz = sb ^ (((sb >> 9) & 1) << 5); R = (st >> 1) * 16 + swz / 64; C = (st & 1) * 32 + (swz % 64) / 2; }
__host__ __device__ __forceinline__ int perm32(int rho) { const int n = rho >> 4, i = rho & 15; return 8 * (i >> 2) + 4 * n + (i & 3); }
struct Unit { int pm, pn; };
struct Gemm { const bf16_t* A; const bf16_t* Bt; int M, N, K; };
struct StaticOrder {
    int nM, nN, nwg, G, c;
    __host__ __device__ void init(int M, int N, int G_, int c_) { nM = M / BM; nN = N / BM; nwg = nM * nN; G = G_; c = c_; }
    __host__ __device__ bool next(int i, Unit& u) const {
        const long L = (long)i * G + c; if (L >= nwg) return false;
        int wgid = (int)L; { const int q = nwg / NXCD, r = nwg % NXCD, xcd = wgid % NXCD, off = wgid / NXCD; wgid = (xcd < r ? xcd * (q + 1) : r * (q + 1) + (xcd - r) * q) + off; }
        const int nig = WGM * nN, gid = wgid / nig, fm = gid * WGM, gsz = (nM - fm) < WGM ? (nM - fm) : WGM;
        u.pm = fm + ((wgid % nig) % gsz); u.pn = (wgid % nig) / gsz; return true;
    }
    __device__ __forceinline__ void a_ready(const Unit&) const {}
    __device__ __forceinline__ void done(const Unit&) const {}
};
struct MaskOrder : StaticOrder {
    __device__ bool next(int i, Unit& u) const { const bool ok = StaticOrder::next(i, u); u.pm &= 7; u.pn &= 3; return ok; }
};
template <int ACT  > struct EpiBf16 {
    static constexpr bool PERM = true, AFTER_DRAIN = false;
    bf16_t* O; int ldc;
    __device__ __forceinline__ void operator()(const f32x4 (&acc)[2][2][4][2], const Unit& u, int wr, int wc, int fr, int fq) const {
        const int row0 = u.pm * BM + wr * 64 + fr; const int col0 = u.pn * BM + wc * 32 + 8 * fq;
#pragma unroll
        for (int ai = 0; ai < 2; ++ai)
#pragma unroll
            for (int m = 0; m < 4; ++m) { bf16_t* rowp = O + (size_t)(row0 + ai * HALF + m * 16) * ldc + col0;
#pragma unroll
                for (int bj = 0; bj < 2; ++bj) { f32x4 v0 = acc[ai][bj][m][0], v1 = acc[ai][bj][m][1];
                    if (ACT == 1) {
#pragma unroll
                        for (int e = 0; e < 4; ++e) { float a = fmaxf(v0[e], 0.f); v0[e] = a * a; float b = fmaxf(v1[e], 0.f); v1[e] = b * b; } }
                    u32x4 w; w.x = cvtpk(v0[0], v0[1]); w.y = cvtpk(v0[2], v0[3]); w.z = cvtpk(v1[0], v1[1]); w.w = cvtpk(v1[2], v1[3]);
                    st16_wt(rowp + bj * HALF, w); } }
    }
};
struct EpiResid {
    static constexpr bool PERM = false, AFTER_DRAIN = false;
    const bf16_t* base; float* out; int ldc; const float* gate;
    __device__ __forceinline__ void operator()(const f32x4 (&acc)[2][2][4][2], const Unit& u, int wr, int wc, int fr, int fq) const {
        const int row0 = u.pm * BM + wr * 64 + fr, col0 = u.pn * BM + wc * 32 + 4 * fq;
        f32x4 gv[2][2];
#pragma unroll
        for (int bj = 0; bj < 2; ++bj)
#pragma unroll
            for (int n = 0; n < 2; ++n) gv[bj][n] = *(const f32x4*)(gate + col0 + bj * HALF + n * 16);
#pragma unroll
        for (int ai = 0; ai < 2; ++ai)
#pragma unroll
            for (int m = 0; m < 4; ++m) { const size_t off = (size_t)(row0 + ai * HALF + m * 16) * ldc + col0;
#pragma unroll
                for (int bj = 0; bj < 2; ++bj)
#pragma unroll
                    for (int n = 0; n < 2; ++n) { const u32x2 bb = *(const u32x2*)(base + off + bj * HALF + n * 16); const f32x4 b = {bflo(bb.x), bfhi(bb.x), bflo(bb.y), bfhi(bb.y)};
                        st16_wt(out + off + bj * HALF + n * 16, b + gv[bj][n] * acc[ai][bj][m][n]); } }
    }
};

template <bool BASE_F32> struct EpiResidNorm {
    static constexpr bool PERM = false, AFTER_DRAIN = true;
    const void* base; bf16_t* out; int ldc; const float* gate;
    const float* ng; const float* sc; const float* sh; bf16_t* H;
    float* xbuf; unsigned* cnt; unsigned* tmo; float eps;
    __device__ __forceinline__ void operator()(const f32x4 (&)[2][2][4][2], const Unit&, int, int, int, int) const {}
    __device__ __forceinline__ void fused(f32x4 (&acc)[2][2][4][2], const Unit& u, int wr, int wc, int fr, int fq, LAS unsigned char* lds, int wid, int lane) const {
        LAS float* P = (LAS float*)lds;
        LAS float* Sr = (LAS float*)(lds + 4096);
        LAS unsigned* flag = (LAS unsigned*)(lds + 4096 + 1024);
        const int row0 = u.pm * BM + wr * 64 + fr, col0 = u.pn * BM + wc * 32 + 4 * fq;
        {
            f32x4 gv[2][2];
#pragma unroll
            for (int bj = 0; bj < 2; ++bj)
#pragma unroll
                for (int n = 0; n < 2; ++n) gv[bj][n] = *(const f32x4*)(gate + col0 + bj * HALF + n * 16);
#pragma unroll
            for (int ai = 0; ai < 2; ++ai)
#pragma unroll
                for (int m = 0; m < 4; ++m) { const size_t off = (size_t)(row0 + ai * HALF + m * 16) * ldc + col0;
                    float s = 0.f;
#pragma unroll
                    for (int bj = 0; bj < 2; ++bj)
#pragma unroll
                        for (int n = 0; n < 2; ++n) { f32x4 b;
                            if constexpr (BASE_F32) b = *(const f32x4*)((const float*)base + off + bj * HALF + n * 16);
                            else { const u32x2 bb = *(const u32x2*)((const bf16_t*)base + off + bj * HALF + n * 16); b = (f32x4){bflo(bb.x), bfhi(bb.x), bflo(bb.y), bfhi(bb.y)}; }
                            const f32x4 x = b + gv[bj][n] * acc[ai][bj][m][n]; acc[ai][bj][m][n] = x;
                            { u32x2 xw; xw.x = cvtpk(x[0], x[1]); xw.y = cvtpk(x[2], x[3]); *(u32x2*)(out + off + bj * HALF + n * 16) = xw; } s += (x[0] * x[0] + x[1] * x[1]) + (x[2] * x[2] + x[3] * x[3]); }
                    s += __shfl_xor(s, 16); s += __shfl_xor(s, 32);
                    if (fq == 0) P[(ai * HALF + wr * 64 + m * 16 + fr) * 4 + wc] = s;
                    if (m & 1) asm volatile("" ::: "memory"); }
        }
        asm volatile("s_waitcnt lgkmcnt(0)" ::: "memory"); __builtin_amdgcn_s_barrier(); asm volatile("" ::: "memory");
        const int row = wid * 32 + (lane & 31);
        if (lane < 32) {
            const float tot = (P[row * 4 + 0] + P[row * 4 + 1]) + (P[row * 4 + 2] + P[row * 4 + 3]);
            __hip_atomic_store((unsigned*)xbuf + ((size_t)(u.pm * BM + row) * 4 + u.pn), __float_as_uint(tot), __ATOMIC_RELAXED, __HIP_MEMORY_SCOPE_AGENT);
        }
        asm volatile("s_waitcnt vmcnt(0)" ::: "memory");
        if (lane == 0) __hip_atomic_fetch_add(cnt + 64 * u.pm, 1u, __ATOMIC_RELAXED, __HIP_MEMORY_SCOPE_AGENT);
        if (wid == 0) {
            unsigned sp = 0; bool dead = false;
            for (;;) {
                if ((unsigned)__builtin_amdgcn_readfirstlane(__hip_atomic_load(cnt + 64 * u.pm, __ATOMIC_RELAXED, __HIP_MEMORY_SCOPE_AGENT)) >= 32u) break;
                __builtin_amdgcn_s_sleep(2);
                if (++sp > (1u << 20)) { if (lane == 0) __hip_atomic_store(tmo, 1u, __ATOMIC_RELAXED, __HIP_MEMORY_SCOPE_AGENT); dead = true; break; }
            }
            __builtin_amdgcn_fence(__ATOMIC_ACQUIRE, "agent");
            if (lane == 0) flag[0] = dead ? 1u : 0u;
        }
        asm volatile("s_waitcnt vmcnt(0) lgkmcnt(0)" ::: "memory"); __builtin_amdgcn_s_barrier(); asm volatile("" ::: "memory");
        if (lane < 32) {
            const unsigned* slot = (const unsigned*)xbuf + (size_t)(u.pm * BM + row) * 4; float t = 0.f;
#pragma unroll
            for (int k = 0; k < 4; ++k) t += __uint_as_float(__hip_atomic_load(slot + k, __ATOMIC_RELAXED, __HIP_MEMORY_SCOPE_AGENT));
            Sr[row] = 1.0f / sqrtf(t * (1.0f / 1024.0f) + eps);
        }
        asm volatile("s_waitcnt lgkmcnt(0)" ::: "memory"); __builtin_amdgcn_s_barrier(); asm volatile("" ::: "memory");
        float rs[2][4];
#pragma unroll
        for (int ai = 0; ai < 2; ++ai)
#pragma unroll
            for (int m = 0; m < 4; ++m) rs[ai][m] = Sr[ai * HALF + wr * 64 + m * 16 + fr];
#pragma unroll
        for (int bj = 0; bj < 2; ++bj)
#pragma unroll
            for (int n = 0; n < 2; ++n) { const int c = col0 + bj * HALF + n * 16;
                const f32x4 ga = *(const f32x4*)(ng + c) * (*(const f32x4*)(sc + c) + 1.0f), gb = *(const f32x4*)(sh + c);
#pragma unroll
                for (int ai = 0; ai < 2; ++ai)
#pragma unroll
                    for (int m = 0; m < 4; ++m) { const int r = ai * HALF + wr * 64 + m * 16 + fr; const size_t off = (size_t)(u.pm * BM + r) * ldc + c;
                        const f32x4 y = acc[ai][bj][m][n] * rs[ai][m] * ga + gb; u32x2 w; w.x = cvtpk(y[0], y[1]); w.y = cvtpk(y[2], y[3]);
                        *(u32x2*)(H + off) = w; } }
    }
};

template <class Epi, class Sched, bool ALIGN_EPI = false, bool SP2 = false>
__device__ __forceinline__ void gemm_phase(LAS unsigned char* lds, const Gemm g, const Sched& S, const Epi& E) {
    int tid_ = threadIdx.x; asm volatile("" : "+v"(tid_));
    const int tid = tid_, wid = __builtin_amdgcn_readfirstlane(tid >> 6), lane = tid & 63, wr = wid >> 2, wc = wid & 3, fr = lane & 15, fq = lane >> 4;
    const int K = g.K, nt = K / BK;
    unsigned voffA[2], voffB[2];
#pragma unroll
    for (int i = 0; i < 2; ++i) { int R, C; stage_rc(tid * 16 + i * 8192, R, C); const int Rb = Epi::PERM ? ((R & ~31) + perm32(R & 31)) : R;
        voffA[i] = (unsigned)(R * K + C) * 2u; voffB[i] = (unsigned)(Rb * K + C) * 2u; }
    const size_t kstep = (size_t)(BK * 2);
    const size_t hstep = (size_t)HALF * K * 2;
    const size_t tstep = 2 * hstep;
    const unsigned ldsw = (unsigned)wid * 1024u;
    const int aoff = lds_byte(wr * 64 + fr, fq * 8), boff = lds_byte(wc * 32 + fr, fq * 8);
#define PG8_SA(b, h) (((b) * 2 + (h)) * HTB)
#define PG8_SB(b, h) ((4 + (b) * 2 + (h)) * HTB)
#define PG8_STAGE(bufoff, gbase, voff) do { _Pragma("unroll") for (int _i = 0; _i < 2; ++_i) \
        __builtin_amdgcn_global_load_lds((const unsigned*)((const char*)(gbase) + (voff)[_i]), (LAS unsigned*)(lds + (bufoff) + ldsw + _i * 8192), 16, 0, 0); } while (0)
#define PG8_LDA(dst, b, h) do { _Pragma("unroll") for (int m = 0; m < 4; ++m) _Pragma("unroll") for (int k = 0; k < 2; ++k) dst[m][k] = *(const LAS bf16x8*)(lds + PG8_SA(b, h) + aoff + m * 2048 + k * 1024); } while (0)
#define PG8_LDB(dst, b, h) do { _Pragma("unroll") for (int n = 0; n < 2; ++n) _Pragma("unroll") for (int k = 0; k < 2; ++k) dst[n][k] = *(const LAS bf16x8*)(lds + PG8_SB(b, h) + boff + n * 2048 + k * 1024); } while (0)
#define PG8_MMA(ai, bj, At, Bt) do { __builtin_amdgcn_s_setprio(1); _Pragma("unroll") for (int m = 0; m < 4; ++m) _Pragma("unroll") for (int n = 0; n < 2; ++n) _Pragma("unroll") for (int k = 0; k < 2; ++k) \
        acc[ai][bj][m][n] = __builtin_amdgcn_mfma_f32_16x16x32_bf16(Bt[n][k], At[m][k], acc[ai][bj][m][n], 0, 0, 0); __builtin_amdgcn_s_setprio(0); } while (0)
#define PG8_WAIT_V(n) asm volatile("s_waitcnt vmcnt(" #n ")" ::: "memory")
#define PG8_WAIT_L(n) asm volatile("s_waitcnt lgkmcnt(" #n ")" ::: "memory")
#define PG8_BAR __builtin_amdgcn_s_barrier()
#define PG8_SCHED __builtin_amdgcn_sched_barrier(0)
    Unit cur, nxt; int ui = 0;
    if (!S.next(0, cur)) return;
    f32x4 acc[2][2][4][2];
#pragma unroll
    for (int a = 0; a < 2; ++a)
#pragma unroll
        for (int b = 0; b < 2; ++b)
#pragma unroll
            for (int m = 0; m < 4; ++m)
#pragma unroll
                for (int n = 0; n < 2; ++n) acc[a][b][m][n] = (f32x4){0.f, 0.f, 0.f, 0.f};
    bf16x8 At[4][2], B0[2][2], B1[2][2];
    const char* cA = (const char*)g.A + (size_t)cur.pm * tstep; const char* cB = (const char*)g.Bt + (size_t)cur.pn * tstep;
    S.a_ready(cur);
    if constexpr (SP2) {
        PG8_STAGE(PG8_SB(0, 0), cB, voffB); PG8_STAGE(PG8_SB(0, 1), cB + hstep, voffB); PG8_STAGE(PG8_SA(0, 0), cA, voffA); PG8_STAGE(PG8_SA(0, 1), cA + hstep, voffA);
        if (wr == 1) PG8_BAR;
        PG8_WAIT_V(2); PG8_BAR;
        PG8_STAGE(PG8_SB(1, 0), cB + kstep, voffB); PG8_STAGE(PG8_SA(1, 0), cA + kstep, voffA); PG8_STAGE(PG8_SB(1, 1), cB + hstep + kstep, voffB);
        PG8_WAIT_V(6); PG8_BAR;
    } else {
        PG8_STAGE(PG8_SB(0, 0), cB, voffB); PG8_STAGE(PG8_SA(0, 0), cA, voffA); PG8_STAGE(PG8_SB(0, 1), cB + hstep, voffB); PG8_STAGE(PG8_SA(0, 1), cA + hstep, voffA);
        if (wr == 1) PG8_BAR;
        PG8_WAIT_V(4); PG8_BAR;
        PG8_STAGE(PG8_SB(1, 0), cB + kstep, voffB); PG8_STAGE(PG8_SA(1, 0), cA + kstep, voffA); PG8_STAGE(PG8_SB(1, 1), cB + hstep + kstep, voffB);
        PG8_WAIT_V(6); PG8_BAR;
    }
    for (;;) {
        const bool has_next = S.next(ui + 1, nxt);
        const char* nA = has_next ? (const char*)g.A + (size_t)nxt.pm * tstep : cA; const char* nB = has_next ? (const char*)g.Bt + (size_t)nxt.pn * tstep : cB;
        for (int t = 0; t < nt; t += 2) {
            const bool last = (t == nt - 2);
            const char* a1 = cA + (size_t)(t + 1) * kstep;
            const char* a2 = last ? nA : cA + (size_t)(t + 2) * kstep; const char* b2 = last ? nB : cB + (size_t)(t + 2) * kstep;
            const char* a3 = a2 + kstep; const char* b3 = b2 + kstep;
            if (last && has_next) S.a_ready(nxt);
            if constexpr (SP2) {
            PG8_LDB(B0, 0, 0); PG8_LDB(B1, 0, 1); PG8_SCHED; PG8_LDA(At, 0, 0); PG8_STAGE(PG8_SA(1, 1), a1 + hstep, voffA);
            PG8_WAIT_V(8); PG8_WAIT_L(0); PG8_BAR; PG8_MMA(0, 0, At, B0); PG8_MMA(0, 1, At, B1); PG8_BAR; PG8_SCHED;
            PG8_LDA(At, 0, 1); PG8_STAGE(PG8_SB(0, 0), b2, voffB); PG8_STAGE(PG8_SB(0, 1), b2 + hstep, voffB); PG8_STAGE(PG8_SA(0, 0), a2, voffA);
            PG8_WAIT_V(8); PG8_WAIT_L(0); PG8_BAR; PG8_MMA(1, 0, At, B0); PG8_MMA(1, 1, At, B1); PG8_BAR; PG8_SCHED;
            PG8_LDB(B0, 1, 0); PG8_LDB(B1, 1, 1); PG8_SCHED; PG8_LDA(At, 1, 0); PG8_STAGE(PG8_SA(0, 1), a2 + hstep, voffA);
            PG8_WAIT_V(8); PG8_WAIT_L(0); PG8_BAR; PG8_MMA(0, 0, At, B0); PG8_MMA(0, 1, At, B1); PG8_BAR; PG8_SCHED;
            PG8_LDA(At, 1, 1); PG8_STAGE(PG8_SB(1, 0), b3, voffB); PG8_STAGE(PG8_SB(1, 1), b3 + hstep, voffB); PG8_STAGE(PG8_SA(1, 0), a3, voffA);
            PG8_WAIT_V(8); PG8_WAIT_L(0); PG8_BAR; PG8_MMA(1, 0, At, B0); PG8_MMA(1, 1, At, B1); PG8_BAR; PG8_SCHED;
            } else {
            PG8_LDB(B0, 0, 0); PG8_SCHED; PG8_LDA(At, 0, 0); PG8_STAGE(PG8_SA(1, 1), a1 + hstep, voffA);
            PG8_WAIT_L(8); PG8_BAR; PG8_WAIT_L(0); PG8_MMA(0, 0, At, B0); PG8_BAR; PG8_SCHED;
            PG8_LDB(B1, 0, 1); PG8_STAGE(PG8_SB(0, 0), b2, voffB);
            PG8_BAR; PG8_WAIT_L(0); PG8_MMA(0, 1, At, B1); PG8_BAR;
            PG8_LDA(At, 0, 1); PG8_STAGE(PG8_SA(0, 0), a2, voffA);
            PG8_BAR; PG8_WAIT_L(0); PG8_MMA(1, 0, At, B0); PG8_BAR; PG8_SCHED;
            PG8_STAGE(PG8_SB(0, 1), b2 + hstep, voffB);
            PG8_WAIT_V(6); PG8_BAR; PG8_MMA(1, 1, At, B1); PG8_BAR;
            PG8_LDB(B0, 1, 0); PG8_SCHED; PG8_LDA(At, 1, 0); PG8_STAGE(PG8_SA(0, 1), a2 + hstep, voffA);
            PG8_WAIT_L(8); PG8_BAR; PG8_WAIT_L(0); PG8_MMA(0, 0, At, B0); PG8_BAR; PG8_SCHED;
            PG8_LDB(B1, 1, 1); PG8_STAGE(PG8_SB(1, 0), b3, voffB);
            PG8_BAR; PG8_WAIT_L(0); PG8_MMA(0, 1, At, B1); PG8_BAR;
            PG8_LDA(At, 1, 1); PG8_STAGE(PG8_SA(1, 0), a3, voffA);
            PG8_BAR; PG8_WAIT_L(0); PG8_MMA(1, 0, At, B0); PG8_BAR; PG8_SCHED;
            PG8_STAGE(PG8_SB(1, 1), b3 + hstep, voffB);
            PG8_WAIT_V(6); PG8_BAR; PG8_MMA(1, 1, At, B1); PG8_BAR;
            }
        }
        if constexpr (ALIGN_EPI) { if (wr == 0) PG8_BAR; }
        if constexpr (!Epi::AFTER_DRAIN) { E(acc, cur, wr, wc, fr, fq); S.done(cur); }
        if (!has_next) break;
#pragma unroll
        for (int a = 0; a < 2; ++a)
#pragma unroll
            for (int b = 0; b < 2; ++b)
#pragma unroll
                for (int m = 0; m < 4; ++m)
#pragma unroll
                    for (int n = 0; n < 2; ++n) acc[a][b][m][n] = (f32x4){0.f, 0.f, 0.f, 0.f};
        cur = nxt; cA = nA; cB = nB; ++ui;
        if constexpr (ALIGN_EPI) { if (wr == 1) PG8_BAR; }
    }
    PG8_WAIT_V(0);
    if constexpr (!ALIGN_EPI) { if (wr == 0) PG8_BAR; }
    PG8_BAR;
    if constexpr (Epi::AFTER_DRAIN) { E.fused(acc, cur, wr, wc, fr, fq, lds, wid, lane); }
#undef PG8_SA
#undef PG8_SB
#undef PG8_STAGE
#undef PG8_LDA
#undef PG8_LDB
#undef PG8_MMA
#undef PG8_WAIT_V
#undef PG8_WAIT_L
#undef PG8_BAR
#undef PG8_SCHED
}
}

#define XB_TMO      128
#define XB_XCNT(j)  (256  + 64 * (j))
#define XB_XSUB(j)  (1280 + 64 * (j))
#define XB_XGEN(j)  (2304 + 64 * (j))
#define XB_TOP      3328
#define XB_TOPGEN   3392
#define XCD_BAR_WORDS 3456
#define XB_SPIN_CAP (1u << 18)
__device__ __forceinline__ unsigned xb_ld(unsigned* p)              { return __hip_atomic_load(p, __ATOMIC_RELAXED, __HIP_MEMORY_SCOPE_AGENT); }
__device__ __forceinline__ unsigned xb_add(unsigned* p, unsigned v) { return __hip_atomic_fetch_add(p, v, __ATOMIC_RELAXED, __HIP_MEMORY_SCOPE_AGENT); }
__device__ __forceinline__ unsigned xb_xcc_id() { return (unsigned)__builtin_amdgcn_s_getreg((3 << 11) | 20) & 0xFu; }
#define XB_SPIN(cond, bar) do { unsigned _sp = 0; while (cond) { __builtin_amdgcn_s_sleep(1); \
    if ((++_sp & 255u) == 0u) { if (xb_ld(&(bar)[XB_TMO])) break; if (_sp > XB_SPIN_CAP) { atomicAdd(&(bar)[XB_TMO], 1u); break; } } } } while (0)
struct XcdBarrier { unsigned* bar; unsigned x; volatile LAS unsigned* st; };
__device__ __forceinline__ XcdBarrier xcd_barrier_post(unsigned* bar, volatile LAS unsigned* st) {
    XcdBarrier b; b.bar = bar; b.x = xb_xcc_id(); b.st = st;
    if (threadIdx.x == 0) (void)xb_add(&bar[XB_XCNT(b.x)], 1u);
    return b;
}
__device__ __forceinline__ void xcd_barrier_complete(unsigned* bar, unsigned x, unsigned& nloc, unsigned& nx) {
    const unsigned G = gridDim.x * gridDim.y * gridDim.z;
    unsigned sum, cnt, mine, sp = 0u;
    for (;;) {
        sum = 0u; cnt = 0u; mine = 0u;
#pragma unroll
        for (unsigned j = 0; j < 16; ++j) { const unsigned c = xb_ld(&bar[XB_XCNT(j)]); sum += c; cnt += (c > 0u) ? 1u : 0u; }
        mine = xb_ld(&bar[XB_XCNT(x)]);
        if (sum == G) break;
        __builtin_amdgcn_s_sleep(1);
        if ((++sp & 255u) == 0u) { if (xb_ld(&bar[XB_TMO])) break; if (sp > XB_SPIN_CAP) { atomicAdd(&bar[XB_TMO], 1u); break; } }
    }
    nloc = mine > 0u ? mine : 1u; nx = cnt > 0u ? cnt : 1u;
}
__device__ __forceinline__ void xcd_barrier(const XcdBarrier& b) {
    asm volatile("s_waitcnt vmcnt(0)" ::: "memory");
    __syncthreads();
    if (threadIdx.x == 0) {
        unsigned* bar = b.bar; asm volatile("" : "+s"(bar));
        __builtin_amdgcn_s_waitcnt(0);
        unsigned nloc = b.st[0], nx = b.st[1];
        if (nloc == 0u) { xcd_barrier_complete(bar, b.x, nloc, nx); b.st[0] = nloc; b.st[1] = nx; }
        const unsigned old = xb_add(&bar[XB_XSUB(b.x)], 1u);
        const unsigned gen = old / nloc;
        if (old + 1u == (gen + 1u) * nloc) {
            __builtin_amdgcn_fence(__ATOMIC_RELEASE, "agent");
            asm volatile("s_waitcnt vmcnt(0)" ::: "memory");
            const unsigned og = xb_add(&bar[XB_TOP], 1u);
            const unsigned tg = og / nx;
            if (og + 1u == (tg + 1u) * nx) xb_add(&bar[XB_TOPGEN], 1u);
            else XB_SPIN(xb_ld(&bar[XB_TOPGEN]) == tg, bar);
            __builtin_amdgcn_fence(__ATOMIC_ACQUIRE, "agent");
            xb_add(&bar[XB_XGEN(b.x)], 1u);
            asm volatile("s_waitcnt vmcnt(0)" ::: "memory");
        } else {
            XB_SPIN(xb_ld(&bar[XB_XGEN(b.x)]) == gen, bar);
            __builtin_amdgcn_fence(__ATOMIC_ACQUIRE, "agent");
            asm volatile("s_waitcnt vmcnt(0)" ::: "memory");
        }
    }
    __syncthreads();
}
constexpr int NWAVES = 8, NTHR = 512;
constexpr int LDS_BYTES = 147456;
constexpr int RING_BYTES = 131072;
constexpr int MISC_OFF = LDS_BYTES - 256;
constexpr size_t MiB = 1u << 20;
constexpr size_t WS_CTL = 0, CTL_ZERO_BYTES = 1 * MiB;
constexpr size_t WS_MOD = 1 * MiB;
constexpr size_t WS_COS = 2 * MiB, WS_SIN = 6 * MiB;
constexpr size_t WS_WGIN = 10 * MiB;
constexpr size_t WS_WGLR = 22 * MiB;
constexpr size_t WS_WGOUT = 23 * MiB;
constexpr size_t WS_WMIN = 27 * MiB;
constexpr size_t WS_WMOUT = 39 * MiB;
constexpr size_t WS_W1 = 43 * MiB;
constexpr size_t WS_W2 = 75 * MiB;
constexpr size_t WS_H = 107 * MiB;
constexpr size_t WS_MIX = 139 * MiB;
constexpr size_t WS_QKV = 171 * MiB;
constexpr size_t WS_AUX = 267 * MiB;
constexpr size_t WS_HID = 171 * MiB;
constexpr size_t WS_END = 363 * MiB;
constexpr size_t WS_SBUF = WS_AUX;
constexpr size_t WS_GLR = WS_AUX + 32 * MiB;
constexpr size_t WS_DG = WS_AUX + 33 * MiB;
constexpr size_t WS_XB = WS_AUX + 64 * MiB;
constexpr size_t WS_KMEAN = WS_MOD + 128 * 1024;
constexpr size_t WS_LPART = WS_H + 1 * MiB;
constexpr size_t WS_LIST = WS_H + 4 * MiB;
constexpr int CW_BAR = 4096;
constexpr int CW_MCNT = 16384;
constexpr int CW_TMO = 0;
constexpr int CW_SEAM = 32768, SEAM_BANK = 64 * 64;
constexpr size_t WS_XBUF = WS_MOD + 512 * 1024;
struct Frame {
    LAS unsigned char* lds;
    int tid, lane, wave, vcu, G;
};
__device__ __forceinline__ Frame opaque(const Frame& F0) { Frame F = F0; int t = F0.tid; asm volatile("" : "+v"(t)); F.tid = t; F.lane = t & 63; F.wave = __builtin_amdgcn_readfirstlane(t >> 6); return F; }
__device__ __forceinline__ float wave_sum(float v) {
#pragma unroll
    for (int o = 1; o < 64; o <<= 1) v += __shfl_xor(v, o);
    return v;
}
__device__ __forceinline__ float silu_f(float x) { return x / (1.f + __expf(-x)); }
__device__ __forceinline__ void sincos_acc(double ang, float& s, float& c) {
    const double n = rint(ang * 0.15915494309189535);
    double r = fma(-n, 6.283185307179586, ang); r = fma(-n, 2.4492935982947064e-16, r);
    const double x = r * 0.25, x2 = x * x;
    const double sn = x * (1.0 + x2 * (-1.0 / 6 + x2 * (1.0 / 120 + x2 * (-1.0 / 5040 + x2 * (1.0 / 362880 + x2 * (-1.0 / 39916800 + x2 * (1.0 / 6227020800.0)))))));
    const double cs = 1.0 + x2 * (-0.5 + x2 * (1.0 / 24 + x2 * (-1.0 / 720 + x2 * (1.0 / 40320 + x2 * (-1.0 / 3628800 + x2 * (1.0 / 479001600 + x2 * (-1.0 / 87178291200.0)))))));
    const double s2 = 2 * sn * cs, c2 = 1 - 2 * sn * sn;
    s = (float)(2 * s2 * c2); c = (float)(1 - 2 * s2 * s2);
}
constexpr int TR_SCR = 64 * 65 * 4;
struct TrItem { const float* W; int ld, n_off, n_cnt, K; bf16_t* WT; int item; };
__device__ __forceinline__ void tr_load(const TrItem& t, int lane, f32x4 (&v)[16]) {
    const int nblk = (t.n_cnt + 63) >> 6, kb = t.item / nblk, nb = t.item - kb * nblk, k0 = 64 * kb, n0 = 64 * nb;
    const int c4 = (lane & 15) * 4, kr = lane >> 4;
    const bool ok = (n0 + c4) < t.n_cnt;
#pragma unroll
    for (int i = 0; i < 16; ++i) v[i] = ok ? *(const f32x4*)(t.W + (size_t)(k0 + 4 * i + kr) * t.ld + t.n_off + n0 + c4) : (f32x4){0.f, 0.f, 0.f, 0.f};
}
__device__ __forceinline__ void tr_store(const TrItem& t, int lane, const f32x4 (&v)[16], LAS float* scr) {
    const int nblk = (t.n_cnt + 63) >> 6, kb = t.item / nblk, nb = t.item - kb * nblk, k0 = 64 * kb, n0 = 64 * nb;
    const int c4 = (lane & 15) * 4, kr = lane >> 4;
#pragma unroll
    for (int i = 0; i < 16; ++i) { LAS float* s = scr + (4 * i + kr) * 65 + c4; s[0] = v[i].x; s[1] = v[i].y; s[2] = v[i].z; s[3] = v[i].w; }
    asm volatile("s_waitcnt lgkmcnt(0)" ::: "memory");
    const int c = lane & 7;
#pragma unroll
    for (int j = 0; j < 8; ++j) { const int n = (lane >> 3) + 8 * j; const LAS float* s = scr + (8 * c) * 65 + n;
        u32x4 o; o.x = cvtpk(s[0 * 65], s[1 * 65]); o.y = cvtpk(s[2 * 65], s[3 * 65]); o.z = cvtpk(s[4 * 65], s[5 * 65]); o.w = cvtpk(s[6 * 65], s[7 * 65]);
        if (n0 + n < t.n_cnt) *(u32x4*)(t.WT + (size_t)(n0 + n) * t.K + k0 + 8 * c) = o; }
    asm volatile("s_waitcnt lgkmcnt(0)" ::: "memory");
}
struct MegaArgs {
    const float* in[18]; float* out; unsigned char* ws; int ph_lo, ph_hi;
};
__device__ __forceinline__ void p0_prologue(const Frame& F0, const MegaArgs& a) {
    const Frame F = opaque(F0);
    unsigned char* ws = a.ws;
    {
        LAS float* scr = (LAS float*)(F.lds + F.wave * TR_SCR);
        const int gw = F.vcu * NWAVES + F.wave, NGW = F.G * NWAVES;
        constexpr int I_GIN = 16 * 48, I_GLR = 16, I_SQ = 16 * 16, I_W1 = 16 * 64, I_W2 = 64 * 16;
        constexpr int NITEMS = 2 * I_GIN + 2 * I_GLR + 2 * I_SQ + 2 * I_GIN + 2 * I_SQ + 4 * I_W1 + 4 * I_W2;
        auto decode = [&](int it) -> TrItem {
            int r = it;
            if (r < 2 * I_GIN) { const int j = r / I_GIN; return TrItem{a.in[7] + (size_t)j * D * GLA_IN, GLA_IN, 0, 3072, D, (bf16_t*)(ws + WS_WGIN) + (size_t)j * 3072 * D, r % I_GIN}; } r -= 2 * I_GIN;
            if (r < 2 * I_GLR) { const int j = r / I_GLR; return TrItem{a.in[7] + (size_t)j * D * GLA_IN, GLA_IN, 3072, 16, D, (bf16_t*)(ws + WS_WGLR) + (size_t)j * 16 * D, r % I_GLR}; } r -= 2 * I_GLR;
            if (r < 2 * I_SQ) { const int j = r / I_SQ; return TrItem{a.in[11] + (size_t)j * D * D, D, 0, D, D, (bf16_t*)(ws + WS_WGOUT) + (size_t)j * D * D, r % I_SQ}; } r -= 2 * I_SQ;
            if (r < 2 * I_GIN) { const int j = r / I_GIN; return TrItem{a.in[12] + (size_t)j * D * MB_IN, MB_IN, 0, 3072, D, (bf16_t*)(ws + WS_WMIN) + (size_t)j * 3072 * D, r % I_GIN}; } r -= 2 * I_GIN;
            if (r < 2 * I_SQ) { const int j = r / I_SQ; return TrItem{a.in[15] + (size_t)j * D * D, D, 0, D, D, (bf16_t*)(ws + WS_WMOUT) + (size_t)j * D * D, r % I_SQ}; } r -= 2 * I_SQ;
            if (r < 4 * I_W1) { const int j = r / I_W1; return TrItem{a.in[16] + (size_t)j * D * DFF, DFF, 0, DFF, D, (bf16_t*)(ws + WS_W1) + (size_t)j * DFF * D, r % I_W1}; } r -= 4 * I_W1;
            { const int j = r / I_W2; return TrItem{a.in[17] + (size_t)j * DFF * D, D, 0, D, DFF, (bf16_t*)(ws + WS_W2) + (size_t)j * D * DFF, r % I_W2}; }
        };
        f32x4 va[16], vb[16];
        int it = gw;
        if (it < NITEMS) { TrItem cur = decode(it); tr_load(cur, F.lane, va);
            for (;;) {
                const int itn = it + NGW; TrItem nx = cur; const bool more = itn < NITEMS;
                if (more) { nx = decode(itn); tr_load(nx, F.lane, vb); }
                tr_store(cur, F.lane, va, scr);
                if (!more) break;
                const int itn2 = itn + NGW; const bool more2 = itn2 < NITEMS; TrItem nx2 = nx;
                if (more2) { nx2 = decode(itn2); tr_load(nx2, F.lane, va); }
                tr_store(nx, F.lane, vb, scr);
                if (!more2) break;
                cur = nx2; it = itn2;
            }
        }
    }
    __syncthreads();
    {
        const float* c = a.in[1]; const float* ada_w = a.in[3]; const float* ada_b = a.in[4]; float* mod = (float*)(ws + WS_MOD);
        LAS float* sc = (LAS float*)F.lds;
        LAS float* red = (LAS float*)F.lds + 1024;
        for (int k = F.tid; k < D; k += NTHR) sc[k] = silu_f(c[k]);
        __syncthreads();
        const int kg = F.tid >> 5, cl = F.tid & 31;
        for (int chunk = F.vcu; chunk < 256; chunk += F.G) {
            float part[3];
#pragma unroll
            for (int cc = 0; cc < 3; ++cc) {
                const int col = chunk * 96 + cc * 32 + cl, i = col / (6 * D), n = col - i * 6 * D;
                const float* w = ada_w + (size_t)i * D * 6 * D + (size_t)(kg * 64) * 6 * D + n;
                float wv[64];
#pragma unroll
                for (int k = 0; k < 64; ++k) wv[k] = w[(size_t)k * 6 * D];
                float acc = 0.f;
#pragma unroll
                for (int k = 0; k < 64; ++k) acc += sc[kg * 64 + k] * wv[k];
                part[cc] = acc;
            }
#pragma unroll
            for (int cc = 0; cc < 3; ++cc) red[kg * 96 + cc * 32 + cl] = part[cc];
            __syncthreads();
            if (F.tid < 96) { float s = 0.f;
#pragma unroll
                for (int g = 0; g < 16; ++g) s += red[g * 96 + F.tid];
                mod[chunk * 96 + F.tid] = s + ada_b[chunk * 96 + F.tid]; }
            __syncthreads();
        }
    }
    {
        const int* pos = (const int*)a.in[2]; float* ct = (float*)(ws + WS_COS); float* st = (float*)(ws + WS_SIN);
        for (int idx = F.vcu * NTHR + F.tid; idx < S * 64; idx += F.G * NTHR) {
            const int t = idx >> 6, i = idx & 63;
            const float inv_freq = (float)exp2(-(double)i * (13.287712379549449 / 64.0));
            const float angf = (float)pos[t] * inv_freq;
            float sn, cs; sincos_acc((double)angf, sn, cs);
            ct[idx] = cs; st[idx] = sn;
        }
    }
}
__device__ __forceinline__ void norm_phase(const Frame& F0, const float* __restrict__ x, const float* __restrict__ g, const float* __restrict__ sc, const float* __restrict__ sh, bf16_t* __restrict__ h) {
    const Frame F = opaque(F0);
    f32x4 ga[4], gb[4];
#pragma unroll
    for (int j = 0; j < 4; ++j) { const f32x4 gg = ((const f32x4*)g)[F.lane + 64 * j], s1 = ((const f32x4*)sc)[F.lane + 64 * j]; ga[j] = gg * (s1 + 1.0f); gb[j] = ((const f32x4*)sh)[F.lane + 64 * j]; }
    const int gw = F.vcu * NWAVES + F.wave, NGW = F.G * NWAVES;
    for (int m = gw; m < S; m += NGW) {
        const f32x4* xr = (const f32x4*)(x + (size_t)m * D) + F.lane;
        f32x4 v[4]; float ss = 0.f;
#pragma unroll
        for (int j = 0; j < 4; ++j) { v[j] = xr[64 * j]; ss += (v[j].x * v[j].x + v[j].y * v[j].y) + (v[j].z * v[j].z + v[j].w * v[j].w); }
        const float r = 1.0f / sqrtf(wave_sum(ss) * (1.f / D) + EPS);
        u32x2* o8 = (u32x2*)(h + (size_t)m * D) + F.lane;
#pragma unroll
        for (int j = 0; j < 4; ++j) { const f32x4 y = v[j] * r * ga[j] + gb[j]; u32x2 w; w.x = cvtpk(y.x, y.y); w.y = cvtpk(y.z, y.w); o8[64 * j] = w; }
    }
}
__device__ __forceinline__ void glr_phase(const Frame& F0, const bf16_t* __restrict__ H, const bf16_t* __restrict__ WglrT, float* __restrict__ glr) {
    const Frame F = opaque(F0);
    if (F.wave >= 4) return;
    const int l15 = F.lane & 15, q = F.lane >> 4;
    for (int rb = F.vcu; rb < S / 64; rb += F.G) {
        const int row0 = rb * 64 + F.wave * 16;
        const bf16_t* ap = H + (size_t)(row0 + l15) * D + 8 * q;
        const bf16_t* bp = WglrT + (size_t)l15 * D + 8 * q;
        f32x4 acc = {0.f, 0.f, 0.f, 0.f};
#pragma unroll 8
        for (int ks = 0; ks < 32; ++ks) {
            const bf16x8 av = *(const bf16x8*)(ap + ks * 32), bv = *(const bf16x8*)(bp + ks * 32);
            acc = __builtin_amdgcn_mfma_f32_16x16x32_bf16(av, bv, acc, 0, 0, 0);
        }
#pragma unroll
        for (int r = 0; r < 4; ++r) glr[(size_t)(row0 + 4 * q + r) * 16 + l15] = acc[r];
    }
}
typedef short v4i16_t __attribute__((ext_vector_type(4)));
__device__ __forceinline__ s16x4 vtr(const LAS unsigned char* p) { return __builtin_bit_cast(s16x4, __builtin_amdgcn_ds_read_tr16_b64_v4i16((LAS v4i16_t*)p)); }
__device__ __forceinline__ int crow(int reg, int h) { return (reg & 3) + 8 * (reg >> 2) + 4 * h; }
__device__ __forceinline__ unsigned off_b(unsigned row, unsigned ch) { return 272u * row + 16u * ch; }
__device__ __forceinline__ unsigned tr_addr(unsigned lane, unsigned c, unsigned rowblk) {
    const unsigned blk = (lane >> 4) & 1, q = (lane & 15) >> 2, p = lane & 3;
    return off_b(rowblk + q, 4 * c + 2 * blk + (p >> 1)) + 8 * (p & 1);
}
constexpr int GL_IMG = 64 * 272, GL_PST = 144;
constexpr int GL_QD = 0, GL_KI = GL_IMG, GL_KT = 2 * GL_IMG, GL_V = 3 * GL_IMG, GL_P = 5 * GL_IMG, GL_GL = GL_P + 64 * GL_PST, GL_SEG = GL_GL + 4096, GL_DEC = GL_SEG + 2048, GL_RED = GL_DEC + 512;
static_assert(GL_RED + 2048 <= RING_BYTES, "gla lds");
#define MFMA32(a, b, c) __builtin_amdgcn_mfma_f32_32x32x16_bf16((a), (b), (c), 0, 0, 0)

struct GlaPre { f32x4 ga, gb; unsigned qk[16]; };
__device__ __forceinline__ void gla_prefetch_g(const Frame& F, const float* __restrict__ GLR, int t0, GlaPre& P) {
    const int ib = F.wave >> 2, l31 = F.lane & 31, h = F.lane >> 5;
    const float* gp = GLR + (size_t)(t0 + 32 * ib + l31) * 16 + 8 * h;
    P.ga = *(const f32x4*)gp; P.gb = *(const f32x4*)(gp + 4);
}
template <bool WITH_Q>
__device__ __forceinline__ void gla_prefetch(const Frame& F, const bf16_t* __restrict__ QKV, const float* __restrict__ GLR, int t0, int hd, GlaPre& P);
template <bool WITH_Q>
__device__ __forceinline__ void gla_prefetch_qk(const Frame& F, const bf16_t* __restrict__ QKV, int t0, int hd, GlaPre& P) {
    const int w = F.wave, ib = w >> 2, db = w & 3, l31 = F.lane & 31, h = F.lane >> 5;
#pragma unroll
    for (int r = 0; r < 16; ++r) {
        const bf16_t* row = QKV + (size_t)(t0 + 32 * ib + crow(r, h)) * 3072 + hd * 128 + 32 * db + l31;
        const unsigned kk = row[512]; const unsigned qq = WITH_Q ? (unsigned)row[0] : 0u;
        P.qk[r] = qq | (kk << 16);
    }
}
template <bool WITH_Q>
__device__ __forceinline__ void gla_prefetch(const Frame& F, const bf16_t* __restrict__ QKV, const float* __restrict__ GLR, int t0, int hd, GlaPre& P) {
    gla_prefetch_g(F, GLR, t0, P); gla_prefetch_qk<WITH_Q>(F, QKV, t0, hd, P);
}
struct GlaW { u32x4 bhi, blo; float bias; };
__device__ __forceinline__ void gla_load_w(const float* __restrict__ wupg, const float* __restrict__ bgg, int hd, const Frame& F, GlaW& W) {
    const int db = F.wave & 3, l31 = F.lane & 31, h = F.lane >> 5, d = hd * 128 + 32 * db + l31;
    float wv[8];
#pragma unroll
    for (int j = 0; j < 8; ++j) wv[j] = wupg[(8 * h + j) * 512 + d];
    W.bhi.x = cvtpk(wv[0], wv[1]); W.bhi.y = cvtpk(wv[2], wv[3]); W.bhi.z = cvtpk(wv[4], wv[5]); W.bhi.w = cvtpk(wv[6], wv[7]);
    W.blo.x = cvtpk(wv[0] - bflo(W.bhi.x), wv[1] - bfhi(W.bhi.x)); W.blo.y = cvtpk(wv[2] - bflo(W.bhi.y), wv[3] - bfhi(W.bhi.y));
    W.blo.z = cvtpk(wv[4] - bflo(W.bhi.z), wv[5] - bfhi(W.bhi.z)); W.blo.w = cvtpk(wv[6] - bflo(W.bhi.w), wv[7] - bfhi(W.bhi.w));
    W.bias = bgg[d];
}
template <bool WITH_Q, bool VPRE>
__device__ __forceinline__ float gla_chunk_prep(const Frame& F, const GlaPre& P, const GlaW& W, const bf16_t* __restrict__ QKV, int t0, int hd, const u32x4 (&vpre)[4]) {
    LAS unsigned char* lds = F.lds;
    const int w = F.wave, ib = w >> 2, db = w & 3, l31 = F.lane & 31, h = F.lane >> 5, d = 32 * db + l31;
    u32x4 vv[4];
#pragma unroll
    for (int k = 0; k < 4; ++k) { const int c = F.tid + 512 * k, j = c >> 5, ch = c & 31; vv[k] = VPRE ? vpre[k] : *(const u32x4*)(QKV + (size_t)(t0 + j) * 3072 + 1024 + hd * 256 + ch * 8); }
    u32x4 ahi, alo;
    ahi.x = cvtpk(P.ga.x, P.ga.y); ahi.y = cvtpk(P.ga.z, P.ga.w); ahi.z = cvtpk(P.gb.x, P.gb.y); ahi.w = cvtpk(P.gb.z, P.gb.w);
    alo.x = cvtpk(P.ga.x - bflo(ahi.x), P.ga.y - bfhi(ahi.x)); alo.y = cvtpk(P.ga.z - bflo(ahi.y), P.ga.w - bfhi(ahi.y));
    alo.z = cvtpk(P.gb.x - bflo(ahi.z), P.gb.y - bfhi(ahi.z)); alo.w = cvtpk(P.gb.z - bflo(ahi.w), P.gb.w - bfhi(ahi.w));
    f32x16 X;
#pragma unroll
    for (int r = 0; r < 16; ++r) X[r] = W.bias;
    X = MFMA32(__builtin_bit_cast(bf16x8, ahi), __builtin_bit_cast(bf16x8, W.bhi), X);
    X = MFMA32(__builtin_bit_cast(bf16x8, alo), __builtin_bit_cast(bf16x8, W.bhi), X);
    X = MFMA32(__builtin_bit_cast(bf16x8, ahi), __builtin_bit_cast(bf16x8, W.blo), X);
    float G[16], sk[4];
#pragma unroll
    for (int k = 0; k < 4; ++k) { float run = 0.f;
#pragma unroll
        for (int j = 0; j < 4; ++j) { const float x = X[4 * k + j]; const float ls = fminf(x, 0.f) - __logf(1.f + __expf(-fabsf(x))); run += ls * (1.f / 16.f); G[4 * k + j] = run; }
        sk[k] = run; }
    float base = 0.f, tot;
    {
        float ps[4];
#pragma unroll
        for (int k = 0; k < 4; ++k) ps[k] = __shfl_xor(sk[k], 32);
#pragma unroll
        for (int k = 0; k < 4; ++k) { const float bk = base + (h ? ps[k] : 0.f);
#pragma unroll
            for (int j = 0; j < 4; ++j) G[4 * k + j] += bk;
            base += sk[k] + ps[k]; }
        tot = base;
    }
    LAS float* HT = (LAS float*)(lds + GL_SEG);
    if (h == 0) HT[ib * 128 + d] = tot;
#pragma unroll
    for (int k = 0; k < 4; ++k) { const int c = F.tid + 512 * k, j = c >> 5, ch = c & 31; *(LAS u32x4*)(lds + GL_V + (ch >> 4) * GL_IMG + off_b(j, ch & 15)) = vv[k]; }
    __syncthreads();
    const float t0h = HT[d], t1h = HT[128 + d], glast = t0h + t1h;
    const float add = ib ? t0h : 0.f;
    const float qs = 0.08838834764831845f;
#pragma unroll
    for (int r = 0; r < 16; ++r) {
        const int i = 32 * ib + crow(r, h); const float Gv = G[r] + add;
        const unsigned a = off_b(i, d >> 3) + 2 * (d & 7);
        const float kf = bfhi(P.qk[r]);
        if (WITH_Q) {
            *(LAS unsigned short*)(lds + GL_QD + a) = (unsigned short)(cvtpk(bflo(P.qk[r]) * qs * __expf(Gv), 0.f) & 0xffffu);
            *(LAS unsigned short*)(lds + GL_KI + a) = (unsigned short)(cvtpk(kf * __expf(-Gv), 0.f) & 0xffffu);
        }
        *(LAS unsigned short*)(lds + GL_KT + a) = (unsigned short)(cvtpk(kf * __expf(glast - Gv), 0.f) & 0xffffu);
    }
    if (ib == 0 && h == 0) ((LAS float*)(lds + GL_DEC))[d] = __expf(glast);
    __syncthreads();
    return glast;
}
__device__ __forceinline__ void gla_state_update(const Frame& F, f32x16 (&St)[4]) {
    LAS unsigned char* lds = F.lds;
    const int h = F.lane >> 5, w = F.wave;
    const LAS float* dec = (const LAS float*)(lds + GL_DEC);
#pragma unroll
    for (int db = 0; db < 4; ++db)
#pragma unroll
        for (int r = 0; r < 16; ++r) St[db][r] *= dec[32 * db + crow(r, h)];
    const LAS unsigned char* vimg = lds + GL_V + (w >> 2) * GL_IMG;
#pragma unroll
    for (int ks = 0; ks < 4; ++ks) {
        const s16x4 vlo = vtr(vimg + tr_addr(F.lane, w & 3, 16 * ks + 8 * h)), vhi = vtr(vimg + tr_addr(F.lane, w & 3, 16 * ks + 8 * h + 4));
        const bf16x8 vb = __builtin_shufflevector(vlo, vhi, 0, 1, 2, 3, 4, 5, 6, 7);
#pragma unroll
        for (int db = 0; db < 4; ++db) {
            const s16x4 klo = vtr(lds + GL_KT + tr_addr(F.lane, db, 16 * ks + 8 * h)), khi = vtr(lds + GL_KT + tr_addr(F.lane, db, 16 * ks + 8 * h + 4));
            const bf16x8 ka = __builtin_shufflevector(klo, khi, 0, 1, 2, 3, 4, 5, 6, 7);
            St[db] = MFMA32(ka, vb, St[db]);
        }
    }
}
__device__ __forceinline__ void gla_g1(const Frame& F0, const bf16_t* __restrict__ QKV, const float* __restrict__ GLR, const float* __restrict__ wupg, const float* __restrict__ bgg, float* __restrict__ SBUF, float* __restrict__ DG) {
    const Frame F = opaque(F0);
    const int h = F.lane >> 5, w = F.wave;
    for (int u = F.vcu; u < 256; u += F.G) {
        const int gi = u >> 2, hd = u & 3;
        GlaW W; gla_load_w(wupg, bgg, hd, F, W);
        f32x16 St[4];
#pragma unroll
        for (int db = 0; db < 4; ++db)
#pragma unroll
            for (int r = 0; r < 16; ++r) St[db][r] = 0.f;
        float gsum = 0.f;
        GlaPre P; gla_prefetch<false>(F, QKV, GLR, gi * 256, hd, P);
        u32x4 vpre[4];
#define GLA_VPRE(t0_) do { _Pragma("unroll") for (int k_ = 0; k_ < 4; ++k_) { const int c_ = F.tid + 512 * k_, j_ = c_ >> 5, ch_ = c_ & 31; vpre[k_] = *(const u32x4*)(QKV + (size_t)((t0_) + j_) * 3072 + 1024 + hd * 256 + ch_ * 8); } } while (0)
        GLA_VPRE(gi * 256);
#pragma unroll 1
        for (int c = 0; c < 4; ++c) {
            gsum += gla_chunk_prep<false, true>(F, P, W, QKV, gi * 256 + c * 64, hd, vpre);
            if (c < 3) { gla_prefetch<false>(F, QKV, GLR, gi * 256 + (c + 1) * 64, hd, P); GLA_VPRE(gi * 256 + (c + 1) * 64); }
            gla_state_update(F, St);
            __syncthreads();
        }
        float* sp = SBUF + ((size_t)u * 128) * 256 + 32 * w + (F.lane & 31);
#pragma unroll
        for (int db = 0; db < 4; ++db)
#pragma unroll
            for (int r = 0; r < 16; ++r) sp[(size_t)(32 * db + crow(r, h)) * 256] = St[db][r];
        if ((w >> 2) == 0 && h == 0) DG[u * 128 + 32 * (w & 3) + (F.lane & 31)] = __expf(gsum);
    }
}
__device__ __forceinline__ void gla_g2(const Frame& F0, float* __restrict__ SBUF, const float* __restrict__ DG) {
    const Frame F = opaque(F0);
    for (int e = F.vcu * NTHR + F.tid; e < 4 * 128 * 256; e += F.G * NTHR) {
        const int hd = e >> 15, d = (e >> 8) & 127;
        float run = 0.f;
#pragma unroll 1
        for (int g0 = 0; g0 < 64; g0 += 8) {
            float tmp[8], dec[8];
#pragma unroll
            for (int k = 0; k < 8; ++k) { const int g = g0 + k; tmp[k] = SBUF[(size_t)(g * 4 + hd) * 32768 + (e & 32767)]; dec[k] = DG[(g * 4 + hd) * 128 + d]; }
#pragma unroll
            for (int k = 0; k < 8; ++k) { const int g = g0 + k; SBUF[(size_t)(g * 4 + hd) * 32768 + (e & 32767)] = run; run = dec[k] * run + tmp[k]; }
        }
    }
}
__device__ __forceinline__ void gla_g3(const Frame& F0, const bf16_t* __restrict__ QKV, const float* __restrict__ GLR, const float* __restrict__ wupg, const float* __restrict__ bgg,
                                       const float* __restrict__ SBUF, const float* __restrict__ og, bf16_t* __restrict__ MIX) {
    const Frame F = opaque(F0);
    LAS unsigned char* lds = F.lds;
    const int h = F.lane >> 5, w = F.wave, l31 = F.lane & 31;
    for (int u = F.vcu; u < 256; u += F.G) {
        const int gi = u >> 2, hd = u & 3;
        GlaW W; gla_load_w(wupg, bgg, hd, F, W);
        f32x16 St[4];
        { const float* sp = SBUF + ((size_t)u * 128) * 256 + 32 * w + l31;
#pragma unroll
          for (int db = 0; db < 4; ++db)
#pragma unroll
              for (int r = 0; r < 16; ++r) St[db][r] = sp[(size_t)(32 * db + crow(r, h)) * 256]; }
#pragma unroll 1
        for (int c = 0; c < 4; ++c) {
            const int t0 = gi * 256 + c * 64;
            { GlaPre P; gla_prefetch<true>(F, QKV, GLR, t0, hd, P); u32x4 vdum[4]; (void)gla_chunk_prep<true, false>(F, P, W, QKV, t0, hd, vdum); }
            if (w < 3) {
                const int ib = (w >= 1), jb = (w == 2);
                f32x16 acc;
#pragma unroll
                for (int r = 0; r < 16; ++r) acc[r] = 0.f;
#pragma unroll
                for (int s = 0; s < 8; ++s) {
                    const bf16x8 a = *(const LAS bf16x8*)(lds + GL_QD + off_b(32 * ib + l31, 2 * s + h));
                    const bf16x8 b = *(const LAS bf16x8*)(lds + GL_KI + off_b(32 * jb + l31, 2 * s + h));
                    acc = MFMA32(a, b, acc);
                }
                const int jabs = 32 * jb + l31;
#pragma unroll
                for (int r = 0; r < 16; ++r) { const int iabs = 32 * ib + crow(r, h); const float pv = (jabs <= iabs) ? acc[r] : 0.f;
                    *(LAS unsigned short*)(lds + GL_P + iabs * GL_PST + 2 * jabs) = (unsigned short)(cvtpk(pv, 0.f) & 0xffffu); }
            }
            f32x16 oT[2];
#pragma unroll
            for (int ib = 0; ib < 2; ++ib)
#pragma unroll
                for (int r = 0; r < 16; ++r) oT[ib][r] = 0.f;
#pragma unroll
            for (int db = 0; db < 4; ++db)
#pragma unroll
                for (int s = 0; s < 2; ++s) {
                    u32x4 pk; pk.x = cvtpk(St[db][8 * s + 0], St[db][8 * s + 1]); pk.y = cvtpk(St[db][8 * s + 2], St[db][8 * s + 3]); pk.z = cvtpk(St[db][8 * s + 4], St[db][8 * s + 5]); pk.w = cvtpk(St[db][8 * s + 6], St[db][8 * s + 7]);
                    const bf16x8 xa = __builtin_bit_cast(bf16x8, pk);
#pragma unroll
                    for (int ib = 0; ib < 2; ++ib) {
                        const u32x2 qlo = *(const LAS u32x2*)(lds + GL_QD + off_b(32 * ib + l31, 4 * db + 2 * s + 0) + 8 * h);
                        const u32x2 qhi = *(const LAS u32x2*)(lds + GL_QD + off_b(32 * ib + l31, 4 * db + 2 * s + 1) + 8 * h);
                        u32x4 qq; qq.x = qlo.x; qq.y = qlo.y; qq.z = qhi.x; qq.w = qhi.y;
                        oT[ib] = MFMA32(xa, __builtin_bit_cast(bf16x8, qq), oT[ib]);
                    }
                }
            __syncthreads();
            {
                const LAS unsigned char* vimg = lds + GL_V + (w >> 2) * GL_IMG;
#pragma unroll
                for (int ks = 0; ks < 4; ++ks) {
                    const s16x4 vlo = vtr(vimg + tr_addr(F.lane, w & 3, 16 * ks + 8 * h)), vhi = vtr(vimg + tr_addr(F.lane, w & 3, 16 * ks + 8 * h + 4));
                    const bf16x8 va = __builtin_shufflevector(vlo, vhi, 0, 1, 2, 3, 4, 5, 6, 7);
#pragma unroll
                    for (int ib = 0; ib < 2; ++ib) {
                        if (ib == 0 && ks >= 2) continue;
                        const int irow = 32 * ib + l31;
                        const bf16x8 pb = *(const LAS bf16x8*)(lds + GL_P + irow * GL_PST + 16 * (2 * ks + h));
                        oT[ib] = MFMA32(va, pb, oT[ib]);
                    }
                }
            }
            float ssq[2];
#pragma unroll
            for (int ib = 0; ib < 2; ++ib) { float s = 0.f;
#pragma unroll
                for (int r = 0; r < 16; ++r) s += oT[ib][r] * oT[ib][r];
                s += __shfl_xor(s, 32); ssq[ib] = s; }
            if (h == 0) { ((LAS float*)(lds + GL_RED))[w * 64 + l31] = ssq[0]; ((LAS float*)(lds + GL_RED))[w * 64 + 32 + l31] = ssq[1]; }
            __syncthreads();
#pragma unroll
            for (int ib = 0; ib < 2; ++ib) {
                float tot = 0.f;
#pragma unroll
                for (int ww = 0; ww < 8; ++ww) tot += ((LAS float*)(lds + GL_RED))[ww * 64 + 32 * ib + l31];
                const float rn = 1.0f / sqrtf(tot * (1.f / 256.f) + EPS);
                const int t = t0 + 32 * ib + l31;
#pragma unroll
                for (int g = 0; g < 4; ++g) {
                    const int e0 = 32 * w + 8 * g + 4 * h;
                    const u32x2 rg = *(const u32x2*)(QKV + (size_t)t * 3072 + 2048 + hd * 256 + e0);
                    const f32x4 ogv = *(const f32x4*)(og + e0);
                    const float r0 = bflo(rg.x), r1 = bfhi(rg.x), r2 = bflo(rg.y), r3 = bfhi(rg.y);
                    const float y0 = oT[ib][4 * g + 0] * rn * ogv.x * (r0 / (1.f + __expf(-r0)));
                    const float y1 = oT[ib][4 * g + 1] * rn * ogv.y * (r1 / (1.f + __expf(-r1)));
                    const float y2 = oT[ib][4 * g + 2] * rn * ogv.z * (r2 / (1.f + __expf(-r2)));
                    const float y3 = oT[ib][4 * g + 3] * rn * ogv.w * (r3 / (1.f + __expf(-r3)));
                    u32x2 o; o.x = cvtpk(y0, y1); o.y = cvtpk(y2, y3);
                    *(u32x2*)(MIX + (size_t)t * D + hd * 256 + e0) = o;
                }
            }
            if (c < 3) gla_state_update(F, St);
            __syncthreads();
        }
    }
}
constexpr int MB_LIST_H = 516096;
__device__ __forceinline__ int mb_list_off(int n) { return 256 * (63 * n - (n * (n - 1)) / 2); }
constexpr int MB_OST = 2 * 128 * 256, MB_OSTW = 32 * 264;
constexpr int MB_PRE = MB_OST + 8 * MB_OSTW, MB_END = MB_PRE + 2064;
static_assert(MB_END <= MISC_OFF, "moba lds");

__device__ __forceinline__ void moba_m1_tile(const Frame& F, int pm, int pn, bf16_t* __restrict__ QKV, const float* __restrict__ COS, const float* __restrict__ SIN,
                                             const float* __restrict__ qg, const float* __restrict__ kg, float* __restrict__ KMEAN) {
    LAS unsigned char* lds = F.lds;
    const int which = (pn >= 4), h0 = 2 * (pn & 3);
    const int ts = F.lane >> 4, hs = (F.lane >> 3) & 1, j = F.lane & 7;
    const float* g = which ? kg : qg;
    const float gsc = which ? 1.0f : (0.08838834764831845f * 1.4426950408889634f);
    float g1[8], g2[8], a1[8], a2[8];
#pragma unroll
    for (int e = 0; e < 8; ++e) { g1[e] = g[8 * j + e] * gsc; g2[e] = g[64 + 8 * j + e] * gsc; a1[e] = 0.f; a2[e] = 0.f; }
#pragma unroll 2
    for (int it = 0; it < 8; ++it) {
        const int t = pm * 256 + (it * 8 + F.wave) * 4 + ts;
        bf16_t* p = QKV + (size_t)t * 3072 + which * 1024 + (h0 + hs) * 128 + 8 * j;
        const u32x4 ra = *(const u32x4*)p, rb = *(const u32x4*)(p + 64);
        const f32x4 c0 = *(const f32x4*)(COS + (size_t)t * 64 + 8 * j), c1 = *(const f32x4*)(COS + (size_t)t * 64 + 8 * j + 4);
        const f32x4 s0 = *(const f32x4*)(SIN + (size_t)t * 64 + 8 * j), s1 = *(const f32x4*)(SIN + (size_t)t * 64 + 8 * j + 4);
        float x1[8] = {bflo(ra.x), bfhi(ra.x), bflo(ra.y), bfhi(ra.y), bflo(ra.z), bfhi(ra.z), bflo(ra.w), bfhi(ra.w)};
        float x2[8] = {bflo(rb.x), bfhi(rb.x), bflo(rb.y), bfhi(rb.y), bflo(rb.z), bfhi(rb.z), bflo(rb.w), bfhi(rb.w)};
        const float cs[8] = {c0.x, c0.y, c0.z, c0.w, c1.x, c1.y, c1.z, c1.w};
        const float sn[8] = {s0.x, s0.y, s0.z, s0.w, s1.x, s1.y, s1.z, s1.w};
        float ss = 0.f;
#pragma unroll
        for (int e = 0; e < 8; ++e) ss += x1[e] * x1[e] + x2[e] * x2[e];
        ss += __shfl_xor(ss, 1); ss += __shfl_xor(ss, 2); ss += __shfl_xor(ss, 4);
        const float r = 1.0f / sqrtf(ss * (1.f / 128.f) + EPS);
        float o1[8], o2[8];
#pragma unroll
        for (int e = 0; e < 8; ++e) { const float y1 = x1[e] * r * g1[e], y2 = x2[e] * r * g2[e]; o1[e] = y1 * cs[e] - y2 * sn[e]; o2[e] = y2 * cs[e] + y1 * sn[e]; a1[e] += o1[e]; a2[e] += o2[e]; }
        u32x4 wa, wb;
        wa.x = cvtpk(o1[0], o1[1]); wa.y = cvtpk(o1[2], o1[3]); wa.z = cvtpk(o1[4], o1[5]); wa.w = cvtpk(o1[6], o1[7]);
        wb.x = cvtpk(o2[0], o2[1]); wb.y = cvtpk(o2[2], o2[3]); wb.z = cvtpk(o2[4], o2[5]); wb.w = cvtpk(o2[6], o2[7]);
        *(u32x4*)p = wa; *(u32x4*)(p + 64) = wb;
    }
    if (which) {
#pragma unroll
        for (int e = 0; e < 8; ++e) { a1[e] += __shfl_xor(a1[e], 16); a1[e] += __shfl_xor(a1[e], 32); a2[e] += __shfl_xor(a2[e], 16); a2[e] += __shfl_xor(a2[e], 32); }
        LAS float* red = (LAS float*)lds;
        if (ts == 0) {
#pragma unroll
            for (int e = 0; e < 8; ++e) { red[(F.wave * 2 + hs) * 128 + 8 * j + e] = a1[e]; red[(F.wave * 2 + hs) * 128 + 64 + 8 * j + e] = a2[e]; } }
        __syncthreads();
        if (F.tid < 256) { const int hh = F.tid >> 7, d = F.tid & 127; float s = 0.f;
#pragma unroll
            for (int w = 0; w < 8; ++w) s += red[(w * 2 + hh) * 128 + d];
            KMEAN[((size_t)(h0 + hh) * 64 + pm) * 128 + d] = s * (1.f / 256.f); }
        __syncthreads();
    }
}
__device__ __forceinline__ void moba_m1_tail(const Frame& F0, int G, int c, bf16_t* __restrict__ QKV, const float* __restrict__ COS, const float* __restrict__ SIN,
                                             const float* __restrict__ qg, const float* __restrict__ kg, float* __restrict__ KMEAN) {
    const Frame F = opaque(F0);
    pg8::StaticOrder So; So.init(S, 3072, G, c);
#pragma unroll 1
    for (int i = 0; i < 3; ++i) {
        pg8::Unit u; if (!So.next(i, u)) break;
        if (u.pn < 8) moba_m1_tile(F, u.pm, u.pn, QKV, COS, SIN, qg, kg, KMEAN);
    }
}
#define MB_INS(v, i) do { const float v_ = (v); const int i_ = (i); \
    const bool b0_ = v_ > v0 || (v_ == v0 && i_ < i0), b1_ = v_ > v1 || (v_ == v1 && i_ < i1), b2_ = v_ > v2 || (v_ == v2 && i_ < i2); \
    if (b0_) { v2 = v1; i2 = i1; v1 = v0; i1 = i0; v0 = v_; i0 = i_; } else if (b1_) { v2 = v1; i2 = i1; v1 = v_; i1 = i_; } else if (b2_) { v2 = v_; i2 = i_; } } while (0)
__device__ __forceinline__ void moba_m2(const Frame& F0, const bf16_t* __restrict__ QKV, const float* __restrict__ KMEAN, unsigned* __restrict__ gcnt, int* __restrict__ LIST) {
    const Frame F = opaque(F0);
    LAS unsigned char* lds = F.lds;
    LAS int* cntl = (LAS int*)lds;
    LAS float* kml = (LAS float*)(lds + 1024);
    const int h2 = F.lane >> 5, l31 = F.lane & 31, w = F.wave;
    for (int u = F.vcu; u < 512; u += F.G) {
        const int b = u >> 3, h = u & 7;
        if (b == 0) continue;
        if (F.tid < 64) cntl[F.tid] = 0;
#pragma unroll
        for (int k = 0; k < 4; ++k) { const int idx = F.tid + 512 * k, nr = idx >> 5, c4 = (idx & 31) * 4;
            if (nr < b) { const f32x4 v = *(const f32x4*)(KMEAN + ((size_t)h * 64 + nr) * 128 + c4); *(LAS f32x4*)(kml + nr * 132 + c4) = v; } }
        __syncthreads();
        const int t = b * 256 + 32 * w + l31;
        bf16x8 qf[8];
#pragma unroll
        for (int s = 0; s < 8; ++s) qf[s] = *(const bf16x8*)(QKV + (size_t)t * 3072 + h * 128 + 16 * s + 8 * h2);
        float v0 = -INFINITY, v1 = -INFINITY, v2 = -INFINITY; int i0 = 64, i1 = 64, i2 = 64;
#pragma unroll
        for (int nb = 0; nb < 2; ++nb) {
            if (nb == 1 && b <= 32) continue;
            f32x16 acc;
#pragma unroll
            for (int r = 0; r < 16; ++r) acc[r] = 0.f;
            const LAS float* kmp = kml + (32 * nb + l31) * 132 + 8 * h2;
#pragma unroll
            for (int s = 0; s < 8; ++s) {
                const f32x4 ka = *(const LAS f32x4*)(kmp + 16 * s), kb = *(const LAS f32x4*)(kmp + 16 * s + 4);
                u32x4 hi; hi.x = cvtpk(ka.x, ka.y); hi.y = cvtpk(ka.z, ka.w); hi.z = cvtpk(kb.x, kb.y); hi.w = cvtpk(kb.z, kb.w);
                u32x4 lo; lo.x = cvtpk(ka.x - bflo(hi.x), ka.y - bfhi(hi.x)); lo.y = cvtpk(ka.z - bflo(hi.y), ka.w - bfhi(hi.y));
                lo.z = cvtpk(kb.x - bflo(hi.z), kb.y - bfhi(hi.z)); lo.w = cvtpk(kb.z - bflo(hi.w), kb.w - bfhi(hi.w));
                acc = MFMA32(__builtin_bit_cast(bf16x8, hi), qf[s], acc);
                acc = MFMA32(__builtin_bit_cast(bf16x8, lo), qf[s], acc);
            }
#pragma unroll
            for (int r = 0; r < 16; ++r) { const int n = 32 * nb + crow(r, h2); const float gv = (n < b) ? acc[r] : -INFINITY; MB_INS(gv, n); }
        }
        { const float p0 = __shfl_xor(v0, 32), p1 = __shfl_xor(v1, 32), p2 = __shfl_xor(v2, 32); const int q0 = __shfl_xor(i0, 32), q1 = __shfl_xor(i1, 32), q2 = __shfl_xor(i2, 32);
          MB_INS(p0, q0); MB_INS(p1, q1); MB_INS(p2, q2); }
        int pos0 = 0, pos1 = 0, pos2 = 0;
        const bool e0 = (h2 == 0) && (v0 > -INFINITY), e1 = (h2 == 0) && (v1 > -INFINITY), e2 = (h2 == 0) && (v2 > -INFINITY);
        if (e0) pos0 = __hip_atomic_fetch_add(cntl + i0, 1, __ATOMIC_RELAXED, __HIP_MEMORY_SCOPE_WORKGROUP);
        if (e1) pos1 = __hip_atomic_fetch_add(cntl + i1, 1, __ATOMIC_RELAXED, __HIP_MEMORY_SCOPE_WORKGROUP);
        if (e2) pos2 = __hip_atomic_fetch_add(cntl + i2, 1, __ATOMIC_RELAXED, __HIP_MEMORY_SCOPE_WORKGROUP);
        __syncthreads();
        if (F.tid < 64) { const int c = cntl[F.tid]; int base = 0; if (c > 0) base = (int)__hip_atomic_fetch_add(gcnt + h * 64 + F.tid, (unsigned)c, __ATOMIC_RELAXED, __HIP_MEMORY_SCOPE_AGENT); cntl[64 + F.tid] = base; }
        __syncthreads();
        int* lst = LIST + (size_t)h * MB_LIST_H;
        if (e0) lst[mb_list_off(i0) + cntl[64 + i0] + pos0] = (t << 2) | 0;
        if (e1) lst[mb_list_off(i1) + cntl[64 + i1] + pos1] = (t << 2) | 1;
        if (e2) lst[mb_list_off(i2) + cntl[64 + i2] + pos2] = (t << 2) | 2;
        __syncthreads();
    }
}
constexpr int MB_HALF = 128 * 256;
__device__ __forceinline__ unsigned off_x(unsigned row, unsigned ch) { return 256u * row + 16u * (ch ^ (((row & 3) << 2) | ((row >> 2) & 3))); }
__device__ __forceinline__ void mb_decode(int v, const LAS int* pre, const unsigned* __restrict__ gcnt, int& h, int& n, int& count, int& lbase, bool& own) {
    if (v < 512) { n = v >> 3; h = v & 7; count = 256; lbase = 0; own = true; return; }
    const int x = v - 512; int lo_ = 0, hi_ = 511;
    while (lo_ < hi_) { const int mid = (lo_ + hi_) >> 1; if (pre[mid] > x) hi_ = mid; else lo_ = mid + 1; }
    const int hn = lo_; h = hn >> 6; n = hn & 63;
    const int tile = x - (hn ? pre[hn - 1] : 0);
    count = (int)gcnt[hn] - tile * 256; if (count > 256) count = 256;
    lbase = h * MB_LIST_H + mb_list_off(n) + tile * 256; own = false;
}
#define MB_STAGE(hh_, nn_, hf_, buf_) do { _Pragma("unroll") for (int k_ = 0; k_ < 4; ++k_) { const int pc_ = w * 4 + k_;               \
        const int r_ = 4 * pc_ + (F.lane >> 4); const int ch_ = (F.lane & 15) ^ (((r_ & 3) << 2) | ((r_ >> 2) & 3)); \
        const bf16_t* src_ = QKV + (size_t)((nn_) * 256 + (hf_) * 128 + r_) * 3072 + 1024 + (hh_) * 128 + 8 * ch_; \
        __builtin_amdgcn_global_load_lds((const unsigned*)src_, (LAS unsigned*)(lds + (buf_) * 2 * MB_HALF + pc_ * 1024), 16, 0, 0); \
        __builtin_amdgcn_global_load_lds((const unsigned*)(src_ + 1024), (LAS unsigned*)(lds + (buf_) * 2 * MB_HALF + MB_HALF + pc_ * 1024), 16, 0, 0); } } while (0)
#define MB_VMWAIT() asm volatile("s_waitcnt vmcnt(0)" ::: "memory")
#define MB_ENT(entv_, own_, nn_, cnt_, lb_) do { const int qi_ = 32 * w + l31; \
        if (own_) entv_ = (((nn_) * 256 + qi_) << 2) | 3; else entv_ = (qi_ < (cnt_)) ? LIST[(lb_) + qi_] : -1; } while (0)
#define MB_GATHER(entv_, qv_, nn_, hh_) do { \
        const int tq_ = (entv_ >= 0) ? (entv_ >> 2) : ((nn_) * 256); \
        _Pragma("unroll") for (int s_ = 0; s_ < 8; ++s_) qv_[s_] = *(const bf16x8*)(QKV + (size_t)tq_ * 3072 + (hh_) * 128 + 16 * s_ + 8 * h2); } while (0)
#define MB_COMPUTE(buf_, hf_, nkt_, own_) do { \
        const LAS unsigned char* kb_ = lds + (buf_) * 2 * MB_HALF + 256 * l31; \
        const LAS unsigned char* vb_ = lds + (buf_) * 2 * MB_HALF + MB_HALF + 256 * (4 * h2 + vq) + 8 * (vp & 1); \
        _Pragma("unroll 1") for (int kt_ = 0; kt_ < (nkt_); ++kt_) { \
            bf16x8 ka_[4]; \
            _Pragma("unroll") for (int s_ = 0; s_ < 4; ++s_) ka_[s_] = *(const LAS bf16x8*)(kb_ + kt_ * (32 * 256) + 16 * ((2 * s_ + h2) ^ fK)); \
            f32x16 acc_; _Pragma("unroll") for (int r_ = 0; r_ < 16; ++r_) acc_[r_] = 0.f; \
            _Pragma("unroll") for (int s_ = 0; s_ < 4; ++s_) acc_ = MFMA32(ka_[s_], qf[s_], acc_); \
            _Pragma("unroll") for (int s_ = 0; s_ < 4; ++s_) ka_[s_] = *(const LAS bf16x8*)(kb_ + kt_ * (32 * 256) + 16 * ((2 * (s_ + 4) + h2) ^ fK)); \
            _Pragma("unroll") for (int s_ = 0; s_ < 4; ++s_) acc_ = MFMA32(ka_[s_], qf[s_ + 4], acc_); \
            s16x4 vl0_[4], vh0_[4]; \
            _Pragma("unroll") for (int db_ = 0; db_ < 4; ++db_) { const LAS unsigned char* vp_ = vb_ + (kt_ * 32) * 256 + 64 * (db_ ^ vq); \
                vl0_[db_] = vtr(vp_ + 16 * (vj ^ h2)); vh0_[db_] = vtr(vp_ + 8 * 256 + 16 * (vj ^ (2 + h2))); } \
            float pr_[16]; \
            _Pragma("unroll") for (int r_ = 0; r_ < 16; ++r_) { float p_ = __builtin_amdgcn_exp2f(acc_[r_]); if ((own_) && (128 * (hf_) + 32 * kt_ + crow(r_, h2) > 32 * w + l31)) p_ = 0.f; pr_[r_] = p_; lsum += p_; } \
            { u32x4 pk_; pk_.x = cvtpk(pr_[0], pr_[1]); pk_.y = cvtpk(pr_[2], pr_[3]); pk_.z = cvtpk(pr_[4], pr_[5]); pk_.w = cvtpk(pr_[6], pr_[7]); \
              const bf16x8 pb_ = __builtin_bit_cast(bf16x8, pk_); \
              _Pragma("unroll") for (int db_ = 0; db_ < 4; ++db_) O[db_] = MFMA32(__builtin_shufflevector(vl0_[db_], vh0_[db_], 0, 1, 2, 3, 4, 5, 6, 7), pb_, O[db_]); } \
            _Pragma("unroll") for (int db_ = 0; db_ < 4; ++db_) { const LAS unsigned char* vp_ = vb_ + (kt_ * 32 + 16) * 256 + 64 * (db_ ^ vq); \
                vl0_[db_] = vtr(vp_ + 16 * (vj ^ h2)); vh0_[db_] = vtr(vp_ + 8 * 256 + 16 * (vj ^ (2 + h2))); } \
            { u32x4 pk_; pk_.x = cvtpk(pr_[8], pr_[9]); pk_.y = cvtpk(pr_[10], pr_[11]); pk_.z = cvtpk(pr_[12], pr_[13]); pk_.w = cvtpk(pr_[14], pr_[15]); \
              const bf16x8 pb_ = __builtin_bit_cast(bf16x8, pk_); \
              _Pragma("unroll") for (int db_ = 0; db_ < 4; ++db_) O[db_] = MFMA32(__builtin_shufflevector(vl0_[db_], vh0_[db_], 0, 1, 2, 3, 4, 5, 6, 7), pb_, O[db_]); } } } while (0)
template <int MODE  >
__device__ __forceinline__ void moba_m3(const Frame& F0, const bf16_t* __restrict__ QKV, const unsigned* __restrict__ gcnt, const int* __restrict__ LIST,
                                        bf16_t* __restrict__ OPART01, bf16_t* __restrict__ OPART2, bf16_t* __restrict__ MIX, float* __restrict__ LPART) {
    const Frame F = opaque(F0);
    LAS unsigned char* lds = F.lds;
    LAS int* pre = (LAS int*)(lds + MB_PRE);
    const int h2 = F.lane >> 5, l31 = F.lane & 31, w = F.wave;
    const int fK = ((l31 & 3) << 2) | ((l31 >> 2) & 3);
    const int vq = (F.lane & 15) >> 2, vp = F.lane & 3, vj = 2 * ((F.lane >> 4) & 1) + (vp >> 1);
    { int v = ((int)gcnt[F.tid] + 255) >> 8; pre[F.tid] = v; __syncthreads();
#pragma unroll 1
      for (int o = 1; o < 512; o <<= 1) { const int add = (F.tid >= o) ? pre[F.tid - o] : 0; __syncthreads(); pre[F.tid] += add; __syncthreads(); } }
    const int total = 512 + pre[511];
    const int u_lo = MODE ? 0 : 512, u_hi = MODE ? 512 : total;
    const int n_units = (u_hi - u_lo - F.vcu + F.G - 1) / F.G;
    if (n_units <= 0) return;
#define MB_UNIT_V(it_) (u_lo + F.vcu + (it_) * F.G)
    int h, n, count, lbase; bool own;
    mb_decode(MB_UNIT_V(0), pre, gcnt, h, n, count, lbase, own);
    int ent; bf16x8 qf[8];
    MB_ENT(ent, own, n, count, lbase);
    MB_GATHER(ent, qf, n, h);
    MB_STAGE(h, n, 0, 0);
    MB_VMWAIT();
    __syncthreads();
#pragma unroll 1
    for (int it = 0; it < n_units; ++it) {
        f32x16 O[4];
#pragma unroll
        for (int db = 0; db < 4; ++db)
#pragma unroll
            for (int r = 0; r < 16; ++r) O[db][r] = 0.f;
        float lsum = 0.f;
        MB_STAGE(h, n, 1, 1);
        { const int nkt = own ? ((w + 1 < 4) ? (w + 1) : 4) : 4; MB_COMPUTE(0, 0, nkt, own); }
        const bool more = (it + 1 < n_units);
        int h_n = h, n_n = n, count_n = count, lbase_n = lbase; bool own_n = own;
        int ent_n = -1;
        if (more) { mb_decode(MB_UNIT_V(it + 1), pre, gcnt, h_n, n_n, count_n, lbase_n, own_n); MB_ENT(ent_n, own_n, n_n, count_n, lbase_n); }
        MB_VMWAIT();
        __syncthreads();
        if (more) MB_STAGE(h_n, n_n, 0, 0);
        { const int nkt = own ? ((w >= 4) ? (w - 3) : 0) : 4; MB_COMPUTE(1, 1, nkt, own); }
        const int ent_c = ent, h_c = h;
        if (more) MB_GATHER(ent_n, qf, n_n, h_n);
        lsum += __shfl_xor(lsum, 32);
        if (MODE == 0) { if (ent_c >= 0 && h2 == 0) LPART[((size_t)(ent_c & 3) * S + (ent_c >> 2)) * 8 + h_c] = lsum; }
        float linv = 0.f;
        if (MODE == 1) {
            const int tq = ent_c >> 2, nsel = (tq >> 8) < 3 ? (tq >> 8) : 3; float lt = lsum;
#pragma unroll
            for (int sl = 0; sl < 3; ++sl) if (sl < nsel) lt += LPART[((size_t)sl * S + tq) * 8 + h_c];
            linv = 1.f / lt;
        }
        __syncthreads();
        {
            LAS unsigned char* ost = lds + MB_OST + w * MB_OSTW;
#pragma unroll
            for (int db = 0; db < 4; ++db)
#pragma unroll
                for (int g = 0; g < 4; ++g) { u32x2 o; o.x = cvtpk(O[db][4 * g + 0], O[db][4 * g + 1]); o.y = cvtpk(O[db][4 * g + 2], O[db][4 * g + 3]);
                    *(LAS u32x2*)(ost + l31 * 264 + 2 * (32 * db + 8 * g + 4 * h2)) = o; }
            asm volatile("s_waitcnt lgkmcnt(0)" ::: "memory");
#pragma unroll
            for (int i = 0; i < 8; ++i) {
                const int row = 4 * i + (F.lane >> 4), ch = F.lane & 15;
                const int er = __shfl(ent_c, row);
                const u32x4 v = *(const LAS u32x4*)(ost + row * 264 + 16 * ch);
                if (MODE == 0) {
                    if (er >= 0) { const int sl = er & 3, tq = er >> 2;
                        bf16_t* dst = ((sl == 2) ? (OPART2 + (size_t)tq * D) : (OPART01 + ((size_t)sl * S + tq) * D)) + h_c * 128 + 8 * ch;
                        *(u32x4*)dst = v; }
                } else {
                    const float li = __shfl(linv, row);
                    const int tq = er >> 2, nsel = (tq >> 8) < 3 ? (tq >> 8) : 3;
                    float o[8] = {bflo(v.x), bfhi(v.x), bflo(v.y), bfhi(v.y), bflo(v.z), bfhi(v.z), bflo(v.w), bfhi(v.w)};
#pragma unroll
                    for (int sl = 0; sl < 3; ++sl) if (sl < nsel) {
                        const u32x4 p = *(const u32x4*)(((sl == 2) ? (OPART2 + (size_t)tq * D) : (OPART01 + ((size_t)sl * S + tq) * D)) + h_c * 128 + 8 * ch);
                        o[0] += bflo(p.x); o[1] += bfhi(p.x); o[2] += bflo(p.y); o[3] += bfhi(p.y); o[4] += bflo(p.z); o[5] += bfhi(p.z); o[6] += bflo(p.w); o[7] += bfhi(p.w); }
                    u32x4 r; r.x = cvtpk(o[0] * li, o[1] * li); r.y = cvtpk(o[2] * li, o[3] * li); r.z = cvtpk(o[4] * li, o[5] * li); r.w = cvtpk(o[6] * li, o[7] * li);
                    *(u32x4*)(MIX + (size_t)tq * D + h_c * 128 + 8 * ch) = r;
                }
            }
        }
        if (more) { h = h_n; n = n_n; count = count_n; lbase = lbase_n; own = own_n; ent = ent_n; }
        MB_VMWAIT();
        __syncthreads();
    }
#undef MB_UNIT_V
}
__device__ __forceinline__ float wave_max(float v) {
#pragma unroll
    for (int o = 1; o < 64; o <<= 1) v = fmaxf(v, __shfl_xor(v, o));
    return v;
}
__device__ __forceinline__ float logsigmoid_f(float x) { return fminf(x, 0.f) - log1pf(expf(-fabsf(x))); }
__global__ void nk_gla_gate(const float* __restrict__ glr, const float* __restrict__ wup, const float* __restrict__ bg, float* __restrict__ g) {
    const size_t idx = (size_t)blockIdx.x * blockDim.x + threadIdx.x;
    const int t = (int)(idx >> 9), j = (int)(idx & 511);
    float acc = bg[j];
#pragma unroll
    for (int r = 0; r < 16; ++r) acc += glr[(size_t)t * 16 + r] * wup[r * 512 + j];
    g[idx] = logsigmoid_f(acc) * (1.f / 16.f);
}
__global__ __launch_bounds__(256) void nk_gla_recur(const bf16_t* __restrict__ qkv, const float* __restrict__ g, float* __restrict__ o) {
    __shared__ float sq[16][128], sk[16][128], sa[16][128];
    const int h = blockIdx.x, tid = threadIdx.x;
    float St[128];
#pragma unroll
    for (int d = 0; d < 128; ++d) St[d] = 0.f;
    const float qs = 0.08838834764831845f;
    for (int t0 = 0; t0 < S; t0 += 16) {
        float vv[16];
#pragma unroll
        for (int tt = 0; tt < 16; ++tt) vv[tt] = bf2f(qkv[(size_t)(t0 + tt) * 3072 + 1024 + h * 256 + tid]);
#pragma unroll
        for (int i = 0; i < 8; ++i) {
            const int e = tid + i * 256, tok = e >> 7, d = e & 127;
            const bf16_t* row = qkv + (size_t)(t0 + tok) * 3072;
            sq[tok][d] = bf2f(row[h * 128 + d]) * qs;
            sk[tok][d] = bf2f(row[512 + h * 128 + d]);
            sa[tok][d] = expf(g[(size_t)(t0 + tok) * 512 + h * 128 + d]);
        }
        __syncthreads();
#pragma unroll 1
        for (int tt = 0; tt < 16; ++tt) {
            const float v = vv[0];
#pragma unroll
            for (int i = 0; i < 15; ++i) vv[i] = vv[i + 1];
            float acc = 0.f;
#pragma unroll
            for (int d = 0; d < 128; ++d) { St[d] = sa[tt][d] * St[d] + sk[tt][d] * v; acc += sq[tt][d] * St[d]; }
            o[(size_t)(t0 + tt) * D + h * 256 + tid] = acc;
        }
        __syncthreads();
    }
}
__global__ __launch_bounds__(256) void nk_gla_post(const float* __restrict__ o, const bf16_t* __restrict__ qkv, const float* __restrict__ og, bf16_t* __restrict__ mix) {
    const int w = blockIdx.x * 4 + (threadIdx.x >> 6), lane = threadIdx.x & 63;
    const int t = w >> 2, h = w & 3;
    f32x4 v = *(const f32x4*)(o + (size_t)t * D + h * 256 + lane * 4);
    const float ss = wave_sum(v.x * v.x + v.y * v.y + v.z * v.z + v.w * v.w);
    const float r = 1.0f / sqrtf(ss * (1.f / 256.f) + EPS);
    const f32x4 gg = *(const f32x4*)(og + lane * 4);
    const bf16_t* rp = qkv + (size_t)t * 3072 + 2048 + h * 256 + lane * 4;
    bf16_t* mp = mix + (size_t)t * D + h * 256 + lane * 4;
#pragma unroll
    for (int e = 0; e < 4; ++e) { const float rr = bf2f(rp[e]); const float y = v[e] * r * gg[e] * (rr / (1.f + expf(-rr))); mp[e] = (bf16_t)(cvtpk(y, 0.f) & 0xffffu); }
}
__global__ __launch_bounds__(256) void nk_moba_qk(bf16_t* __restrict__ qkv, const int* __restrict__ pos, const float* __restrict__ qg, const float* __restrict__ kg) {
    const int w = blockIdx.x * 4 + (threadIdx.x >> 6), lane = threadIdx.x & 63;
    const int t = w >> 4, which = (w >> 3) & 1, h = w & 7;
    bf16_t* p = qkv + (size_t)t * 3072 + which * 1024 + h * 128;
    const float* g = which ? kg : qg;
    float t1 = bf2f(p[lane]), t2 = bf2f(p[lane + 64]);
    const float ss = wave_sum(t1 * t1 + t2 * t2);
    const float r = 1.0f / sqrtf(ss * (1.f / 128.f) + EPS);
    t1 = t1 * r * g[lane]; t2 = t2 * r * g[lane + 64];
    const float inv_freq = (float)exp2(-(double)lane * (13.287712379549449 / 64.0));
    const float angf = (float)pos[t] * inv_freq;
    float cs, sn; sincos_acc((double)angf, sn, cs);
    p[lane] = (bf16_t)(cvtpk(t1 * cs - t2 * sn, 0.f) & 0xffffu);
    p[lane + 64] = (bf16_t)(cvtpk(t2 * cs + t1 * sn, 0.f) & 0xffffu);
}
__global__ __launch_bounds__(128) void nk_moba_kmean(const bf16_t* __restrict__ qkv, float* __restrict__ kmean) {
    const int h = blockIdx.x >> 6, n = blockIdx.x & 63, d = threadIdx.x;
    float acc = 0.f;
    for (int j = 0; j < 256; ++j) acc += bf2f(qkv[(size_t)(n * 256 + j) * 3072 + 1024 + h * 128 + d]);
    kmean[(size_t)blockIdx.x * 128 + d] = acc * (1.f / 256.f);
}
__global__ __launch_bounds__(64) void nk_moba_attn(const bf16_t* __restrict__ qkv, const float* __restrict__ kmean, bf16_t* __restrict__ out) {
    __shared__ float sq[128];
    __shared__ float sp[1024];
    __shared__ int skey[1024];
    const int t = blockIdx.x >> 3, h = blockIdx.x & 7, lane = threadIdx.x;
    const bf16_t* qp = qkv + (size_t)t * 3072 + h * 128;
    sq[lane] = bf2f(qp[lane]); sq[lane + 64] = bf2f(qp[lane + 64]);
    __syncthreads();
    const int own = t >> 8;
    float gate = -INFINITY;
    if (lane < own) {
        const float* km = kmean + ((size_t)h * 64 + lane) * 128;
        float a = 0.f;
        for (int d = 0; d < 128; ++d) a += sq[d] * km[d];
        gate = a;
    }
    int s0 = -1, s1 = -1, s2 = -1;
#pragma unroll
    for (int j = 0; j < 3; ++j) {
        const float m = wave_max(gate);
        int idx = -1;
        if (m > -INFINITY) { const unsigned long long b = __ballot(gate == m); idx = __ffsll((long long)b) - 1; }
        if (j == 0) s0 = idx; else if (j == 1) s1 = idx; else s2 = idx;
        if (lane == idx) gate = -INFINITY;
    }
    int nk = 0;
    if (s0 >= 0) { for (int i = lane; i < 256; i += 64) skey[nk + i] = s0 * 256 + i; nk += 256; }
    if (s1 >= 0) { for (int i = lane; i < 256; i += 64) skey[nk + i] = s1 * 256 + i; nk += 256; }
    if (s2 >= 0) { for (int i = lane; i < 256; i += 64) skey[nk + i] = s2 * 256 + i; nk += 256; }
    const int nown = t - own * 256 + 1;
    for (int i = lane; i < nown; i += 64) skey[nk + i] = own * 256 + i;
    nk += nown;
    __syncthreads();
    const float scale = 0.08838834764831845f;
    float mx = -INFINITY;
    for (int i = lane; i < nk; i += 64) {
        const bf16_t* kp = qkv + (size_t)skey[i] * 3072 + 1024 + h * 128;
        float a = 0.f;
        for (int d = 0; d < 128; d += 8) { const u32x4 kk = *(const u32x4*)(kp + d);
            a += sq[d] * bflo(kk.x) + sq[d + 1] * bfhi(kk.x) + sq[d + 2] * bflo(kk.y) + sq[d + 3] * bfhi(kk.y) + sq[d + 4] * bflo(kk.z) + sq[d + 5] * bfhi(kk.z) + sq[d + 6] * bflo(kk.w) + sq[d + 7] * bfhi(kk.w); }
        a *= scale; sp[i] = a; mx = fmaxf(mx, a);
    }
    mx = wave_max(mx);
    float sum = 0.f;
    for (int i = lane; i < nk; i += 64) { const float p = expf(sp[i] - mx); sp[i] = p; sum += p; }
    sum = wave_sum(sum);
    __syncthreads();
    float o0 = 0.f, o1 = 0.f;
    for (int i = 0; i < nk; ++i) {
        const bf16_t* vp = qkv + (size_t)skey[i] * 3072 + 2048 + h * 128;
        const float p = sp[i];
        o0 += p * bf2f(vp[lane]); o1 += p * bf2f(vp[lane + 64]);
    }
    const float inv = 1.f / sum;
    out[(size_t)t * D + h * 128 + lane] = (bf16_t)(cvtpk(o0 * inv, 0.f) & 0xffffu);
    out[(size_t)t * D + h * 128 + lane + 64] = (bf16_t)(cvtpk(o1 * inv, 0.f) & 0xffffu);
}
constexpr int PH_PER_LAYER = 10, PH_L0 = 2, N_PHASES = PH_L0 + DEPTH * PH_PER_LAYER;
__global__ void __launch_bounds__(NTHR, 2) mega(MegaArgs args) {
    extern __shared__ __attribute__((aligned(16))) unsigned char lds_raw[];
    Frame F;
    F.lds = (LAS unsigned char*)lds_raw;
    F.tid = threadIdx.x; F.lane = F.tid & 63; F.wave = __builtin_amdgcn_readfirstlane(F.tid >> 6);
    F.G = gridDim.x; { const int bx = blockIdx.x; F.vcu = (F.G % 8 == 0) ? (bx % 8) * (F.G / 8) + bx / 8 : bx; }
    volatile LAS unsigned* MISC = (volatile LAS unsigned*)(F.lds + MISC_OFF);
    unsigned char* ws = args.ws;
    unsigned* ctl = (unsigned*)(ws + WS_CTL);
    for (int u = F.tid; u < (LDS_BYTES - MISC_OFF) / 4; u += NTHR) ((LAS unsigned*)(F.lds + MISC_OFF))[u] = 0u;
    __syncthreads();
    XcdBarrier bar = xcd_barrier_post(ctl + CW_BAR, MISC + 8);
    const int lo = args.ph_lo, hi = args.ph_hi;
#define IN(k) (lo <= (k) && (k) < hi)
#define SEAM(k) do { if (lo <= (k) && (k) + 1 < hi) xcd_barrier(bar); } while (0)
    const float* mod = (const float*)(ws + WS_MOD);
    bf16_t* H = (bf16_t*)(ws + WS_H); bf16_t* MIX = (bf16_t*)(ws + WS_MIX); bf16_t* QKV = (bf16_t*)(ws + WS_QKV); bf16_t* HID = (bf16_t*)(ws + WS_HID);
    float* xout = args.out;
    bf16_t* XB = (bf16_t*)(ws + WS_XB);

    if (IN(0)) { p0_prologue(F, args); }
    if (lo < 0) cg::this_grid().sync();
    if (lo <= 0 && 1 < hi) xcd_barrier(bar);
    if (IN(1)) { norm_phase(F, args.in[0], args.in[5], mod + D, mod, H); }
    SEAM(1);
#pragma unroll 1
    for (int L = 0; L < DEPTH; ++L) {
        const int pb = PH_L0 + L * PH_PER_LAYER, j = L >> 1;
        const float* m = mod + (size_t)L * 6 * D;
        if (pb + PH_PER_LAYER <= lo || pb >= hi) continue;
        if ((L & 1) == 0) {
            if (IN(pb + 0)) {
                pg8::Gemm g{H, (const bf16_t*)(ws + WS_WGIN) + (size_t)j * 3072 * D, S, 3072, D}; pg8::StaticOrder So; So.init(S, 3072, F.G, (int)blockIdx.x);
                pg8::EpiBf16<0> E{QKV, 3072};
                pg8::gemm_phase<pg8::EpiBf16<0>, pg8::StaticOrder, true, true>(F.lds, g, So, E);
                glr_phase(F, H, (const bf16_t*)(ws + WS_WGLR) + (size_t)j * 16 * D, (float*)(ws + WS_GLR));
            }
            SEAM(pb + 0);
        } else {
            if (IN(pb + 0)) {
                pg8::Gemm g{H, (const bf16_t*)(ws + WS_WMIN) + (size_t)j * 3072 * D, S, 3072, D}; pg8::StaticOrder So; So.init(S, 3072, F.G, (int)blockIdx.x);
                pg8::EpiBf16<0> E{QKV, 3072};
                pg8::gemm_phase<pg8::EpiBf16<0>, pg8::StaticOrder, true, true>(F.lds, g, So, E);
                asm volatile("s_waitcnt vmcnt(0)" ::: "memory"); __syncthreads();
                moba_m1_tail(F, F.G, (int)blockIdx.x, QKV, (const float*)(args.ws + WS_COS), (const float*)(args.ws + WS_SIN), args.in[13] + (size_t)j * 128, args.in[14] + (size_t)j * 128, (float*)(args.ws + WS_KMEAN));
            }
            SEAM(pb + 0);
        }
        if ((L & 1) == 0) {
            unsigned char* ws = args.ws; asm volatile("" : "+s"(ws));
            const float* wupg = args.in[8] + (size_t)j * 16 * 512; const float* bgg = args.in[9] + (size_t)j * 512;
            if (IN(pb + 1)) gla_g1(F, QKV, (const float*)(ws + WS_GLR), wupg, bgg, (float*)(ws + WS_SBUF), (float*)(ws + WS_DG));
            SEAM(pb + 1);
            if (IN(pb + 2)) gla_g2(F, (float*)(ws + WS_SBUF), (const float*)(ws + WS_DG));
            SEAM(pb + 2);
            if (IN(pb + 3)) gla_g3(F, QKV, (const float*)(ws + WS_GLR), wupg, bgg, (const float*)(ws + WS_SBUF), args.in[10] + (size_t)j * 256, MIX);
            if (lo <= pb + 3 && pb + 5 < hi) xcd_barrier(bar);
        } else {
            unsigned char* ws = args.ws; asm volatile("" : "+s"(ws));
            unsigned* gcnt = (unsigned*)(ws + WS_CTL) + CW_MCNT + j * 512;
            if (IN(pb + 2)) moba_m2(F, QKV, (const float*)(ws + WS_KMEAN), gcnt, (int*)(ws + WS_LIST));
            SEAM(pb + 2);
            if (IN(pb + 3)) moba_m3<0>(F, QKV, gcnt, (const int*)(ws + WS_LIST), (bf16_t*)xout, (bf16_t*)(ws + WS_AUX), MIX, (float*)(ws + WS_LPART));
            SEAM(pb + 3);
            if (IN(pb + 4)) moba_m3<1>(F, QKV, gcnt, (const int*)(ws + WS_LIST), (bf16_t*)xout, (bf16_t*)(ws + WS_AUX), MIX, (float*)(ws + WS_LPART));
            SEAM(pb + 4);
        }
        if (IN(pb + 5)) {
            const bf16_t* wo = ((L & 1) == 0) ? (const bf16_t*)(ws + WS_WGOUT) + (size_t)j * D * D : (const bf16_t*)(ws + WS_WMOUT) + (size_t)j * D * D;
            pg8::Gemm g{MIX, wo, S, D, D}; pg8::StaticOrder So; So.init(S, D, F.G, (int)blockIdx.x);
            if (L == 0) {
                pg8::EpiResidNorm<true> E{args.in[0], XB, D, m + 2 * D, args.in[6] + (size_t)L * D, m + 4 * D, m + 3 * D, H, (float*)(ws + WS_XBUF), ctl + CW_SEAM + (2 * L) * SEAM_BANK, ctl + CW_TMO, EPS};
                pg8::gemm_phase<pg8::EpiResidNorm<true>, pg8::StaticOrder, false, true>(F.lds, g, So, E);
            } else {
                pg8::EpiResidNorm<false> E{XB, XB, D, m + 2 * D, args.in[6] + (size_t)L * D, m + 4 * D, m + 3 * D, H, (float*)(ws + WS_XBUF), ctl + CW_SEAM + (2 * L) * SEAM_BANK, ctl + CW_TMO, EPS};
                pg8::gemm_phase<pg8::EpiResidNorm<false>, pg8::StaticOrder, false, true>(F.lds, g, So, E);
            }
        }
        SEAM(pb + 5);
        if (IN(pb + 7)) {
            pg8::Gemm g{H, (const bf16_t*)(ws + WS_W1) + (size_t)L * DFF * D, S, DFF, D}; pg8::StaticOrder So; So.init(S, DFF, F.G, (int)blockIdx.x);
            pg8::EpiBf16<1> E{HID, DFF};
            pg8::gemm_phase<pg8::EpiBf16<1>, pg8::StaticOrder, true, true>(F.lds, g, So, E);
        }
        SEAM(pb + 7);
        if (IN(pb + 8)) {
            pg8::Gemm g{HID, (const bf16_t*)(ws + WS_W2) + (size_t)L * D * DFF, S, D, DFF}; pg8::StaticOrder So; So.init(S, D, F.G, (int)blockIdx.x);
            pg8::EpiResid E{XB, xout, D, m + 5 * D};
            if (L + 1 < DEPTH) {
                const float* mn = mod + (size_t)(L + 1) * 6 * D;
                pg8::EpiResidNorm<false> EN{XB, XB, D, m + 5 * D, args.in[5] + (size_t)(L + 1) * D, mn + D, mn, H, (float*)(ws + WS_XBUF), ctl + CW_SEAM + (2 * L + 1) * SEAM_BANK, ctl + CW_TMO, EPS};
                pg8::gemm_phase<pg8::EpiResidNorm<false>, pg8::StaticOrder, false, true>(F.lds, g, So, EN);
            } else
            pg8::gemm_phase<pg8::EpiResid, pg8::StaticOrder, false, true>(F.lds, g, So, E);
        }
        if (L + 1 < DEPTH) SEAM(pb + 8);
    }
#undef IN
#undef SEAM
}
static int g_grid = 0;
static void launch_mega(MegaArgs a, int lo, int hi, hipStream_t stream) {
    a.ph_lo = lo; a.ph_hi = hi;
    (void)hipMemsetAsync((char*)a.ws + WS_CTL + CW_BAR * 4, 0, XCD_BAR_WORDS * 4, stream);
    void* params[] = {&a};
    hipError_t e = hipLaunchCooperativeKernel((const void*)mega, dim3(g_grid), dim3(NTHR), params, LDS_BYTES, stream);
    if (e != hipSuccess) fprintf(stderr, "cooperative launch failed: %s (grid %d)\n", hipGetErrorString(e), g_grid);
}
extern "C" void kernel_launch(void* const* d_in, const int* in_sizes, int n_in, void* d_out, int out_size, void* d_ws, size_t ws_size, hipStream_t stream) {
    if (g_grid == 0) {
        int dev = 0, cus = 0, per_cu = 0;
        (void)hipGetDevice(&dev);
        (void)hipDeviceGetAttribute(&cus, hipDeviceAttributeMultiprocessorCount, dev);
        (void)hipFuncSetAttribute((const void*)mega, hipFuncAttributeMaxDynamicSharedMemorySize, LDS_BYTES);
        (void)hipOccupancyMaxActiveBlocksPerMultiprocessor(&per_cu, (const void*)mega, NTHR, LDS_BYTES);
        if (per_cu < 1) { fprintf(stderr, "occupancy query says %d blocks/CU\n", per_cu); per_cu = 1; }
        g_grid = cus;
        if (ws_size < WS_END || n_in != 18) { fprintf(stderr, "bad ws_size %zu / n_in %d\n", ws_size, n_in); g_grid = -1; }
    }
    if (g_grid < 0) return;
    (void)hipMemsetAsync((char*)d_ws + WS_CTL, 0, CTL_ZERO_BYTES, stream);
    MegaArgs a{};
    for (int i = 0; i < 18; ++i) a.in[i] = (const float*)d_in[i];
    a.out = (float*)d_out; a.ws = (unsigned char*)d_ws;
    launch_mega(a, 0, N_PHASES, stream);
}
```

```cpp
#include <hip/hip_runtime.h>
#include <hip/hip_cooperative_groups.h>
#include <cstdio>
#include <cstdint>
#include <cmath>
namespace cg = cooperative_groups;
constexpr int D = 1024, S = 16384, DEPTH = 4, DFF = 4096;
constexpr int GLA_IN = 3088, MB_IN = 3072;
constexpr float EPS = 1e-6f;
#ifndef PROBE
#define PROBE 0
#endif
#ifndef TCAT
#define TCAT 0
#endif
#ifndef TBLK
#define TBLK 0
#endif
#define LAS __attribute__((address_space(3)))
#define GAS __attribute__((address_space(1)))
typedef unsigned short bf16_t;
typedef short bf16x8 __attribute__((ext_vector_type(8)));
typedef short s16x4 __attribute__((ext_vector_type(4)));
typedef float f32x4 __attribute__((ext_vector_type(4)));
typedef float f32x16 __attribute__((ext_vector_type(16)));
typedef float f32x2 __attribute__((ext_vector_type(2)));
typedef unsigned u32x4 __attribute__((ext_vector_type(4)));
typedef unsigned u32x2 __attribute__((ext_vector_type(2)));
typedef __bf16 bf16x2_t __attribute__((ext_vector_type(2)));

__device__ __forceinline__ unsigned cvtpk(float lo, float hi) { f32x2 v = {lo, hi}; bf16x2_t b = __builtin_convertvector(v, bf16x2_t); return __builtin_bit_cast(unsigned, b); }
__device__ __forceinline__ float bf2f(unsigned short b) { return __uint_as_float((unsigned)b << 16); }
__device__ __forceinline__ float bflo(unsigned w) { return __uint_as_float(w << 16); }
__device__ __forceinline__ float bfhi(unsigned w) { return __uint_as_float(w & 0xffff0000u); }

#ifndef WT_STORES
#define WT_STORES 0
#endif
__device__ __forceinline__ void st16_wt(void* p, u32x4 v) {
#if WT_STORES
    asm volatile("global_store_dwordx4 %0, %1, off sc1\n\ts_nop 1" :: "v"(p), "v"(v) : "memory");
#else
    *(u32x4*)p = v;
#endif
}
__device__ __forceinline__ void st16_wt(void* p, f32x4 v) { st16_wt(p, __builtin_bit_cast(u32x4, v)); }
namespace pg8 {
constexpr int BM = 256, BK = 64, HALF = 128, HTB = HALF * BK * 2, STAGE_BYTES = 8 * HTB, NXCD = 8, WGM = 8;
__host__ __device__ __forceinline__ int lds_byte(int r, int c) { const int st = (r >> 4) * 2 + (c >> 5), rr = r & 15, cc = c & 31, ob = rr * 64 + cc * 2; return st * 1024 + (ob ^ (((ob >> 9) & 1) << 5)); }
__host__ __device__ __forceinline__ void stage_rc(int b, int& R, int& C) { const int st = b / 1024, sb = b % 1024, swz = sb ^ (((sb >> 9) & 1) << 5); R = (st >> 1) * 16 + swz / 64; C = (st & 1) * 32 + (swz % 64) / 2; }
__host__ __device__ __forceinline__ int perm32(int rho) { const int n = rho >> 4, i = rho & 15; return 8 * (i >> 2) + 4 * n + (i & 3); }
struct Unit { int pm, pn; };
struct Gemm { const bf16_t* A; const bf16_t* Bt; int M, N, K; };
struct StaticOrder {
    int nM, nN, nwg, G, c;
    __host__ __device__ void init(int M, int N, int G_, int c_) { nM = M / BM; nN = N / BM; nwg = nM * nN; G = G_; c = c_; }
    __host__ __device__ bool next(int i, Unit& u) const {
        const long L = (long)i * G + c; if (L >= nwg) return false;
        int wgid = (int)L; { const int q = nwg / NXCD, r = nwg % NXCD, xcd = wgid % NXCD, off = wgid / NXCD; wgid = (xcd < r ? xcd * (q + 1) : r * (q + 1) + (xcd - r) * q) + off; }
        const int nig = WGM * nN, gid = wgid / nig, fm = gid * WGM, gsz = (nM - fm) < WGM ? (nM - fm) : WGM;
        u.pm = fm + ((wgid % nig) % gsz); u.pn = (wgid % nig) / gsz; return true;
    }
    __device__ __forceinline__ void a_ready(const Unit&) const {}
    __device__ __forceinline__ void done(const Unit&) const {}
};
struct MaskOrder : StaticOrder {
    __device__ bool next(int i, Unit& u) const { const bool ok = StaticOrder::next(i, u); u.pm &= 7; u.pn &= 3; return ok; }
};
template <int ACT  > struct EpiBf16 {
    static constexpr bool PERM = true, AFTER_DRAIN = false;
    bf16_t* O; int ldc;
    __device__ __forceinline__ void operator()(const f32x4 (&acc)[2][2][4][2], const Unit& u, int wr, int wc, int fr, int fq) const {
        const int row0 = u.pm * BM + wr * 64 + fr; const int col0 = u.pn * BM + wc * 32 + 8 * fq;
#pragma unroll
        for (int ai = 0; ai < 2; ++ai)
#pragma unroll
            for (int m = 0; m < 4; ++m) { bf16_t* rowp = O + (size_t)(row0 + ai * HALF + m * 16) * ldc + col0;
#pragma unroll
                for (int bj = 0; bj < 2; ++bj) { f32x4 v0 = acc[ai][bj][m][0], v1 = acc[ai][bj][m][1];
                    if (ACT == 1) {
#pragma unroll
                        for (int e = 0; e < 4; ++e) { float a = fmaxf(v0[e], 0.f); v0[e] = a * a; float b = fmaxf(v1[e], 0.f); v1[e] = b * b; } }
                    u32x4 w; w.x = cvtpk(v0[0], v0[1]); w.y = cvtpk(v0[2], v0[3]); w.z = cvtpk(v1[0], v1[1]); w.w = cvtpk(v1[2], v1[3]);
                    st16_wt(rowp + bj * HALF, w); } }
    }
};
struct EpiResid {
    static constexpr bool PERM = false, AFTER_DRAIN = false;
    const bf16_t* base; float* out; int ldc; const float* gate;
    __device__ __forceinline__ void operator()(const f32x4 (&acc)[2][2][4][2], const Unit& u, int wr, int wc, int fr, int fq) const {
        const int row0 = u.pm * BM + wr * 64 + fr, col0 = u.pn * BM + wc * 32 + 4 * fq;
        f32x4 gv[2][2];
#pragma unroll
        for (int bj = 0; bj < 2; ++bj)
#pragma unroll
            for (int n = 0; n < 2; ++n) gv[bj][n] = *(const f32x4*)(gate + col0 + bj * HALF + n * 16);
#pragma unroll
        for (int ai = 0; ai < 2; ++ai)
#pragma unroll
            for (int m = 0; m < 4; ++m) { const size_t off = (size_t)(row0 + ai * HALF + m * 16) * ldc + col0;
#pragma unroll
                for (int bj = 0; bj < 2; ++bj)
#pragma unroll
                    for (int n = 0; n < 2; ++n) { const u32x2 bb = *(const u32x2*)(base + off + bj * HALF + n * 16); const f32x4 b = {bflo(bb.x), bfhi(bb.x), bflo(bb.y), bfhi(bb.y)};
                        st16_wt(out + off + bj * HALF + n * 16, b + gv[bj][n] * acc[ai][bj][m][n]); } }
    }
};

template <bool BASE_F32> struct EpiResidNorm {
    static constexpr bool PERM = false, AFTER_DRAIN = true;
    const void* base; bf16_t* out; int ldc; const float* gate;
    const float* ng; const float* sc; const float* sh; bf16_t* H;
    float* xbuf; unsigned* cnt; unsigned* tmo; float eps;
    __device__ __forceinline__ void operator()(const f32x4 (&)[2][2][4][2], const Unit&, int, int, int, int) const {}
    __device__ __forceinline__ void fused(f32x4 (&acc)[2][2][4][2], const Unit& u, int wr, int wc, int fr, int fq, LAS unsigned char* lds, int wid, int lane) const {
        LAS float* P = (LAS float*)lds;
        LAS float* Sr = (LAS float*)(lds + 4096);
        LAS unsigned* flag = (LAS unsigned*)(lds + 4096 + 1024);
        const int row0 = u.pm * BM + wr * 64 + fr, col0 = u.pn * BM + wc * 32 + 4 * fq;
        {
            f32x4 gv[2][2];
#pragma unroll
            for (int bj = 0; bj < 2; ++bj)
#pragma unroll
                for (int n = 0; n < 2; ++n) gv[bj][n] = *(const f32x4*)(gate + col0 + bj * HALF + n * 16);
#pragma unroll
            for (int ai = 0; ai < 2; ++ai)
#pragma unroll
                for (int m = 0; m < 4; ++m) { const size_t off = (size_t)(row0 + ai * HALF + m * 16) * ldc + col0;
                    float s = 0.f;
#pragma unroll
                    for (int bj = 0; bj < 2; ++bj)
#pragma unroll
                        for (int n = 0; n < 2; ++n) { f32x4 b;
                            if constexpr (BASE_F32) b = *(const f32x4*)((const float*)base + off + bj * HALF + n * 16);
                            else { const u32x2 bb = *(const u32x2*)((const bf16_t*)base + off + bj * HALF + n * 16); b = (f32x4){bflo(bb.x), bfhi(bb.x), bflo(bb.y), bfhi(bb.y)}; }
                            const f32x4 x = b + gv[bj][n] * acc[ai][bj][m][n]; acc[ai][bj][m][n] = x;
                            { u32x2 xw; xw.x = cvtpk(x[0], x[1]); xw.y = cvtpk(x[2], x[3]); *(u32x2*)(out + off + bj * HALF + n * 16) = xw; } s += (x[0] * x[0] + x[1] * x[1]) + (x[2] * x[2] + x[3] * x[3]); }
                    s += __shfl_xor(s, 16); s += __shfl_xor(s, 32);
                    if (fq == 0) P[(ai * HALF + wr * 64 + m * 16 + fr) * 4 + wc] = s;
                    if (m & 1) asm volatile("" ::: "memory"); }
        }
        asm volatile("s_waitcnt lgkmcnt(0)" ::: "memory"); __builtin_amdgcn_s_barrier(); asm volatile("" ::: "memory");
        const int row = wid * 32 + (lane & 31);
        if (lane < 32) {
            const float tot = (P[row * 4 + 0] + P[row * 4 + 1]) + (P[row * 4 + 2] + P[row * 4 + 3]);
            __hip_atomic_store((unsigned*)xbuf + ((size_t)(u.pm * BM + row) * 4 + u.pn), __float_as_uint(tot), __ATOMIC_RELAXED, __HIP_MEMORY_SCOPE_AGENT);
        }
        asm volatile("s_waitcnt vmcnt(0)" ::: "memory");
        if (lane == 0) __hip_atomic_fetch_add(cnt + 64 * u.pm, 1u, __ATOMIC_RELAXED, __HIP_MEMORY_SCOPE_AGENT);
        if (wid == 0) {
            unsigned sp = 0; bool dead = false;
            for (;;) {
                if ((unsigned)__builtin_amdgcn_readfirstlane(__hip_atomic_load(cnt + 64 * u.pm, __ATOMIC_RELAXED, __HIP_MEMORY_SCOPE_AGENT)) >= 32u) break;
                __builtin_amdgcn_s_sleep(2);
                if (++sp > (1u << 20)) { if (lane == 0) __hip_atomic_store(tmo, 1u, __ATOMIC_RELAXED, __HIP_MEMORY_SCOPE_AGENT); dead = true; break; }
            }
            __builtin_amdgcn_fence(__ATOMIC_ACQUIRE, "agent");
            if (lane == 0) flag[0] = dead ? 1u : 0u;
        }
        asm volatile("s_waitcnt vmcnt(0) lgkmcnt(0)" ::: "memory"); __builtin_amdgcn_s_barrier(); asm volatile("" ::: "memory");
        if (lane < 32) {
            const unsigned* slot = (const unsigned*)xbuf + (size_t)(u.pm * BM + row) * 4; float t = 0.f;
#pragma unroll
            for (int k = 0; k < 4; ++k) t += __uint_as_float(__hip_atomic_load(slot + k, __ATOMIC_RELAXED, __HIP_MEMORY_SCOPE_AGENT));
            Sr[row] = 1.0f / sqrtf(t * (1.0f / 1024.0f) + eps);
        }
        asm volatile("s_waitcnt lgkmcnt(0)" ::: "memory"); __builtin_amdgcn_s_barrier(); asm volatile("" ::: "memory");
        float rs[2][4];
#pragma unroll
        for (int ai = 0; ai < 2; ++ai)
#pragma unroll
            for (int m = 0; m < 4; ++m) rs[ai][m] = Sr[ai * HALF + wr * 64 + m * 16 + fr];
#pragma unroll
        for (int bj = 0; bj < 2; ++bj)
#pragma unroll
            for (int n = 0; n < 2; ++n) { const int c = col0 + bj * HALF + n * 16;
                const f32x4 ga = *(const f32x4*)(ng + c) * (*(const f32x4*)(sc + c) + 1.0f), gb = *(const f32x4*)(sh + c);
#pragma unroll
                for (int ai = 0; ai < 2; ++ai)
#pragma unroll
                    for (int m = 0; m < 4; ++m) { const int r = ai * HALF + wr * 64 + m * 16 + fr; const size_t off = (size_t)(u.pm * BM + r) * ldc + c;
                        const f32x4 y = acc[ai][bj][m][n] * rs[ai][m] * ga + gb; u32x2 w; w.x = cvtpk(y[0], y[1]); w.y = cvtpk(y[2], y[3]);
                        *(u32x2*)(H + off) = w; } }
    }
};

template <class Epi, class Sched, bool ALIGN_EPI = false, bool SP2 = false>
__device__ __forceinline__ void gemm_phase(LAS unsigned char* lds, const Gemm g, const Sched& S, const Epi& E) {
    int tid_ = threadIdx.x; asm volatile("" : "+v"(tid_));
    const int tid = tid_, wid = __builtin_amdgcn_readfirstlane(tid >> 6), lane = tid & 63, wr = wid >> 2, wc = wid & 3, fr = lane & 15, fq = lane >> 4;
    const int K = g.K, nt = K / BK;
    unsigned voffA[2], voffB[2];
#pragma unroll
    for (int i = 0; i < 2; ++i) { int R, C; stage_rc(tid * 16 + i * 8192, R, C); const int Rb = Epi::PERM ? ((R & ~31) + perm32(R & 31)) : R;
        voffA[i] = (unsigned)(R * K + C) * 2u; voffB[i] = (unsigned)(Rb * K + C) * 2u; }
    const size_t kstep = (size_t)(BK * 2);
    const size_t hstep = (size_t)HALF * K * 2;
    const size_t tstep = 2 * hstep;
    const unsigned ldsw = (unsigned)wid * 1024u;
    const int aoff = lds_byte(wr * 64 + fr, fq * 8), boff = lds_byte(wc * 32 + fr, fq * 8);
#define PG8_SA(b, h) (((b) * 2 + (h)) * HTB)
#define PG8_SB(b, h) ((4 + (b) * 2 + (h)) * HTB)
#define PG8_STAGE(bufoff, gbase, voff) do { _Pragma("unroll") for (int _i = 0; _i < 2; ++_i) \
        __builtin_amdgcn_global_load_lds((const unsigned*)((const char*)(gbase) + (voff)[_i]), (LAS unsigned*)(lds + (bufoff) + ldsw + _i * 8192), 16, 0, 0); } while (0)
#define PG8_LDA(dst, b, h) do { _Pragma("unroll") for (int m = 0; m < 4; ++m) _Pragma("unroll") for (int k = 0; k < 2; ++k) dst[m][k] = *(const LAS bf16x8*)(lds + PG8_SA(b, h) + aoff + m * 2048 + k * 1024); } while (0)
#define PG8_LDB(dst, b, h) do { _Pragma("unroll") for (int n = 0; n < 2; ++n) _Pragma("unroll") for (int k = 0; k < 2; ++k) dst[n][k] = *(const LAS bf16x8*)(lds + PG8_SB(b, h) + boff + n * 2048 + k * 1024); } while (0)
#define PG8_MMA(ai, bj, At, Bt) do { __builtin_amdgcn_s_setprio(1); _Pragma("unroll") for (int m = 0; m < 4; ++m) _Pragma("unroll") for (int n = 0; n < 2; ++n) _Pragma("unroll") for (int k = 0; k < 2; ++k) \
        acc[ai][bj][m][n] = __builtin_amdgcn_mfma_f32_16x16x32_bf16(Bt[n][k], At[m][k], acc[ai][bj][m][n], 0, 0, 0); __builtin_amdgcn_s_setprio(0); } while (0)
#define PG8_WAIT_V(n) asm volatile("s_waitcnt vmcnt(" #n ")" ::: "memory")
#define PG8_WAIT_L(n) asm volatile("s_waitcnt lgkmcnt(" #n ")" ::: "memory")
#define PG8_BAR __builtin_amdgcn_s_barrier()
#define PG8_SCHED __builtin_amdgcn_sched_barrier(0)
    Unit cur, nxt; int ui = 0;
    if (!S.next(0, cur)) return;
    f32x4 acc[2][2][4][2];
#pragma unroll
    for (int a = 0; a < 2; ++a)
#pragma unroll
        for (int b = 0; b < 2; ++b)
#pragma unroll
            for (int m = 0; m < 4; ++m)
#pragma unroll
                for (int n = 0; n < 2; ++n) acc[a][b][m][n] = (f32x4){0.f, 0.f, 0.f, 0.f};
    bf16x8 At[4][2], B0[2][2], B1[2][2];
    const char* cA = (const char*)g.A + (size_t)cur.pm * tstep; const char* cB = (const char*)g.Bt + (size_t)cur.pn * tstep;
    S.a_ready(cur);
    if constexpr (SP2) {
        PG8_STAGE(PG8_SB(0, 0), cB, voffB); PG8_STAGE(PG8_SB(0, 1), cB + hstep, voffB); PG8_STAGE(PG8_SA(0, 0), cA, voffA); PG8_STAGE(PG8_SA(0, 1), cA + hstep, voffA);
        if (wr == 1) PG8_BAR;
        PG8_WAIT_V(2); PG8_BAR;
        PG8_STAGE(PG8_SB(1, 0), cB + kstep, voffB); PG8_STAGE(PG8_SA(1, 0), cA + kstep, voffA); PG8_STAGE(PG8_SB(1, 1), cB + hstep + kstep, voffB);
        PG8_WAIT_V(6); PG8_BAR;
    } else {
        PG8_STAGE(PG8_SB(0, 0), cB, voffB); PG8_STAGE(PG8_SA(0, 0), cA, voffA); PG8_STAGE(PG8_SB(0, 1), cB + hstep, voffB); PG8_STAGE(PG8_SA(0, 1), cA + hstep, voffA);
        if (wr == 1) PG8_BAR;
        PG8_WAIT_V(4); PG8_BAR;
        PG8_STAGE(PG8_SB(1, 0), cB + kstep, voffB); PG8_STAGE(PG8_SA(1, 0), cA + kstep, voffA); PG8_STAGE(PG8_SB(1, 1), cB + hstep + kstep, voffB);
        PG8_WAIT_V(6); PG8_BAR;
    }
    for (;;) {
        const bool has_next = S.next(ui + 1, nxt);
        const char* nA = has_next ? (const char*)g.A + (size_t)nxt.pm * tstep : cA; const char* nB = has_next ? (const char*)g.Bt + (size_t)nxt.pn * tstep : cB;
        for (int t = 0; t < nt; t += 2) {
            const bool last = (t == nt - 2);
            const char* a1 = cA + (size_t)(t + 1) * kstep;
            const char* a2 = last ? nA : cA + (size_t)(t + 2) * kstep; const char* b2 = last ? nB : cB + (size_t)(t + 2) * kstep;
            const char* a3 = a2 + kstep; const char* b3 = b2 + kstep;
            if (last && has_next) S.a_ready(nxt);
            if constexpr (SP2) {
            PG8_LDB(B0, 0, 0); PG8_LDB(B1, 0, 1); PG8_SCHED; PG8_LDA(At, 0, 0); PG8_STAGE(PG8_SA(1, 1), a1 + hstep, voffA);
            PG8_WAIT_V(8); PG8_WAIT_L(0); PG8_BAR; PG8_MMA(0, 0, At, B0); PG8_MMA(0, 1, At, B1); PG8_BAR; PG8_SCHED;
            PG8_LDA(At, 0, 1); PG8_STAGE(PG8_SB(0, 0), b2, voffB); PG8_STAGE(PG8_SB(0, 1), b2 + hstep, voffB); PG8_STAGE(PG8_SA(0, 0), a2, voffA);
            PG8_WAIT_V(8); PG8_WAIT_L(0); PG8_BAR; PG8_MMA(1, 0, At, B0); PG8_MMA(1, 1, At, B1); PG8_BAR; PG8_SCHED;
            PG8_LDB(B0, 1, 0); PG8_LDB(B1, 1, 1); PG8_SCHED; PG8_LDA(At, 1, 0); PG8_STAGE(PG8_SA(0, 1), a2 + hstep, voffA);
            PG8_WAIT_V(8); PG8_WAIT_L(0); PG8_BAR; PG8_MMA(0, 0, At, B0); PG8_MMA(0, 1, At, B1); PG8_BAR; PG8_SCHED;
            PG8_LDA(At, 1, 1); PG8_STAGE(PG8_SB(1, 0), b3, voffB); PG8_STAGE(PG8_SB(1, 1), b3 + hstep, voffB); PG8_STAGE(PG8_SA(1, 0), a3, voffA);
            PG8_WAIT_V(8); PG8_WAIT_L(0); PG8_BAR; PG8_MMA(1, 0, At, B0); PG8_MMA(1, 1, At, B1); PG8_BAR; PG8_SCHED;
            } else {
            PG8_LDB(B0, 0, 0); PG8_SCHED; PG8_LDA(At, 0, 0); PG8_STAGE(PG8_SA(1, 1), a1 + hstep, voffA);
            PG8_WAIT_L(8); PG8_BAR; PG8_WAIT_L(0); PG8_MMA(0, 0, At, B0); PG8_BAR; PG8_SCHED;
            PG8_LDB(B1, 0, 1); PG8_STAGE(PG8_SB(0, 0), b2, voffB);
            PG8_BAR; PG8_WAIT_L(0); PG8_MMA(0, 1, At, B1); PG8_BAR;
            PG8_LDA(At, 0, 1); PG8_STAGE(PG8_SA(0, 0), a2, voffA);
            PG8_BAR; PG8_WAIT_L(0); PG8_MMA(1, 0, At, B0); PG8_BAR; PG8_SCHED;
            PG8_STAGE(PG8_SB(0, 1), b2 + hstep, voffB);
            PG8_WAIT_V(6); PG8_BAR; PG8_MMA(1, 1, At, B1); PG8_BAR;
            PG8_LDB(B0, 1, 0); PG8_SCHED; PG8_LDA(At, 1, 0); PG8_STAGE(PG8_SA(0, 1), a2 + hstep, voffA);
            PG8_WAIT_L(8); PG8_BAR; PG8_WAIT_L(0); PG8_MMA(0, 0, At, B0); PG8_BAR; PG8_SCHED;
            PG8_LDB(B1, 1, 1); PG8_STAGE(PG8_SB(1, 0), b3, voffB);
            PG8_BAR; PG8_WAIT_L(0); PG8_MMA(0, 1, At, B1); PG8_BAR;
            PG8_LDA(At, 1, 1); PG8_STAGE(PG8_SA(1, 0), a3, voffA);
            PG8_BAR; PG8_WAIT_L(0); PG8_MMA(1, 0, At, B0); PG8_BAR; PG8_SCHED;
            PG8_STAGE(PG8_SB(1, 1), b3 + hstep, voffB);
            PG8_WAIT_V(6); PG8_BAR; PG8_MMA(1, 1, At, B1); PG8_BAR;
            }
        }
        if constexpr (ALIGN_EPI) { if (wr == 0) PG8_BAR; }
        if constexpr (!Epi::AFTER_DRAIN) { E(acc, cur, wr, wc, fr, fq); S.done(cur); }
        if (!has_next) break;
#pragma unroll
        for (int a = 0; a < 2; ++a)
#pragma unroll
            for (int b = 0; b < 2; ++b)
#pragma unroll
                for (int m = 0; m < 4; ++m)
#pragma unroll
                    for (int n = 0; n < 2; ++n) acc[a][b][m][n] = (f32x4){0.f, 0.f, 0.f, 0.f};
        cur = nxt; cA = nA; cB = nB; ++ui;
        if constexpr (ALIGN_EPI) { if (wr == 1) PG8_BAR; }
    }
    PG8_WAIT_V(0);
    if constexpr (!ALIGN_EPI) { if (wr == 0) PG8_BAR; }
    PG8_BAR;
    if constexpr (Epi::AFTER_DRAIN) { E.fused(acc, cur, wr, wc, fr, fq, lds, wid, lane); }
#undef PG8_SA
#undef PG8_SB
#undef PG8_STAGE
#undef PG8_LDA
#undef PG8_LDB
#undef PG8_MMA
#undef PG8_WAIT_V
#undef PG8_WAIT_L
#undef PG8_BAR
#undef PG8_SCHED
}
}

#define XB_TMO      128
#define XB_XCNT(j)  (256  + 64 * (j))
#define XB_XSUB(j)  (1280 + 64 * (j))
#define XB_XGEN(j)  (2304 + 64 * (j))
#define XB_TOP      3328
#define XB_TOPGEN   3392
#define XCD_BAR_WORDS 3456
#define XB_SPIN_CAP (1u << 18)
__device__ __forceinline__ unsigned xb_ld(unsigned* p)              { return __hip_atomic_load(p, __ATOMIC_RELAXED, __HIP_MEMORY_SCOPE_AGENT); }
__device__ __forceinline__ unsigned xb_add(unsigned* p, unsigned v) { return __hip_atomic_fetch_add(p, v, __ATOMIC_RELAXED, __HIP_MEMORY_SCOPE_AGENT); }
__device__ __forceinline__ unsigned xb_xcc_id() { return (unsigned)__builtin_amdgcn_s_getreg((3 << 11) | 20) & 0xFu; }
#define XB_SPIN(cond, bar) do { unsigned _sp = 0; while (cond) { __builtin_amdgcn_s_sleep(1); \
    if ((++_sp & 255u) == 0u) { if (xb_ld(&(bar)[XB_TMO])) break; if (_sp > XB_SPIN_CAP) { atomicAdd(&(bar)[XB_TMO], 1u); break; } } } } while (0)
struct XcdBarrier { unsigned* bar; unsigned x; volatile LAS unsigned* st; };
__device__ __forceinline__ XcdBarrier xcd_barrier_post(unsigned* bar, volatile LAS unsigned* st) {
    XcdBarrier b; b.bar = bar; b.x = xb_xcc_id(); b.st = st;
    if (threadIdx.x == 0) (void)xb_add(&bar[XB_XCNT(b.x)], 1u);
    return b;
}
__device__ __forceinline__ void xcd_barrier_complete(unsigned* bar, unsigned x, unsigned& nloc, unsigned& nx) {
    const unsigned G = gridDim.x * gridDim.y * gridDim.z;
    unsigned sum, cnt, mine, sp = 0u;
    for (;;) {
        sum = 0u; cnt = 0u; mine = 0u;
#pragma unroll
        for (unsigned j = 0; j < 16; ++j) { const unsigned c = xb_ld(&bar[XB_XCNT(j)]); sum += c; cnt += (c > 0u) ? 1u : 0u; }
        mine = xb_ld(&bar[XB_XCNT(x)]);
        if (sum == G) break;
        __builtin_amdgcn_s_sleep(1);
        if ((++sp & 255u) == 0u) { if (xb_ld(&bar[XB_TMO])) break; if (sp > XB_SPIN_CAP) { atomicAdd(&bar[XB_TMO], 1u); break; } }
    }
    nloc = mine > 0u ? mine : 1u; nx = cnt > 0u ? cnt : 1u;
}
__device__ __forceinline__ void xcd_barrier(const XcdBarrier& b) {
    asm volatile("s_waitcnt vmcnt(0)" ::: "memory");
    __syncthreads();
    if (threadIdx.x == 0) {
        unsigned* bar = b.bar; asm volatile("" : "+s"(bar));
        __builtin_amdgcn_s_waitcnt(0);
        unsigned nloc = b.st[0], nx = b.st[1];
        if (nloc == 0u) { xcd_barrier_complete(bar, b.x, nloc, nx); b.st[0] = nloc; b.st[1] = nx; }
        const unsigned old = xb_add(&bar[XB_XSUB(b.x)], 1u);
        const unsigned gen = old / nloc;
        if (old + 1u == (gen + 1u) * nloc) {
            __builtin_amdgcn_fence(__ATOMIC_RELEASE, "agent");
            asm volatile("s_waitcnt vmcnt(0)" ::: "memory");
            const unsigned og = xb_add(&bar[XB_TOP], 1u);
            const unsigned tg = og / nx;
            if (og + 1u == (tg + 1u) * nx) xb_add(&bar[XB_TOPGEN], 1u);
            else XB_SPIN(xb_ld(&bar[XB_TOPGEN]) == tg, bar);
            __builtin_amdgcn_fence(__ATOMIC_ACQUIRE, "agent");
            xb_add(&bar[XB_XGEN(b.x)], 1u);
            asm volatile("s_waitcnt vmcnt(0)" ::: "memory");
        } else {
            XB_SPIN(xb_ld(&bar[XB_XGEN(b.x)]) == gen, bar);
            __builtin_amdgcn_fence(__ATOMIC_ACQUIRE, "agent");
            asm volatile("s_waitcnt vmcnt(0)" ::: "memory");
        }
    }
    __syncthreads();
}
constexpr int NWAVES = 8, NTHR = 512;
constexpr int LDS_BYTES = 147456;
constexpr int RING_BYTES = 131072;
constexpr int MISC_OFF = LDS_BYTES - 256;
constexpr size_t MiB = 1u << 20;
constexpr size_t WS_CTL = 0, CTL_ZERO_BYTES = 1 * MiB;
constexpr size_t WS_MOD = 1 * MiB;
constexpr size_t WS_COS = 2 * MiB, WS_SIN = 6 * MiB;
constexpr size_t WS_WGIN = 10 * MiB;
constexpr size_t WS_WGLR = 22 * MiB;
constexpr size_t WS_WGOUT = 23 * MiB;
constexpr size_t WS_WMIN = 27 * MiB;
constexpr size_t WS_WMOUT = 39 * MiB;
constexpr size_t WS_W1 = 43 * MiB;
constexpr size_t WS_W2 = 75 * MiB;
constexpr size_t WS_H = 107 * MiB;
constexpr size_t WS_MIX = 139 * MiB;
constexpr size_t WS_QKV = 171 * MiB;
constexpr size_t WS_AUX = 267 * MiB;
constexpr size_t WS_HID = 171 * MiB;
constexpr size_t WS_END = 363 * MiB;
constexpr size_t WS_SBUF = WS_AUX;
constexpr size_t WS_GLR = WS_AUX + 32 * MiB;
constexpr size_t WS_DG = WS_AUX + 33 * MiB;
constexpr size_t WS_XB = WS_AUX + 64 * MiB;
constexpr size_t WS_KMEAN = WS_MOD + 128 * 1024;
constexpr size_t WS_LPART = WS_H + 1 * MiB;
constexpr size_t WS_LIST = WS_H + 4 * MiB;
constexpr int CW_BAR = 4096;
constexpr int CW_MCNT = 16384;
constexpr int CW_TMO = 0;
constexpr int CW_SEAM = 32768, SEAM_BANK = 64 * 64;
constexpr size_t WS_XBUF = WS_MOD + 512 * 1024;
struct Frame {
    LAS unsigned char* lds;
    int tid, lane, wave, vcu, G;
};
__device__ __forceinline__ Frame opaque(const Frame& F0) { Frame F = F0; int t = F0.tid; asm volatile("" : "+v"(t)); F.tid = t; F.lane = t & 63; F.wave = __builtin_amdgcn_readfirstlane(t >> 6); return F; }
__device__ __forceinline__ float wave_sum(float v) {
#pragma unroll
    for (int o = 1; o < 64; o <<= 1) v += __shfl_xor(v, o);
    return v;
}
__device__ __forceinline__ float silu_f(float x) { return x / (1.f + __expf(-x)); }
__device__ __forceinline__ void sincos_acc(double ang, float& s, float& c) {
    const double n = rint(ang * 0.15915494309189535);
    double r = fma(-n, 6.283185307179586, ang); r = fma(-n, 2.4492935982947064e-16, r);
    const double x = r * 0.25, x2 = x * x;
    const double sn = x * (1.0 + x2 * (-1.0 / 6 + x2 * (1.0 / 120 + x2 * (-1.0 / 5040 + x2 * (1.0 / 362880 + x2 * (-1.0 / 39916800 + x2 * (1.0 / 6227020800.0)))))));
    const double cs = 1.0 + x2 * (-0.5 + x2 * (1.0 / 24 + x2 * (-1.0 / 720 + x2 * (1.0 / 40320 + x2 * (-1.0 / 3628800 + x2 * (1.0 / 479001600 + x2 * (-1.0 / 87178291200.0)))))));
    const double s2 = 2 * sn * cs, c2 = 1 - 2 * sn * sn;
    s = (float)(2 * s2 * c2); c = (float)(1 - 2 * s2 * s2);
}
constexpr int TR_SCR = 64 * 65 * 4;
struct TrItem { const float* W; int ld, n_off, n_cnt, K; bf16_t* WT; int item; };
__device__ __forceinline__ void tr_load(const TrItem& t, int lane, f32x4 (&v)[16]) {
    const int nblk = (t.n_cnt + 63) >> 6, kb = t.item / nblk, nb = t.item - kb * nblk, k0 = 64 * kb, n0 = 64 * nb;
    const int c4 = (lane & 15) * 4, kr = lane >> 4;
    const bool ok = (n0 + c4) < t.n_cnt;
#pragma unroll
    for (int i = 0; i < 16; ++i) v[i] = ok ? *(const f32x4*)(t.W + (size_t)(k0 + 4 * i + kr) * t.ld + t.n_off + n0 + c4) : (f32x4){0.f, 0.f, 0.f, 0.f};
}
__device__ __forceinline__ void tr_store(const TrItem& t, int lane, const f32x4 (&v)[16], LAS float* scr) {
    const int nblk = (t.n_cnt + 63) >> 6, kb = t.item / nblk, nb = t.item - kb * nblk, k0 = 64 * kb, n0 = 64 * nb;
    const int c4 = (lane & 15) * 4, kr = lane >> 4;
#pragma unroll
    for (int i = 0; i < 16; ++i) { LAS float* s = scr + (4 * i + kr) * 65 + c4; s[0] = v[i].x; s[1] = v[i].y; s[2] = v[i].z; s[3] = v[i].w; }
    asm volatile("s_waitcnt lgkmcnt(0)" ::: "memory");
    const int c = lane & 7;
#pragma unroll
    for (int j = 0; j < 8; ++j) { const int n = (lane >> 3) + 8 * j; const LAS float* s = scr + (8 * c) * 65 + n;
        u32x4 o; o.x = cvtpk(s[0 * 65], s[1 * 65]); o.y = cvtpk(s[2 * 65], s[3 * 65]); o.z = cvtpk(s[4 * 65], s[5 * 65]); o.w = cvtpk(s[6 * 65], s[7 * 65]);
        if (n0 + n < t.n_cnt) *(u32x4*)(t.WT + (size_t)(n0 + n) * t.K + k0 + 8 * c) = o; }
    asm volatile("s_waitcnt lgkmcnt(0)" ::: "memory");
}
struct MegaArgs {
    const float* in[18]; float* out; unsigned char* ws; int ph_lo, ph_hi;
};
__device__ __forceinline__ void p0_prologue(const Frame& F0, const MegaArgs& a) {
    const Frame F = opaque(F0);
    unsigned char* ws = a.ws;
    {
        LAS float* scr = (LAS float*)(F.lds + F.wave * TR_SCR);
        const int gw = F.vcu * NWAVES + F.wave, NGW = F.G * NWAVES;
        constexpr int I_GIN = 16 * 48, I_GLR = 16, I_SQ = 16 * 16, I_W1 = 16 * 64, I_W2 = 64 * 16;
        constexpr int NITEMS = 2 * I_GIN + 2 * I_GLR + 2 * I_SQ + 2 * I_GIN + 2 * I_SQ + 4 * I_W1 + 4 * I_W2;
        auto decode = [&](int it) -> TrItem {
            int r = it;
            if (r < 2 * I_GIN) { const int j = r / I_GIN; return TrItem{a.in[7] + (size_t)j * D * GLA_IN, GLA_IN, 0, 3072, D, (bf16_t*)(ws + WS_WGIN) + (size_t)j * 3072 * D, r % I_GIN}; } r -= 2 * I_GIN;
            if (r < 2 * I_GLR) { const int j = r / I_GLR; return TrItem{a.in[7] + (size_t)j * D * GLA_IN, GLA_IN, 3072, 16, D, (bf16_t*)(ws + WS_WGLR) + (size_t)j * 16 * D, r % I_GLR}; } r -= 2 * I_GLR;
            if (r < 2 * I_SQ) { const int j = r / I_SQ; return TrItem{a.in[11] + (size_t)j * D * D, D, 0, D, D, (bf16_t*)(ws + WS_WGOUT) + (size_t)j * D * D, r % I_SQ}; } r -= 2 * I_SQ;
            if (r < 2 * I_GIN) { const int j = r / I_GIN; return TrItem{a.in[12] + (size_t)j * D * MB_IN, MB_IN, 0, 3072, D, (bf16_t*)(ws + WS_WMIN) + (size_t)j * 3072 * D, r % I_GIN}; } r -= 2 * I_GIN;
            if (r < 2 * I_SQ) { const int j = r / I_SQ; return TrItem{a.in[15] + (size_t)j * D * D, D, 0, D, D, (bf16_t*)(ws + WS_WMOUT) + (size_t)j * D * D, r % I_SQ}; } r -= 2 * I_SQ;
            if (r < 4 * I_W1) { const int j = r / I_W1; return TrItem{a.in[16] + (size_t)j * D * DFF, DFF, 0, DFF, D, (bf16_t*)(ws + WS_W1) + (size_t)j * DFF * D, r % I_W1}; } r -= 4 * I_W1;
            { const int j = r / I_W2; return TrItem{a.in[17] + (size_t)j * DFF * D, D, 0, D, DFF, (bf16_t*)(ws + WS_W2) + (size_t)j * D * DFF, r % I_W2}; }
        };
        f32x4 va[16], vb[16];
        int it = gw;
        if (it < NITEMS) { TrItem cur = decode(it); tr_load(cur, F.lane, va);
            for (;;) {
                const int itn = it + NGW; TrItem nx = cur; const bool more = itn < NITEMS;
                if (more) { nx = decode(itn); tr_load(nx, F.lane, vb); }
                tr_store(cur, F.lane, va, scr);
                if (!more) break;
                const int itn2 = itn + NGW; const bool more2 = itn2 < NITEMS; TrItem nx2 = nx;
                if (more2) { nx2 = decode(itn2); tr_load(nx2, F.lane, va); }
                tr_store(nx, F.lane, vb, scr);
                if (!more2) break;
                cur = nx2; it = itn2;
            }
        }
    }
    __syncthreads();
    {
        const float* c = a.in[1]; const float* ada_w = a.in[3]; const float* ada_b = a.in[4]; float* mod = (float*)(ws + WS_MOD);
        LAS float* sc = (LAS float*)F.lds;
        LAS float* red = (LAS float*)F.lds + 1024;
        for (int k = F.tid; k < D; k += NTHR) sc[k] = silu_f(c[k]);
        __syncthreads();
        const int kg = F.tid >> 5, cl = F.tid & 31;
        for (int chunk = F.vcu; chunk < 256; chunk += F.G) {
            float part[3];
#pragma unroll
            for (int cc = 0; cc < 3; ++cc) {
                const int col = chunk * 96 + cc * 32 + cl, i = col / (6 * D), n = col - i * 6 * D;
                const float* w = ada_w + (size_t)i * D * 6 * D + (size_t)(kg * 64) * 6 * D + n;
                float wv[64];
#pragma unroll
                for (int k = 0; k < 64; ++k) wv[k] = w[(size_t)k * 6 * D];
                float acc = 0.f;
#pragma unroll
                for (int k = 0; k < 64; ++k) acc += sc[kg * 64 + k] * wv[k];
                part[cc] = acc;
            }
#pragma unroll
            for (int cc = 0; cc < 3; ++cc) red[kg * 96 + cc * 32 + cl] = part[cc];
            __syncthreads();
            if (F.tid < 96) { float s = 0.f;
#pragma unroll
                for (int g = 0; g < 16; ++g) s += red[g * 96 + F.tid];
                mod[chunk * 96 + F.tid] = s + ada_b[chunk * 96 + F.tid]; }
            __syncthreads();
        }
    }
    {
        const int* pos = (const int*)a.in[2]; float* ct = (float*)(ws + WS_COS); float* st = (float*)(ws + WS_SIN);
        for (int idx = F.vcu * NTHR + F.tid; idx < S * 64; idx += F.G * NTHR) {
            const int t = idx >> 6, i = idx & 63;
            const float inv_freq = (float)exp2(-(double)i * (13.287712379549449 / 64.0));
            const float angf = (float)pos[t] * inv_freq;
            float sn, cs; sincos_acc((double)angf, sn, cs);
            ct[idx] = cs; st[idx] = sn;
        }
    }
}
__device__ __forceinline__ void norm_phase(const Frame& F0, const float* __restrict__ x, const float* __restrict__ g, const float* __restrict__ sc, const float* __restrict__ sh, bf16_t* __restrict__ h) {
    const Frame F = opaque(F0);
    f32x4 ga[4], gb[4];
#pragma unroll
    for (int j = 0; j < 4; ++j) { const f32x4 gg = ((const f32x4*)g)[F.lane + 64 * j], s1 = ((const f32x4*)sc)[F.lane + 64 * j]; ga[j] = gg * (s1 + 1.0f); gb[j] = ((const f32x4*)sh)[F.lane + 64 * j]; }
    const int gw = F.vcu * NWAVES + F.wave, NGW = F.G * NWAVES;
    for (int m = gw; m < S; m += NGW) {
        const f32x4* xr = (const f32x4*)(x + (size_t)m * D) + F.lane;
        f32x4 v[4]; float ss = 0.f;
#pragma unroll
        for (int j = 0; j < 4; ++j) { v[j] = xr[64 * j]; ss += (v[j].x * v[j].x + v[j].y * v[j].y) + (v[j].z * v[j].z + v[j].w * v[j].w); }
        const float r = 1.0f / sqrtf(wave_sum(ss) * (1.f / D) + EPS);
        u32x2* o8 = (u32x2*)(h + (size_t)m * D) + F.lane;
#pragma unroll
        for (int j = 0; j < 4; ++j) { const f32x4 y = v[j] * r * ga[j] + gb[j]; u32x2 w; w.x = cvtpk(y.x, y.y); w.y = cvtpk(y.z, y.w); o8[64 * j] = w; }
    }
}
__device__ __forceinline__ void glr_phase(const Frame& F0, const bf16_t* __restrict__ H, const bf16_t* __restrict__ WglrT, float* __restrict__ glr) {
    const Frame F = opaque(F0);
    const int l15 = F.lane & 15, q = F.lane >> 4, mt = F.wave & 3, kh = F.wave >> 2;
    LAS f32x4* part = (LAS f32x4*)F.lds;
    for (int rb = F.vcu; rb < S / 64; rb += F.G) {
        const int row0 = rb * 64 + mt * 16;
        const bf16_t* ap = H + (size_t)(row0 + l15) * D + 8 * q + kh * 512;
        const bf16_t* bp = WglrT + (size_t)l15 * D + 8 * q + kh * 512;
        f32x4 acc = {0.f, 0.f, 0.f, 0.f};
#pragma unroll 16
        for (int ks = 0; ks < 16; ++ks) {
            const bf16x8 av = *(const bf16x8*)(ap + ks * 32), bv = *(const bf16x8*)(bp + ks * 32);
            acc = __builtin_amdgcn_mfma_f32_16x16x32_bf16(av, bv, acc, 0, 0, 0);
        }
        if (kh) part[mt * 64 + F.lane] = acc;
        __syncthreads();
        if (!kh) { acc += part[mt * 64 + F.lane];
#pragma unroll
            for (int r = 0; r < 4; ++r) glr[(size_t)(row0 + 4 * q + r) * 16 + l15] = acc[r]; }
        __syncthreads();
    }
}
typedef short v4i16_t __attribute__((ext_vector_type(4)));
__device__ __forceinline__ s16x4 vtr(const LAS unsigned char* p) { return __builtin_bit_cast(s16x4, __builtin_amdgcn_ds_read_tr16_b64_v4i16((LAS v4i16_t*)p)); }
__device__ __forceinline__ int crow(int reg, int h) { return (reg & 3) + 8 * (reg >> 2) + 4 * h; }
__device__ __forceinline__ unsigned off_b(unsigned row, unsigned ch) { return 272u * row + 16u * ch; }
__device__ __forceinline__ unsigned tr_addr(unsigned lane, unsigned c, unsigned rowblk) {
    const unsigned blk = (lane >> 4) & 1, q = (lane & 15) >> 2, p = lane & 3;
    return off_b(rowblk + q, 4 * c + 2 * blk + (p >> 1)) + 8 * (p & 1);
}
constexpr int GL_IMG = 64 * 272, GL_PST = 144;
constexpr int GL_QD = 0, GL_KI = GL_IMG, GL_KT = 2 * GL_IMG, GL_V = 3 * GL_IMG, GL_P = 5 * GL_IMG, GL_GL = GL_P + 64 * GL_PST, GL_SEG = GL_GL + 4096, GL_DEC = GL_SEG + 2048, GL_RED = GL_DEC + 512;
static_assert(GL_RED + 2048 <= RING_BYTES, "gla lds");
#define MFMA32(a, b, c) __builtin_amdgcn_mfma_f32_32x32x16_bf16((a), (b), (c), 0, 0, 0)

struct GlaPre { f32x4 ga, gb; unsigned qk[16]; };
__device__ __forceinline__ void gla_prefetch_g(const Frame& F, const float* __restrict__ GLR, int t0, GlaPre& P) {
    const int ib = F.wave >> 2, l31 = F.lane & 31, h = F.lane >> 5;
    const float* gp = GLR + (size_t)(t0 + 32 * ib + l31) * 16 + 8 * h;
    P.ga = *(const f32x4*)gp; P.gb = *(const f32x4*)(gp + 4);
}
template <bool WITH_Q>
__device__ __forceinline__ void gla_prefetch(const Frame& F, const bf16_t* __restrict__ QKV, const float* __restrict__ GLR, int t0, int hd, GlaPre& P);
template <bool WITH_Q>
__device__ __forceinline__ void gla_prefetch_qk(const Frame& F, const bf16_t* __restrict__ QKV, int t0, int hd, GlaPre& P) {
    const int w = F.wave, ib = w >> 2, db = w & 3, l31 = F.lane & 31, h = F.lane >> 5;
#pragma unroll
    for (int r = 0; r < 16; ++r) {
        const bf16_t* row = QKV + (size_t)(t0 + 32 * ib + crow(r, h)) * 3072 + hd * 128 + 32 * db + l31;
        const unsigned kk = row[512]; const unsigned qq = WITH_Q ? (unsigned)row[0] : 0u;
        P.qk[r] = qq | (kk << 16);
    }
}
template <bool WITH_Q>
__device__ __forceinline__ void gla_prefetch(const Frame& F, const bf16_t* __restrict__ QKV, const float* __restrict__ GLR, int t0, int hd, GlaPre& P) {
    gla_prefetch_g(F, GLR, t0, P); gla_prefetch_qk<WITH_Q>(F, QKV, t0, hd, P);
}
struct GlaW { u32x4 bhi, blo; float bias; };
__device__ __forceinline__ void gla_load_w(const float* __restrict__ wupg, const float* __restrict__ bgg, int hd, const Frame& F, GlaW& W) {
    const int db = F.wave & 3, l31 = F.lane & 31, h = F.lane >> 5, d = hd * 128 + 32 * db + l31;
    float wv[8];
#pragma unroll
    for (int j = 0; j < 8; ++j) wv[j] = wupg[(8 * h + j) * 512 + d];
    W.bhi.x = cvtpk(wv[0], wv[1]); W.bhi.y = cvtpk(wv[2], wv[3]); W.bhi.z = cvtpk(wv[4], wv[5]); W.bhi.w = cvtpk(wv[6], wv[7]);
    W.blo.x = cvtpk(wv[0] - bflo(W.bhi.x), wv[1] - bfhi(W.bhi.x)); W.blo.y = cvtpk(wv[2] - bflo(W.bhi.y), wv[3] - bfhi(W.bhi.y));
    W.blo.z = cvtpk(wv[4] - bflo(W.bhi.z), wv[5] - bfhi(W.bhi.z)); W.blo.w = cvtpk(wv[6] - bflo(W.bhi.w), wv[7] - bfhi(W.bhi.w));
    W.bias = bgg[d];
}
template <bool WITH_Q, bool VPRE>
__device__ __forceinline__ float gla_chunk_prep(const Frame& F, const GlaPre& P, const GlaW& W, const bf16_t* __restrict__ QKV, int t0, int hd, const u32x4 (&vpre)[4]) {
    LAS unsigned char* lds = F.lds;
    const int w = F.wave, ib = w >> 2, db = w & 3, l31 = F.lane & 31, h = F.lane >> 5, d = 32 * db + l31;
    u32x4 vv[4];
#pragma unroll
    for (int k = 0; k < 4; ++k) { const int c = F.tid + 512 * k, j = c >> 5, ch = c & 31; vv[k] = VPRE ? vpre[k] : *(const u32x4*)(QKV + (size_t)(t0 + j) * 3072 + 1024 + hd * 256 + ch * 8); }
    u32x4 ahi, alo;
    ahi.x = cvtpk(P.ga.x, P.ga.y); ahi.y = cvtpk(P.ga.z, P.ga.w); ahi.z = cvtpk(P.gb.x, P.gb.y); ahi.w = cvtpk(P.gb.z, P.gb.w);
    alo.x = cvtpk(P.ga.x - bflo(ahi.x), P.ga.y - bfhi(ahi.x)); alo.y = cvtpk(P.ga.z - bflo(ahi.y), P.ga.w - bfhi(ahi.y));
    alo.z = cvtpk(P.gb.x - bflo(ahi.z), P.gb.y - bfhi(ahi.z)); alo.w = cvtpk(P.gb.z - bflo(ahi.w), P.gb.w - bfhi(ahi.w));
    f32x16 X;
#pragma unroll
    for (int r = 0; r < 16; ++r) X[r] = W.bias;
    X = MFMA32(__builtin_bit_cast(bf16x8, ahi), __builtin_bit_cast(bf16x8, W.bhi), X);
    X = MFMA32(__builtin_bit_cast(bf16x8, alo), __builtin_bit_cast(bf16x8, W.bhi), X);
    X = MFMA32(__builtin_bit_cast(bf16x8, ahi), __builtin_bit_cast(bf16x8, W.blo), X);
    float G[16], sk[4];
#pragma unroll
    for (int k = 0; k < 4; ++k) { float run = 0.f;
#pragma unroll
        for (int j = 0; j < 4; ++j) { const float x = X[4 * k + j]; const float ls = fminf(x, 0.f) - __logf(1.f + __expf(-fabsf(x))); run += ls * (1.f / 16.f); G[4 * k + j] = run; }
        sk[k] = run; }
    float base = 0.f, tot;
    {
        float ps[4];
#pragma unroll
        for (int k = 0; k < 4; ++k) ps[k] = __shfl_xor(sk[k], 32);
#pragma unroll
        for (int k = 0; k < 4; ++k) { const float bk = base + (h ? ps[k] : 0.f);
#pragma unroll
            for (int j = 0; j < 4; ++j) G[4 * k + j] += bk;
            base += sk[k] + ps[k]; }
        tot = base;
    }
    LAS float* HT = (LAS float*)(lds + GL_SEG);
    if (h == 0) HT[ib * 128 + d] = tot;
#pragma unroll
    for (int k = 0; k < 4; ++k) { const int c = F.tid + 512 * k, j = c >> 5, ch = c & 31; *(LAS u32x4*)(lds + GL_V + (ch >> 4) * GL_IMG + off_b(j, ch & 15)) = vv[k]; }
    __syncthreads();
    const float t0h = HT[d], t1h = HT[128 + d], glast = t0h + t1h;
    const float add = ib ? t0h : 0.f;
    const float qs = 0.08838834764831845f;
#pragma unroll
    for (int r = 0; r < 16; ++r) {
        const int i = 32 * ib + crow(r, h); const float Gv = G[r] + add;
        const unsigned a = off_b(i, d >> 3) + 2 * (d & 7);
        const float kf = bfhi(P.qk[r]);
        if (WITH_Q) {
            *(LAS unsigned short*)(lds + GL_QD + a) = (unsigned short)(cvtpk(bflo(P.qk[r]) * qs * __expf(Gv), 0.f) & 0xffffu);
            *(LAS unsigned short*)(lds + GL_KI + a) = (unsigned short)(cvtpk(kf * __expf(-Gv), 0.f) & 0xffffu);
        }
        *(LAS unsigned short*)(lds + GL_KT + a) = (unsigned short)(cvtpk(kf * __expf(glast - Gv), 0.f) & 0xffffu);
    }
    if (ib == 0 && h == 0) ((LAS float*)(lds + GL_DEC))[d] = __expf(glast);
    __syncthreads();
    return glast;
}
__device__ __forceinline__ void gla_state_update(const Frame& F, f32x16 (&St)[4]) {
    LAS unsigned char* lds = F.lds;
    const int h = F.lane >> 5, w = F.wave;
    const LAS float* dec = (const LAS float*)(lds + GL_DEC);
#pragma unroll
    for (int db = 0; db < 4; ++db)
#pragma unroll
        for (int r = 0; r < 16; ++r) St[db][r] *= dec[32 * db + crow(r, h)];
    const LAS unsigned char* vimg = lds + GL_V + (w >> 2) * GL_IMG;
#pragma unroll
    for (int ks = 0; ks < 4; ++ks) {
        const s16x4 vlo = vtr(vimg + tr_addr(F.lane, w & 3, 16 * ks + 8 * h)), vhi = vtr(vimg + tr_addr(F.lane, w & 3, 16 * ks + 8 * h + 4));
        const bf16x8 vb = __builtin_shufflevector(vlo, vhi, 0, 1, 2, 3, 4, 5, 6, 7);
#pragma unroll
        for (int db = 0; db < 4; ++db) {
            const s16x4 klo = vtr(lds + GL_KT + tr_addr(F.lane, db, 16 * ks + 8 * h)), khi = vtr(lds + GL_KT + tr_addr(F.lane, db, 16 * ks + 8 * h + 4));
            const bf16x8 ka = __builtin_shufflevector(klo, khi, 0, 1, 2, 3, 4, 5, 6, 7);
            St[db] = MFMA32(ka, vb, St[db]);
        }
    }
}
__device__ __forceinline__ void gla_g1(const Frame& F0, const bf16_t* __restrict__ QKV, const float* __restrict__ GLR, const float* __restrict__ wupg, const float* __restrict__ bgg, float* __restrict__ SBUF, float* __restrict__ DG) {
    const Frame F = opaque(F0);
    const int h = F.lane >> 5, w = F.wave;
    for (int u = F.vcu; u < 256; u += F.G) {
        const int gi = u >> 2, hd = u & 3;
        GlaW W; gla_load_w(wupg, bgg, hd, F, W);
        f32x16 St[4];
#pragma unroll
        for (int db = 0; db < 4; ++db)
#pragma unroll
            for (int r = 0; r < 16; ++r) St[db][r] = 0.f;
        float gsum = 0.f;
        GlaPre P; gla_prefetch<false>(F, QKV, GLR, gi * 256, hd, P);
        u32x4 vpre[4];
#define GLA_VPRE(t0_) do { _Pragma("unroll") for (int k_ = 0; k_ < 4; ++k_) { const int c_ = F.tid + 512 * k_, j_ = c_ >> 5, ch_ = c_ & 31; vpre[k_] = *(const u32x4*)(QKV + (size_t)((t0_) + j_) * 3072 + 1024 + hd * 256 + ch_ * 8); } } while (0)
        GLA_VPRE(gi * 256);
#pragma unroll 1
        for (int c = 0; c < 4; ++c) {
            gsum += gla_chunk_prep<false, true>(F, P, W, QKV, gi * 256 + c * 64, hd, vpre);
            if (c < 3) { gla_prefetch<false>(F, QKV, GLR, gi * 256 + (c + 1) * 64, hd, P); GLA_VPRE(gi * 256 + (c + 1) * 64); }
            gla_state_update(F, St);
            __syncthreads();
        }
        float* sp = SBUF + ((size_t)u * 128) * 256 + 32 * w + (F.lane & 31);
#pragma unroll
        for (int db = 0; db < 4; ++db)
#pragma unroll
            for (int r = 0; r < 16; ++r) sp[(size_t)(32 * db + crow(r, h)) * 256] = St[db][r];
        if ((w >> 2) == 0 && h == 0) DG[u * 128 + 32 * (w & 3) + (F.lane & 31)] = __expf(gsum);
    }
}
__device__ __forceinline__ void gla_g2(const Frame& F0, float* __restrict__ SBUF, const float* __restrict__ DG) {
    const Frame F = opaque(F0);
    for (int e = F.vcu * NTHR + F.tid; e < 4 * 128 * 256; e += F.G * NTHR) {
        const int hd = e >> 15, d = (e >> 8) & 127;
        float run = 0.f;
#pragma unroll 1
        for (int g0 = 0; g0 < 64; g0 += 8) {
            float tmp[8], dec[8];
#pragma unroll
            for (int k = 0; k < 8; ++k) { const int g = g0 + k; tmp[k] = SBUF[(size_t)(g * 4 + hd) * 32768 + (e & 32767)]; dec[k] = DG[(g * 4 + hd) * 128 + d]; }
#pragma unroll
            for (int k = 0; k < 8; ++k) { const int g = g0 + k; SBUF[(size_t)(g * 4 + hd) * 32768 + (e & 32767)] = run; run = dec[k] * run + tmp[k]; }
        }
    }
}
__device__ __forceinline__ void gla_g3(const Frame& F0, const bf16_t* __restrict__ QKV, const float* __restrict__ GLR, const float* __restrict__ wupg, const float* __restrict__ bgg,
                                       const float* __restrict__ SBUF, const float* __restrict__ og, bf16_t* __restrict__ MIX) {
    const Frame F = opaque(F0);
    LAS unsigned char* lds = F.lds;
    const int h = F.lane >> 5, w = F.wave, l31 = F.lane & 31;
    for (int u = F.vcu; u < 256; u += F.G) {
        const int gi = u >> 2, hd = u & 3;
        GlaW W; gla_load_w(wupg, bgg, hd, F, W);
        f32x16 St[4];
        { const float* sp = SBUF + ((size_t)u * 128) * 256 + 32 * w + l31;
#pragma unroll
          for (int db = 0; db < 4; ++db)
#pragma unroll
              for (int r = 0; r < 16; ++r) St[db][r] = sp[(size_t)(32 * db + crow(r, h)) * 256]; }
#pragma unroll 1
        for (int c = 0; c < 4; ++c) {
            const int t0 = gi * 256 + c * 64;
            { GlaPre P; gla_prefetch<true>(F, QKV, GLR, t0, hd, P); u32x4 vdum[4]; (void)gla_chunk_prep<true, false>(F, P, W, QKV, t0, hd, vdum); }
            if (w < 3) {
                const int ib = (w >= 1), jb = (w == 2);
                f32x16 acc;
#pragma unroll
                for (int r = 0; r < 16; ++r) acc[r] = 0.f;
#pragma unroll
                for (int s = 0; s < 8; ++s) {
                    const bf16x8 a = *(const LAS bf16x8*)(lds + GL_QD + off_b(32 * ib + l31, 2 * s + h));
                    const bf16x8 b = *(const LAS bf16x8*)(lds + GL_KI + off_b(32 * jb + l31, 2 * s + h));
                    acc = MFMA32(a, b, acc);
                }
                const int jabs = 32 * jb + l31;
#pragma unroll
                for (int r = 0; r < 16; ++r) { const int iabs = 32 * ib + crow(r, h); const float pv = (jabs <= iabs) ? acc[r] : 0.f;
                    *(LAS unsigned short*)(lds + GL_P + iabs * GL_PST + 2 * jabs) = (unsigned short)(cvtpk(pv, 0.f) & 0xffffu); }
            }
            f32x16 oT[2];
#pragma unroll
            for (int ib = 0; ib < 2; ++ib)
#pragma unroll
                for (int r = 0; r < 16; ++r) oT[ib][r] = 0.f;
#pragma unroll
            for (int db = 0; db < 4; ++db)
#pragma unroll
                for (int s = 0; s < 2; ++s) {
                    u32x4 pk; pk.x = cvtpk(St[db][8 * s + 0], St[db][8 * s + 1]); pk.y = cvtpk(St[db][8 * s + 2], St[db][8 * s + 3]); pk.z = cvtpk(St[db][8 * s + 4], St[db][8 * s + 5]); pk.w = cvtpk(St[db][8 * s + 6], St[db][8 * s + 7]);
                    const bf16x8 xa = __builtin_bit_cast(bf16x8, pk);
#pragma unroll
                    for (int ib = 0; ib < 2; ++ib) {
                        const u32x2 qlo = *(const LAS u32x2*)(lds + GL_QD + off_b(32 * ib + l31, 4 * db + 2 * s + 0) + 8 * h);
                        const u32x2 qhi = *(const LAS u32x2*)(lds + GL_QD + off_b(32 * ib + l31, 4 * db + 2 * s + 1) + 8 * h);
                        u32x4 qq; qq.x = qlo.x; qq.y = qlo.y; qq.z = qhi.x; qq.w = qhi.y;
                        oT[ib] = MFMA32(xa, __builtin_bit_cast(bf16x8, qq), oT[ib]);
                    }
                }
            __syncthreads();
            {
                const LAS unsigned char* vimg = lds + GL_V + (w >> 2) * GL_IMG;
#pragma unroll
                for (int ks = 0; ks < 4; ++ks) {
                    const s16x4 vlo = vtr(vimg + tr_addr(F.lane, w & 3, 16 * ks + 8 * h)), vhi = vtr(vimg + tr_addr(F.lane, w & 3, 16 * ks + 8 * h + 4));
                    const bf16x8 va = __builtin_shufflevector(vlo, vhi, 0, 1, 2, 3, 4, 5, 6, 7);
#pragma unroll
                    for (int ib = 0; ib < 2; ++ib) {
                        if (ib == 0 && ks >= 2) continue;
                        const int irow = 32 * ib + l31;
                        const bf16x8 pb = *(const LAS bf16x8*)(lds + GL_P + irow * GL_PST + 16 * (2 * ks + h));
                        oT[ib] = MFMA32(va, pb, oT[ib]);
                    }
                }
            }
            float ssq[2];
#pragma unroll
            for (int ib = 0; ib < 2; ++ib) { float s = 0.f;
#pragma unroll
                for (int r = 0; r < 16; ++r) s += oT[ib][r] * oT[ib][r];
                s += __shfl_xor(s, 32); ssq[ib] = s; }
            if (h == 0) { ((LAS float*)(lds + GL_RED))[w * 64 + l31] = ssq[0]; ((LAS float*)(lds + GL_RED))[w * 64 + 32 + l31] = ssq[1]; }
            __syncthreads();
#pragma unroll
            for (int ib = 0; ib < 2; ++ib) {
                float tot = 0.f;
#pragma unroll
                for (int ww = 0; ww < 8; ++ww) tot += ((LAS float*)(lds + GL_RED))[ww * 64 + 32 * ib + l31];
                const float rn = 1.0f / sqrtf(tot * (1.f / 256.f) + EPS);
                const int t = t0 + 32 * ib + l31;
#pragma unroll
                for (int g = 0; g < 4; ++g) {
                    const int e0 = 32 * w + 8 * g + 4 * h;
                    const u32x2 rg = *(const u32x2*)(QKV + (size_t)t * 3072 + 2048 + hd * 256 + e0);
                    const f32x4 ogv = *(const f32x4*)(og + e0);
                    const float r0 = bflo(rg.x), r1 = bfhi(rg.x), r2 = bflo(rg.y), r3 = bfhi(rg.y);
                    const float y0 = oT[ib][4 * g + 0] * rn * ogv.x * (r0 / (1.f + __expf(-r0)));
                    const float y1 = oT[ib][4 * g + 1] * rn * ogv.y * (r1 / (1.f + __expf(-r1)));
                    const float y2 = oT[ib][4 * g + 2] * rn * ogv.z * (r2 / (1.f + __expf(-r2)));
                    const float y3 = oT[ib][4 * g + 3] * rn * ogv.w * (r3 / (1.f + __expf(-r3)));
                    u32x2 o; o.x = cvtpk(y0, y1); o.y = cvtpk(y2, y3);
                    *(u32x2*)(MIX + (size_t)t * D + hd * 256 + e0) = o;
                }
            }
            if (c < 3) gla_state_update(F, St);
            __syncthreads();
        }
    }
}
constexpr int MB_LIST_H = 516096;
__device__ __forceinline__ int mb_list_off(int n) { return 256 * (63 * n - (n * (n - 1)) / 2); }
constexpr int MB_OST = 2 * 128 * 256, MB_OSTW = 32 * 264;
constexpr int MB_PRE = MB_OST + 8 * MB_OSTW, MB_END = MB_PRE + 2064;
static_assert(MB_END <= MISC_OFF, "moba lds");

__device__ __forceinline__ void moba_m1_tile(const Frame& F, int pm, int pn, bf16_t* __restrict__ QKV, const float* __restrict__ COS, const float* __restrict__ SIN,
                                             const float* __restrict__ qg, const float* __restrict__ kg, float* __restrict__ KMEAN) {
    LAS unsigned char* lds = F.lds;
    const int which = (pn >= 4), h0 = 2 * (pn & 3);
    const int ts = F.lane >> 4, hs = (F.lane >> 3) & 1, j = F.lane & 7;
    const float* g = which ? kg : qg;
    const float gsc = which ? 1.0f : (0.08838834764831845f * 1.4426950408889634f);
    float g1[8], g2[8], a1[8], a2[8];
#pragma unroll
    for (int e = 0; e < 8; ++e) { g1[e] = g[8 * j + e] * gsc; g2[e] = g[64 + 8 * j + e] * gsc; a1[e] = 0.f; a2[e] = 0.f; }
#pragma unroll 2
    for (int it = 0; it < 8; ++it) {
        const int t = pm * 256 + (it * 8 + F.wave) * 4 + ts;
        bf16_t* p = QKV + (size_t)t * 3072 + which * 1024 + (h0 + hs) * 128 + 8 * j;
        const u32x4 ra = *(const u32x4*)p, rb = *(const u32x4*)(p + 64);
        const f32x4 c0 = *(const f32x4*)(COS + (size_t)t * 64 + 8 * j), c1 = *(const f32x4*)(COS + (size_t)t * 64 + 8 * j + 4);
        const f32x4 s0 = *(const f32x4*)(SIN + (size_t)t * 64 + 8 * j), s1 = *(const f32x4*)(SIN + (size_t)t * 64 + 8 * j + 4);
        float x1[8] = {bflo(ra.x), bfhi(ra.x), bflo(ra.y), bfhi(ra.y), bflo(ra.z), bfhi(ra.z), bflo(ra.w), bfhi(ra.w)};
        float x2[8] = {bflo(rb.x), bfhi(rb.x), bflo(rb.y), bfhi(rb.y), bflo(rb.z), bfhi(rb.z), bflo(rb.w), bfhi(rb.w)};
        const float cs[8] = {c0.x, c0.y, c0.z, c0.w, c1.x, c1.y, c1.z, c1.w};
        const float sn[8] = {s0.x, s0.y, s0.z, s0.w, s1.x, s1.y, s1.z, s1.w};
        float ss = 0.f;
#pragma unroll
        for (int e = 0; e < 8; ++e) ss += x1[e] * x1[e] + x2[e] * x2[e];
        ss += __shfl_xor(ss, 1); ss += __shfl_xor(ss, 2); ss += __shfl_xor(ss, 4);
        const float r = 1.0f / sqrtf(ss * (1.f / 128.f) + EPS);
        float o1[8], o2[8];
#pragma unroll
        for (int e = 0; e < 8; ++e) { const float y1 = x1[e] * r * g1[e], y2 = x2[e] * r * g2[e]; o1[e] = y1 * cs[e] - y2 * sn[e]; o2[e] = y2 * cs[e] + y1 * sn[e]; a1[e] += o1[e]; a2[e] += o2[e]; }
        u32x4 wa, wb;
        wa.x = cvtpk(o1[0], o1[1]); wa.y = cvtpk(o1[2], o1[3]); wa.z = cvtpk(o1[4], o1[5]); wa.w = cvtpk(o1[6], o1[7]);
        wb.x = cvtpk(o2[0], o2[1]); wb.y = cvtpk(o2[2], o2[3]); wb.z = cvtpk(o2[4], o2[5]); wb.w = cvtpk(o2[6], o2[7]);
        *(u32x4*)p = wa; *(u32x4*)(p + 64) = wb;
    }
    if (which) {
#pragma unroll
        for (int e = 0; e < 8; ++e) { a1[e] += __shfl_xor(a1[e], 16); a1[e] += __shfl_xor(a1[e], 32); a2[e] += __shfl_xor(a2[e], 16); a2[e] += __shfl_xor(a2[e], 32); }
        LAS float* red = (LAS float*)lds;
        if (ts == 0) {
#pragma unroll
            for (int e = 0; e < 8; ++e) { red[(F.wave * 2 + hs) * 128 + 8 * j + e] = a1[e]; red[(F.wave * 2 + hs) * 128 + 64 + 8 * j + e] = a2[e]; } }
        __syncthreads();
        if (F.tid < 256) { const int hh = F.tid >> 7, d = F.tid & 127; float s = 0.f;
#pragma unroll
            for (int w = 0; w < 8; ++w) s += red[(w * 2 + hh) * 128 + d];
            KMEAN[((size_t)(h0 + hh) * 64 + pm) * 128 + d] = s * (1.f / 256.f); }
        __syncthreads();
    }
}
__device__ __forceinline__ void moba_m1_tail(const Frame& F0, int G, int c, bf16_t* __restrict__ QKV, const float* __restrict__ COS, const float* __restrict__ SIN,
                                             const float* __restrict__ qg, const float* __restrict__ kg, float* __restrict__ KMEAN) {
    const Frame F = opaque(F0);
    pg8::StaticOrder So; So.init(S, 3072, G, c);
#pragma unroll 1
    for (int i = 0; i < 3; ++i) {
        pg8::Unit u; if (!So.next(i, u)) break;
        if (u.pn < 8) moba_m1_tile(F, u.pm, u.pn, QKV, COS, SIN, qg, kg, KMEAN);
    }
}
#define MB_INS(v, i) do { const float v_ = (v); const int i_ = (i); \
    const bool b0_ = v_ > v0 || (v_ == v0 && i_ < i0), b1_ = v_ > v1 || (v_ == v1 && i_ < i1), b2_ = v_ > v2 || (v_ == v2 && i_ < i2); \
    if (b0_) { v2 = v1; i2 = i1; v1 = v0; i1 = i0; v0 = v_; i0 = i_; } else if (b1_) { v2 = v1; i2 = i1; v1 = v_; i1 = i_; } else if (b2_) { v2 = v_; i2 = i_; } } while (0)
__device__ __forceinline__ void moba_m2(const Frame& F0, const bf16_t* __restrict__ QKV, const float* __restrict__ KMEAN, unsigned* __restrict__ gcnt, int* __restrict__ LIST) {
    const Frame F = opaque(F0);
    LAS unsigned char* lds = F.lds;
    LAS int* cntl = (LAS int*)lds;
    LAS float* kml = (LAS float*)(lds + 1024);
    const int h2 = F.lane >> 5, l31 = F.lane & 31, w = F.wave;
    for (int u = F.vcu; u < 512; u += F.G) {
        const int b = u >> 3, h = u & 7;
        if (b == 0) continue;
        if (F.tid < 64) cntl[F.tid] = 0;
#pragma unroll
        for (int k = 0; k < 4; ++k) { const int idx = F.tid + 512 * k, nr = idx >> 5, c4 = (idx & 31) * 4;
            if (nr < b) { const f32x4 v = *(const f32x4*)(KMEAN + ((size_t)h * 64 + nr) * 128 + c4); *(LAS f32x4*)(kml + nr * 132 + c4) = v; } }
        __syncthreads();
        const int t = b * 256 + 32 * w + l31;
        bf16x8 qf[8];
#pragma unroll
        for (int s = 0; s < 8; ++s) qf[s] = *(const bf16x8*)(QKV + (size_t)t * 3072 + h * 128 + 16 * s + 8 * h2);
        float v0 = -INFINITY, v1 = -INFINITY, v2 = -INFINITY; int i0 = 64, i1 = 64, i2 = 64;
#pragma unroll
        for (int nb = 0; nb < 2; ++nb) {
            if (nb == 1 && b <= 32) continue;
            f32x16 acc;
#pragma unroll
            for (int r = 0; r < 16; ++r) acc[r] = 0.f;
            const LAS float* kmp = kml + (32 * nb + l31) * 132 + 8 * h2;
#pragma unroll
            for (int s = 0; s < 8; ++s) {
                const f32x4 ka = *(const LAS f32x4*)(kmp + 16 * s), kb = *(const LAS f32x4*)(kmp + 16 * s + 4);
                u32x4 hi; hi.x = cvtpk(ka.x, ka.y); hi.y = cvtpk(ka.z, ka.w); hi.z = cvtpk(kb.x, kb.y); hi.w = cvtpk(kb.z, kb.w);
                u32x4 lo; lo.x = cvtpk(ka.x - bflo(hi.x), ka.y - bfhi(hi.x)); lo.y = cvtpk(ka.z - bflo(hi.y), ka.w - bfhi(hi.y));
                lo.z = cvtpk(kb.x - bflo(hi.z), kb.y - bfhi(hi.z)); lo.w = cvtpk(kb.z - bflo(hi.w), kb.w - bfhi(hi.w));
                acc = MFMA32(__builtin_bit_cast(bf16x8, hi), qf[s], acc);
                acc = MFMA32(__builtin_bit_cast(bf16x8, lo), qf[s], acc);
            }
#pragma unroll
            for (int r = 0; r < 16; ++r) { const int n = 32 * nb + crow(r, h2); const float gv = (n < b) ? acc[r] : -INFINITY; MB_INS(gv, n); }
        }
        { const float p0 = __shfl_xor(v0, 32), p1 = __shfl_xor(v1, 32), p2 = __shfl_xor(v2, 32); const int q0 = __shfl_xor(i0, 32), q1 = __shfl_xor(i1, 32), q2 = __shfl_xor(i2, 32);
          MB_INS(p0, q0); MB_INS(p1, q1); MB_INS(p2, q2); }
        int pos0 = 0, pos1 = 0, pos2 = 0;
        const bool e0 = (h2 == 0) && (v0 > -INFINITY), e1 = (h2 == 0) && (v1 > -INFINITY), e2 = (h2 == 0) && (v2 > -INFINITY);
        if (e0) pos0 = __hip_atomic_fetch_add(cntl + i0, 1, __ATOMIC_RELAXED, __HIP_MEMORY_SCOPE_WORKGROUP);
        if (e1) pos1 = __hip_atomic_fetch_add(cntl + i1, 1, __ATOMIC_RELAXED, __HIP_MEMORY_SCOPE_WORKGROUP);
        if (e2) pos2 = __hip_atomic_fetch_add(cntl + i2, 1, __ATOMIC_RELAXED, __HIP_MEMORY_SCOPE_WORKGROUP);
        __syncthreads();
        if (F.tid < 64) { const int c = cntl[F.tid]; int base = 0; if (c > 0) base = (int)__hip_atomic_fetch_add(gcnt + h * 64 + F.tid, (unsigned)c, __ATOMIC_RELAXED, __HIP_MEMORY_SCOPE_AGENT); cntl[64 + F.tid] = base; }
        __syncthreads();
        int* lst = LIST + (size_t)h * MB_LIST_H;
        if (e0) lst[mb_list_off(i0) + cntl[64 + i0] + pos0] = (t << 2) | 0;
        if (e1) lst[mb_list_off(i1) + cntl[64 + i1] + pos1] = (t << 2) | 1;
        if (e2) lst[mb_list_off(i2) + cntl[64 + i2] + pos2] = (t << 2) | 2;
        __syncthreads();
    }
}
constexpr int MB_HALF = 128 * 256;
__device__ __forceinline__ unsigned off_x(unsigned row, unsigned ch) { return 256u * row + 16u * (ch ^ (((row & 3) << 2) | ((row >> 2) & 3))); }
__device__ __forceinline__ void mb_decode(int v, const LAS int* pre, const unsigned* __restrict__ gcnt, int& h, int& n, int& count, int& lbase, bool& own) {
    if (v < 512) { n = v >> 3; h = v & 7; count = 256; lbase = 0; own = true; return; }
    const int x = v - 512; int lo_ = 0, hi_ = 511;
    while (lo_ < hi_) { const int mid = (lo_ + hi_) >> 1; if (pre[mid] > x) hi_ = mid; else lo_ = mid + 1; }
    const int hn = lo_; h = hn >> 6; n = hn & 63;
    const int tile = x - (hn ? pre[hn - 1] : 0);
    count = (int)gcnt[hn] - tile * 256; if (count > 256) count = 256;
    lbase = h * MB_LIST_H + mb_list_off(n) + tile * 256; own = false;
}
#define MB_STAGE(hh_, nn_, hf_, buf_) do { _Pragma("unroll") for (int k_ = 0; k_ < 4; ++k_) { const int pc_ = w * 4 + k_;               \
        const int r_ = 4 * pc_ + (F.lane >> 4); const int ch_ = (F.lane & 15) ^ (((r_ & 3) << 2) | ((r_ >> 2) & 3)); \
        const bf16_t* src_ = QKV + (size_t)((nn_) * 256 + (hf_) * 128 + r_) * 3072 + 1024 + (hh_) * 128 + 8 * ch_; \
        __builtin_amdgcn_global_load_lds((const unsigned*)src_, (LAS unsigned*)(lds + (buf_) * 2 * MB_HALF + pc_ * 1024), 16, 0, 0); \
        __builtin_amdgcn_global_load_lds((const unsigned*)(src_ + 1024), (LAS unsigned*)(lds + (buf_) * 2 * MB_HALF + MB_HALF + pc_ * 1024), 16, 0, 0); } } while (0)
#define MB_VMWAIT() asm volatile("s_waitcnt vmcnt(0)" ::: "memory")
#define MB_ENT(entv_, own_, nn_, cnt_, lb_) do { const int qi_ = 32 * w + l31; \
        if (own_) entv_ = (((nn_) * 256 + qi_) << 2) | 3; else entv_ = (qi_ < (cnt_)) ? LIST[(lb_) + qi_] : -1; } while (0)
#define MB_GATHER(entv_, qv_, nn_, hh_) do { \
        const int tq_ = (entv_ >= 0) ? (entv_ >> 2) : ((nn_) * 256); \
        _Pragma("unroll") for (int s_ = 0; s_ < 8; ++s_) qv_[s_] = *(const bf16x8*)(QKV + (size_t)tq_ * 3072 + (hh_) * 128 + 16 * s_ + 8 * h2); } while (0)
#define MB_COMPUTE(buf_, hf_, nkt_, own_) do { \
        const LAS unsigned char* kb_ = lds + (buf_) * 2 * MB_HALF + 256 * l31; \
        const LAS unsigned char* vb_ = lds + (buf_) * 2 * MB_HALF + MB_HALF + 256 * (4 * h2 + vq) + 8 * (vp & 1); \
        _Pragma("unroll 1") for (int kt_ = 0; kt_ < (nkt_); ++kt_) { \
            bf16x8 ka_[4]; \
            _Pragma("unroll") for (int s_ = 0; s_ < 4; ++s_) ka_[s_] = *(const LAS bf16x8*)(kb_ + kt_ * (32 * 256) + 16 * ((2 * s_ + h2) ^ fK)); \
            f32x16 acc_; _Pragma("unroll") for (int r_ = 0; r_ < 16; ++r_) acc_[r_] = 0.f; \
            _Pragma("unroll") for (int s_ = 0; s_ < 4; ++s_) acc_ = MFMA32(ka_[s_], qf[s_], acc_); \
            _Pragma("unroll") for (int s_ = 0; s_ < 4; ++s_) ka_[s_] = *(const LAS bf16x8*)(kb_ + kt_ * (32 * 256) + 16 * ((2 * (s_ + 4) + h2) ^ fK)); \
            _Pragma("unroll") for (int s_ = 0; s_ < 4; ++s_) acc_ = MFMA32(ka_[s_], qf[s_ + 4], acc_); \
            s16x4 vl0_[4], vh0_[4]; \
            _Pragma("unroll") for (int db_ = 0; db_ < 4; ++db_) { const LAS unsigned char* vp_ = vb_ + (kt_ * 32) * 256 + 64 * (db_ ^ vq); \
                vl0_[db_] = vtr(vp_ + 16 * (vj ^ h2)); vh0_[db_] = vtr(vp_ + 8 * 256 + 16 * (vj ^ (2 + h2))); } \
            float pr_[16]; \
            _Pragma("unroll") for (int r_ = 0; r_ < 16; ++r_) { float p_ = __builtin_amdgcn_exp2f(acc_[r_]); if ((own_) && (128 * (hf_) + 32 * kt_ + crow(r_, h2) > 32 * w + l31)) p_ = 0.f; pr_[r_] = p_; lsum += p_; } \
            { u32x4 pk_; pk_.x = cvtpk(pr_[0], pr_[1]); pk_.y = cvtpk(pr_[2], pr_[3]); pk_.z = cvtpk(pr_[4], pr_[5]); pk_.w = cvtpk(pr_[6], pr_[7]); \
              const bf16x8 pb_ = __builtin_bit_cast(bf16x8, pk_); \
              _Pragma("unroll") for (int db_ = 0; db_ < 4; ++db_) O[db_] = MFMA32(__builtin_shufflevector(vl0_[db_], vh0_[db_], 0, 1, 2, 3, 4, 5, 6, 7), pb_, O[db_]); } \
            _Pragma("unroll") for (int db_ = 0; db_ < 4; ++db_) { const LAS unsigned char* vp_ = vb_ + (kt_ * 32 + 16) * 256 + 64 * (db_ ^ vq); \
                vl0_[db_] = vtr(vp_ + 16 * (vj ^ h2)); vh0_[db_] = vtr(vp_ + 8 * 256 + 16 * (vj ^ (2 + h2))); } \
            { u32x4 pk_; pk_.x = cvtpk(pr_[8], pr_[9]); pk_.y = cvtpk(pr_[10], pr_[11]); pk_.z = cvtpk(pr_[12], pr_[13]); pk_.w = cvtpk(pr_[14], pr_[15]); \
              const bf16x8 pb_ = __builtin_bit_cast(bf16x8, pk_); \
              _Pragma("unroll") for (int db_ = 0; db_ < 4; ++db_) O[db_] = MFMA32(__builtin_shufflevector(vl0_[db_], vh0_[db_], 0, 1, 2, 3, 4, 5, 6, 7), pb_, O[db_]); } } } while (0)
template <int MODE  >
__device__ __forceinline__ void moba_m3(const Frame& F0, const bf16_t* __restrict__ QKV, const unsigned* __restrict__ gcnt, const int* __restrict__ LIST,
                                        bf16_t* __restrict__ OPART01, bf16_t* __restrict__ OPART2, bf16_t* __restrict__ MIX, float* __restrict__ LPART) {
    const Frame F = opaque(F0);
    LAS unsigned char* lds = F.lds;
    LAS int* pre = (LAS int*)(lds + MB_PRE);
    const int h2 = F.lane >> 5, l31 = F.lane & 31, w = F.wave;
    const int fK = ((l31 & 3) << 2) | ((l31 >> 2) & 3);
    const int vq = (F.lane & 15) >> 2, vp = F.lane & 3, vj = 2 * ((F.lane >> 4) & 1) + (vp >> 1);
    if (MODE == 0) { int v = ((int)gcnt[F.tid] + 255) >> 8; pre[F.tid] = v; __syncthreads();
#pragma unroll 1
      for (int o = 1; o < 512; o <<= 1) { const int add = (F.tid >= o) ? pre[F.tid - o] : 0; __syncthreads(); pre[F.tid] += add; __syncthreads(); } }
    const int total = MODE ? 512 : (512 + pre[511]);
    const int u_lo = MODE ? 0 : 512, u_hi = MODE ? 512 : total;
    const int n_units = (u_hi - u_lo - F.vcu + F.G - 1) / F.G;
    if (n_units <= 0) return;
#define MB_UNIT_V(it_) (u_lo + F.vcu + (it_) * F.G)
    int h, n, count, lbase; bool own;
    mb_decode(MB_UNIT_V(0), pre, gcnt, h, n, count, lbase, own);
    int ent; bf16x8 qf[8];
    MB_ENT(ent, own, n, count, lbase);
    MB_GATHER(ent, qf, n, h);
    MB_STAGE(h, n, 0, 0);
    MB_VMWAIT();
    __syncthreads();
#pragma unroll 1
    for (int it = 0; it < n_units; ++it) {
        f32x16 O[4];
#pragma unroll
        for (int db = 0; db < 4; ++db)
#pragma unroll
            for (int r = 0; r < 16; ++r) O[db][r] = 0.f;
        float lsum = 0.f;
        MB_STAGE(h, n, 1, 1);
        { const int nkt = own ? ((w + 1 < 4) ? (w + 1) : 4) : 4; MB_COMPUTE(0, 0, nkt, own); }
        const bool more = (it + 1 < n_units);
        int h_n = h, n_n = n, count_n = count, lbase_n = lbase; bool own_n = own;
        int ent_n = -1;
        if (more) { mb_decode(MB_UNIT_V(it + 1), pre, gcnt, h_n, n_n, count_n, lbase_n, own_n); MB_ENT(ent_n, own_n, n_n, count_n, lbase_n); }
        MB_VMWAIT();
        __syncthreads();
        if (more) MB_STAGE(h_n, n_n, 0, 0);
        { const int nkt = own ? ((w >= 4) ? (w - 3) : 0) : 4; MB_COMPUTE(1, 1, nkt, own); }
        const int ent_c = ent, h_c = h;
        if (more) MB_GATHER(ent_n, qf, n_n, h_n);
        lsum += __shfl_xor(lsum, 32);
        if (MODE == 0) { if (ent_c >= 0 && h2 == 0) LPART[((size_t)(ent_c & 3) * S + (ent_c >> 2)) * 8 + h_c] = lsum; }
        float linv = 0.f;
        if (MODE == 1) {
            const int tq = ent_c >> 2, nsel = (tq >> 8) < 3 ? (tq >> 8) : 3; float lt = lsum;
#pragma unroll
            for (int sl = 0; sl < 3; ++sl) if (sl < nsel) lt += LPART[((size_t)sl * S + tq) * 8 + h_c];
            linv = 1.f / lt;
        }
        __syncthreads();
        {
            LAS unsigned char* ost = lds + MB_OST + w * MB_OSTW;
#pragma unroll
            for (int db = 0; db < 4; ++db)
#pragma unroll
                for (int g = 0; g < 4; ++g) { u32x2 o; o.x = cvtpk(O[db][4 * g + 0], O[db][4 * g + 1]); o.y = cvtpk(O[db][4 * g + 2], O[db][4 * g + 3]);
                    *(LAS u32x2*)(ost + l31 * 264 + 2 * (32 * db + 8 * g + 4 * h2)) = o; }
            asm volatile("s_waitcnt lgkmcnt(0)" ::: "memory");
#pragma unroll
            for (int i = 0; i < 8; ++i) {
                const int row = 4 * i + (F.lane >> 4), ch = F.lane & 15;
                const int er = __shfl(ent_c, row);
                const u32x4 v = *(const LAS u32x4*)(ost + row * 264 + 16 * ch);
                if (MODE == 0) {
                    if (er >= 0) { const int sl = er & 3, tq = er >> 2;
                        bf16_t* dst = ((sl == 2) ? (OPART2 + (size_t)tq * D) : (OPART01 + ((size_t)sl * S + tq) * D)) + h_c * 128 + 8 * ch;
                        *(u32x4*)dst = v; }
                } else {
                    const float li = __shfl(linv, row);
                    const int tq = er >> 2, nsel = (tq >> 8) < 3 ? (tq >> 8) : 3;
                    float o[8] = {bflo(v.x), bfhi(v.x), bflo(v.y), bfhi(v.y), bflo(v.z), bfhi(v.z), bflo(v.w), bfhi(v.w)};
#pragma unroll
                    for (int sl = 0; sl < 3; ++sl) if (sl < nsel) {
                        const u32x4 p = *(const u32x4*)(((sl == 2) ? (OPART2 + (size_t)tq * D) : (OPART01 + ((size_t)sl * S + tq) * D)) + h_c * 128 + 8 * ch);
                        o[0] += bflo(p.x); o[1] += bfhi(p.x); o[2] += bflo(p.y); o[3] += bfhi(p.y); o[4] += bflo(p.z); o[5] += bfhi(p.z); o[6] += bflo(p.w); o[7] += bfhi(p.w); }
                    u32x4 r; r.x = cvtpk(o[0] * li, o[1] * li); r.y = cvtpk(o[2] * li, o[3] * li); r.z = cvtpk(o[4] * li, o[5] * li); r.w = cvtpk(o[6] * li, o[7] * li);
                    *(u32x4*)(MIX + (size_t)tq * D + h_c * 128 + 8 * ch) = r;
                }
            }
        }
        if (more) { h = h_n; n = n_n; count = count_n; lbase = lbase_n; own = own_n; ent = ent_n; }
        MB_VMWAIT();
        __syncthreads();
    }
#undef MB_UNIT_V
}
__device__ __forceinline__ float wave_max(float v) {
#pragma unroll
    for (int o = 1; o < 64; o <<= 1) v = fmaxf(v, __shfl_xor(v, o));
    return v;
}
__device__ __forceinline__ float logsigmoid_f(float x) { return fminf(x, 0.f) - log1pf(expf(-fabsf(x))); }
__global__ void nk_gla_gate(const float* __restrict__ glr, const float* __restrict__ wup, const float* __restrict__ bg, float* __restrict__ g) {
    const size_t idx = (size_t)blockIdx.x * blockDim.x + threadIdx.x;
    const int t = (int)(idx >> 9), j = (int)(idx & 511);
    float acc = bg[j];
#pragma unroll
    for (int r = 0; r < 16; ++r) acc += glr[(size_t)t * 16 + r] * wup[r * 512 + j];
    g[idx] = logsigmoid_f(acc) * (1.f / 16.f);
}
__global__ __launch_bounds__(256) void nk_gla_recur(const bf16_t* __restrict__ qkv, const float* __restrict__ g, float* __restrict__ o) {
    __shared__ float sq[16][128], sk[16][128], sa[16][128];
    const int h = blockIdx.x, tid = threadIdx.x;
    float St[128];
#pragma unroll
    for (int d = 0; d < 128; ++d) St[d] = 0.f;
    const float qs = 0.08838834764831845f;
    for (int t0 = 0; t0 < S; t0 += 16) {
        float vv[16];
#pragma unroll
        for (int tt = 0; tt < 16; ++tt) vv[tt] = bf2f(qkv[(size_t)(t0 + tt) * 3072 + 1024 + h * 256 + tid]);
#pragma unroll
        for (int i = 0; i < 8; ++i) {
            const int e = tid + i * 256, tok = e >> 7, d = e & 127;
            const bf16_t* row = qkv + (size_t)(t0 + tok) * 3072;
            sq[tok][d] = bf2f(row[h * 128 + d]) * qs;
            sk[tok][d] = bf2f(row[512 + h * 128 + d]);
            sa[tok][d] = expf(g[(size_t)(t0 + tok) * 512 + h * 128 + d]);
        }
        __syncthreads();
#pragma unroll 1
        for (int tt = 0; tt < 16; ++tt) {
            const float v = vv[0];
#pragma unroll
            for (int i = 0; i < 15; ++i) vv[i] = vv[i + 1];
            float acc = 0.f;
#pragma unroll
            for (int d = 0; d < 128; ++d) { St[d] = sa[tt][d] * St[d] + sk[tt][d] * v; acc += sq[tt][d] * St[d]; }
            o[(size_t)(t0 + tt) * D + h * 256 + tid] = acc;
        }
        __syncthreads();
    }
}
__global__ __launch_bounds__(256) void nk_gla_post(const float* __restrict__ o, const bf16_t* __restrict__ qkv, const float* __restrict__ og, bf16_t* __restrict__ mix) {
    const int w = blockIdx.x * 4 + (threadIdx.x >> 6), lane = threadIdx.x & 63;
    const int t = w >> 2, h = w & 3;
    f32x4 v = *(const f32x4*)(o + (size_t)t * D + h * 256 + lane * 4);
    const float ss = wave_sum(v.x * v.x + v.y * v.y + v.z * v.z + v.w * v.w);
    const float r = 1.0f / sqrtf(ss * (1.f / 256.f) + EPS);
    const f32x4 gg = *(const f32x4*)(og + lane * 4);
    const bf16_t* rp = qkv + (size_t)t * 3072 + 2048 + h * 256 + lane * 4;
    bf16_t* mp = mix + (size_t)t * D + h * 256 + lane * 4;
#pragma unroll
    for (int e = 0; e < 4; ++e) { const float rr = bf2f(rp[e]); const float y = v[e] * r * gg[e] * (rr / (1.f + expf(-rr))); mp[e] = (bf16_t)(cvtpk(y, 0.f) & 0xffffu); }
}
__global__ __launch_bounds__(256) void nk_moba_qk(bf16_t* __restrict__ qkv, const int* __restrict__ pos, const float* __restrict__ qg, const float* __restrict__ kg) {
    const int w = blockIdx.x * 4 + (threadIdx.x >> 6), lane = threadIdx.x & 63;
    const int t = w >> 4, which = (w >> 3) & 1, h = w & 7;
    bf16_t* p = qkv + (size_t)t * 3072 + which * 1024 + h * 128;
    const float* g = which ? kg : qg;
    float t1 = bf2f(p[lane]), t2 = bf2f(p[lane + 64]);
    const float ss = wave_sum(t1 * t1 + t2 * t2);
    const float r = 1.0f / sqrtf(ss * (1.f / 128.f) + EPS);
    t1 = t1 * r * g[lane]; t2 = t2 * r * g[lane + 64];
    const float inv_freq = (float)exp2(-(double)lane * (13.287712379549449 / 64.0));
    const float angf = (float)pos[t] * inv_freq;
    float cs, sn; sincos_acc((double)angf, sn, cs);
    p[lane] = (bf16_t)(cvtpk(t1 * cs - t2 * sn, 0.f) & 0xffffu);
    p[lane + 64] = (bf16_t)(cvtpk(t2 * cs + t1 * sn, 0.f) & 0xffffu);
}
__global__ __launch_bounds__(128) void nk_moba_kmean(const bf16_t* __restrict__ qkv, float* __restrict__ kmean) {
    const int h = blockIdx.x >> 6, n = blockIdx.x & 63, d = threadIdx.x;
    float acc = 0.f;
    for (int j = 0; j < 256; ++j) acc += bf2f(qkv[(size_t)(n * 256 + j) * 3072 + 1024 + h * 128 + d]);
    kmean[(size_t)blockIdx.x * 128 + d] = acc * (1.f / 256.f);
}
__global__ __launch_bounds__(64) void nk_moba_attn(const bf16_t* __restrict__ qkv, const float* __restrict__ kmean, bf16_t* __restrict__ out) {
    __shared__ float sq[128];
    __shared__ float sp[1024];
    __shared__ int skey[1024];
    const int t = blockIdx.x >> 3, h = blockIdx.x & 7, lane = threadIdx.x;
    const bf16_t* qp = qkv + (size_t)t * 3072 + h * 128;
    sq[lane] = bf2f(qp[lane]); sq[lane + 64] = bf2f(qp[lane + 64]);
    __syncthreads();
    const int own = t >> 8;
    float gate = -INFINITY;
    if (lane < own) {
        const float* km = kmean + ((size_t)h * 64 + lane) * 128;
        float a = 0.f;
        for (int d = 0; d < 128; ++d) a += sq[d] * km[d];
        gate = a;
    }
    int s0 = -1, s1 = -1, s2 = -1;
#pragma unroll
    for (int j = 0; j < 3; ++j) {
        const float m = wave_max(gate);
        int idx = -1;
        if (m > -INFINITY) { const unsigned long long b = __ballot(gate == m); idx = __ffsll((long long)b) - 1; }
        if (j == 0) s0 = idx; else if (j == 1) s1 = idx; else s2 = idx;
        if (lane == idx) gate = -INFINITY;
    }
    int nk = 0;
    if (s0 >= 0) { for (int i = lane; i < 256; i += 64) skey[nk + i] = s0 * 256 + i; nk += 256; }
    if (s1 >= 0) { for (int i = lane; i < 256; i += 64) skey[nk + i] = s1 * 256 + i; nk += 256; }
    if (s2 >= 0) { for (int i = lane; i < 256; i += 64) skey[nk + i] = s2 * 256 + i; nk += 256; }
    const int nown = t - own * 256 + 1;
    for (int i = lane; i < nown; i += 64) skey[nk + i] = own * 256 + i;
    nk += nown;
    __syncthreads();
    const float scale = 0.08838834764831845f;
    float mx = -INFINITY;
    for (int i = lane; i < nk; i += 64) {
        const bf16_t* kp = qkv + (size_t)skey[i] * 3072 + 1024 + h * 128;
        float a = 0.f;
        for (int d = 0; d < 128; d += 8) { const u32x4 kk = *(const u32x4*)(kp + d);
            a += sq[d] * bflo(kk.x) + sq[d + 1] * bfhi(kk.x) + sq[d + 2] * bflo(kk.y) + sq[d + 3] * bfhi(kk.y) + sq[d + 4] * bflo(kk.z) + sq[d + 5] * bfhi(kk.z) + sq[d + 6] * bflo(kk.w) + sq[d + 7] * bfhi(kk.w); }
        a *= scale; sp[i] = a; mx = fmaxf(mx, a);
    }
    mx = wave_max(mx);
    float sum = 0.f;
    for (int i = lane; i < nk; i += 64) { const float p = expf(sp[i] - mx); sp[i] = p; sum += p; }
    sum = wave_sum(sum);
    __syncthreads();
    float o0 = 0.f, o1 = 0.f;
    for (int i = 0; i < nk; ++i) {
        const bf16_t* vp = qkv + (size_t)skey[i] * 3072 + 2048 + h * 128;
        const float p = sp[i];
        o0 += p * bf2f(vp[lane]); o1 += p * bf2f(vp[lane + 64]);
    }
    const float inv = 1.f / sum;
    out[(size_t)t * D + h * 128 + lane] = (bf16_t)(cvtpk(o0 * inv, 0.f) & 0xffffu);
    out[(size_t)t * D + h * 128 + lane + 64] = (bf16_t)(cvtpk(o1 * inv, 0.f) & 0xffffu);
}
constexpr int PH_PER_LAYER = 10, PH_L0 = 2, N_PHASES = PH_L0 + DEPTH * PH_PER_LAYER;
__global__ void __launch_bounds__(NTHR, 2) mega(MegaArgs args) {
    extern __shared__ __attribute__((aligned(16))) unsigned char lds_raw[];
    Frame F;
    F.lds = (LAS unsigned char*)lds_raw;
    F.tid = threadIdx.x; F.lane = F.tid & 63; F.wave = __builtin_amdgcn_readfirstlane(F.tid >> 6);
    F.G = gridDim.x; { const int bx = blockIdx.x; F.vcu = (F.G % 8 == 0) ? (bx % 8) * (F.G / 8) + bx / 8 : bx; }
    volatile LAS unsigned* MISC = (volatile LAS unsigned*)(F.lds + MISC_OFF);
    unsigned char* ws = args.ws;
    unsigned* ctl = (unsigned*)(ws + WS_CTL);
    for (int u = F.tid; u < (LDS_BYTES - MISC_OFF) / 4; u += NTHR) ((LAS unsigned*)(F.lds + MISC_OFF))[u] = 0u;
    __syncthreads();
    XcdBarrier bar = xcd_barrier_post(ctl + CW_BAR, MISC + 8);
    const int lo = args.ph_lo, hi = args.ph_hi;
#define IN(k) (lo <= (k) && (k) < hi)
#define SEAM(k) do { if (lo <= (k) && (k) + 1 < hi) xcd_barrier(bar); } while (0)
    const float* mod = (const float*)(ws + WS_MOD);
    bf16_t* H = (bf16_t*)(ws + WS_H); bf16_t* MIX = (bf16_t*)(ws + WS_MIX); bf16_t* QKV = (bf16_t*)(ws + WS_QKV); bf16_t* HID = (bf16_t*)(ws + WS_HID);
    float* xout = args.out;
    bf16_t* XB = (bf16_t*)(ws + WS_XB);

    if (IN(0)) { p0_prologue(F, args); }
    if (lo < 0) cg::this_grid().sync();
    if (lo <= 0 && 1 < hi) xcd_barrier(bar);
    if (IN(1)) { norm_phase(F, args.in[0], args.in[5], mod + D, mod, H); }
    SEAM(1);
#pragma unroll 1
    for (int L = 0; L < DEPTH; ++L) {
        const int pb = PH_L0 + L * PH_PER_LAYER, j = L >> 1;
        const float* m = mod + (size_t)L * 6 * D;
        if (pb + PH_PER_LAYER <= lo || pb >= hi) continue;
        if ((L & 1) == 0) {
            if (IN(pb + 0)) {
                pg8::Gemm g{H, (const bf16_t*)(ws + WS_WGIN) + (size_t)j * 3072 * D, S, 3072, D}; pg8::StaticOrder So; So.init(S, 3072, F.G, (int)blockIdx.x);
                pg8::EpiBf16<0> E{QKV, 3072};
                pg8::gemm_phase<pg8::EpiBf16<0>, pg8::StaticOrder, true, true>(F.lds, g, So, E);
                glr_phase(F, H, (const bf16_t*)(ws + WS_WGLR) + (size_t)j * 16 * D, (float*)(ws + WS_GLR));
            }
            SEAM(pb + 0);
        } else {
            if (IN(pb + 0)) {
                pg8::Gemm g{H, (const bf16_t*)(ws + WS_WMIN) + (size_t)j * 3072 * D, S, 3072, D}; pg8::StaticOrder So; So.init(S, 3072, F.G, (int)blockIdx.x);
                pg8::EpiBf16<0> E{QKV, 3072};
                pg8::gemm_phase<pg8::EpiBf16<0>, pg8::StaticOrder, true, true>(F.lds, g, So, E);
                asm volatile("s_waitcnt vmcnt(0)" ::: "memory"); __syncthreads();
                moba_m1_tail(F, F.G, (int)blockIdx.x, QKV, (const float*)(args.ws + WS_COS), (const float*)(args.ws + WS_SIN), args.in[13] + (size_t)j * 128, args.in[14] + (size_t)j * 128, (float*)(args.ws + WS_KMEAN));
            }
            SEAM(pb + 0);
        }
        if ((L & 1) == 0) {
            unsigned char* ws = args.ws; asm volatile("" : "+s"(ws));
            const float* wupg = args.in[8] + (size_t)j * 16 * 512; const float* bgg = args.in[9] + (size_t)j * 512;
            if (IN(pb + 1)) gla_g1(F, QKV, (const float*)(ws + WS_GLR), wupg, bgg, (float*)(ws + WS_SBUF), (float*)(ws + WS_DG));
            SEAM(pb + 1);
            if (IN(pb + 2)) gla_g2(F, (float*)(ws + WS_SBUF), (const float*)(ws + WS_DG));
            SEAM(pb + 2);
            if (IN(pb + 3)) gla_g3(F, QKV, (const float*)(ws + WS_GLR), wupg, bgg, (const float*)(ws + WS_SBUF), args.in[10] + (size_t)j * 256, MIX);
            if (lo <= pb + 3 && pb + 5 < hi) xcd_barrier(bar);
        } else {
            unsigned char* ws = args.ws; asm volatile("" : "+s"(ws));
            unsigned* gcnt = (unsigned*)(ws + WS_CTL) + CW_MCNT + j * 512;
            if (IN(pb + 2)) moba_m2(F, QKV, (const float*)(ws + WS_KMEAN), gcnt, (int*)(ws + WS_LIST));
            SEAM(pb + 2);
            if (IN(pb + 3)) moba_m3<0>(F, QKV, gcnt, (const int*)(ws + WS_LIST), (bf16_t*)xout, (bf16_t*)(ws + WS_AUX), MIX, (float*)(ws + WS_LPART));
            SEAM(pb + 3);
            if (IN(pb + 4)) moba_m3<1>(F, QKV, gcnt, (const int*)(ws + WS_LIST), (bf16_t*)xout, (bf16_t*)(ws + WS_AUX), MIX, (float*)(ws + WS_LPART));
            SEAM(pb + 4);
        }
        if (IN(pb + 5)) {
            const bf16_t* wo = ((L & 1) == 0) ? (const bf16_t*)(ws + WS_WGOUT) + (size_t)j * D * D : (const bf16_t*)(ws + WS_WMOUT) + (size_t)j * D * D;
            pg8::Gemm g{MIX, wo, S, D, D}; pg8::StaticOrder So; So.init(S, D, F.G, (int)blockIdx.x);
            if (L == 0) {
                pg8::EpiResidNorm<true> E{args.in[0], XB, D, m + 2 * D, args.in[6] + (size_t)L * D, m + 4 * D, m + 3 * D, H, (float*)(ws + WS_XBUF), ctl + CW_SEAM + (2 * L) * SEAM_BANK, ctl + CW_TMO, EPS};
                pg8::gemm_phase<pg8::EpiResidNorm<true>, pg8::StaticOrder, false, true>(F.lds, g, So, E);
            } else {
                pg8::EpiResidNorm<false> E{XB, XB, D, m + 2 * D, args.in[6] + (size_t)L * D, m + 4 * D, m + 3 * D, H, (float*)(ws + WS_XBUF), ctl + CW_SEAM + (2 * L) * SEAM_BANK, ctl + CW_TMO, EPS};
                pg8::gemm_phase<pg8::EpiResidNorm<false>, pg8::StaticOrder, false, true>(F.lds, g, So, E);
            }
        }
        SEAM(pb + 5);
        if (IN(pb + 7)) {
            pg8::Gemm g{H, (const bf16_t*)(ws + WS_W1) + (size_t)L * DFF * D, S, DFF, D}; pg8::StaticOrder So; So.init(S, DFF, F.G, (int)blockIdx.x);
            pg8::EpiBf16<1> E{HID, DFF};
            pg8::gemm_phase<pg8::EpiBf16<1>, pg8::StaticOrder, true, true>(F.lds, g, So, E);
        }
        SEAM(pb + 7);
        if (IN(pb + 8)) {
            pg8::Gemm g{HID, (const bf16_t*)(ws + WS_W2) + (size_t)L * D * DFF, S, D, DFF}; pg8::StaticOrder So; So.init(S, D, F.G, (int)blockIdx.x);
            pg8::EpiResid E{XB, xout, D, m + 5 * D};
            if (L + 1 < DEPTH) {
                const float* mn = mod + (size_t)(L + 1) * 6 * D;
                pg8::EpiResidNorm<false> EN{XB, XB, D, m + 5 * D, args.in[5] + (size_t)(L + 1) * D, mn + D, mn, H, (float*)(ws + WS_XBUF), ctl + CW_SEAM + (2 * L + 1) * SEAM_BANK, ctl + CW_TMO, EPS};
                pg8::gemm_phase<pg8::EpiResidNorm<false>, pg8::StaticOrder, false, true>(F.lds, g, So, EN);
            } else
            pg8::gemm_phase<pg8::EpiResid, pg8::StaticOrder, false, true>(F.lds, g, So, E);
        }
        if (L + 1 < DEPTH) SEAM(pb + 8);
    }
#undef IN
#undef SEAM
}
static int g_grid = 0;
static void launch_mega(MegaArgs a, int lo, int hi, hipStream_t stream) {
    a.ph_lo = lo; a.ph_hi = hi;
    (void)hipMemsetAsync((char*)a.ws + WS_CTL + CW_BAR * 4, 0, XCD_BAR_WORDS * 4, stream);
    void* params[] = {&a};
    hipError_t e = hipLaunchCooperativeKernel((const void*)mega, dim3(g_grid), dim3(NTHR), params, LDS_BYTES, stream);
    if (e != hipSuccess) fprintf(stderr, "cooperative launch failed: %s (grid %d)\n", hipGetErrorString(e), g_grid);
}
extern "C" void kernel_launch(void* const* d_in, const int* in_sizes, int n_in, void* d_out, int out_size, void* d_ws, size_t ws_size, hipStream_t stream) {
    if (g_grid == 0) {
        int dev = 0, cus = 0, per_cu = 0;
        (void)hipGetDevice(&dev);
        (void)hipDeviceGetAttribute(&cus, hipDeviceAttributeMultiprocessorCount, dev);
        (void)hipFuncSetAttribute((const void*)mega, hipFuncAttributeMaxDynamicSharedMemorySize, LDS_BYTES);
        (void)hipOccupancyMaxActiveBlocksPerMultiprocessor(&per_cu, (const void*)mega, NTHR, LDS_BYTES);
        if (per_cu < 1) { fprintf(stderr, "occupancy query says %d blocks/CU\n", per_cu); per_cu = 1; }
        g_grid = cus;
        if (ws_size < WS_END || n_in != 18) { fprintf(stderr, "bad ws_size %zu / n_in %d\n", ws_size, n_in); g_grid = -1; }
    }
    if (g_grid < 0) return;
    (void)hipMemsetAsync((char*)d_ws + WS_CTL, 0, CTL_ZERO_BYTES, stream);
    MegaArgs a{};
    for (int i = 0; i < 18; ++i) a.in[i] = (const float*)d_in[i];
    a.out = (float*)d_out; a.ws = (unsigned char*)d_ws;
    launch_mega(a, 0, N_PHASES, stream);
}
```

```cpp
#include <hip/hip_runtime.h>
#include <hip/hip_cooperative_groups.h>
#include <cstdio>
#include <cstdint>
#include <cmath>
namespace cg = cooperative_groups;
constexpr int D = 1024, S = 16384, DEPTH = 4, DFF = 4096;
constexpr int GLA_IN = 3088, MB_IN = 3072;
constexpr float EPS = 1e-6f;
#ifndef PROBE
#define PROBE 0
#endif
#ifndef TCAT
#define TCAT 0
#endif
#ifndef TBLK
#define TBLK 0
#endif
#define LAS __attribute__((address_space(3)))
#define GAS __attribute__((address_space(1)))
typedef unsigned short bf16_t;
typedef short bf16x8 __attribute__((ext_vector_type(8)));
typedef short s16x4 __attribute__((ext_vector_type(4)));
typedef float f32x4 __attribute__((ext_vector_type(4)));
typedef float f32x16 __attribute__((ext_vector_type(16)));
typedef float f32x2 __attribute__((ext_vector_type(2)));
typedef unsigned u32x4 __attribute__((ext_vector_type(4)));
typedef unsigned u32x2 __attribute__((ext_vector_type(2)));
typedef __bf16 bf16x2_t __attribute__((ext_vector_type(2)));

__device__ __forceinline__ unsigned cvtpk(float lo, float hi) { f32x2 v = {lo, hi}; bf16x2_t b = __builtin_convertvector(v, bf16x2_t); return __builtin_bit_cast(unsigned, b); }
__device__ __forceinline__ float bf2f(unsigned short b) { return __uint_as_float((unsigned)b << 16); }
__device__ __forceinline__ float bflo(unsigned w) { return __uint_as_float(w << 16); }
__device__ __forceinline__ float bfhi(unsigned w) { return __uint_as_float(w & 0xffff0000u); }

#ifndef WT_STORES
#define WT_STORES 0
#endif
__device__ __forceinline__ void st16_wt(void* p, u32x4 v) {
#if WT_STORES
    asm volatile("global_store_dwordx4 %0, %1, off sc1\n\ts_nop 1" :: "v"(p), "v"(v) : "memory");
#else
    *(u32x4*)p = v;
#endif
}
__device__ __forceinline__ void st16_wt(void* p, f32x4 v) { st16_wt(p, __builtin_bit_cast(u32x4, v)); }
namespace pg8 {
constexpr int BM = 256, BK = 64, HALF = 128, HTB = HALF * BK * 2, STAGE_BYTES = 8 * HTB, NXCD = 8, WGM = 8;
__host__ __device__ __forceinline__ int lds_byte(int r, int c) { const int st = (r >> 4) * 2 + (c >> 5), rr = r & 15, cc = c & 31, ob = rr * 64 + cc * 2; return st * 1024 + (ob ^ (((ob >> 9) & 1) << 5)); }
__host__ __device__ __forceinline__ void stage_rc(int b, int& R, int& C) { const int st = b / 1024, sb = b % 1024, swz = sb ^ (((sb >> 9) & 1) << 5); R = (st >> 1) * 16 + swz / 64; C = (st & 1) * 32 + (swz % 64) / 2; }
__host__ __device__ __forceinline__ int perm32(int rho) { const int n = rho >> 4, i = rho & 15; return 8 * (i >> 2) + 4 * n + (i & 3); }
struct Unit { int pm, pn; };
struct Gemm { const bf16_t* A; const bf16_t* Bt; int M, N, K; };
struct StaticOrder {
    int nM, nN, nwg, G, c;
    __host__ __device__ void init(int M, int N, int G_, int c_) { nM = M / BM; nN = N / BM; nwg = nM * nN; G = G_; c = c_; }
    __host__ __device__ bool next(int i, Unit& u) const {
        const long L = (long)i * G + c; if (L >= nwg) return false;
        int wgid = (int)L; { const int q = nwg / NXCD, r = nwg % NXCD, xcd = wgid % NXCD, off = wgid / NXCD; wgid = (xcd < r ? xcd * (q + 1) : r * (q + 1) + (xcd - r) * q) + off; }
        const int nig = WGM * nN, gid = wgid / nig, fm = gid * WGM, gsz = (nM - fm) < WGM ? (nM - fm) : WGM;
        u.pm = fm + ((wgid % nig) % gsz); u.pn = (wgid % nig) / gsz; return true;
    }
    __device__ __forceinline__ void a_ready(const Unit&) const {}
    __device__ __forceinline__ void done(const Unit&) const {}
};
struct MaskOrder : StaticOrder {
    __device__ bool next(int i, Unit& u) const { const bool ok = StaticOrder::next(i, u); u.pm &= 7; u.pn &= 3; return ok; }
};
template <int ACT  > struct EpiBf16 {
    static constexpr bool PERM = true, AFTER_DRAIN = false;
    bf16_t* O; int ldc;
    __device__ __forceinline__ void operator()(const f32x4 (&acc)[2][2][4][2], const Unit& u, int wr, int wc, int fr, int fq) const {
        const int row0 = u.pm * BM + wr * 64 + fr; const int col0 = u.pn * BM + wc * 32 + 8 * fq;
#pragma unroll
        for (int ai = 0; ai < 2; ++ai)
#pragma unroll
            for (int m = 0; m < 4; ++m) { bf16_t* rowp = O + (size_t)(row0 + ai * HALF + m * 16) * ldc + col0;
#pragma unroll
                for (int bj = 0; bj < 2; ++bj) { f32x4 v0 = acc[ai][bj][m][0], v1 = acc[ai][bj][m][1];
                    if (ACT == 1) {
#pragma unroll
                        for (int e = 0; e < 4; ++e) { float a = fmaxf(v0[e], 0.f); v0[e] = a * a; float b = fmaxf(v1[e], 0.f); v1[e] = b * b; } }
                    u32x4 w; w.x = cvtpk(v0[0], v0[1]); w.y = cvtpk(v0[2], v0[3]); w.z = cvtpk(v1[0], v1[1]); w.w = cvtpk(v1[2], v1[3]);
                    st16_wt(rowp + bj * HALF, w); } }
    }
};
struct EpiResid {
    static constexpr bool PERM = false, AFTER_DRAIN = false;
    const bf16_t* base; float* out; int ldc; const float* gate;
    __device__ __forceinline__ void operator()(const f32x4 (&acc)[2][2][4][2], const Unit& u, int wr, int wc, int fr, int fq) const {
        const int row0 = u.pm * BM + wr * 64 + fr, col0 = u.pn * BM + wc * 32 + 4 * fq;
        f32x4 gv[2][2];
#pragma unroll
        for (int bj = 0; bj < 2; ++bj)
#pragma unroll
            for (int n = 0; n < 2; ++n) gv[bj][n] = *(const f32x4*)(gate + col0 + bj * HALF + n * 16);
#pragma unroll
        for (int ai = 0; ai < 2; ++ai)
#pragma unroll
            for (int m = 0; m < 4; ++m) { const size_t off = (size_t)(row0 + ai * HALF + m * 16) * ldc + col0;
#pragma unroll
                for (int bj = 0; bj < 2; ++bj)
#pragma unroll
                    for (int n = 0; n < 2; ++n) { const u32x2 bb = *(const u32x2*)(base + off + bj * HALF + n * 16); const f32x4 b = {bflo(bb.x), bfhi(bb.x), bflo(bb.y), bfhi(bb.y)};
                        st16_wt(out + off + bj * HALF + n * 16, b + gv[bj][n] * acc[ai][bj][m][n]); } }
    }
};

template <bool BASE_F32> struct EpiResidNorm {
    static constexpr bool PERM = false, AFTER_DRAIN = true;
    const void* base; bf16_t* out; int ldc; const float* gate;
    const float* ng; const float* sc; const float* sh; bf16_t* H;
    float* xbuf; unsigned* cnt; unsigned* tmo; float eps;
    __device__ __forceinline__ void operator()(const f32x4 (&)[2][2][4][2], const Unit&, int, int, int, int) const {}
    __device__ __forceinline__ void fused(f32x4 (&acc)[2][2][4][2], const Unit& u, int wr, int wc, int fr, int fq, LAS unsigned char* lds, int wid, int lane) const {
        LAS float* P = (LAS float*)lds;
        LAS float* Sr = (LAS float*)(lds + 4096);
        LAS unsigned* flag = (LAS unsigned*)(lds + 4096 + 1024);
        const int row0 = u.pm * BM + wr * 64 + fr, col0 = u.pn * BM + wc * 32 + 4 * fq;
        {
            f32x4 gv[2][2];
#pragma unroll
            for (int bj = 0; bj < 2; ++bj)
#pragma unroll
                for (int n = 0; n < 2; ++n) gv[bj][n] = *(const f32x4*)(gate + col0 + bj * HALF + n * 16);
#pragma unroll
            for (int ai = 0; ai < 2; ++ai)
#pragma unroll
                for (int m = 0; m < 4; ++m) { const size_t off = (size_t)(row0 + ai * HALF + m * 16) * ldc + col0;
                    float s = 0.f;
#pragma unroll
                    for (int bj = 0; bj < 2; ++bj)
#pragma unroll
                        for (int n = 0; n < 2; ++n) { f32x4 b;
                            if constexpr (BASE_F32) b = *(const f32x4*)((const float*)base + off + bj * HALF + n * 16);
                            else { const u32x2 bb = *(const u32x2*)((const bf16_t*)base + off + bj * HALF + n * 16); b = (f32x4){bflo(bb.x), bfhi(bb.x), bflo(bb.y), bfhi(bb.y)}; }
                            const f32x4 x = b + gv[bj][n] * acc[ai][bj][m][n]; acc[ai][bj][m][n] = x;
                            { u32x2 xw; xw.x = cvtpk(x[0], x[1]); xw.y = cvtpk(x[2], x[3]); *(u32x2*)(out + off + bj * HALF + n * 16) = xw; } s += (x[0] * x[0] + x[1] * x[1]) + (x[2] * x[2] + x[3] * x[3]); }
                    s += __shfl_xor(s, 16); s += __shfl_xor(s, 32);
                    if (fq == 0) P[(ai * HALF + wr * 64 + m * 16 + fr) * 4 + wc] = s;
                    if (m & 1) asm volatile("" ::: "memory"); }
        }
        asm volatile("s_waitcnt lgkmcnt(0)" ::: "memory"); __builtin_amdgcn_s_barrier(); asm volatile("" ::: "memory");
        const int row = wid * 32 + (lane & 31);
        if (lane < 32) {
            const float tot = (P[row * 4 + 0] + P[row * 4 + 1]) + (P[row * 4 + 2] + P[row * 4 + 3]);
            __hip_atomic_store((unsigned*)xbuf + ((size_t)(u.pm * BM + row) * 4 + u.pn), __float_as_uint(tot), __ATOMIC_RELAXED, __HIP_MEMORY_SCOPE_AGENT);
        }
        asm volatile("s_waitcnt vmcnt(0)" ::: "memory");
        if (lane == 0) __hip_atomic_fetch_add(cnt + 64 * u.pm, 1u, __ATOMIC_RELAXED, __HIP_MEMORY_SCOPE_AGENT);
        if (wid == 0) {
            unsigned sp = 0; bool dead = false;
            for (;;) {
                if ((unsigned)__builtin_amdgcn_readfirstlane(__hip_atomic_load(cnt + 64 * u.pm, __ATOMIC_RELAXED, __HIP_MEMORY_SCOPE_AGENT)) >= 32u) break;
                __builtin_amdgcn_s_sleep(2);
                if (++sp > (1u << 20)) { if (lane == 0) __hip_atomic_store(tmo, 1u, __ATOMIC_RELAXED, __HIP_MEMORY_SCOPE_AGENT); dead = true; break; }
            }
            __builtin_amdgcn_fence(__ATOMIC_ACQUIRE, "agent");
            if (lane == 0) flag[0] = dead ? 1u : 0u;
        }
        asm volatile("s_waitcnt vmcnt(0) lgkmcnt(0)" ::: "memory"); __builtin_amdgcn_s_barrier(); asm volatile("" ::: "memory");
        if (lane < 32) {
            const unsigned* slot = (const unsigned*)xbuf + (size_t)(u.pm * BM + row) * 4; float t = 0.f;
#pragma unroll
            for (int k = 0; k < 4; ++k) t += __uint_as_float(__hip_atomic_load(slot + k, __ATOMIC_RELAXED, __HIP_MEMORY_SCOPE_AGENT));
            Sr[row] = 1.0f / sqrtf(t * (1.0f / 1024.0f) + eps);
        }
        asm volatile("s_waitcnt lgkmcnt(0)" ::: "memory"); __builtin_amdgcn_s_barrier(); asm volatile("" ::: "memory");
        float rs[2][4];
#pragma unroll
        for (int ai = 0; ai < 2; ++ai)
#pragma unroll
            for (int m = 0; m < 4; ++m) rs[ai][m] = Sr[ai * HALF + wr * 64 + m * 16 + fr];
#pragma unroll
        for (int bj = 0; bj < 2; ++bj)
#pragma unroll
            for (int n = 0; n < 2; ++n) { const int c = col0 + bj * HALF + n * 16;
                const f32x4 ga = *(const f32x4*)(ng + c) * (*(const f32x4*)(sc + c) + 1.0f), gb = *(const f32x4*)(sh + c);
#pragma unroll
                for (int ai = 0; ai < 2; ++ai)
#pragma unroll
                    for (int m = 0; m < 4; ++m) { const int r = ai * HALF + wr * 64 + m * 16 + fr; const size_t off = (size_t)(u.pm * BM + r) * ldc + c;
                        const f32x4 y = acc[ai][bj][m][n] * rs[ai][m] * ga + gb; u32x2 w; w.x = cvtpk(y[0], y[1]); w.y = cvtpk(y[2], y[3]);
                        *(u32x2*)(H + off) = w; } }
    }
};

template <class Epi, class Sched, bool ALIGN_EPI = false, bool SP2 = false>
__device__ __forceinline__ void gemm_phase(LAS unsigned char* lds, const Gemm g, const Sched& S, const Epi& E) {
    int tid_ = threadIdx.x; asm volatile("" : "+v"(tid_));
    const int tid = tid_, wid = __builtin_amdgcn_readfirstlane(tid >> 6), lane = tid & 63, wr = wid >> 2, wc = wid & 3, fr = lane & 15, fq = lane >> 4;
    const int K = g.K, nt = K / BK;
    unsigned voffA[2], voffB[2];
#pragma unroll
    for (int i = 0; i < 2; ++i) { int R, C; stage_rc(tid * 16 + i * 8192, R, C); const int Rb = Epi::PERM ? ((R & ~31) + perm32(R & 31)) : R;
        voffA[i] = (unsigned)(R * K + C) * 2u; voffB[i] = (unsigned)(Rb * K + C) * 2u; }
    const size_t kstep = (size_t)(BK * 2);
    const size_t hstep = (size_t)HALF * K * 2;
    const size_t tstep = 2 * hstep;
    const unsigned ldsw = (unsigned)wid * 1024u;
    const int aoff = lds_byte(wr * 64 + fr, fq * 8), boff = lds_byte(wc * 32 + fr, fq * 8);
#define PG8_SA(b, h) (((b) * 2 + (h)) * HTB)
#define PG8_SB(b, h) ((4 + (b) * 2 + (h)) * HTB)
#define PG8_STAGE(bufoff, gbase, voff) do { _Pragma("unroll") for (int _i = 0; _i < 2; ++_i) \
        __builtin_amdgcn_global_load_lds((const unsigned*)((const char*)(gbase) + (voff)[_i]), (LAS unsigned*)(lds + (bufoff) + ldsw + _i * 8192), 16, 0, 0); } while (0)
#define PG8_LDA(dst, b, h) do { _Pragma("unroll") for (int m = 0; m < 4; ++m) _Pragma("unroll") for (int k = 0; k < 2; ++k) dst[m][k] = *(const LAS bf16x8*)(lds + PG8_SA(b, h) + aoff + m * 2048 + k * 1024); } while (0)
#define PG8_LDB(dst, b, h) do { _Pragma("unroll") for (int n = 0; n < 2; ++n) _Pragma("unroll") for (int k = 0; k < 2; ++k) dst[n][k] = *(const LAS bf16x8*)(lds + PG8_SB(b, h) + boff + n * 2048 + k * 1024); } while (0)
#define PG8_MMA(ai, bj, At, Bt) do { __builtin_amdgcn_s_setprio(1); _Pragma("unroll") for (int m = 0; m < 4; ++m) _Pragma("unroll") for (int n = 0; n < 2; ++n) _Pragma("unroll") for (int k = 0; k < 2; ++k) \
        acc[ai][bj][m][n] = __builtin_amdgcn_mfma_f32_16x16x32_bf16(Bt[n][k], At[m][k], acc[ai][bj][m][n], 0, 0, 0); __builtin_amdgcn_s_setprio(0); } while (0)
#define PG8_WAIT_V(n) asm volatile("s_waitcnt vmcnt(" #n ")" ::: "memory")
#define PG8_WAIT_L(n) asm volatile("s_waitcnt lgkmcnt(" #n ")" ::: "memory")
#define PG8_BAR __builtin_amdgcn_s_barrier()
#define PG8_SCHED __builtin_amdgcn_sched_barrier(0)
    Unit cur, nxt; int ui = 0;
    if (!S.next(0, cur)) return;
    f32x4 acc[2][2][4][2];
#pragma unroll
    for (int a = 0; a < 2; ++a)
#pragma unroll
        for (int b = 0; b < 2; ++b)
#pragma unroll
            for (int m = 0; m < 4; ++m)
#pragma unroll
                for (int n = 0; n < 2; ++n) acc[a][b][m][n] = (f32x4){0.f, 0.f, 0.f, 0.f};
    bf16x8 At[4][2], B0[2][2], B1[2][2];
    const char* cA = (const char*)g.A + (size_t)cur.pm * tstep; const char* cB = (const char*)g.Bt + (size_t)cur.pn * tstep;
    S.a_ready(cur);
    if constexpr (SP2) {
        PG8_STAGE(PG8_SB(0, 0), cB, voffB); PG8_STAGE(PG8_SB(0, 1), cB + hstep, voffB); PG8_STAGE(PG8_SA(0, 0), cA, voffA); PG8_STAGE(PG8_SA(0, 1), cA + hstep, voffA);
        if (wr == 1) PG8_BAR;
        PG8_WAIT_V(2); PG8_BAR;
        PG8_STAGE(PG8_SB(1, 0), cB + kstep, voffB); PG8_STAGE(PG8_SA(1, 0), cA + kstep, voffA); PG8_STAGE(PG8_SB(1, 1), cB + hstep + kstep, voffB);
        PG8_WAIT_V(6); PG8_BAR;
    } else {
        PG8_STAGE(PG8_SB(0, 0), cB, voffB); PG8_STAGE(PG8_SA(0, 0), cA, voffA); PG8_STAGE(PG8_SB(0, 1), cB + hstep, voffB); PG8_STAGE(PG8_SA(0, 1), cA + hstep, voffA);
        if (wr == 1) PG8_BAR;
        PG8_WAIT_V(4); PG8_BAR;
        PG8_STAGE(PG8_SB(1, 0), cB + kstep, voffB); PG8_STAGE(PG8_SA(1, 0), cA + kstep, voffA); PG8_STAGE(PG8_SB(1, 1), cB + hstep + kstep, voffB);
        PG8_WAIT_V(6); PG8_BAR;
    }
    for (;;) {
        const bool has_next = S.next(ui + 1, nxt);
        const char* nA = has_next ? (const char*)g.A + (size_t)nxt.pm * tstep : cA; const char* nB = has_next ? (const char*)g.Bt + (size_t)nxt.pn * tstep : cB;
        for (int t = 0; t < nt; t += 2) {
            const bool last = (t == nt - 2);
            const char* a1 = cA + (size_t)(t + 1) * kstep;
            const char* a2 = last ? nA : cA + (size_t)(t + 2) * kstep; const char* b2 = last ? nB : cB + (size_t)(t + 2) * kstep;
            const char* a3 = a2 + kstep; const char* b3 = b2 + kstep;
            if (last && has_next) S.a_ready(nxt);
            if constexpr (SP2) {
            PG8_LDB(B0, 0, 0); PG8_LDB(B1, 0, 1); PG8_SCHED; PG8_LDA(At, 0, 0); PG8_STAGE(PG8_SA(1, 1), a1 + hstep, voffA);
            PG8_WAIT_V(8); PG8_WAIT_L(0); PG8_BAR; PG8_MMA(0, 0, At, B0); PG8_MMA(0, 1, At, B1); PG8_BAR; PG8_SCHED;
            PG8_LDA(At, 0, 1); PG8_STAGE(PG8_SB(0, 0), b2, voffB); PG8_STAGE(PG8_SB(0, 1), b2 + hstep, voffB); PG8_STAGE(PG8_SA(0, 0), a2, voffA);
            PG8_WAIT_V(8); PG8_WAIT_L(0); PG8_BAR; PG8_MMA(1, 0, At, B0); PG8_MMA(1, 1, At, B1); PG8_BAR; PG8_SCHED;
            PG8_LDB(B0, 1, 0); PG8_LDB(B1, 1, 1); PG8_SCHED; PG8_LDA(At, 1, 0); PG8_STAGE(PG8_SA(0, 1), a2 + hstep, voffA);
            PG8_WAIT_V(8); PG8_WAIT_L(0); PG8_BAR; PG8_MMA(0, 0, At, B0); PG8_MMA(0, 1, At, B1); PG8_BAR; PG8_SCHED;
            PG8_LDA(At, 1, 1); PG8_STAGE(PG8_SB(1, 0), b3, voffB); PG8_STAGE(PG8_SB(1, 1), b3 + hstep, voffB); PG8_STAGE(PG8_SA(1, 0), a3, voffA);
            PG8_WAIT_V(8); PG8_WAIT_L(0); PG8_BAR; PG8_MMA(1, 0, At, B0); PG8_MMA(1, 1, At, B1); PG8_BAR; PG8_SCHED;
            } else {
            PG8_LDB(B0, 0, 0); PG8_SCHED; PG8_LDA(At, 0, 0); PG8_STAGE(PG8_SA(1, 1), a1 + hstep, voffA);
            PG8_WAIT_L(8); PG8_BAR; PG8_WAIT_L(0); PG8_MMA(0, 0, At, B0); PG8_BAR; PG8_SCHED;
            PG8_LDB(B1, 0, 1); PG8_STAGE(PG8_SB(0, 0), b2, voffB);
            PG8_BAR; PG8_WAIT_L(0); PG8_MMA(0, 1, At, B1); PG8_BAR;
            PG8_LDA(At, 0, 1); PG8_STAGE(PG8_SA(0, 0), a2, voffA);
            PG8_BAR; PG8_WAIT_L(0); PG8_MMA(1, 0, At, B0); PG8_BAR; PG8_SCHED;
            PG8_STAGE(PG8_SB(0, 1), b2 + hstep, voffB);
            PG8_WAIT_V(6); PG8_BAR; PG8_MMA(1, 1, At, B1); PG8_BAR;
            PG8_LDB(B0, 1, 0); PG8_SCHED; PG8_LDA(At, 1, 0); PG8_STAGE(PG8_SA(0, 1), a2 + hstep, voffA);
            PG8_WAIT_L(8); PG8_BAR; PG8_WAIT_L(0); PG8_MMA(0, 0, At, B0); PG8_BAR; PG8_SCHED;
            PG8_LDB(B1, 1, 1); PG8_STAGE(PG8_SB(1, 0), b3, voffB);
            PG8_BAR; PG8_WAIT_L(0); PG8_MMA(0, 1, At, B1); PG8_BAR;
            PG8_LDA(At, 1, 1); PG8_STAGE(PG8_SA(1, 0), a3, voffA);
            PG8_BAR; PG8_WAIT_L(0); PG8_MMA(1, 0, At, B0); PG8_BAR; PG8_SCHED;
            PG8_STAGE(PG8_SB(1, 1), b3 + hstep, voffB);
            PG8_WAIT_V(6); PG8_BAR; PG8_MMA(1, 1, At, B1); PG8_BAR;
            }
        }
        if constexpr (ALIGN_EPI) { if (wr == 0) PG8_BAR; }
        if constexpr (!Epi::AFTER_DRAIN) { E(acc, cur, wr, wc, fr, fq); S.done(cur); }
        if (!has_next) break;
#pragma unroll
        for (int a = 0; a < 2; ++a)
#pragma unroll
            for (int b = 0; b < 2; ++b)
#pragma unroll
                for (int m = 0; m < 4; ++m)
#pragma unroll
                    for (int n = 0; n < 2; ++n) acc[a][b][m][n] = (f32x4){0.f, 0.f, 0.f, 0.f};
        cur = nxt; cA = nA; cB = nB; ++ui;
        if constexpr (ALIGN_EPI) { if (wr == 1) PG8_BAR; }
    }
    PG8_WAIT_V(0);
    if constexpr (!ALIGN_EPI) { if (wr == 0) PG8_BAR; }
    PG8_BAR;
    if constexpr (Epi::AFTER_DRAIN) { E.fused(acc, cur, wr, wc, fr, fq, lds, wid, lane); }
#undef PG8_SA
#undef PG8_SB
#undef PG8_STAGE
#undef PG8_LDA
#undef PG8_LDB
#undef PG8_MMA
#undef PG8_WAIT_V
#undef PG8_WAIT_L
#undef PG8_BAR
#undef PG8_SCHED
}
}

#define XB_TMO      128
#define XB_XCNT(j)  (256  + 64 * (j))
#define XB_XSUB(j)  (1280 + 64 * (j))
#define XB_XGEN(j)  (2304 + 64 * (j))
#define XB_TOP      3328
#define XB_TOPGEN   3392
#define XCD_BAR_WORDS 3456
#define XB_SPIN_CAP (1u << 18)
__device__ __forceinline__ unsigned xb_ld(unsigned* p)              { return __hip_atomic_load(p, __ATOMIC_RELAXED, __HIP_MEMORY_SCOPE_AGENT); }
__device__ __forceinline__ unsigned xb_add(unsigned* p, unsigned v) { return __hip_atomic_fetch_add(p, v, __ATOMIC_RELAXED, __HIP_MEMORY_SCOPE_AGENT); }
__device__ __forceinline__ unsigned xb_xcc_id() { return (unsigned)__builtin_amdgcn_s_getreg((3 << 11) | 20) & 0xFu; }
#define XB_SPIN(cond, bar) do { unsigned _sp = 0; while (cond) { __builtin_amdgcn_s_sleep(1); \
    if ((++_sp & 255u) == 0u) { if (xb_ld(&(bar)[XB_TMO])) break; if (_sp > XB_SPIN_CAP) { atomicAdd(&(bar)[XB_TMO], 1u); break; } } } } while (0)
struct XcdBarrier { unsigned* bar; unsigned x; volatile LAS unsigned* st; };
__device__ __forceinline__ XcdBarrier xcd_barrier_post(unsigned* bar, volatile LAS unsigned* st) {
    XcdBarrier b; b.bar = bar; b.x = xb_xcc_id(); b.st = st;
    if (threadIdx.x == 0) (void)xb_add(&bar[XB_XCNT(b.x)], 1u);
    return b;
}
__device__ __forceinline__ void xcd_barrier_complete(unsigned* bar, unsigned x, unsigned& nloc, unsigned& nx) {
    const unsigned G = gridDim.x * gridDim.y * gridDim.z;
    unsigned sum, cnt, mine, sp = 0u;
    for (;;) {
        sum = 0u; cnt = 0u; mine = 0u;
#pragma unroll
        for (unsigned j = 0; j < 16; ++j) { const unsigned c = xb_ld(&bar[XB_XCNT(j)]); sum += c; cnt += (c > 0u) ? 1u : 0u; }
        mine = xb_ld(&bar[XB_XCNT(x)]);
        if (sum == G) break;
        __builtin_amdgcn_s_sleep(1);
        if ((++sp & 255u) == 0u) { if (xb_ld(&bar[XB_TMO])) break; if (sp > XB_SPIN_CAP) { atomicAdd(&bar[XB_TMO], 1u); break; } }
    }
    nloc = mine > 0u ? mine : 1u; nx = cnt > 0u ? cnt : 1u;
}
__device__ __forceinline__ void xcd_barrier(const XcdBarrier& b) {
    asm volatile("s_waitcnt vmcnt(0)" ::: "memory");
    __syncthreads();
    if (threadIdx.x == 0) {
        unsigned* bar = b.bar; asm volatile("" : "+s"(bar));
        __builtin_amdgcn_s_waitcnt(0);
        unsigned nloc = b.st[0], nx = b.st[1];
        if (nloc == 0u) { xcd_barrier_complete(bar, b.x, nloc, nx); b.st[0] = nloc; b.st[1] = nx; }
        const unsigned old = xb_add(&bar[XB_XSUB(b.x)], 1u);
        const unsigned gen = old / nloc;
        if (old + 1u == (gen + 1u) * nloc) {
            __builtin_amdgcn_fence(__ATOMIC_RELEASE, "agent");
            asm volatile("s_waitcnt vmcnt(0)" ::: "memory");
            const unsigned og = xb_add(&bar[XB_TOP], 1u);
            const unsigned tg = og / nx;
            if (og + 1u == (tg + 1u) * nx) xb_add(&bar[XB_TOPGEN], 1u);
            else XB_SPIN(xb_ld(&bar[XB_TOPGEN]) == tg, bar);
            __builtin_amdgcn_fence(__ATOMIC_ACQUIRE, "agent");
            xb_add(&bar[XB_XGEN(b.x)], 1u);
            asm volatile("s_waitcnt vmcnt(0)" ::: "memory");
        } else {
            XB_SPIN(xb_ld(&bar[XB_XGEN(b.x)]) == gen, bar);
            __builtin_amdgcn_fence(__ATOMIC_ACQUIRE, "agent");
            asm volatile("s_waitcnt vmcnt(0)" ::: "memory");
        }
    }
    __syncthreads();
}
constexpr int NWAVES = 8, NTHR = 512;
constexpr int LDS_BYTES = 147456;
constexpr int RING_BYTES = 131072;
constexpr int MISC_OFF = LDS_BYTES - 256;
constexpr size_t MiB = 1u << 20;
constexpr size_t WS_CTL = 0, CTL_ZERO_BYTES = 1 * MiB;
constexpr size_t WS_MOD = 1 * MiB;
constexpr size_t WS_COS = 2 * MiB, WS_SIN = 6 * MiB;
constexpr size_t WS_WGIN = 10 * MiB;
constexpr size_t WS_WGLR = 22 * MiB;
constexpr size_t WS_WGOUT = 23 * MiB;
constexpr size_t WS_WMIN = 27 * MiB;
constexpr size_t WS_WMOUT = 39 * MiB;
constexpr size_t WS_W1 = 43 * MiB;
constexpr size_t WS_W2 = 75 * MiB;
constexpr size_t WS_H = 107 * MiB;
constexpr size_t WS_MIX = 139 * MiB;
constexpr size_t WS_QKV = 171 * MiB;
constexpr size_t WS_AUX = 267 * MiB;
constexpr size_t WS_HID = 171 * MiB;
constexpr size_t WS_END = 363 * MiB;
constexpr size_t WS_SBUF = WS_AUX;
constexpr size_t WS_GLR = WS_AUX + 32 * MiB;
constexpr size_t WS_DG = WS_AUX + 33 * MiB;
constexpr size_t WS_XB = WS_AUX + 64 * MiB;
constexpr size_t WS_KMEAN = WS_MOD + 128 * 1024;
constexpr size_t WS_LPART = WS_H + 1 * MiB;
constexpr size_t WS_LIST = WS_H + 4 * MiB;
constexpr int CW_BAR = 4096;
constexpr int CW_MCNT = 16384;
constexpr int CW_TMO = 0;
constexpr int CW_SEAM = 32768, SEAM_BANK = 64 * 64;
constexpr size_t WS_XBUF = WS_MOD + 512 * 1024;
struct Frame {
    LAS unsigned char* lds;
    int tid, lane, wave, vcu, G;
};
__device__ __forceinline__ Frame opaque(const Frame& F0) { Frame F = F0; int t = F0.tid; asm volatile("" : "+v"(t)); F.tid = t; F.lane = t & 63; F.wave = __builtin_amdgcn_readfirstlane(t >> 6); return F; }
__device__ __forceinline__ float wave_sum(float v) {
#pragma unroll
    for (int o = 1; o < 64; o <<= 1) v += __shfl_xor(v, o);
    return v;
}
__device__ __forceinline__ float silu_f(float x) { return x / (1.f + __expf(-x)); }
__device__ __forceinline__ void sincos_acc(double ang, float& s, float& c) {
    const double n = rint(ang * 0.15915494309189535);
    double r = fma(-n, 6.283185307179586, ang); r = fma(-n, 2.4492935982947064e-16, r);
    const double x = r * 0.25, x2 = x * x;
    const double sn = x * (1.0 + x2 * (-1.0 / 6 + x2 * (1.0 / 120 + x2 * (-1.0 / 5040 + x2 * (1.0 / 362880 + x2 * (-1.0 / 39916800 + x2 * (1.0 / 6227020800.0)))))));
    const double cs = 1.0 + x2 * (-0.5 + x2 * (1.0 / 24 + x2 * (-1.0 / 720 + x2 * (1.0 / 40320 + x2 * (-1.0 / 3628800 + x2 * (1.0 / 479001600 + x2 * (-1.0 / 87178291200.0)))))));
    const double s2 = 2 * sn * cs, c2 = 1 - 2 * sn * sn;
    s = (float)(2 * s2 * c2); c = (float)(1 - 2 * s2 * s2);
}
constexpr int TR_SCR = 64 * 65 * 4;
struct TrItem { const float* W; int ld, n_off, n_cnt, K; bf16_t* WT; int item; };
__device__ __forceinline__ void tr_load(const TrItem& t, int lane, f32x4 (&v)[16]) {
    const int nblk = (t.n_cnt + 63) >> 6, kb = t.item / nblk, nb = t.item - kb * nblk, k0 = 64 * kb, n0 = 64 * nb;
    const int c4 = (lane & 15) * 4, kr = lane >> 4;
    const bool ok = (n0 + c4) < t.n_cnt;
#pragma unroll
    for (int i = 0; i < 16; ++i) v[i] = ok ? *(const f32x4*)(t.W + (size_t)(k0 + 4 * i + kr) * t.ld + t.n_off + n0 + c4) : (f32x4){0.f, 0.f, 0.f, 0.f};
}
__device__ __forceinline__ void tr_store(const TrItem& t, int lane, const f32x4 (&v)[16], LAS float* scr) {
    const int nblk = (t.n_cnt + 63) >> 6, kb = t.item / nblk, nb = t.item - kb * nblk, k0 = 64 * kb, n0 = 64 * nb;
    const int c4 = (lane & 15) * 4, kr = lane >> 4;
#pragma unroll
    for (int i = 0; i < 16; ++i) { LAS float* s = scr + (4 * i + kr) * 65 + c4; s[0] = v[i].x; s[1] = v[i].y; s[2] = v[i].z; s[3] = v[i].w; }
    asm volatile("s_waitcnt lgkmcnt(0)" ::: "memory");
    const int c = lane & 7;
#pragma unroll
    for (int j = 0; j < 8; ++j) { const int n = (lane >> 3) + 8 * j; const LAS float* s = scr + (8 * c) * 65 + n;
        u32x4 o; o.x = cvtpk(s[0 * 65], s[1 * 65]); o.y = cvtpk(s[2 * 65], s[3 * 65]); o.z = cvtpk(s[4 * 65], s[5 * 65]); o.w = cvtpk(s[6 * 65], s[7 * 65]);
        if (n0 + n < t.n_cnt) *(u32x4*)(t.WT + (size_t)(n0 + n) * t.K + k0 + 8 * c) = o; }
    asm volatile("s_waitcnt lgkmcnt(0)" ::: "memory");
}
struct MegaArgs {
    const float* in[18]; float* out; unsigned char* ws; int ph_lo, ph_hi;
};
__device__ __forceinline__ void p0_prologue(const Frame& F0, const MegaArgs& a) {
    const Frame F = opaque(F0);
    unsigned char* ws = a.ws;
    {
        LAS float* scr = (LAS float*)(F.lds + F.wave * TR_SCR);
        const int gw = F.vcu * NWAVES + F.wave, NGW = F.G * NWAVES;
        constexpr int I_GIN = 16 * 48, I_GLR = 16, I_SQ = 16 * 16, I_W1 = 16 * 64, I_W2 = 64 * 16;
        constexpr int NITEMS = 2 * I_GIN + 2 * I_GLR + 2 * I_SQ + 2 * I_GIN + 2 * I_SQ + 4 * I_W1 + 4 * I_W2;
        auto decode = [&](int it) -> TrItem {
            int r = it;
            if (r < 2 * I_GIN) { const int j = r / I_GIN; return TrItem{a.in[7] + (size_t)j * D * GLA_IN, GLA_IN, 0, 3072, D, (bf16_t*)(ws + WS_WGIN) + (size_t)j * 3072 * D, r % I_GIN}; } r -= 2 * I_GIN;
            if (r < 2 * I_GLR) { const int j = r / I_GLR; return TrItem{a.in[7] + (size_t)j * D * GLA_IN, GLA_IN, 3072, 16, D, (bf16_t*)(ws + WS_WGLR) + (size_t)j * 16 * D, r % I_GLR}; } r -= 2 * I_GLR;
            if (r < 2 * I_SQ) { const int j = r / I_SQ; return TrItem{a.in[11] + (size_t)j * D * D, D, 0, D, D, (bf16_t*)(ws + WS_WGOUT) + (size_t)j * D * D, r % I_SQ}; } r -= 2 * I_SQ;
            if (r < 2 * I_GIN) { const int j = r / I_GIN; return TrItem{a.in[12] + (size_t)j * D * MB_IN, MB_IN, 0, 3072, D, (bf16_t*)(ws + WS_WMIN) + (size_t)j * 3072 * D, r % I_GIN}; } r -= 2 * I_GIN;
            if (r < 2 * I_SQ) { const int j = r / I_SQ; return TrItem{a.in[15] + (size_t)j * D * D, D, 0, D, D, (bf16_t*)(ws + WS_WMOUT) + (size_t)j * D * D, r % I_SQ}; } r -= 2 * I_SQ;
            if (r < 4 * I_W1) { const int j = r / I_W1; return TrItem{a.in[16] + (size_t)j * D * DFF, DFF, 0, DFF, D, (bf16_t*)(ws + WS_W1) + (size_t)j * DFF * D, r % I_W1}; } r -= 4 * I_W1;
            { const int j = r / I_W2; return TrItem{a.in[17] + (size_t)j * DFF * D, D, 0, D, DFF, (bf16_t*)(ws + WS_W2) + (size_t)j * D * DFF, r % I_W2}; }
        };
        f32x4 va[16], vb[16];
        int it = gw;
        if (it < NITEMS) { TrItem cur = decode(it); tr_load(cur, F.lane, va);
            for (;;) {
                const int itn = it + NGW; TrItem nx = cur; const bool more = itn < NITEMS;
                if (more) { nx = decode(itn); tr_load(nx, F.lane, vb); }
                tr_store(cur, F.lane, va, scr);
                if (!more) break;
                const int itn2 = itn + NGW; const bool more2 = itn2 < NITEMS; TrItem nx2 = nx;
                if (more2) { nx2 = decode(itn2); tr_load(nx2, F.lane, va); }
                tr_store(nx, F.lane, vb, scr);
                if (!more2) break;
                cur = nx2; it = itn2;
            }
        }
    }
    __syncthreads();
    {
        const float* c = a.in[1]; const float* ada_w = a.in[3]; const float* ada_b = a.in[4]; float* mod = (float*)(ws + WS_MOD);
        LAS float* sc = (LAS float*)F.lds;
        LAS float* red = (LAS float*)F.lds + 1024;
        for (int k = F.tid; k < D; k += NTHR) sc[k] = silu_f(c[k]);
        __syncthreads();
        const int kg = F.tid >> 5, cl = F.tid & 31;
        for (int chunk = F.vcu; chunk < 256; chunk += F.G) {
            float part[3];
#pragma unroll
            for (int cc = 0; cc < 3; ++cc) {
                const int col = chunk * 96 + cc * 32 + cl, i = col / (6 * D), n = col - i * 6 * D;
                const float* w = ada_w + (size_t)i * D * 6 * D + (size_t)(kg * 64) * 6 * D + n;
                float wv[64];
#pragma unroll
                for (int k = 0; k < 64; ++k) wv[k] = w[(size_t)k * 6 * D];
                float acc = 0.f;
#pragma unroll
                for (int k = 0; k < 64; ++k) acc += sc[kg * 64 + k] * wv[k];
                part[cc] = acc;
            }
#pragma unroll
            for (int cc = 0; cc < 3; ++cc) red[kg * 96 + cc * 32 + cl] = part[cc];
            __syncthreads();
            if (F.tid < 96) { float s = 0.f;
#pragma unroll
                for (int g = 0; g < 16; ++g) s += red[g * 96 + F.tid];
                mod[chunk * 96 + F.tid] = s + ada_b[chunk * 96 + F.tid]; }
            __syncthreads();
        }
    }
    {
        const int* pos = (const int*)a.in[2]; float* ct = (float*)(ws + WS_COS); float* st = (float*)(ws + WS_SIN);
        for (int idx = F.vcu * NTHR + F.tid; idx < S * 64; idx += F.G * NTHR) {
            const int t = idx >> 6, i = idx & 63;
            const float inv_freq = (float)exp2(-(double)i * (13.287712379549449 / 64.0));
            const float angf = (float)pos[t] * inv_freq;
            float sn, cs; sincos_acc((double)angf, sn, cs);
            ct[idx] = cs; st[idx] = sn;
        }
    }
}
__device__ __forceinline__ void norm_phase(const Frame& F0, const float* __restrict__ x, const float* __restrict__ g, const float* __restrict__ sc, const float* __restrict__ sh, bf16_t* __restrict__ h) {
    const Frame F = opaque(F0);
    f32x4 ga[4], gb[4];
#pragma unroll
    for (int j = 0; j < 4; ++j) { const f32x4 gg = ((const f32x4*)g)[F.lane + 64 * j], s1 = ((const f32x4*)sc)[F.lane + 64 * j]; ga[j] = gg * (s1 + 1.0f); gb[j] = ((const f32x4*)sh)[F.lane + 64 * j]; }
    const int gw = F.vcu * NWAVES + F.wave, NGW = F.G * NWAVES;
    for (int m = gw; m < S; m += NGW) {
        const f32x4* xr = (const f32x4*)(x + (size_t)m * D) + F.lane;
        f32x4 v[4]; float ss = 0.f;
#pragma unroll
        for (int j = 0; j < 4; ++j) { v[j] = xr[64 * j]; ss += (v[j].x * v[j].x + v[j].y * v[j].y) + (v[j].z * v[j].z + v[j].w * v[j].w); }
        const float r = 1.0f / sqrtf(wave_sum(ss) * (1.f / D) + EPS);
        u32x2* o8 = (u32x2*)(h + (size_t)m * D) + F.lane;
#pragma unroll
        for (int j = 0; j < 4; ++j) { const f32x4 y = v[j] * r * ga[j] + gb[j]; u32x2 w; w.x = cvtpk(y.x, y.y); w.y = cvtpk(y.z, y.w); o8[64 * j] = w; }
    }
}
__device__ __forceinline__ void glr_phase(const Frame& F0, const bf16_t* __restrict__ H, const bf16_t* __restrict__ WglrT, float* __restrict__ glr) {
    const Frame F = opaque(F0);
    const int l15 = F.lane & 15, q = F.lane >> 4, mt = F.wave & 3, kh = F.wave >> 2;
    LAS f32x4* part = (LAS f32x4*)F.lds;
    for (int rb = F.vcu; rb < S / 64; rb += F.G) {
        const int row0 = rb * 64 + mt * 16;
        const bf16_t* ap = H + (size_t)(row0 + l15) * D + 8 * q + kh * 512;
        const bf16_t* bp = WglrT + (size_t)l15 * D + 8 * q + kh * 512;
        f32x4 acc = {0.f, 0.f, 0.f, 0.f};
#pragma unroll 16
        for (int ks = 0; ks < 16; ++ks) {
            const bf16x8 av = *(const bf16x8*)(ap + ks * 32), bv = *(const bf16x8*)(bp + ks * 32);
            acc = __builtin_amdgcn_mfma_f32_16x16x32_bf16(av, bv, acc, 0, 0, 0);
        }
        if (kh) part[mt * 64 + F.lane] = acc;
        __syncthreads();
        if (!kh) { acc += part[mt * 64 + F.lane];
#pragma unroll
            for (int r = 0; r < 4; ++r) glr[(size_t)(row0 + 4 * q + r) * 16 + l15] = acc[r]; }
        __syncthreads();
    }
}
typedef short v4i16_t __attribute__((ext_vector_type(4)));
__device__ __forceinline__ s16x4 vtr(const LAS unsigned char* p) { return __builtin_bit_cast(s16x4, __builtin_amdgcn_ds_read_tr16_b64_v4i16((LAS v4i16_t*)p)); }
__device__ __forceinline__ int crow(int reg, int h) { return (reg & 3) + 8 * (reg >> 2) + 4 * h; }
__device__ __forceinline__ unsigned off_b(unsigned row, unsigned ch) { return 272u * row + 16u * ch; }
__device__ __forceinline__ unsigned tr_addr(unsigned lane, unsigned c, unsigned rowblk) {
    const unsigned blk = (lane >> 4) & 1, q = (lane & 15) >> 2, p = lane & 3;
    return off_b(rowblk + q, 4 * c + 2 * blk + (p >> 1)) + 8 * (p & 1);
}
constexpr int GL_IMG = 64 * 272, GL_PST = 144;
constexpr int GL_QD = 0, GL_KI = GL_IMG, GL_KT = 2 * GL_IMG, GL_V = 3 * GL_IMG, GL_P = 5 * GL_IMG, GL_GL = GL_P + 64 * GL_PST, GL_SEG = GL_GL + 4096, GL_DEC = GL_SEG + 2048, GL_RED = GL_DEC + 512;
static_assert(GL_RED + 2048 <= RING_BYTES, "gla lds");
#define MFMA32(a, b, c) __builtin_amdgcn_mfma_f32_32x32x16_bf16((a), (b), (c), 0, 0, 0)

struct GlaPre { f32x4 ga, gb; unsigned qk[16]; };
__device__ __forceinline__ void gla_prefetch_g(const Frame& F, const float* __restrict__ GLR, int t0, GlaPre& P) {
    const int ib = F.wave >> 2, l31 = F.lane & 31, h = F.lane >> 5;
    const float* gp = GLR + (size_t)(t0 + 32 * ib + l31) * 16 + 8 * h;
    P.ga = *(const f32x4*)gp; P.gb = *(const f32x4*)(gp + 4);
}
template <bool WITH_Q>
__device__ __forceinline__ void gla_prefetch(const Frame& F, const bf16_t* __restrict__ QKV, const float* __restrict__ GLR, int t0, int hd, GlaPre& P);
template <bool WITH_Q>
__device__ __forceinline__ void gla_prefetch_qk(const Frame& F, const bf16_t* __restrict__ QKV, int t0, int hd, GlaPre& P) {
    const int w = F.wave, ib = w >> 2, db = w & 3, l31 = F.lane & 31, h = F.lane >> 5;
#pragma unroll
    for (int r = 0; r < 16; ++r) {
        const bf16_t* row = QKV + (size_t)(t0 + 32 * ib + crow(r, h)) * 3072 + hd * 128 + 32 * db + l31;
        const unsigned kk = row[512]; const unsigned qq = WITH_Q ? (unsigned)row[0] : 0u;
        P.qk[r] = qq | (kk << 16);
    }
}
template <bool WITH_Q>
__device__ __forceinline__ void gla_prefetch(const Frame& F, const bf16_t* __restrict__ QKV, const float* __restrict__ GLR, int t0, int hd, GlaPre& P) {
    gla_prefetch_g(F, GLR, t0, P); gla_prefetch_qk<WITH_Q>(F, QKV, t0, hd, P);
}
struct GlaW { u32x4 bhi, blo; float bias; };
__device__ __forceinline__ void gla_load_w(const float* __restrict__ wupg, const float* __restrict__ bgg, int hd, const Frame& F, GlaW& W) {
    const int db = F.wave & 3, l31 = F.lane & 31, h = F.lane >> 5, d = hd * 128 + 32 * db + l31;
    float wv[8];
#pragma unroll
    for (int j = 0; j < 8; ++j) wv[j] = wupg[(8 * h + j) * 512 + d];
    W.bhi.x = cvtpk(wv[0], wv[1]); W.bhi.y = cvtpk(wv[2], wv[3]); W.bhi.z = cvtpk(wv[4], wv[5]); W.bhi.w = cvtpk(wv[6], wv[7]);
    W.blo.x = cvtpk(wv[0] - bflo(W.bhi.x), wv[1] - bfhi(W.bhi.x)); W.blo.y = cvtpk(wv[2] - bflo(W.bhi.y), wv[3] - bfhi(W.bhi.y));
    W.blo.z = cvtpk(wv[4] - bflo(W.bhi.z), wv[5] - bfhi(W.bhi.z)); W.blo.w = cvtpk(wv[6] - bflo(W.bhi.w), wv[7] - bfhi(W.bhi.w));
    W.bias = bgg[d];
}
template <bool WITH_Q, bool VPRE>
__device__ __forceinline__ float gla_chunk_prep(const Frame& F, const GlaPre& P, const GlaW& W, const bf16_t* __restrict__ QKV, int t0, int hd, const u32x4 (&vpre)[4]) {
    LAS unsigned char* lds = F.lds;
    const int w = F.wave, ib = w >> 2, db = w & 3, l31 = F.lane & 31, h = F.lane >> 5, d = 32 * db + l31;
    u32x4 vv[4];
#pragma unroll
    for (int k = 0; k < 4; ++k) { const int c = F.tid + 512 * k, j = c >> 5, ch = c & 31; vv[k] = VPRE ? vpre[k] : *(const u32x4*)(QKV + (size_t)(t0 + j) * 3072 + 1024 + hd * 256 + ch * 8); }
    u32x4 ahi, alo;
    ahi.x = cvtpk(P.ga.x, P.ga.y); ahi.y = cvtpk(P.ga.z, P.ga.w); ahi.z = cvtpk(P.gb.x, P.gb.y); ahi.w = cvtpk(P.gb.z, P.gb.w);
    alo.x = cvtpk(P.ga.x - bflo(ahi.x), P.ga.y - bfhi(ahi.x)); alo.y = cvtpk(P.ga.z - bflo(ahi.y), P.ga.w - bfhi(ahi.y));
    alo.z = cvtpk(P.gb.x - bflo(ahi.z), P.gb.y - bfhi(ahi.z)); alo.w = cvtpk(P.gb.z - bflo(ahi.w), P.gb.w - bfhi(ahi.w));
    f32x16 X;
#pragma unroll
    for (int r = 0; r < 16; ++r) X[r] = W.bias;
    X = MFMA32(__builtin_bit_cast(bf16x8, ahi), __builtin_bit_cast(bf16x8, W.bhi), X);
    X = MFMA32(__builtin_bit_cast(bf16x8, alo), __builtin_bit_cast(bf16x8, W.bhi), X);
    X = MFMA32(__builtin_bit_cast(bf16x8, ahi), __builtin_bit_cast(bf16x8, W.blo), X);
    float G[16], sk[4];
#pragma unroll
    for (int k = 0; k < 4; ++k) { float run = 0.f;
#pragma unroll
        for (int j = 0; j < 4; ++j) { const float x = X[4 * k + j]; const float ls = fminf(x, 0.f) - __logf(1.f + __expf(-fabsf(x))); run += ls * (1.f / 16.f); G[4 * k + j] = run; }
        sk[k] = run; }
    float base = 0.f, tot;
    {
        float ps[4];
#pragma unroll
        for (int k = 0; k < 4; ++k) ps[k] = __shfl_xor(sk[k], 32);
#pragma unroll
        for (int k = 0; k < 4; ++k) { const float bk = base + (h ? ps[k] : 0.f);
#pragma unroll
            for (int j = 0; j < 4; ++j) G[4 * k + j] += bk;
            base += sk[k] + ps[k]; }
        tot = base;
    }
    LAS float* HT = (LAS float*)(lds + GL_SEG);
    if (h == 0) HT[ib * 128 + d] = tot;
#pragma unroll
    for (int k = 0; k < 4; ++k) { const int c = F.tid + 512 * k, j = c >> 5, ch = c & 31; *(LAS u32x4*)(lds + GL_V + (ch >> 4) * GL_IMG + off_b(j, ch & 15)) = vv[k]; }
    __syncthreads();
    const float t0h = HT[d], t1h = HT[128 + d], glast = t0h + t1h;
    const float add = ib ? t0h : 0.f;
    const float qs = 0.08838834764831845f;
#pragma unroll
    for (int r = 0; r < 16; ++r) {
        const int i = 32 * ib + crow(r, h); const float Gv = G[r] + add;
        const unsigned a = off_b(i, d >> 3) + 2 * (d & 7);
        const float kf = bfhi(P.qk[r]);
        if (WITH_Q) {
            *(LAS unsigned short*)(lds + GL_QD + a) = (unsigned short)(cvtpk(bflo(P.qk[r]) * qs * __expf(Gv), 0.f) & 0xffffu);
            *(LAS unsigned short*)(lds + GL_KI + a) = (unsigned short)(cvtpk(kf * __expf(-Gv), 0.f) & 0xffffu);
        }
        *(LAS unsigned short*)(lds + GL_KT + a) = (unsigned short)(cvtpk(kf * __expf(glast - Gv), 0.f) & 0xffffu);
    }
    if (ib == 0 && h == 0) ((LAS float*)(lds + GL_DEC))[d] = __expf(glast);
    __syncthreads();
    return glast;
}
__device__ __forceinline__ void gla_state_update(const Frame& F, f32x16 (&St)[4]) {
    LAS unsigned char* lds = F.lds;
    const int h = F.lane >> 5, w = F.wave;
    const LAS float* dec = (const LAS float*)(lds + GL_DEC);
#pragma unroll
    for (int db = 0; db < 4; ++db)
#pragma unroll
        for (int r = 0; r < 16; ++r) St[db][r] *= dec[32 * db + crow(r, h)];
    const LAS unsigned char* vimg = lds + GL_V + (w >> 2) * GL_IMG;
#pragma unroll
    for (int ks = 0; ks < 4; ++ks) {
        const s16x4 vlo = vtr(vimg + tr_addr(F.lane, w & 3, 16 * ks + 8 * h)), vhi = vtr(vimg + tr_addr(F.lane, w & 3, 16 * ks + 8 * h + 4));
        const bf16x8 vb = __builtin_shufflevector(vlo, vhi, 0, 1, 2, 3, 4, 5, 6, 7);
#pragma unroll
        for (int db = 0; db < 4; ++db) {
            const s16x4 klo = vtr(lds + GL_KT + tr_addr(F.lane, db, 16 * ks + 8 * h)), khi = vtr(lds + GL_KT + tr_addr(F.lane, db, 16 * ks + 8 * h + 4));
            const bf16x8 ka = __builtin_shufflevector(klo, khi, 0, 1, 2, 3, 4, 5, 6, 7);
            St[db] = MFMA32(ka, vb, St[db]);
        }
    }
}
__device__ __forceinline__ void gla_g1(const Frame& F0, const bf16_t* __restrict__ QKV, const float* __restrict__ GLR, const float* __restrict__ wupg, const float* __restrict__ bgg, float* __restrict__ SBUF, float* __restrict__ DG) {
    const Frame F = opaque(F0);
    const int h = F.lane >> 5, w = F.wave;
    for (int u = F.vcu; u < 256; u += F.G) {
        const int gi = u >> 2, hd = u & 3;
        GlaW W; gla_load_w(wupg, bgg, hd, F, W);
        f32x16 St[4];
#pragma unroll
        for (int db = 0; db < 4; ++db)
#pragma unroll
            for (int r = 0; r < 16; ++r) St[db][r] = 0.f;
        float gsum = 0.f;
        GlaPre P; gla_prefetch<false>(F, QKV, GLR, gi * 256, hd, P);
        u32x4 vpre[4];
#define GLA_VPRE(t0_) do { _Pragma("unroll") for (int k_ = 0; k_ < 4; ++k_) { const int c_ = F.tid + 512 * k_, j_ = c_ >> 5, ch_ = c_ & 31; vpre[k_] = *(const u32x4*)(QKV + (size_t)((t0_) + j_) * 3072 + 1024 + hd * 256 + ch_ * 8); } } while (0)
        GLA_VPRE(gi * 256);
#pragma unroll 1
        for (int c = 0; c < 4; ++c) {
            gsum += gla_chunk_prep<false, true>(F, P, W, QKV, gi * 256 + c * 64, hd, vpre);
            if (c < 3) { gla_prefetch<false>(F, QKV, GLR, gi * 256 + (c + 1) * 64, hd, P); GLA_VPRE(gi * 256 + (c + 1) * 64); }
            gla_state_update(F, St);
            __syncthreads();
        }
        float* sp = SBUF + ((size_t)u * 128) * 256 + 32 * w + (F.lane & 31);
#pragma unroll
        for (int db = 0; db < 4; ++db)
#pragma unroll
            for (int r = 0; r < 16; ++r) sp[(size_t)(32 * db + crow(r, h)) * 256] = St[db][r];
        if ((w >> 2) == 0 && h == 0) DG[u * 128 + 32 * (w & 3) + (F.lane & 31)] = __expf(gsum);
    }
}
__device__ __forceinline__ void gla_g2(const Frame& F0, float* __restrict__ SBUF, const float* __restrict__ DG) {
    const Frame F = opaque(F0);
    for (int e = F.vcu * NTHR + F.tid; e < 4 * 128 * 256; e += F.G * NTHR) {
        const int hd = e >> 15, d = (e >> 8) & 127;
        float run = 0.f;
#pragma unroll 1
        for (int g0 = 0; g0 < 64; g0 += 8) {
            float tmp[8], dec[8];
#pragma unroll
            for (int k = 0; k < 8; ++k) { const int g = g0 + k; tmp[k] = SBUF[(size_t)(g * 4 + hd) * 32768 + (e & 32767)]; dec[k] = DG[(g * 4 + hd) * 128 + d]; }
#pragma unroll
            for (int k = 0; k < 8; ++k) { const int g = g0 + k; SBUF[(size_t)(g * 4 + hd) * 32768 + (e & 32767)] = run; run = dec[k] * run + tmp[k]; }
        }
    }
}
__device__ __forceinline__ void gla_g3(const Frame& F0, const bf16_t* __restrict__ QKV, const float* __restrict__ GLR, const float* __restrict__ wupg, const float* __restrict__ bgg,
                                       const float* __restrict__ SBUF, const float* __restrict__ og, bf16_t* __restrict__ MIX) {
    const Frame F = opaque(F0);
    LAS unsigned char* lds = F.lds;
    const int h = F.lane >> 5, w = F.wave, l31 = F.lane & 31;
    for (int u = F.vcu; u < 256; u += F.G) {
        const int gi = u >> 2, hd = u & 3;
        GlaW W; gla_load_w(wupg, bgg, hd, F, W);
        f32x16 St[4];
        { const float* sp = SBUF + ((size_t)u * 128) * 256 + 32 * w + l31;
#pragma unroll
          for (int db = 0; db < 4; ++db)
#pragma unroll
              for (int r = 0; r < 16; ++r) St[db][r] = sp[(size_t)(32 * db + crow(r, h)) * 256]; }
#pragma unroll 1
        for (int c = 0; c < 4; ++c) {
            const int t0 = gi * 256 + c * 64;
            { GlaPre P; gla_prefetch<true>(F, QKV, GLR, t0, hd, P); u32x4 vdum[4]; (void)gla_chunk_prep<true, false>(F, P, W, QKV, t0, hd, vdum); }
            if (w < 3) {
                const int ib = (w >= 1), jb = (w == 2);
                f32x16 acc;
#pragma unroll
                for (int r = 0; r < 16; ++r) acc[r] = 0.f;
#pragma unroll
                for (int s = 0; s < 8; ++s) {
                    const bf16x8 a = *(const LAS bf16x8*)(lds + GL_QD + off_b(32 * ib + l31, 2 * s + h));
                    const bf16x8 b = *(const LAS bf16x8*)(lds + GL_KI + off_b(32 * jb + l31, 2 * s + h));
                    acc = MFMA32(a, b, acc);
                }
                const int jabs = 32 * jb + l31;
#pragma unroll
                for (int r = 0; r < 16; ++r) { const int iabs = 32 * ib + crow(r, h); const float pv = (jabs <= iabs) ? acc[r] : 0.f;
                    *(LAS unsigned short*)(lds + GL_P + iabs * GL_PST + 2 * jabs) = (unsigned short)(cvtpk(pv, 0.f) & 0xffffu); }
            }
            f32x16 oT[2];
#pragma unroll
            for (int ib = 0; ib < 2; ++ib)
#pragma unroll
                for (int r = 0; r < 16; ++r) oT[ib][r] = 0.f;
#pragma unroll
            for (int db = 0; db < 4; ++db)
#pragma unroll
                for (int s = 0; s < 2; ++s) {
                    u32x4 pk; pk.x = cvtpk(St[db][8 * s + 0], St[db][8 * s + 1]); pk.y = cvtpk(St[db][8 * s + 2], St[db][8 * s + 3]); pk.z = cvtpk(St[db][8 * s + 4], St[db][8 * s + 5]); pk.w = cvtpk(St[db][8 * s + 6], St[db][8 * s + 7]);
                    const bf16x8 xa = __builtin_bit_cast(bf16x8, pk);
#pragma unroll
                    for (int ib = 0; ib < 2; ++ib) {
                        const u32x2 qlo = *(const LAS u32x2*)(lds + GL_QD + off_b(32 * ib + l31, 4 * db + 2 * s + 0) + 8 * h);
                        const u32x2 qhi = *(const LAS u32x2*)(lds + GL_QD + off_b(32 * ib + l31, 4 * db + 2 * s + 1) + 8 * h);
                        u32x4 qq; qq.x = qlo.x; qq.y = qlo.y; qq.z = qhi.x; qq.w = qhi.y;
                        oT[ib] = MFMA32(xa, __builtin_bit_cast(bf16x8, qq), oT[ib]);
                    }
                }
            __syncthreads();
            {
                const LAS unsigned char* vimg = lds + GL_V + (w >> 2) * GL_IMG;
#pragma unroll
                for (int ks = 0; ks < 4; ++ks) {
                    const s16x4 vlo = vtr(vimg + tr_addr(F.lane, w & 3, 16 * ks + 8 * h)), vhi = vtr(vimg + tr_addr(F.lane, w & 3, 16 * ks + 8 * h + 4));
                    const bf16x8 va = __builtin_shufflevector(vlo, vhi, 0, 1, 2, 3, 4, 5, 6, 7);
#pragma unroll
                    for (int ib = 0; ib < 2; ++ib) {
                        if (ib == 0 && ks >= 2) continue;
                        const int irow = 32 * ib + l31;
                        const bf16x8 pb = *(const LAS bf16x8*)(lds + GL_P + irow * GL_PST + 16 * (2 * ks + h));
                        oT[ib] = MFMA32(va, pb, oT[ib]);
                    }
                }
            }
            float ssq[2];
#pragma unroll
            for (int ib = 0; ib < 2; ++ib) { float s = 0.f;
#pragma unroll
                for (int r = 0; r < 16; ++r) s += oT[ib][r] * oT[ib][r];
                s += __shfl_xor(s, 32); ssq[ib] = s; }
            if (h == 0) { ((LAS float*)(lds + GL_RED))[w * 64 + l31] = ssq[0]; ((LAS float*)(lds + GL_RED))[w * 64 + 32 + l31] = ssq[1]; }
            __syncthreads();
#pragma unroll
            for (int ib = 0; ib < 2; ++ib) {
                float tot = 0.f;
#pragma unroll
                for (int ww = 0; ww < 8; ++ww) tot += ((LAS float*)(lds + GL_RED))[ww * 64 + 32 * ib + l31];
                const float rn = 1.0f / sqrtf(tot * (1.f / 256.f) + EPS);
                const int t = t0 + 32 * ib + l31;
#pragma unroll
                for (int g = 0; g < 4; ++g) {
                    const int e0 = 32 * w + 8 * g + 4 * h;
                    const u32x2 rg = *(const u32x2*)(QKV + (size_t)t * 3072 + 2048 + hd * 256 + e0);
                    const f32x4 ogv = *(const f32x4*)(og + e0);
                    const float r0 = bflo(rg.x), r1 = bfhi(rg.x), r2 = bflo(rg.y), r3 = bfhi(rg.y);
                    const float y0 = oT[ib][4 * g + 0] * rn * ogv.x * (r0 / (1.f + __expf(-r0)));
                    const float y1 = oT[ib][4 * g + 1] * rn * ogv.y * (r1 / (1.f + __expf(-r1)));
                    const float y2 = oT[ib][4 * g + 2] * rn * ogv.z * (r2 / (1.f + __expf(-r2)));
                    const float y3 = oT[ib][4 * g + 3] * rn * ogv.w * (r3 / (1.f + __expf(-r3)));
                    u32x2 o; o.x = cvtpk(y0, y1); o.y = cvtpk(y2, y3);
                    *(u32x2*)(MIX + (size_t)t * D + hd * 256 + e0) = o;
                }
            }
            if (c < 3) gla_state_update(F, St);
            __syncthreads();
        }
    }
}
constexpr int MB_LIST_H = 516096;
__device__ __forceinline__ int mb_list_off(int n) { return 256 * (63 * n - (n * (n - 1)) / 2); }
constexpr int MB_OST = 2 * 128 * 256, MB_OSTW = 32 * 264;
constexpr int MB_PRE = MB_OST + 8 * MB_OSTW, MB_END = MB_PRE + 2064;
static_assert(MB_END <= MISC_OFF, "moba lds");

__device__ __forceinline__ void moba_m1_tile(const Frame& F, int pm, int pn, bf16_t* __restrict__ QKV, const float* __restrict__ COS, const float* __restrict__ SIN,
                                             const float* __restrict__ qg, const float* __restrict__ kg, float* __restrict__ KMEAN) {
    LAS unsigned char* lds = F.lds;
    const int which = (pn >= 4), h0 = 2 * (pn & 3);
    const int ts = F.lane >> 4, hs = (F.lane >> 3) & 1, j = F.lane & 7;
    const float* g = which ? kg : qg;
    const float gsc = which ? 1.0f : (0.08838834764831845f * 1.4426950408889634f);
    float g1[8], g2[8], a1[8], a2[8];
#pragma unroll
    for (int e = 0; e < 8; ++e) { g1[e] = g[8 * j + e] * gsc; g2[e] = g[64 + 8 * j + e] * gsc; a1[e] = 0.f; a2[e] = 0.f; }
#pragma unroll 4
    for (int it = 0; it < 8; ++it) {
        const int t = pm * 256 + (it * 8 + F.wave) * 4 + ts;
        bf16_t* p = QKV + (size_t)t * 3072 + which * 1024 + (h0 + hs) * 128 + 8 * j;
        const u32x4 ra = *(const u32x4*)p, rb = *(const u32x4*)(p + 64);
        const f32x4 c0 = *(const f32x4*)(COS + (size_t)t * 64 + 8 * j), c1 = *(const f32x4*)(COS + (size_t)t * 64 + 8 * j + 4);
        const f32x4 s0 = *(const f32x4*)(SIN + (size_t)t * 64 + 8 * j), s1 = *(const f32x4*)(SIN + (size_t)t * 64 + 8 * j + 4);
        float x1[8] = {bflo(ra.x), bfhi(ra.x), bflo(ra.y), bfhi(ra.y), bflo(ra.z), bfhi(ra.z), bflo(ra.w), bfhi(ra.w)};
        float x2[8] = {bflo(rb.x), bfhi(rb.x), bflo(rb.y), bfhi(rb.y), bflo(rb.z), bfhi(rb.z), bflo(rb.w), bfhi(rb.w)};
        const float cs[8] = {c0.x, c0.y, c0.z, c0.w, c1.x, c1.y, c1.z, c1.w};
        const float sn[8] = {s0.x, s0.y, s0.z, s0.w, s1.x, s1.y, s1.z, s1.w};
        float ss = 0.f;
#pragma unroll
        for (int e = 0; e < 8; ++e) ss += x1[e] * x1[e] + x2[e] * x2[e];
        ss += __shfl_xor(ss, 1); ss += __shfl_xor(ss, 2); ss += __shfl_xor(ss, 4);
        const float r = 1.0f / sqrtf(ss * (1.f / 128.f) + EPS);
        float o1[8], o2[8];
#pragma unroll
        for (int e = 0; e < 8; ++e) { const float y1 = x1[e] * r * g1[e], y2 = x2[e] * r * g2[e]; o1[e] = y1 * cs[e] - y2 * sn[e]; o2[e] = y2 * cs[e] + y1 * sn[e]; a1[e] += o1[e]; a2[e] += o2[e]; }
        u32x4 wa, wb;
        wa.x = cvtpk(o1[0], o1[1]); wa.y = cvtpk(o1[2], o1[3]); wa.z = cvtpk(o1[4], o1[5]); wa.w = cvtpk(o1[6], o1[7]);
        wb.x = cvtpk(o2[0], o2[1]); wb.y = cvtpk(o2[2], o2[3]); wb.z = cvtpk(o2[4], o2[5]); wb.w = cvtpk(o2[6], o2[7]);
        *(u32x4*)p = wa; *(u32x4*)(p + 64) = wb;
    }
    if (which) {
#pragma unroll
        for (int e = 0; e < 8; ++e) { a1[e] += __shfl_xor(a1[e], 16); a1[e] += __shfl_xor(a1[e], 32); a2[e] += __shfl_xor(a2[e], 16); a2[e] += __shfl_xor(a2[e], 32); }
        LAS float* red = (LAS float*)lds;
        if (ts == 0) {
#pragma unroll
            for (int e = 0; e < 8; ++e) { red[(F.wave * 2 + hs) * 128 + 8 * j + e] = a1[e]; red[(F.wave * 2 + hs) * 128 + 64 + 8 * j + e] = a2[e]; } }
        __syncthreads();
        if (F.tid < 256) { const int hh = F.tid >> 7, d = F.tid & 127; float s = 0.f;
#pragma unroll
            for (int w = 0; w < 8; ++w) s += red[(w * 2 + hh) * 128 + d];
            KMEAN[((size_t)(h0 + hh) * 64 + pm) * 128 + d] = s * (1.f / 256.f); }
        __syncthreads();
    }
}
__device__ __forceinline__ void moba_m1_tail(const Frame& F0, int G, int c, bf16_t* __restrict__ QKV, const float* __restrict__ COS, const float* __restrict__ SIN,
                                             const float* __restrict__ qg, const float* __restrict__ kg, float* __restrict__ KMEAN) {
    const Frame F = opaque(F0);
    pg8::StaticOrder So; So.init(S, 3072, G, c);
#pragma unroll 1
    for (int i = 0; i < 3; ++i) {
        pg8::Unit u; if (!So.next(i, u)) break;
        if (u.pn < 8) moba_m1_tile(F, u.pm, u.pn, QKV, COS, SIN, qg, kg, KMEAN);
    }
}
#define MB_INS(v, i) do { const float v_ = (v); const int i_ = (i); \
    const bool b0_ = v_ > v0 || (v_ == v0 && i_ < i0), b1_ = v_ > v1 || (v_ == v1 && i_ < i1), b2_ = v_ > v2 || (v_ == v2 && i_ < i2); \
    if (b0_) { v2 = v1; i2 = i1; v1 = v0; i1 = i0; v0 = v_; i0 = i_; } else if (b1_) { v2 = v1; i2 = i1; v1 = v_; i1 = i_; } else if (b2_) { v2 = v_; i2 = i_; } } while (0)
__device__ __forceinline__ void moba_m2(const Frame& F0, const bf16_t* __restrict__ QKV, const float* __restrict__ KMEAN, unsigned* __restrict__ gcnt, int* __restrict__ LIST) {
    const Frame F = opaque(F0);
    LAS unsigned char* lds = F.lds;
    LAS int* cntl = (LAS int*)lds;
    LAS float* kml = (LAS float*)(lds + 1024);
    const int h2 = F.lane >> 5, l31 = F.lane & 31, w = F.wave;
    for (int u = F.vcu; u < 512; u += F.G) {
        const int b = u >> 3, h = u & 7;
        if (b == 0) continue;
        if (F.tid < 64) cntl[F.tid] = 0;
#pragma unroll
        for (int k = 0; k < 4; ++k) { const int idx = F.tid + 512 * k, nr = idx >> 5, c4 = (idx & 31) * 4;
            if (nr < b) { const f32x4 v = *(const f32x4*)(KMEAN + ((size_t)h * 64 + nr) * 128 + c4); *(LAS f32x4*)(kml + nr * 132 + c4) = v; } }
        __syncthreads();
        const int t = b * 256 + 32 * w + l31;
        bf16x8 qf[8];
#pragma unroll
        for (int s = 0; s < 8; ++s) qf[s] = *(const bf16x8*)(QKV + (size_t)t * 3072 + h * 128 + 16 * s + 8 * h2);
        float v0 = -INFINITY, v1 = -INFINITY, v2 = -INFINITY; int i0 = 64, i1 = 64, i2 = 64;
#pragma unroll
        for (int nb = 0; nb < 2; ++nb) {
            if (nb == 1 && b <= 32) continue;
            f32x16 acc;
#pragma unroll
            for (int r = 0; r < 16; ++r) acc[r] = 0.f;
            const LAS float* kmp = kml + (32 * nb + l31) * 132 + 8 * h2;
#pragma unroll
            for (int s = 0; s < 8; ++s) {
                const f32x4 ka = *(const LAS f32x4*)(kmp + 16 * s), kb = *(const LAS f32x4*)(kmp + 16 * s + 4);
                u32x4 hi; hi.x = cvtpk(ka.x, ka.y); hi.y = cvtpk(ka.z, ka.w); hi.z = cvtpk(kb.x, kb.y); hi.w = cvtpk(kb.z, kb.w);
                u32x4 lo; lo.x = cvtpk(ka.x - bflo(hi.x), ka.y - bfhi(hi.x)); lo.y = cvtpk(ka.z - bflo(hi.y), ka.w - bfhi(hi.y));
                lo.z = cvtpk(kb.x - bflo(hi.z), kb.y - bfhi(hi.z)); lo.w = cvtpk(kb.z - bflo(hi.w), kb.w - bfhi(hi.w));
                acc = MFMA32(__builtin_bit_cast(bf16x8, hi), qf[s], acc);
                acc = MFMA32(__builtin_bit_cast(bf16x8, lo), qf[s], acc);
            }
#pragma unroll
            for (int r = 0; r < 16; ++r) { const int n = 32 * nb + crow(r, h2); const float gv = (n < b) ? acc[r] : -INFINITY; MB_INS(gv, n); }
        }
        { const float p0 = __shfl_xor(v0, 32), p1 = __shfl_xor(v1, 32), p2 = __shfl_xor(v2, 32); const int q0 = __shfl_xor(i0, 32), q1 = __shfl_xor(i1, 32), q2 = __shfl_xor(i2, 32);
          MB_INS(p0, q0); MB_INS(p1, q1); MB_INS(p2, q2); }
        int pos0 = 0, pos1 = 0, pos2 = 0;
        const bool e0 = (h2 == 0) && (v0 > -INFINITY), e1 = (h2 == 0) && (v1 > -INFINITY), e2 = (h2 == 0) && (v2 > -INFINITY);
        if (e0) pos0 = __hip_atomic_fetch_add(cntl + i0, 1, __ATOMIC_RELAXED, __HIP_MEMORY_SCOPE_WORKGROUP);
        if (e1) pos1 = __hip_atomic_fetch_add(cntl + i1, 1, __ATOMIC_RELAXED, __HIP_MEMORY_SCOPE_WORKGROUP);
        if (e2) pos2 = __hip_atomic_fetch_add(cntl + i2, 1, __ATOMIC_RELAXED, __HIP_MEMORY_SCOPE_WORKGROUP);
        __syncthreads();
        if (F.tid < 64) { const int c = cntl[F.tid]; int base = 0; if (c > 0) base = (int)__hip_atomic_fetch_add(gcnt + h * 64 + F.tid, (unsigned)c, __ATOMIC_RELAXED, __HIP_MEMORY_SCOPE_AGENT); cntl[64 + F.tid] = base; }
        __syncthreads();
        int* lst = LIST + (size_t)h * MB_LIST_H;
        if (e0) lst[mb_list_off(i0) + cntl[64 + i0] + pos0] = (t << 2) | 0;
        if (e1) lst[mb_list_off(i1) + cntl[64 + i1] + pos1] = (t << 2) | 1;
        if (e2) lst[mb_list_off(i2) + cntl[64 + i2] + pos2] = (t << 2) | 2;
        __syncthreads();
    }
}
constexpr int MB_HALF = 128 * 256;
__device__ __forceinline__ unsigned off_x(unsigned row, unsigned ch) { return 256u * row + 16u * (ch ^ (((row & 3) << 2) | ((row >> 2) & 3))); }
__device__ __forceinline__ void mb_decode(int v, const LAS int* pre, const unsigned* __restrict__ gcnt, int& h, int& n, int& count, int& lbase, bool& own) {
    if (v < 512) { n = v >> 3; h = v & 7; count = 256; lbase = 0; own = true; return; }
    const int x = v - 512; int lo_ = 0, hi_ = 511;
    while (lo_ < hi_) { const int mid = (lo_ + hi_) >> 1; if (pre[mid] > x) hi_ = mid; else lo_ = mid + 1; }
    const int hn = lo_; h = hn >> 6; n = hn & 63;
    const int tile = x - (hn ? pre[hn - 1] : 0);
    count = (int)gcnt[hn] - tile * 256; if (count > 256) count = 256;
    lbase = h * MB_LIST_H + mb_list_off(n) + tile * 256; own = false;
}
#define MB_STAGE(hh_, nn_, hf_, buf_) do { _Pragma("unroll") for (int k_ = 0; k_ < 4; ++k_) { const int pc_ = w * 4 + k_;               \
        const int r_ = 4 * pc_ + (F.lane >> 4); const int ch_ = (F.lane & 15) ^ (((r_ & 3) << 2) | ((r_ >> 2) & 3)); \
        const bf16_t* src_ = QKV + (size_t)((nn_) * 256 + (hf_) * 128 + r_) * 3072 + 1024 + (hh_) * 128 + 8 * ch_; \
        __builtin_amdgcn_global_load_lds((const unsigned*)src_, (LAS unsigned*)(lds + (buf_) * 2 * MB_HALF + pc_ * 1024), 16, 0, 0); \
        __builtin_amdgcn_global_load_lds((const unsigned*)(src_ + 1024), (LAS unsigned*)(lds + (buf_) * 2 * MB_HALF + MB_HALF + pc_ * 1024), 16, 0, 0); } } while (0)
#define MB_VMWAIT() asm volatile("s_waitcnt vmcnt(0)" ::: "memory")
#define MB_ENT(entv_, own_, nn_, cnt_, lb_) do { const int qi_ = 32 * w + l31; \
        if (own_) entv_ = (((nn_) * 256 + qi_) << 2) | 3; else entv_ = (qi_ < (cnt_)) ? LIST[(lb_) + qi_] : -1; } while (0)
#define MB_GATHER(entv_, qv_, nn_, hh_) do { \
        const int tq_ = (entv_ >= 0) ? (entv_ >> 2) : ((nn_) * 256); \
        _Pragma("unroll") for (int s_ = 0; s_ < 8; ++s_) qv_[s_] = *(const bf16x8*)(QKV + (size_t)tq_ * 3072 + (hh_) * 128 + 16 * s_ + 8 * h2); } while (0)
#define MB_COMPUTE(buf_, hf_, nkt_, own_) do { \
        const LAS unsigned char* kb_ = lds + (buf_) * 2 * MB_HALF + 256 * l31; \
        const LAS unsigned char* vb_ = lds + (buf_) * 2 * MB_HALF + MB_HALF + 256 * (4 * h2 + vq) + 8 * (vp & 1); \
        _Pragma("unroll 1") for (int kt_ = 0; kt_ < (nkt_); ++kt_) { \
            bf16x8 ka_[4]; \
            _Pragma("unroll") for (int s_ = 0; s_ < 4; ++s_) ka_[s_] = *(const LAS bf16x8*)(kb_ + kt_ * (32 * 256) + 16 * ((2 * s_ + h2) ^ fK)); \
            f32x16 acc_; _Pragma("unroll") for (int r_ = 0; r_ < 16; ++r_) acc_[r_] = 0.f; \
            _Pragma("unroll") for (int s_ = 0; s_ < 4; ++s_) acc_ = MFMA32(ka_[s_], qf[s_], acc_); \
            _Pragma("unroll") for (int s_ = 0; s_ < 4; ++s_) ka_[s_] = *(const LAS bf16x8*)(kb_ + kt_ * (32 * 256) + 16 * ((2 * (s_ + 4) + h2) ^ fK)); \
            _Pragma("unroll") for (int s_ = 0; s_ < 4; ++s_) acc_ = MFMA32(ka_[s_], qf[s_ + 4], acc_); \
            s16x4 vl0_[4], vh0_[4]; \
            _Pragma("unroll") for (int db_ = 0; db_ < 4; ++db_) { const LAS unsigned char* vp_ = vb_ + (kt_ * 32) * 256 + 64 * (db_ ^ vq); \
                vl0_[db_] = vtr(vp_ + 16 * (vj ^ h2)); vh0_[db_] = vtr(vp_ + 8 * 256 + 16 * (vj ^ (2 + h2))); } \
            float pr_[16]; \
            _Pragma("unroll") for (int r_ = 0; r_ < 16; ++r_) { float p_ = __builtin_amdgcn_exp2f(acc_[r_]); if ((own_) && (128 * (hf_) + 32 * kt_ + crow(r_, h2) > 32 * w + l31)) p_ = 0.f; pr_[r_] = p_; lsum += p_; } \
            { u32x4 pk_; pk_.x = cvtpk(pr_[0], pr_[1]); pk_.y = cvtpk(pr_[2], pr_[3]); pk_.z = cvtpk(pr_[4], pr_[5]); pk_.w = cvtpk(pr_[6], pr_[7]); \
              const bf16x8 pb_ = __builtin_bit_cast(bf16x8, pk_); \
              _Pragma("unroll") for (int db_ = 0; db_ < 4; ++db_) O[db_] = MFMA32(__builtin_shufflevector(vl0_[db_], vh0_[db_], 0, 1, 2, 3, 4, 5, 6, 7), pb_, O[db_]); } \
            _Pragma("unroll") for (int db_ = 0; db_ < 4; ++db_) { const LAS unsigned char* vp_ = vb_ + (kt_ * 32 + 16) * 256 + 64 * (db_ ^ vq); \
                vl0_[db_] = vtr(vp_ + 16 * (vj ^ h2)); vh0_[db_] = vtr(vp_ + 8 * 256 + 16 * (vj ^ (2 + h2))); } \
            { u32x4 pk_; pk_.x = cvtpk(pr_[8], pr_[9]); pk_.y = cvtpk(pr_[10], pr_[11]); pk_.z = cvtpk(pr_[12], pr_[13]); pk_.w = cvtpk(pr_[14], pr_[15]); \
              const bf16x8 pb_ = __builtin_bit_cast(bf16x8, pk_); \
              _Pragma("unroll") for (int db_ = 0; db_ < 4; ++db_) O[db_] = MFMA32(__builtin_shufflevector(vl0_[db_], vh0_[db_], 0, 1, 2, 3, 4, 5, 6, 7), pb_, O[db_]); } } } while (0)
template <int MODE  >
__device__ __forceinline__ void moba_m3(const Frame& F0, const bf16_t* __restrict__ QKV, const unsigned* __restrict__ gcnt, const int* __restrict__ LIST,
                                        bf16_t* __restrict__ OPART01, bf16_t* __restrict__ OPART2, bf16_t* __restrict__ MIX, float* __restrict__ LPART) {
    const Frame F = opaque(F0);
    LAS unsigned char* lds = F.lds;
    LAS int* pre = (LAS int*)(lds + MB_PRE);
    const int h2 = F.lane >> 5, l31 = F.lane & 31, w = F.wave;
    const int fK = ((l31 & 3) << 2) | ((l31 >> 2) & 3);
    const int vq = (F.lane & 15) >> 2, vp = F.lane & 3, vj = 2 * ((F.lane >> 4) & 1) + (vp >> 1);
    if (MODE == 0) { int v = ((int)gcnt[F.tid] + 255) >> 8; pre[F.tid] = v; __syncthreads();
#pragma unroll 1
      for (int o = 1; o < 512; o <<= 1) { const int add = (F.tid >= o) ? pre[F.tid - o] : 0; __syncthreads(); pre[F.tid] += add; __syncthreads(); } }
    const int total = MODE ? 512 : (512 + pre[511]);
    const int u_lo = MODE ? 0 : 512, u_hi = MODE ? 512 : total;
    const int n_units = (u_hi - u_lo - F.vcu + F.G - 1) / F.G;
    if (n_units <= 0) return;
#define MB_UNIT_V(it_) (u_lo + F.vcu + (it_) * F.G)
    int h, n, count, lbase; bool own;
    mb_decode(MB_UNIT_V(0), pre, gcnt, h, n, count, lbase, own);
    int ent; bf16x8 qf[8];
    MB_ENT(ent, own, n, count, lbase);
    MB_GATHER(ent, qf, n, h);
    MB_STAGE(h, n, 0, 0);
    MB_VMWAIT();
    __syncthreads();
#pragma unroll 1
    for (int it = 0; it < n_units; ++it) {
        f32x16 O[4];
#pragma unroll
        for (int db = 0; db < 4; ++db)
#pragma unroll
            for (int r = 0; r < 16; ++r) O[db][r] = 0.f;
        float lsum = 0.f;
        MB_STAGE(h, n, 1, 1);
        { const int nkt = own ? ((w + 1 < 4) ? (w + 1) : 4) : 4; MB_COMPUTE(0, 0, nkt, own); }
        const bool more = (it + 1 < n_units);
        int h_n = h, n_n = n, count_n = count, lbase_n = lbase; bool own_n = own;
        int ent_n = -1;
        if (more) { mb_decode(MB_UNIT_V(it + 1), pre, gcnt, h_n, n_n, count_n, lbase_n, own_n); MB_ENT(ent_n, own_n, n_n, count_n, lbase_n); }
        MB_VMWAIT();
        __syncthreads();
        if (more) MB_STAGE(h_n, n_n, 0, 0);
        { const int nkt = own ? ((w >= 4) ? (w - 3) : 0) : 4; MB_COMPUTE(1, 1, nkt, own); }
        const int ent_c = ent, h_c = h;
        if (more) MB_GATHER(ent_n, qf, n_n, h_n);
        lsum += __shfl_xor(lsum, 32);
        if (MODE == 0) { if (ent_c >= 0 && h2 == 0) LPART[((size_t)(ent_c & 3) * S + (ent_c >> 2)) * 8 + h_c] = lsum; }
        float linv = 0.f;
        if (MODE == 1) {
            const int tq = ent_c >> 2, nsel = (tq >> 8) < 3 ? (tq >> 8) : 3; float lt = lsum;
#pragma unroll
            for (int sl = 0; sl < 3; ++sl) if (sl < nsel) lt += LPART[((size_t)sl * S + tq) * 8 + h_c];
            linv = 1.f / lt;
        }
        __syncthreads();
        {
            LAS unsigned char* ost = lds + MB_OST + w * MB_OSTW;
#pragma unroll
            for (int db = 0; db < 4; ++db)
#pragma unroll
                for (int g = 0; g < 4; ++g) { u32x2 o; o.x = cvtpk(O[db][4 * g + 0], O[db][4 * g + 1]); o.y = cvtpk(O[db][4 * g + 2], O[db][4 * g + 3]);
                    *(LAS u32x2*)(ost + l31 * 264 + 2 * (32 * db + 8 * g + 4 * h2)) = o; }
            asm volatile("s_waitcnt lgkmcnt(0)" ::: "memory");
#pragma unroll
            for (int i = 0; i < 8; ++i) {
                const int row = 4 * i + (F.lane >> 4), ch = F.lane & 15;
                const int er = __shfl(ent_c, row);
                const u32x4 v = *(const LAS u32x4*)(ost + row * 264 + 16 * ch);
                if (MODE == 0) {
                    if (er >= 0) { const int sl = er & 3, tq = er >> 2;
                        bf16_t* dst = ((sl == 2) ? (OPART2 + (size_t)tq * D) : (OPART01 + ((size_t)sl * S + tq) * D)) + h_c * 128 + 8 * ch;
                        *(u32x4*)dst = v; }
                } else {
                    const float li = __shfl(linv, row);
                    const int tq = er >> 2, nsel = (tq >> 8) < 3 ? (tq >> 8) : 3;
                    float o[8] = {bflo(v.x), bfhi(v.x), bflo(v.y), bfhi(v.y), bflo(v.z), bfhi(v.z), bflo(v.w), bfhi(v.w)};
#pragma unroll
                    for (int sl = 0; sl < 3; ++sl) if (sl < nsel) {
                        const u32x4 p = *(const u32x4*)(((sl == 2) ? (OPART2 + (size_t)tq * D) : (OPART01 + ((size_t)sl * S + tq) * D)) + h_c * 128 + 8 * ch);
                        o[0] += bflo(p.x); o[1] += bfhi(p.x); o[2] += bflo(p.y); o[3] += bfhi(p.y); o[4] += bflo(p.z); o[5] += bfhi(p.z); o[6] += bflo(p.w); o[7] += bfhi(p.w); }
                    u32x4 r; r.x = cvtpk(o[0] * li, o[1] * li); r.y = cvtpk(o[2] * li, o[3] * li); r.z = cvtpk(o[4] * li, o[5] * li); r.w = cvtpk(o[6] * li, o[7] * li);
                    *(u32x4*)(MIX + (size_t)tq * D + h_c * 128 + 8 * ch) = r;
                }
            }
        }
        if (more) { h = h_n; n = n_n; count = count_n; lbase = lbase_n; own = own_n; ent = ent_n; }
        MB_VMWAIT();
        __syncthreads();
    }
#undef MB_UNIT_V
}
__device__ __forceinline__ float wave_max(float v) {
#pragma unroll
    for (int o = 1; o < 64; o <<= 1) v = fmaxf(v, __shfl_xor(v, o));
    return v;
}
__device__ __forceinline__ float logsigmoid_f(float x) { return fminf(x, 0.f) - log1pf(expf(-fabsf(x))); }
__global__ void nk_gla_gate(const float* __restrict__ glr, const float* __restrict__ wup, const float* __restrict__ bg, float* __restrict__ g) {
    const size_t idx = (size_t)blockIdx.x * blockDim.x + threadIdx.x;
    const int t = (int)(idx >> 9), j = (int)(idx & 511);
    float acc = bg[j];
#pragma unroll
    for (int r = 0; r < 16; ++r) acc += glr[(size_t)t * 16 + r] * wup[r * 512 + j];
    g[idx] = logsigmoid_f(acc) * (1.f / 16.f);
}
__global__ __launch_bounds__(256) void nk_gla_recur(const bf16_t* __restrict__ qkv, const float* __restrict__ g, float* __restrict__ o) {
    __shared__ float sq[16][128], sk[16][128], sa[16][128];
    const int h = blockIdx.x, tid = threadIdx.x;
    float St[128];
#pragma unroll
    for (int d = 0; d < 128; ++d) St[d] = 0.f;
    const float qs = 0.08838834764831845f;
    for (int t0 = 0; t0 < S; t0 += 16) {
        float vv[16];
#pragma unroll
        for (int tt = 0; tt < 16; ++tt) vv[tt] = bf2f(qkv[(size_t)(t0 + tt) * 3072 + 1024 + h * 256 + tid]);
#pragma unroll
        for (int i = 0; i < 8; ++i) {
            const int e = tid + i * 256, tok = e >> 7, d = e & 127;
            const bf16_t* row = qkv + (size_t)(t0 + tok) * 3072;
            sq[tok][d] = bf2f(row[h * 128 + d]) * qs;
            sk[tok][d] = bf2f(row[512 + h * 128 + d]);
            sa[tok][d] = expf(g[(size_t)(t0 + tok) * 512 + h * 128 + d]);
        }
        __syncthreads();
#pragma unroll 1
        for (int tt = 0; tt < 16; ++tt) {
            const float v = vv[0];
#pragma unroll
            for (int i = 0; i < 15; ++i) vv[i] = vv[i + 1];
            float acc = 0.f;
#pragma unroll
            for (int d = 0; d < 128; ++d) { St[d] = sa[tt][d] * St[d] + sk[tt][d] * v; acc += sq[tt][d] * St[d]; }
            o[(size_t)(t0 + tt) * D + h * 256 + tid] = acc;
        }
        __syncthreads();
    }
}
__global__ __launch_bounds__(256) void nk_gla_post(const float* __restrict__ o, const bf16_t* __restrict__ qkv, const float* __restrict__ og, bf16_t* __restrict__ mix) {
    const int w = blockIdx.x * 4 + (threadIdx.x >> 6), lane = threadIdx.x & 63;
    const int t = w >> 2, h = w & 3;
    f32x4 v = *(const f32x4*)(o + (size_t)t * D + h * 256 + lane * 4);
    const float ss = wave_sum(v.x * v.x + v.y * v.y + v.z * v.z + v.w * v.w);
    const float r = 1.0f / sqrtf(ss * (1.f / 256.f) + EPS);
    const f32x4 gg = *(const f32x4*)(og + lane * 4);
    const bf16_t* rp = qkv + (size_t)t * 3072 + 2048 + h * 256 + lane * 4;
    bf16_t* mp = mix + (size_t)t * D + h * 256 + lane * 4;
#pragma unroll
    for (int e = 0; e < 4; ++e) { const float rr = bf2f(rp[e]); const float y = v[e] * r * gg[e] * (rr / (1.f + expf(-rr))); mp[e] = (bf16_t)(cvtpk(y, 0.f) & 0xffffu); }
}
__global__ __launch_bounds__(256) void nk_moba_qk(bf16_t* __restrict__ qkv, const int* __restrict__ pos, const float* __restrict__ qg, const float* __restrict__ kg) {
    const int w = blockIdx.x * 4 + (threadIdx.x >> 6), lane = threadIdx.x & 63;
    const int t = w >> 4, which = (w >> 3) & 1, h = w & 7;
    bf16_t* p = qkv + (size_t)t * 3072 + which * 1024 + h * 128;
    const float* g = which ? kg : qg;
    float t1 = bf2f(p[lane]), t2 = bf2f(p[lane + 64]);
    const float ss = wave_sum(t1 * t1 + t2 * t2);
    const float r = 1.0f / sqrtf(ss * (1.f / 128.f) + EPS);
    t1 = t1 * r * g[lane]; t2 = t2 * r * g[lane + 64];
    const float inv_freq = (float)exp2(-(double)lane * (13.287712379549449 / 64.0));
    const float angf = (float)pos[t] * inv_freq;
    float cs, sn; sincos_acc((double)angf, sn, cs);
    p[lane] = (bf16_t)(cvtpk(t1 * cs - t2 * sn, 0.f) & 0xffffu);
    p[lane + 64] = (bf16_t)(cvtpk(t2 * cs + t1 * sn, 0.f) & 0xffffu);
}
__global__ __launch_bounds__(128) void nk_moba_kmean(const bf16_t* __restrict__ qkv, float* __restrict__ kmean) {
    const int h = blockIdx.x >> 6, n = blockIdx.x & 63, d = threadIdx.x;
    float acc = 0.f;
    for (int j = 0; j < 256; ++j) acc += bf2f(qkv[(size_t)(n * 256 + j) * 3072 + 1024 + h * 128 + d]);
    kmean[(size_t)blockIdx.x * 128 + d] = acc * (1.f / 256.f);
}
__global__ __launch_bounds__(64) void nk_moba_attn(const bf16_t* __restrict__ qkv, const float* __restrict__ kmean, bf16_t* __restrict__ out) {
    __shared__ float sq[128];
    __shared__ float sp[1024];
    __shared__ int skey[1024];
    const int t = blockIdx.x >> 3, h = blockIdx.x & 7, lane = threadIdx.x;
    const bf16_t* qp = qkv + (size_t)t * 3072 + h * 128;
    sq[lane] = bf2f(qp[lane]); sq[lane + 64] = bf2f(qp[lane + 64]);
    __syncthreads();
    const int own = t >> 8;
    float gate = -INFINITY;
    if (lane < own) {
        const float* km = kmean + ((size_t)h * 64 + lane) * 128;
        float a = 0.f;
        for (int d = 0; d < 128; ++d) a += sq[d] * km[d];
        gate = a;
    }
    int s0 = -1, s1 = -1, s2 = -1;
#pragma unroll
    for (int j = 0; j < 3; ++j) {
        const float m = wave_max(gate);
        int idx = -1;
        if (m > -INFINITY) { const unsigned long long b = __ballot(gate == m); idx = __ffsll((long long)b) - 1; }
        if (j == 0) s0 = idx; else if (j == 1) s1 = idx; else s2 = idx;
        if (lane == idx) gate = -INFINITY;
    }
    int nk = 0;
    if (s0 >= 0) { for (int i = lane; i < 256; i += 64) skey[nk + i] = s0 * 256 + i; nk += 256; }
    if (s1 >= 0) { for (int i = lane; i < 256; i += 64) skey[nk + i] = s1 * 256 + i; nk += 256; }
    if (s2 >= 0) { for (int i = lane; i < 256; i += 64) skey[nk + i] = s2 * 256 + i; nk += 256; }
    const int nown = t - own * 256 + 1;
    for (int i = lane; i < nown; i += 64) skey[nk + i] = own * 256 + i;
    nk += nown;
    __syncthreads();
    const float scale = 0.08838834764831845f;
    float mx = -INFINITY;
    for (int i = lane; i < nk; i += 64) {
        const bf16_t* kp = qkv + (size_t)skey[i] * 3072 + 1024 + h * 128;
        float a = 0.f;
        for (int d = 0; d < 128; d += 8) { const u32x4 kk = *(const u32x4*)(kp + d);
            a += sq[d] * bflo(kk.x) + sq[d + 1] * bfhi(kk.x) + sq[d + 2] * bflo(kk.y) + sq[d + 3] * bfhi(kk.y) + sq[d + 4] * bflo(kk.z) + sq[d + 5] * bfhi(kk.z) + sq[d + 6] * bflo(kk.w) + sq[d + 7] * bfhi(kk.w); }
        a *= scale; sp[i] = a; mx = fmaxf(mx, a);
    }
    mx = wave_max(mx);
    float sum = 0.f;
    for (int i = lane; i < nk; i += 64) { const float p = expf(sp[i] - mx); sp[i] = p; sum += p; }
    sum = wave_sum(sum);
    __syncthreads();
    float o0 = 0.f, o1 = 0.f;
    for (int i = 0; i < nk; ++i) {
        const bf16_t* vp = qkv + (size_t)skey[i] * 3072 + 2048 + h * 128;
        const float p = sp[i];
        o0 += p * bf2f(vp[lane]); o1 += p * bf2f(vp[lane + 64]);
    }
    const float inv = 1.f / sum;
    out[(size_t)t * D + h * 128 + lane] = (bf16_t)(cvtpk(o0 * inv, 0.f) & 0xffffu);
    out[(size_t)t * D + h * 128 + lane + 64] = (bf16_t)(cvtpk(o1 * inv, 0.f) & 0xffffu);
}
constexpr int PH_PER_LAYER = 10, PH_L0 = 2, N_PHASES = PH_L0 + DEPTH * PH_PER_LAYER;
__global__ void __launch_bounds__(NTHR, 2) mega(MegaArgs args) {
    extern __shared__ __attribute__((aligned(16))) unsigned char lds_raw[];
    Frame F;
    F.lds = (LAS unsigned char*)lds_raw;
    F.tid = threadIdx.x; F.lane = F.tid & 63; F.wave = __builtin_amdgcn_readfirstlane(F.tid >> 6);
    F.G = gridDim.x; { const int bx = blockIdx.x; F.vcu = (F.G % 8 == 0) ? (bx % 8) * (F.G / 8) + bx / 8 : bx; }
    volatile LAS unsigned* MISC = (volatile LAS unsigned*)(F.lds + MISC_OFF);
    unsigned char* ws = args.ws;
    unsigned* ctl = (unsigned*)(ws + WS_CTL);
    for (int u = F.tid; u < (LDS_BYTES - MISC_OFF) / 4; u += NTHR) ((LAS unsigned*)(F.lds + MISC_OFF))[u] = 0u;
    __syncthreads();
    XcdBarrier bar = xcd_barrier_post(ctl + CW_BAR, MISC + 8);
    const int lo = args.ph_lo, hi = args.ph_hi;
#define IN(k) (lo <= (k) && (k) < hi)
#define SEAM(k) do { if (lo <= (k) && (k) + 1 < hi) xcd_barrier(bar); } while (0)
    const float* mod = (const float*)(ws + WS_MOD);
    bf16_t* H = (bf16_t*)(ws + WS_H); bf16_t* MIX = (bf16_t*)(ws + WS_MIX); bf16_t* QKV = (bf16_t*)(ws + WS_QKV); bf16_t* HID = (bf16_t*)(ws + WS_HID);
    float* xout = args.out;
    bf16_t* XB = (bf16_t*)(ws + WS_XB);

    if (IN(0)) { p0_prologue(F, args); }
    if (lo < 0) cg::this_grid().sync();
    if (lo <= 0 && 1 < hi) xcd_barrier(bar);
    if (IN(1)) { norm_phase(F, args.in[0], args.in[5], mod + D, mod, H); }
    SEAM(1);
#pragma unroll 1
    for (int L = 0; L < DEPTH; ++L) {
        const int pb = PH_L0 + L * PH_PER_LAYER, j = L >> 1;
        const float* m = mod + (size_t)L * 6 * D;
        if (pb + PH_PER_LAYER <= lo || pb >= hi) continue;
        if ((L & 1) == 0) {
            if (IN(pb + 0)) {
                pg8::Gemm g{H, (const bf16_t*)(ws + WS_WGIN) + (size_t)j * 3072 * D, S, 3072, D}; pg8::StaticOrder So; So.init(S, 3072, F.G, (int)blockIdx.x);
                pg8::EpiBf16<0> E{QKV, 3072};
                pg8::gemm_phase<pg8::EpiBf16<0>, pg8::StaticOrder, true, true>(F.lds, g, So, E);
                glr_phase(F, H, (const bf16_t*)(ws + WS_WGLR) + (size_t)j * 16 * D, (float*)(ws + WS_GLR));
            }
            SEAM(pb + 0);
        } else {
            if (IN(pb + 0)) {
                pg8::Gemm g{H, (const bf16_t*)(ws + WS_WMIN) + (size_t)j * 3072 * D, S, 3072, D}; pg8::StaticOrder So; So.init(S, 3072, F.G, (int)blockIdx.x);
                pg8::EpiBf16<0> E{QKV, 3072};
                pg8::gemm_phase<pg8::EpiBf16<0>, pg8::StaticOrder, true, true>(F.lds, g, So, E);
                asm volatile("s_waitcnt vmcnt(0)" ::: "memory"); __syncthreads();
                moba_m1_tail(F, F.G, (int)blockIdx.x, QKV, (const float*)(args.ws + WS_COS), (const float*)(args.ws + WS_SIN), args.in[13] + (size_t)j * 128, args.in[14] + (size_t)j * 128, (float*)(args.ws + WS_KMEAN));
            }
            SEAM(pb + 0);
        }
        if ((L & 1) == 0) {
            unsigned char* ws = args.ws; asm volatile("" : "+s"(ws));
            const float* wupg = args.in[8] + (size_t)j * 16 * 512; const float* bgg = args.in[9] + (size_t)j * 512;
            if (IN(pb + 1)) gla_g1(F, QKV, (const float*)(ws + WS_GLR), wupg, bgg, (float*)(ws + WS_SBUF), (float*)(ws + WS_DG));
            SEAM(pb + 1);
            if (IN(pb + 2)) gla_g2(F, (float*)(ws + WS_SBUF), (const float*)(ws + WS_DG));
            SEAM(pb + 2);
            if (IN(pb + 3)) gla_g3(F, QKV, (const float*)(ws + WS_GLR), wupg, bgg, (const float*)(ws + WS_SBUF), args.in[10] + (size_t)j * 256, MIX);
            if (lo <= pb + 3 && pb + 5 < hi) xcd_barrier(bar);
        } else {
            unsigned char* ws = args.ws; asm volatile("" : "+s"(ws));
            unsigned* gcnt = (unsigned*)(ws + WS_CTL) + CW_MCNT + j * 512;
            if (IN(pb + 2)) moba_m2(F, QKV, (const float*)(ws + WS_KMEAN), gcnt, (int*)(ws + WS_LIST));
            SEAM(pb + 2);
            if (IN(pb + 3)) moba_m3<0>(F, QKV, gcnt, (const int*)(ws + WS_LIST), (bf16_t*)xout, (bf16_t*)(ws + WS_AUX), MIX, (float*)(ws + WS_LPART));
            SEAM(pb + 3);
            if (IN(pb + 4)) moba_m3<1>(F, QKV, gcnt, (const int*)(ws + WS_LIST), (bf16_t*)xout, (bf16_t*)(ws + WS_AUX), MIX, (float*)(ws + WS_LPART));
            SEAM(pb + 4);
        }
        if (IN(pb + 5)) {
            const bf16_t* wo = ((L & 1) == 0) ? (const bf16_t*)(ws + WS_WGOUT) + (size_t)j * D * D : (const bf16_t*)(ws + WS_WMOUT) + (size_t)j * D * D;
            pg8::Gemm g{MIX, wo, S, D, D}; pg8::StaticOrder So; So.init(S, D, F.G, (int)blockIdx.x);
            if (L == 0) {
                pg8::EpiResidNorm<true> E{args.in[0], XB, D, m + 2 * D, args.in[6] + (size_t)L * D, m + 4 * D, m + 3 * D, H, (float*)(ws + WS_XBUF), ctl + CW_SEAM + (2 * L) * SEAM_BANK, ctl + CW_TMO, EPS};
                pg8::gemm_phase<pg8::EpiResidNorm<true>, pg8::StaticOrder, false, true>(F.lds, g, So, E);
            } else {
                pg8::EpiResidNorm<false> E{XB, XB, D, m + 2 * D, args.in[6] + (size_t)L * D, m + 4 * D, m + 3 * D, H, (float*)(ws + WS_XBUF), ctl + CW_SEAM + (2 * L) * SEAM_BANK, ctl + CW_TMO, EPS};
                pg8::gemm_phase<pg8::EpiResidNorm<false>, pg8::StaticOrder, false, true>(F.lds, g, So, E);
            }
        }
        SEAM(pb + 5);
        if (IN(pb + 7)) {
            pg8::Gemm g{H, (const bf16_t*)(ws + WS_W1) + (size_t)L * DFF * D, S, DFF, D}; pg8::StaticOrder So; So.init(S, DFF, F.G, (int)blockIdx.x);
            pg8::EpiBf16<1> E{HID, DFF};
            pg8::gemm_phase<pg8::EpiBf16<1>, pg8::StaticOrder, true, true>(F.lds, g, So, E);
        }
        SEAM(pb + 7);
        if (IN(pb + 8)) {
            pg8::Gemm g{HID, (const bf16_t*)(ws + WS_W2) + (size_t)L * D * DFF, S, D, DFF}; pg8::StaticOrder So; So.init(S, D, F.G, (int)blockIdx.x);
            pg8::EpiResid E{XB, xout, D, m + 5 * D};
            if (L + 1 < DEPTH) {
                const float* mn = mod + (size_t)(L + 1) * 6 * D;
                pg8::EpiResidNorm<false> EN{XB, XB, D, m + 5 * D, args.in[5] + (size_t)(L + 1) * D, mn + D, mn, H, (float*)(ws + WS_XBUF), ctl + CW_SEAM + (2 * L + 1) * SEAM_BANK, ctl + CW_TMO, EPS};
                pg8::gemm_phase<pg8::EpiResidNorm<false>, pg8::StaticOrder, false, true>(F.lds, g, So, EN);
            } else
            pg8::gemm_phase<pg8::EpiResid, pg8::StaticOrder, false, true>(F.lds, g, So, E);
        }
        if (L + 1 < DEPTH) SEAM(pb + 8);
    }
#undef IN
#undef SEAM
}
static int g_grid = 0;
static void launch_mega(MegaArgs a, int lo, int hi, hipStream_t stream) {
    a.ph_lo = lo; a.ph_hi = hi;
    (void)hipMemsetAsync((char*)a.ws + WS_CTL + CW_BAR * 4, 0, XCD_BAR_WORDS * 4, stream);
    void* params[] = {&a};
    hipError_t e = hipLaunchCooperativeKernel((const void*)mega, dim3(g_grid), dim3(NTHR), params, LDS_BYTES, stream);
    if (e != hipSuccess) fprintf(stderr, "cooperative launch failed: %s (grid %d)\n", hipGetErrorString(e), g_grid);
}
extern "C" void kernel_launch(void* const* d_in, const int* in_sizes, int n_in, void* d_out, int out_size, void* d_ws, size_t ws_size, hipStream_t stream) {
    if (g_grid == 0) {
        int dev = 0, cus = 0, per_cu = 0;
        (void)hipGetDevice(&dev);
        (void)hipDeviceGetAttribute(&cus, hipDeviceAttributeMultiprocessorCount, dev);
        (void)hipFuncSetAttribute((const void*)mega, hipFuncAttributeMaxDynamicSharedMemorySize, LDS_BYTES);
        (void)hipOccupancyMaxActiveBlocksPerMultiprocessor(&per_cu, (const void*)mega, NTHR, LDS_BYTES);
        if (per_cu < 1) { fprintf(stderr, "occupancy query says %d blocks/CU\n", per_cu); per_cu = 1; }
        g_grid = cus;
        if (ws_size < WS_END || n_in != 18) { fprintf(stderr, "bad ws_size %zu / n_in %d\n", ws_size, n_in); g_grid = -1; }
    }
    if (g_grid < 0) return;
    (void)hipMemsetAsync((char*)d_ws + WS_CTL, 0, CTL_ZERO_BYTES, stream);
    MegaArgs a{};
    for (int i = 0; i < 18; ++i) a.in[i] = (const float*)d_in[i];
    a.out = (float*)d_out; a.ws = (unsigned char*)d_ws;
    launch_mega(a, 0, N_PHASES, stream);
}
```

```cpp
#include <hip/hip_runtime.h>
#include <hip/hip_cooperative_groups.h>
#include <cstdio>
#include <cstdint>
#include <cmath>
namespace cg = cooperative_groups;
constexpr int D = 1024, S = 16384, DEPTH = 4, DFF = 4096;
constexpr int GLA_IN = 3088, MB_IN = 3072;
constexpr float EPS = 1e-6f;
#ifndef PROBE
#define PROBE 0
#endif
#ifndef TCAT
#define TCAT 0
#endif
#ifndef TBLK
#define TBLK 0
#endif
#define LAS __attribute__((address_space(3)))
#define GAS __attribute__((address_space(1)))
typedef unsigned short bf16_t;
typedef short bf16x8 __attribute__((ext_vector_type(8)));
typedef short s16x4 __attribute__((ext_vector_type(4)));
typedef float f32x4 __attribute__((ext_vector_type(4)));
typedef float f32x16 __attribute__((ext_vector_type(16)));
typedef float f32x2 __attribute__((ext_vector_type(2)));
typedef unsigned u32x4 __attribute__((ext_vector_type(4)));
typedef unsigned u32x2 __attribute__((ext_vector_type(2)));
typedef __bf16 bf16x2_t __attribute__((ext_vector_type(2)));

__device__ __forceinline__ unsigned cvtpk(float lo, float hi) { f32x2 v = {lo, hi}; bf16x2_t b = __builtin_convertvector(v, bf16x2_t); return __builtin_bit_cast(unsigned, b); }
__device__ __forceinline__ float bf2f(unsigned short b) { return __uint_as_float((unsigned)b << 16); }
__device__ __forceinline__ float bflo(unsigned w) { return __uint_as_float(w << 16); }
__device__ __forceinline__ float bfhi(unsigned w) { return __uint_as_float(w & 0xffff0000u); }

#ifndef WT_STORES
#define WT_STORES 0
#endif
__device__ __forceinline__ void st16_wt(void* p, u32x4 v) {
#if WT_STORES
    asm volatile("global_store_dwordx4 %0, %1, off sc1\n\ts_nop 1" :: "v"(p), "v"(v) : "memory");
#else
    *(u32x4*)p = v;
#endif
}
__device__ __forceinline__ void st16_wt(void* p, f32x4 v) { st16_wt(p, __builtin_bit_cast(u32x4, v)); }
namespace pg8 {
constexpr int BM = 256, BK = 64, HALF = 128, HTB = HALF * BK * 2, STAGE_BYTES = 8 * HTB, NXCD = 8, WGM = 8;
__host__ __device__ __forceinline__ int lds_byte(int r, int c) { const int st = (r >> 4) * 2 + (c >> 5), rr = r & 15, cc = c & 31, ob = rr * 64 + cc * 2; return st * 1024 + (ob ^ (((ob >> 9) & 1) << 5)); }
__host__ __device__ __forceinline__ void stage_rc(int b, int& R, int& C) { const int st = b / 1024, sb = b % 1024, swz = sb ^ (((sb >> 9) & 1) << 5); R = (st >> 1) * 16 + swz / 64; C = (st & 1) * 32 + (swz % 64) / 2; }
__host__ __device__ __forceinline__ int perm32(int rho) { const int n = rho >> 4, i = rho & 15; return 8 * (i >> 2) + 4 * n + (i & 3); }
struct Unit { int pm, pn; };
struct Gemm { const bf16_t* A; const bf16_t* Bt; int M, N, K; const bf16_t* A2 = nullptr; };
__device__ __forceinline__ const char* hid_panel(const void* A, const void* A2, int pm) {
    const int x = pm >> 3, p = pm & 7;
    return (p < 6) ? (const char*)A + (size_t)x * (12u << 20) + (size_t)p * (2u << 20) : (const char*)A2 + (size_t)x * (4u << 20) + (size_t)(p - 6) * (2u << 20);
}
struct StaticOrder {
    int nM, nN, nwg, G, c;
    __host__ __device__ void init(int M, int N, int G_, int c_) { nM = M / BM; nN = N / BM; nwg = nM * nN; G = G_; c = c_; }
    __host__ __device__ bool next(int i, Unit& u) const {
        const long L = (long)i * G + c; if (L >= nwg) return false;
        int wgid = (int)L; { const int q = nwg / NXCD, r = nwg % NXCD, xcd = wgid % NXCD, off = wgid / NXCD; wgid = (xcd < r ? xcd * (q + 1) : r * (q + 1) + (xcd - r) * q) + off; }
        const int nig = WGM * nN, gid = wgid / nig, fm = gid * WGM, gsz = (nM - fm) < WGM ? (nM - fm) : WGM;
        u.pm = fm + ((wgid % nig) % gsz); u.pn = (wgid % nig) / gsz; return true;
    }
    __device__ __forceinline__ void a_ready(const Unit&) const {}
    __device__ __forceinline__ void done(const Unit&) const {}
};
struct MaskOrder : StaticOrder {
    __device__ bool next(int i, Unit& u) const { const bool ok = StaticOrder::next(i, u); u.pm &= 7; u.pn &= 3; return ok; }
};
template <int ACT  > struct EpiBf16 {
    static constexpr bool PERM = true, AFTER_DRAIN = false;
    bf16_t* O; int ldc; bf16_t* O2;
    const float* pssq; const float* bias;
    __device__ __forceinline__ void operator()(const f32x4 (&acc)[2][2][4][2], const Unit& u, int wr, int wc, int fr, int fq) const {
        bf16_t* O = this->O; const int grow0 = u.pm * BM + wr * 64 + fr; int row0 = grow0; const int col0 = u.pn * BM + wc * 32 + 8 * fq;
        if (O2) { O = (bf16_t*)hid_panel(this->O, O2, u.pm); row0 = wr * 64 + fr; }
        f32x4 bv[2][2];
#pragma unroll
        for (int bj = 0; bj < 2; ++bj) { bv[bj][0] = *(const f32x4*)(bias + col0 + bj * HALF); bv[bj][1] = *(const f32x4*)(bias + col0 + bj * HALF + 4); }
#pragma unroll
        for (int ai = 0; ai < 2; ++ai)
#pragma unroll
            for (int m = 0; m < 4; ++m) { bf16_t* rowp = O + (size_t)(row0 + ai * HALF + m * 16) * ldc + col0;
                const f32x4 q4 = *(const f32x4*)(pssq + (size_t)(grow0 + ai * HALF + m * 16) * 4);
                const float rs = __builtin_amdgcn_rsqf(((q4.x + q4.y) + (q4.z + q4.w)) * (1.0f / 1024.0f) + EPS);
#pragma unroll
                for (int bj = 0; bj < 2; ++bj) { f32x4 v0 = acc[ai][bj][m][0] * rs + bv[bj][0], v1 = acc[ai][bj][m][1] * rs + bv[bj][1];
                    if (ACT == 1) {
#pragma unroll
                        for (int e = 0; e < 4; ++e) { float a = fmaxf(v0[e], 0.f); v0[e] = a * a; float b = fmaxf(v1[e], 0.f); v1[e] = b * b; } }
                    u32x4 w; w.x = cvtpk(v0[0], v0[1]); w.y = cvtpk(v0[2], v0[3]); w.z = cvtpk(v1[0], v1[1]); w.w = cvtpk(v1[2], v1[3]);
                    st16_wt(rowp + bj * HALF, w); } }
    }
};
struct EpiResid {
    static constexpr bool PERM = true, AFTER_DRAIN = false;
    const bf16_t* base; float* out; int ldc; const float* gate;
    __device__ __forceinline__ void operator()(const f32x4 (&acc)[2][2][4][2], const Unit& u, int wr, int wc, int fr, int fq) const {
        const int row0 = u.pm * BM + wr * 64 + fr, col0 = u.pn * BM + wc * 32 + 8 * fq;
        f32x4 gv[2][2];
#pragma unroll
        for (int bj = 0; bj < 2; ++bj)
#pragma unroll
            for (int n = 0; n < 2; ++n) gv[bj][n] = *(const f32x4*)(gate + col0 + bj * HALF + n * 4);
#pragma unroll
        for (int ai = 0; ai < 2; ++ai)
#pragma unroll
            for (int m = 0; m < 4; ++m) { const size_t off = (size_t)(row0 + ai * HALF + m * 16) * ldc + col0;
#pragma unroll
                for (int bj = 0; bj < 2; ++bj) { const u32x4 bb = *(const u32x4*)(base + off + bj * HALF);
                    const f32x4 b0 = {bflo(bb.x), bfhi(bb.x), bflo(bb.y), bfhi(bb.y)}, b1 = {bflo(bb.z), bfhi(bb.z), bflo(bb.w), bfhi(bb.w)};
                    st16_wt(out + off + bj * HALF, b0 + gv[bj][0] * acc[ai][bj][m][0]); st16_wt(out + off + bj * HALF + 4, b1 + gv[bj][1] * acc[ai][bj][m][1]); } }
    }
};

template <bool BASE_F32> struct EpiResidSsq {
    static constexpr bool PERM = true, AFTER_DRAIN = true;
    const void* base; bf16_t* out; int ldc; const float* gate; float* pssq;
    __device__ __forceinline__ void operator()(const f32x4 (&)[2][2][4][2], const Unit&, int, int, int, int) const {}
    __device__ __forceinline__ void fused(f32x4 (&acc)[2][2][4][2], const Unit& u, int wr, int wc, int fr, int fq, LAS unsigned char* lds, int wid, int lane) const {
        LAS float* P = (LAS float*)lds;
        const int row0 = u.pm * BM + wr * 64 + fr, col0 = u.pn * BM + wc * 32 + 8 * fq;
        {
            f32x4 gv[2][2];
#pragma unroll
            for (int bj = 0; bj < 2; ++bj)
#pragma unroll
                for (int n = 0; n < 2; ++n) gv[bj][n] = *(const f32x4*)(gate + col0 + bj * HALF + n * 4);
#pragma unroll
            for (int ai = 0; ai < 2; ++ai)
#pragma unroll
                for (int m = 0; m < 4; ++m) { const size_t off = (size_t)(row0 + ai * HALF + m * 16) * ldc + col0;
                    float s = 0.f;
#pragma unroll
                    for (int bj = 0; bj < 2; ++bj) { f32x4 b0, b1;
                        if constexpr (BASE_F32) { b0 = *(const f32x4*)((const float*)base + off + bj * HALF); b1 = *(const f32x4*)((const float*)base + off + bj * HALF + 4); }
                        else { const u32x4 bb = *(const u32x4*)((const bf16_t*)base + off + bj * HALF); b0 = (f32x4){bflo(bb.x), bfhi(bb.x), bflo(bb.y), bfhi(bb.y)}; b1 = (f32x4){bflo(bb.z), bfhi(bb.z), bflo(bb.w), bfhi(bb.w)}; }
                        const f32x4 x0 = b0 + gv[bj][0] * acc[ai][bj][m][0], x1 = b1 + gv[bj][1] * acc[ai][bj][m][1];
                        { u32x4 xw; xw.x = cvtpk(x0[0], x0[1]); xw.y = cvtpk(x0[2], x0[3]); xw.z = cvtpk(x1[0], x1[1]); xw.w = cvtpk(x1[2], x1[3]); *(u32x4*)(out + off + bj * HALF) = xw; }
                        s += ((x0[0] * x0[0] + x0[1] * x0[1]) + (x0[2] * x0[2] + x0[3] * x0[3])) + ((x1[0] * x1[0] + x1[1] * x1[1]) + (x1[2] * x1[2] + x1[3] * x1[3])); }
                    s += __shfl_xor(s, 16); s += __shfl_xor(s, 32);
                    if (fq == 0) P[(ai * HALF + wr * 64 + m * 16 + fr) * 4 + wc] = s;
                    if (m & 1) asm volatile("" ::: "memory"); }
        }
        asm volatile("s_waitcnt lgkmcnt(0)" ::: "memory"); __builtin_amdgcn_s_barrier(); asm volatile("" ::: "memory");
        if (lane < 32) {
            const int row = wid * 32 + lane;
            pssq[(size_t)(u.pm * BM + row) * 4 + u.pn] = (P[row * 4 + 0] + P[row * 4 + 1]) + (P[row * 4 + 2] + P[row * 4 + 3]);
        }
    }
};

template <class Epi, class Sched, bool ALIGN_EPI = false, bool SP2 = false>
__device__ __forceinline__ void gemm_phase(LAS unsigned char* lds, const Gemm g, const Sched& S, const Epi& E) {
    int tid_ = threadIdx.x; asm volatile("" : "+v"(tid_));
    const int tid = tid_, wid = __builtin_amdgcn_readfirstlane(tid >> 6), lane = tid & 63, wr = wid >> 2, wc = wid & 3, fr = lane & 15, fq = lane >> 4;
    const int K = g.K, nt = K / BK;
    unsigned voffA[2], voffB[2];
#pragma unroll
    for (int i = 0; i < 2; ++i) { int R, C; stage_rc(tid * 16 + i * 8192, R, C); const int Rb = Epi::PERM ? ((R & ~31) + perm32(R & 31)) : R;
        voffA[i] = (unsigned)(R * K + C) * 2u; voffB[i] = (unsigned)(Rb * K + C) * 2u; }
    const size_t kstep = (size_t)(BK * 2);
    const size_t hstep = (size_t)HALF * K * 2;
    const size_t tstep = 2 * hstep;
    const unsigned ldsw = (unsigned)wid * 1024u;
    const int aoff = lds_byte(wr * 64 + fr, fq * 8), boff = lds_byte(wc * 32 + fr, fq * 8);
#define PG8_SA(b, h) (((b) * 2 + (h)) * HTB)
#define PG8_SB(b, h) ((4 + (b) * 2 + (h)) * HTB)
#define PG8_STAGE(bufoff, gbase, voff) do { _Pragma("unroll") for (int _i = 0; _i < 2; ++_i) \
        __builtin_amdgcn_global_load_lds((const unsigned*)((const char*)(gbase) + (voff)[_i]), (LAS unsigned*)(lds + (bufoff) + ldsw + _i * 8192), 16, 0, 0); } while (0)
#define PG8_LDA(dst, b, h) do { _Pragma("unroll") for (int m = 0; m < 4; ++m) _Pragma("unroll") for (int k = 0; k < 2; ++k) dst[m][k] = *(const LAS bf16x8*)(lds + PG8_SA(b, h) + aoff + m * 2048 + k * 1024); } while (0)
#define PG8_LDB(dst, b, h) do { _Pragma("unroll") for (int n = 0; n < 2; ++n) _Pragma("unroll") for (int k = 0; k < 2; ++k) dst[n][k] = *(const LAS bf16x8*)(lds + PG8_SB(b, h) + boff + n * 2048 + k * 1024); } while (0)
#define PG8_MMA(ai, bj, At, Bt) do { __builtin_amdgcn_s_setprio(1); _Pragma("unroll") for (int m = 0; m < 4; ++m) _Pragma("unroll") for (int n = 0; n < 2; ++n) _Pragma("unroll") for (int k = 0; k < 2; ++k) \
        acc[ai][bj][m][n] = __builtin_amdgcn_mfma_f32_16x16x32_bf16(Bt[n][k], At[m][k], acc[ai][bj][m][n], 0, 0, 0); __builtin_amdgcn_s_setprio(0); } while (0)
#define PG8_WAIT_V(n) asm volatile("s_waitcnt vmcnt(" #n ")" ::: "memory")
#define PG8_WAIT_L(n) asm volatile("s_waitcnt lgkmcnt(" #n ")" ::: "memory")
#define PG8_BAR __builtin_amdgcn_s_barrier()
#define PG8_SCHED __builtin_amdgcn_sched_barrier(0)
    Unit cur, nxt; int ui = 0;
    if (!S.next(0, cur)) return;
    f32x4 acc[2][2][4][2];
#pragma unroll
    for (int a = 0; a < 2; ++a)
#pragma unroll
        for (int b = 0; b < 2; ++b)
#pragma unroll
            for (int m = 0; m < 4; ++m)
#pragma unroll
                for (int n = 0; n < 2; ++n) acc[a][b][m][n] = (f32x4){0.f, 0.f, 0.f, 0.f};
    bf16x8 At[4][2], B0[2][2], B1[2][2];
    const char* cA = g.A2 ? hid_panel(g.A, g.A2, cur.pm) : (const char*)g.A + (size_t)cur.pm * tstep; const char* cB = (const char*)g.Bt + (size_t)cur.pn * tstep;
    S.a_ready(cur);
    if constexpr (SP2) {
        PG8_STAGE(PG8_SB(0, 0), cB, voffB); PG8_STAGE(PG8_SB(0, 1), cB + hstep, voffB); PG8_STAGE(PG8_SA(0, 0), cA, voffA); PG8_STAGE(PG8_SA(0, 1), cA + hstep, voffA);
        if (wr == 1) PG8_BAR;
        PG8_WAIT_V(2); PG8_BAR;
        PG8_STAGE(PG8_SB(1, 0), cB + kstep, voffB); PG8_STAGE(PG8_SA(1, 0), cA + kstep, voffA); PG8_STAGE(PG8_SB(1, 1), cB + hstep + kstep, voffB);
        PG8_WAIT_V(6); PG8_BAR;
    } else {
        PG8_STAGE(PG8_SB(0, 0), cB, voffB); PG8_STAGE(PG8_SA(0, 0), cA, voffA); PG8_STAGE(PG8_SB(0, 1), cB + hstep, voffB); PG8_STAGE(PG8_SA(0, 1), cA + hstep, voffA);
        if (wr == 1) PG8_BAR;
        PG8_WAIT_V(4); PG8_BAR;
        PG8_STAGE(PG8_SB(1, 0), cB + kstep, voffB); PG8_STAGE(PG8_SA(1, 0), cA + kstep, voffA); PG8_STAGE(PG8_SB(1, 1), cB + hstep + kstep, voffB);
        PG8_WAIT_V(6); PG8_BAR;
    }
    for (;;) {
        const bool has_next = S.next(ui + 1, nxt);
        const char* nA = has_next ? (g.A2 ? hid_panel(g.A, g.A2, nxt.pm) : (const char*)g.A + (size_t)nxt.pm * tstep) : cA; const char* nB = has_next ? (const char*)g.Bt + (size_t)nxt.pn * tstep : cB;
        for (int t = 0; t < nt; t += 2) {
            const bool last = (t == nt - 2);
            const char* a1 = cA + (size_t)(t + 1) * kstep;
            const char* a2 = last ? nA : cA + (size_t)(t + 2) * kstep; const char* b2 = last ? nB : cB + (size_t)(t + 2) * kstep;
            const char* a3 = a2 + kstep; const char* b3 = b2 + kstep;
            if (last && has_next) S.a_ready(nxt);
            if constexpr (SP2) {
            PG8_LDB(B0, 0, 0); PG8_LDB(B1, 0, 1); PG8_SCHED; PG8_LDA(At, 0, 0); PG8_STAGE(PG8_SA(1, 1), a1 + hstep, voffA);
            PG8_WAIT_V(8); PG8_WAIT_L(0); PG8_BAR; PG8_MMA(0, 0, At, B0); PG8_MMA(0, 1, At, B1); PG8_BAR; PG8_SCHED;
            PG8_LDA(At, 0, 1); PG8_STAGE(PG8_SB(0, 0), b2, voffB); PG8_STAGE(PG8_SB(0, 1), b2 + hstep, voffB); PG8_STAGE(PG8_SA(0, 0), a2, voffA);
            PG8_WAIT_V(8); PG8_WAIT_L(0); PG8_BAR; PG8_MMA(1, 0, At, B0); PG8_MMA(1, 1, At, B1); PG8_BAR; PG8_SCHED;
            PG8_LDB(B0, 1, 0); PG8_LDB(B1, 1, 1); PG8_SCHED; PG8_LDA(At, 1, 0); PG8_STAGE(PG8_SA(0, 1), a2 + hstep, voffA);
            PG8_WAIT_V(8); PG8_WAIT_L(0); PG8_BAR; PG8_MMA(0, 0, At, B0); PG8_MMA(0, 1, At, B1); PG8_BAR; PG8_SCHED;
            PG8_LDA(At, 1, 1); PG8_STAGE(PG8_SB(1, 0), b3, voffB); PG8_STAGE(PG8_SB(1, 1), b3 + hstep, voffB); PG8_STAGE(PG8_SA(1, 0), a3, voffA);
            PG8_WAIT_V(8); PG8_WAIT_L(0); PG8_BAR; PG8_MMA(1, 0, At, B0); PG8_MMA(1, 1, At, B1); PG8_BAR; PG8_SCHED;
            } else {
            PG8_LDB(B0, 0, 0); PG8_SCHED; PG8_LDA(At, 0, 0); PG8_STAGE(PG8_SA(1, 1), a1 + hstep, voffA);
            PG8_WAIT_L(8); PG8_BAR; PG8_WAIT_L(0); PG8_MMA(0, 0, At, B0); PG8_BAR; PG8_SCHED;
            PG8_LDB(B1, 0, 1); PG8_STAGE(PG8_SB(0, 0), b2, voffB);
            PG8_BAR; PG8_WAIT_L(0); PG8_MMA(0, 1, At, B1); PG8_BAR;
            PG8_LDA(At, 0, 1); PG8_STAGE(PG8_SA(0, 0), a2, voffA);
            PG8_BAR; PG8_WAIT_L(0); PG8_MMA(1, 0, At, B0); PG8_BAR; PG8_SCHED;
            PG8_STAGE(PG8_SB(0, 1), b2 + hstep, voffB);
            PG8_WAIT_V(6); PG8_BAR; PG8_MMA(1, 1, At, B1); PG8_BAR;
            PG8_LDB(B0, 1, 0); PG8_SCHED; PG8_LDA(At, 1, 0); PG8_STAGE(PG8_SA(0, 1), a2 + hstep, voffA);
            PG8_WAIT_L(8); PG8_BAR; PG8_WAIT_L(0); PG8_MMA(0, 0, At, B0); PG8_BAR; PG8_SCHED;
            PG8_LDB(B1, 1, 1); PG8_STAGE(PG8_SB(1, 0), b3, voffB);
            PG8_BAR; PG8_WAIT_L(0); PG8_MMA(0, 1, At, B1); PG8_BAR;
            PG8_LDA(At, 1, 1); PG8_STAGE(PG8_SA(1, 0), a3, voffA);
            PG8_BAR; PG8_WAIT_L(0); PG8_MMA(1, 0, At, B0); PG8_BAR; PG8_SCHED;
            PG8_STAGE(PG8_SB(1, 1), b3 + hstep, voffB);
            PG8_WAIT_V(6); PG8_BAR; PG8_MMA(1, 1, At, B1); PG8_BAR;
            }
        }
        if constexpr (ALIGN_EPI) { if (wr == 0) PG8_BAR; }
        if constexpr (!Epi::AFTER_DRAIN) { E(acc, cur, wr, wc, fr, fq); S.done(cur); }
        if (!has_next) break;
#pragma unroll
        for (int a = 0; a < 2; ++a)
#pragma unroll
            for (int b = 0; b < 2; ++b)
#pragma unroll
                for (int m = 0; m < 4; ++m)
#pragma unroll
                    for (int n = 0; n < 2; ++n) acc[a][b][m][n] = (f32x4){0.f, 0.f, 0.f, 0.f};
        cur = nxt; cA = nA; cB = nB; ++ui;
        if constexpr (ALIGN_EPI) { if (wr == 1) PG8_BAR; }
    }
    PG8_WAIT_V(0);
    if constexpr (!ALIGN_EPI) { if (wr == 0) PG8_BAR; }
    PG8_BAR;
    if constexpr (Epi::AFTER_DRAIN) { E.fused(acc, cur, wr, wc, fr, fq, lds, wid, lane); }
#undef PG8_SA
#undef PG8_SB
#undef PG8_STAGE
#undef PG8_LDA
#undef PG8_LDB
#undef PG8_MMA
#undef PG8_WAIT_V
#undef PG8_WAIT_L
#undef PG8_BAR
#undef PG8_SCHED
}
}

#define XB_TMO      128
#define XB_XCNT(j)  (256  + 64 * (j))
#define XB_XSUB(j)  (1280 + 64 * (j))
#define XB_XGEN(j)  (2304 + 64 * (j))
#define XB_TOP      3328
#define XB_TOPGEN   3392
#define XCD_BAR_WORDS 3456
#define XB_SPIN_CAP (1u << 18)
__device__ __forceinline__ unsigned xb_ld(unsigned* p)              { return __hip_atomic_load(p, __ATOMIC_RELAXED, __HIP_MEMORY_SCOPE_AGENT); }
__device__ __forceinline__ unsigned xb_add(unsigned* p, unsigned v) { return __hip_atomic_fetch_add(p, v, __ATOMIC_RELAXED, __HIP_MEMORY_SCOPE_AGENT); }
__device__ __forceinline__ unsigned xb_xcc_id() { return (unsigned)__builtin_amdgcn_s_getreg((3 << 11) | 20) & 0xFu; }
#define XB_SPIN(cond, bar) do { unsigned _sp = 0; while (cond) { __builtin_amdgcn_s_sleep(1); \
    if ((++_sp & 255u) == 0u) { if (xb_ld(&(bar)[XB_TMO])) break; if (_sp > XB_SPIN_CAP) { atomicAdd(&(bar)[XB_TMO], 1u); break; } } } } while (0)
struct XcdBarrier { unsigned* bar; unsigned x; volatile LAS unsigned* st; };
__device__ __forceinline__ XcdBarrier xcd_barrier_post(unsigned* bar, volatile LAS unsigned* st) {
    XcdBarrier b; b.bar = bar; b.x = xb_xcc_id(); b.st = st;
    if (threadIdx.x == 0) { const unsigned rk = xb_add(&bar[XB_XCNT(b.x)], 1u); st[2] = rk; st[3] = b.x; }
    return b;
}
#define XL_SUB(j)  (3520 + 64 * (j))
#define XL_GEN(j)  (4544 + 64 * (j))
#define XL_WORDS   5632
__device__ __forceinline__ void xcd_local_barrier(const XcdBarrier& b, unsigned nloc) {
    asm volatile("s_waitcnt vmcnt(0)" ::: "memory");
    __syncthreads();
    if (threadIdx.x == 0) {
        unsigned* bar = b.bar; asm volatile("" : "+s"(bar));
        const unsigned old = xb_add(&bar[XL_SUB(b.x)], 1u);
        const unsigned gen = old / nloc;
        if (old + 1u == (gen + 1u) * nloc) xb_add(&bar[XL_GEN(b.x)], 1u);
        else XB_SPIN(xb_ld(&bar[XL_GEN(b.x)]) == gen, bar);
        __builtin_amdgcn_fence(__ATOMIC_ACQUIRE, "agent");
        asm volatile("s_waitcnt vmcnt(0)" ::: "memory");
    }
    __syncthreads();
}
#define XG_SUB(g)  (5632 + 32 * (g))
#define XG_GEN(g)  (5632 + 32 * (g) + 16)
#define XG_WORDS   (5632 + 32 * 64)
__device__ __forceinline__ void xcd_group_barrier(const XcdBarrier& b, unsigned gid) {
    asm volatile("s_waitcnt vmcnt(0)" ::: "memory");
    __syncthreads();
    if (threadIdx.x == 0) {
        unsigned* bar = b.bar; asm volatile("" : "+s"(bar));
        const unsigned old = xb_add(&bar[XG_SUB(gid)], 1u);
        const unsigned gen = old >> 2;
        if ((old & 3u) == 3u) xb_add(&bar[XG_GEN(gid)], 1u);
        else XB_SPIN(xb_ld(&bar[XG_GEN(gid)]) == gen, bar);
        __builtin_amdgcn_fence(__ATOMIC_ACQUIRE, "agent");
        asm volatile("s_waitcnt vmcnt(0)" ::: "memory");
    }
    __syncthreads();
}
__device__ __forceinline__ void xcd_barrier_complete(unsigned* bar, unsigned x, unsigned& nloc, unsigned& nx) {
    const unsigned G = gridDim.x * gridDim.y * gridDim.z;
    unsigned sum, cnt, mine, sp = 0u;
    for (;;) {
        sum = 0u; cnt = 0u; mine = 0u;
#pragma unroll
        for (unsigned j = 0; j < 16; ++j) { const unsigned c = xb_ld(&bar[XB_XCNT(j)]); sum += c; cnt += (c > 0u) ? 1u : 0u; }
        mine = xb_ld(&bar[XB_XCNT(x)]);
        if (sum == G) break;
        __builtin_amdgcn_s_sleep(1);
        if ((++sp & 255u) == 0u) { if (xb_ld(&bar[XB_TMO])) break; if (sp > XB_SPIN_CAP) { atomicAdd(&bar[XB_TMO], 1u); break; } }
    }
    nloc = mine > 0u ? mine : 1u; nx = cnt > 0u ? cnt : 1u;
}
__device__ __forceinline__ void xcd_barrier(const XcdBarrier& b) {
    asm volatile("s_waitcnt vmcnt(0)" ::: "memory");
    __syncthreads();
    if (threadIdx.x == 0) {
        unsigned* bar = b.bar; asm volatile("" : "+s"(bar));
        __builtin_amdgcn_s_waitcnt(0);
        unsigned nloc = b.st[0], nx = b.st[1];
        if (nloc == 0u) { xcd_barrier_complete(bar, b.x, nloc, nx); b.st[0] = nloc; b.st[1] = nx; }
        const unsigned old = xb_add(&bar[XB_XSUB(b.x)], 1u);
        const unsigned gen = old / nloc;
        if (old + 1u == (gen + 1u) * nloc) {
            __builtin_amdgcn_fence(__ATOMIC_RELEASE, "agent");
            asm volatile("s_waitcnt vmcnt(0)" ::: "memory");
            const unsigned og = xb_add(&bar[XB_TOP], 1u);
            const unsigned tg = og / nx;
            if (og + 1u == (tg + 1u) * nx) xb_add(&bar[XB_TOPGEN], 1u);
            else XB_SPIN(xb_ld(&bar[XB_TOPGEN]) == tg, bar);
            __builtin_amdgcn_fence(__ATOMIC_ACQUIRE, "agent");
            xb_add(&bar[XB_XGEN(b.x)], 1u);
            asm volatile("s_waitcnt vmcnt(0)" ::: "memory");
        } else {
            XB_SPIN(xb_ld(&bar[XB_XGEN(b.x)]) == gen, bar);
            __builtin_amdgcn_fence(__ATOMIC_ACQUIRE, "agent");
            asm volatile("s_waitcnt vmcnt(0)" ::: "memory");
        }
    }
    __syncthreads();
}
constexpr int NWAVES = 8, NTHR = 512;
constexpr int LDS_BYTES = 147456;
constexpr int RING_BYTES = 131072;
constexpr int MISC_OFF = LDS_BYTES - 256;
constexpr size_t MiB = 1u << 20;
constexpr size_t WS_CTL = 0, CTL_ZERO_BYTES = 256 * 1024;
constexpr size_t WS_MOD = 1 * MiB;
constexpr size_t WS_COS = 2 * MiB, WS_SIN = 6 * MiB;
constexpr size_t WS_WGIN = 10 * MiB;
constexpr size_t WS_WGLR = 22 * MiB;
constexpr size_t WS_WGOUT = 23 * MiB;
constexpr size_t WS_WMIN = 27 * MiB;
constexpr size_t WS_WMOUT = 39 * MiB;
constexpr size_t WS_W1 = 43 * MiB;
constexpr size_t WS_W2 = 75 * MiB;
constexpr size_t WS_H = 107 * MiB;
constexpr size_t WS_MIX = 139 * MiB;
constexpr size_t WS_QKV = 171 * MiB;
constexpr size_t WS_AUX = 267 * MiB;
constexpr size_t WS_HID = 171 * MiB;
constexpr size_t WS_END = 363 * MiB;
constexpr size_t WS_SBUF = WS_AUX;
constexpr size_t WS_GLR = WS_AUX + 32 * MiB;
constexpr size_t WS_DG = WS_AUX + 33 * MiB;
constexpr size_t WS_XB = WS_AUX + 64 * MiB;
constexpr size_t WS_KMEAN = WS_MOD + 128 * 1024;
constexpr size_t WS_LPART = WS_AUX + 34 * MiB;
constexpr size_t WS_LIST = WS_AUX + 36 * MiB;
constexpr int CW_BAR = 4096;
constexpr int CW_MCNT = 16384;
constexpr int CW_TMO = 0;
constexpr int CW_SEAM = 32768, SEAM_BANK = 64 * 64;
static_assert((CW_SEAM + 7 * SEAM_BANK) * 4 <= (int)CTL_ZERO_BYTES && (CW_BAR + 5632 + 32 * 64) <= CW_MCNT, "CTL words fit the per-call memset");
constexpr size_t WS_PSSQ = WS_MOD + 512 * 1024;
constexpr size_t WS_BIAS = WS_MOD + 768 * 1024;
constexpr size_t WS_PB = WS_H;
constexpr int BIAS_IN_LD = 3088, BIAS_UP_OFF = 4 * BIAS_IN_LD;
constexpr int CW_BCNT = CW_SEAM;
struct Frame {
    LAS unsigned char* lds;
    int tid, lane, wave, vcu, G;
};
__device__ __forceinline__ Frame opaque(const Frame& F0) { Frame F = F0; int t = F0.tid; asm volatile("" : "+v"(t)); F.tid = t; F.lane = t & 63; F.wave = __builtin_amdgcn_readfirstlane(t >> 6); return F; }
__device__ __forceinline__ void lds_barrier() { asm volatile("s_waitcnt lgkmcnt(0)" ::: "memory"); __builtin_amdgcn_s_barrier(); asm volatile("" ::: "memory"); }
__device__ __forceinline__ void young_half_prio_on(const Frame& F) { if (F.wave >= 4) __builtin_amdgcn_s_setprio(1); }
__device__ __forceinline__ void young_half_prio_off(const Frame& F) { if (F.wave >= 4) __builtin_amdgcn_s_setprio(0); }
__device__ __forceinline__ float wave_sum(float v) {
#pragma unroll
    for (int o = 1; o < 64; o <<= 1) v += __shfl_xor(v, o);
    return v;
}
__device__ __forceinline__ float silu_f(float x) { return x / (1.f + __expf(-x)); }
__device__ __forceinline__ void sincos_acc(double ang, float& s, float& c) {
    const double n = rint(ang * 0.15915494309189535);
    double r = fma(-n, 6.283185307179586, ang); r = fma(-n, 2.4492935982947064e-16, r);
    const double x = r * 0.25, x2 = x * x;
    const double sn = x * (1.0 + x2 * (-1.0 / 6 + x2 * (1.0 / 120 + x2 * (-1.0 / 5040 + x2 * (1.0 / 362880 + x2 * (-1.0 / 39916800 + x2 * (1.0 / 6227020800.0)))))));
    const double cs = 1.0 + x2 * (-0.5 + x2 * (1.0 / 24 + x2 * (-1.0 / 720 + x2 * (1.0 / 40320 + x2 * (-1.0 / 3628800 + x2 * (1.0 / 479001600 + x2 * (-1.0 / 87178291200.0)))))));
    const double s2 = 2 * sn * cs, c2 = 1 - 2 * sn * sn;
    s = (float)(2 * s2 * c2); c = (float)(1 - 2 * s2 * s2);
}
constexpr int TR_SCR = 64 * 65 * 4;
struct TrItem { const float* W; int ld, n_off, n_cnt, K; bf16_t* WT; int item; const float* g; const float* sc; const float* sh; float* pb; unsigned* cnt; float* bias; };
template <bool SCALED>
__device__ __forceinline__ void tr_load(const TrItem& t, int lane, f32x4 (&v)[16], float& gmr, float& shr) {
    const int nblk = (t.n_cnt + 63) >> 6, kb = t.item / nblk, nb = t.item - kb * nblk, k0 = 64 * kb, n0 = 64 * nb;
    const int c4 = (lane & 15) * 4, kr = lane >> 4;
    const bool ok = (n0 + c4) < t.n_cnt;
#pragma unroll
    for (int i = 0; i < 16; ++i) v[i] = ok ? __builtin_nontemporal_load((const f32x4*)(t.W + (size_t)(k0 + 4 * i + kr) * t.ld + t.n_off + n0 + c4)) : (f32x4){0.f, 0.f, 0.f, 0.f};
    if (SCALED) { gmr = t.g[k0 + lane] * (1.0f + t.sc[k0 + lane]); shr = t.sh[k0 + lane]; }
}
template <bool SCALED>
__device__ __forceinline__ void tr_store(const TrItem& t, int lane, const f32x4 (&v)[16], float gmr, float shr, LAS float* scr) {
    const int nblk = (t.n_cnt + 63) >> 6, kb = t.item / nblk, nb = t.item - kb * nblk, k0 = 64 * kb, n0 = 64 * nb;
    const int c4 = (lane & 15) * 4, kr = lane >> 4;
    f32x4 p = {0.f, 0.f, 0.f, 0.f};
#pragma unroll
    for (int i = 0; i < 16; ++i) { LAS float* s = scr + (4 * i + kr) * 65 + c4; f32x4 w = v[i];
        if (SCALED) { const float gmv = __shfl(gmr, 4 * i + kr), shv = __shfl(shr, 4 * i + kr); p += w * shv; w = w * gmv; }
        s[0] = w.x; s[1] = w.y; s[2] = w.z; s[3] = w.w; }
    asm volatile("s_waitcnt lgkmcnt(0)" ::: "memory");
    const int c = lane & 7;
#pragma unroll
    for (int j = 0; j < 8; ++j) { const int n = (lane >> 3) + 8 * j; const LAS float* s = scr + (8 * c) * 65 + n;
        u32x4 o; o.x = cvtpk(s[0 * 65], s[1 * 65]); o.y = cvtpk(s[2 * 65], s[3 * 65]); o.z = cvtpk(s[4 * 65], s[5 * 65]); o.w = cvtpk(s[6 * 65], s[7 * 65]);
        if (n0 + n < t.n_cnt) *(u32x4*)(t.WT + (size_t)(n0 + n) * t.K + k0 + 8 * c) = o; }
    asm volatile("s_waitcnt lgkmcnt(0)" ::: "memory");
    if (SCALED) {
#pragma unroll
        for (int e = 0; e < 4; ++e) { float x = p[e]; x += __shfl_xor(x, 16); x += __shfl_xor(x, 32); p[e] = x; }
        if (kr == 0) { unsigned* slot = (unsigned*)(t.pb + (size_t)kb * (nblk * 64) + n0 + c4);
#pragma unroll
            for (int e = 0; e < 4; ++e) __hip_atomic_store(slot + e, __float_as_uint(p[e]), __ATOMIC_RELAXED, __HIP_MEMORY_SCOPE_AGENT); }
    }
}
__device__ __forceinline__ void tr_bias_arrive(const TrItem& t, int lane) {
    const int nblk = (t.n_cnt + 63) >> 6, kb = t.item / nblk, nb = t.item - kb * nblk, n0 = 64 * nb, nk = t.K >> 6;
    unsigned old = 0u;
    if (lane == 0) old = __hip_atomic_fetch_add(t.cnt + nb, 1u, __ATOMIC_RELAXED, __HIP_MEMORY_SCOPE_AGENT);
    old = (unsigned)__builtin_amdgcn_readfirstlane((int)old);
    if (old == (unsigned)(nk - 1)) {
        __builtin_amdgcn_fence(__ATOMIC_ACQUIRE, "agent");
        const unsigned* slot = (const unsigned*)(t.pb + n0 + lane); float s = 0.f;
        for (int k = 0; k < nk; ++k) s += __uint_as_float(__hip_atomic_load(slot + (size_t)k * (nblk * 64), __ATOMIC_RELAXED, __HIP_MEMORY_SCOPE_AGENT));
        if (n0 + lane < t.n_cnt) t.bias[n0 + lane] = s;
    }
}
struct MegaArgs {
    const float* in[18]; float* out; unsigned char* ws; int ph_lo, ph_hi;
};
constexpr int I_GIN = 16 * 48, I_GLR = 16, I_SQ = 16 * 16, I_W1 = 16 * 64, I_W2 = 64 * 16;
__device__ __forceinline__ TrItem tr_decode_plain(const MegaArgs& a, int it) {
    unsigned char* ws = a.ws; int r = it;
    if (r < 2 * I_SQ) { const int j = r / I_SQ; return TrItem{a.in[11] + (size_t)j * D * D, D, 0, D, D, (bf16_t*)(ws + WS_WGOUT) + (size_t)j * D * D, r % I_SQ, nullptr, nullptr, nullptr, nullptr, nullptr, nullptr}; } r -= 2 * I_SQ;
    if (r < 2 * I_SQ) { const int j = r / I_SQ; return TrItem{a.in[15] + (size_t)j * D * D, D, 0, D, D, (bf16_t*)(ws + WS_WMOUT) + (size_t)j * D * D, r % I_SQ, nullptr, nullptr, nullptr, nullptr, nullptr, nullptr}; } r -= 2 * I_SQ;
    { const int j = r / I_W2; return TrItem{a.in[17] + (size_t)j * DFF * D, D, 0, D, DFF, (bf16_t*)(ws + WS_W2) + (size_t)j * D * DFF, r % I_W2, nullptr, nullptr, nullptr, nullptr, nullptr, nullptr}; }
}
__device__ __forceinline__ TrItem tr_decode_scaled(const MegaArgs& a, int it) {
    unsigned char* ws = a.ws; int r = it;
    const float* mod = (const float*)(ws + WS_MOD); float* pb = (float*)(ws + WS_PB); unsigned* bc = (unsigned*)(ws + WS_CTL) + CW_BCNT; float* bias = (float*)(ws + WS_BIAS);
    if (r < 2 * I_GIN) { const int j = r / I_GIN, L = 2 * j; const float* m = mod + (size_t)L * 6 * D;
        return TrItem{a.in[7] + (size_t)j * D * GLA_IN, GLA_IN, 0, 3072, D, (bf16_t*)(ws + WS_WGIN) + (size_t)j * 3072 * D, r % I_GIN, a.in[5] + L * D, m + D, m, pb + j * 49152, bc + j * 48, bias + L * BIAS_IN_LD}; } r -= 2 * I_GIN;
    if (r < 2 * I_GLR) { const int j = r / I_GLR, L = 2 * j; const float* m = mod + (size_t)L * 6 * D;
        return TrItem{a.in[7] + (size_t)j * D * GLA_IN, GLA_IN, 3072, 16, D, (bf16_t*)(ws + WS_WGLR) + (size_t)j * 16 * D, r % I_GLR, a.in[5] + L * D, m + D, m, pb + 98304 + j * 1024, bc + 96 + j, bias + L * BIAS_IN_LD + 3072}; } r -= 2 * I_GLR;
    if (r < 2 * I_GIN) { const int j = r / I_GIN, L = 2 * j + 1; const float* m = mod + (size_t)L * 6 * D;
        return TrItem{a.in[12] + (size_t)j * D * MB_IN, MB_IN, 0, 3072, D, (bf16_t*)(ws + WS_WMIN) + (size_t)j * 3072 * D, r % I_GIN, a.in[5] + L * D, m + D, m, pb + 100352 + j * 49152, bc + 98 + j * 48, bias + L * BIAS_IN_LD}; } r -= 2 * I_GIN;
    { const int L = r / I_W1; const float* m = mod + (size_t)L * 6 * D;
        return TrItem{a.in[16] + (size_t)L * D * DFF, DFF, 0, DFF, D, (bf16_t*)(ws + WS_W1) + (size_t)L * DFF * D, r % I_W1, a.in[6] + L * D, m + 4 * D, m + 3 * D, pb + 198656 + L * 65536, bc + 194 + L * 64, bias + BIAS_UP_OFF + L * 4096}; }
}
template <bool SCALED>
__device__ __forceinline__ void tr_run(const Frame& F, const MegaArgs& a) {
    constexpr int NITEMS = SCALED ? (4 * I_GIN + 2 * I_GLR + 4 * I_W1) : (4 * I_SQ + 4 * I_W2);
    LAS float* scr = (LAS float*)(F.lds + F.wave * TR_SCR);
    const int gw = F.vcu * NWAVES + F.wave, NGW = F.G * NWAVES;
    auto decode = [&](int it) -> TrItem { return SCALED ? tr_decode_scaled(a, it) : tr_decode_plain(a, it); };
    f32x4 va[16], vb[16]; float ga = 1.f, sa = 0.f, gb = 1.f, sb = 0.f;
    int it = gw;
    if (it < NITEMS) { TrItem cur = decode(it); tr_load<SCALED>(cur, F.lane, va, ga, sa);
        for (;;) {
            const int itn = it + NGW; TrItem nx = cur; const bool more = itn < NITEMS;
            if (more) { nx = decode(itn); tr_load<SCALED>(nx, F.lane, vb, gb, sb); }
            tr_store<SCALED>(cur, F.lane, va, ga, sa, scr);
            if (!more) break;
            const int itn2 = itn + NGW; const bool more2 = itn2 < NITEMS; TrItem nx2 = nx;
            if (more2) { nx2 = decode(itn2); tr_load<SCALED>(nx2, F.lane, va, ga, sa); }
            tr_store<SCALED>(nx, F.lane, vb, gb, sb, scr);
            if (!more2) break;
            cur = nx2; it = itn2;
        }
    }
    if (SCALED) {
        asm volatile("s_waitcnt vmcnt(0)" ::: "memory");
#pragma unroll 1
        for (int i2 = gw; i2 < NITEMS; i2 += NGW) { const TrItem t = decode(i2); tr_bias_arrive(t, F.lane); }
    }
}
__device__ __forceinline__ void p0_prologue(const Frame& F0, const MegaArgs& a) {
    const Frame F = opaque(F0);
    unsigned char* ws = a.ws;
    {
        const float* c = a.in[1]; const float* ada_w = a.in[3]; const float* ada_b = a.in[4]; float* mod = (float*)(ws + WS_MOD);
        LAS float* sc = (LAS float*)F.lds;
        LAS float* red = (LAS float*)F.lds + 1024;
        for (int k = F.tid; k < D; k += NTHR) sc[k] = silu_f(c[k]);
        __syncthreads();
        const int kg = F.tid >> 5, cl = F.tid & 31;
        for (int chunk = F.vcu; chunk < 256; chunk += F.G) {
            float part[3];
#pragma unroll
            for (int cc = 0; cc < 3; ++cc) {
                const int col = chunk * 96 + cc * 32 + cl, i = col / (6 * D), n = col - i * 6 * D;
                const float* w = ada_w + (size_t)i * D * 6 * D + (size_t)(kg * 64) * 6 * D + n;
                float wv[64];
#pragma unroll
                for (int k = 0; k < 64; ++k) wv[k] = __builtin_nontemporal_load(w + (size_t)k * 6 * D);
                float acc = 0.f;
#pragma unroll
                for (int k = 0; k < 64; ++k) acc += sc[kg * 64 + k] * wv[k];
                part[cc] = acc;
            }
#pragma unroll
            for (int cc = 0; cc < 3; ++cc) red[kg * 96 + cc * 32 + cl] = part[cc];
            __syncthreads();
            if (F.tid < 96) { float s = 0.f;
#pragma unroll
                for (int g = 0; g < 16; ++g) s += red[g * 96 + F.tid];
                mod[chunk * 96 + F.tid] = s + ada_b[chunk * 96 + F.tid]; }
            __syncthreads();
        }
    }
    tr_run<false>(F, a);
    {
        const int* pos = (const int*)a.in[2]; float* ct = (float*)(ws + WS_COS); float* st = (float*)(ws + WS_SIN);
        const float inv_freq = (float)exp2(-(double)(F.tid & 63) * (13.287712379549449 / 64.0));
        for (int idx = F.vcu * NTHR + F.tid; idx < S * 64; idx += F.G * NTHR) {
            const int t = idx >> 6;
            const float angf = (float)pos[t] * inv_freq;
            float sn, cs; sincos_acc((double)angf, sn, cs);
            ct[idx] = cs; st[idx] = sn;
        }
    }
}
__device__ __forceinline__ void x0_phase(const Frame& F0, const float* __restrict__ x, bf16_t* __restrict__ xb, float* __restrict__ pssq) {
    const Frame F = opaque(F0);
    const int gw = F.vcu * NWAVES + F.wave, NGW = F.G * NWAVES;
    f32x4 v[4], v2[4], nv[4], nv2[4];
#define X0_LOAD(m_, a_, b_) do { const int m2_ = (m_) + NGW; const f32x4* x1_ = (const f32x4*)(x + (size_t)(m_) * D) + F.lane; const f32x4* x2_ = (const f32x4*)(x + (size_t)((m2_ < S) ? m2_ : (m_)) * D) + F.lane; \
        _Pragma("unroll") for (int j_ = 0; j_ < 4; ++j_) { a_[j_] = __builtin_nontemporal_load(x1_ + 64 * j_); b_[j_] = __builtin_nontemporal_load(x2_ + 64 * j_); } } while (0)
    if (gw < S) X0_LOAD(gw, v, v2);
    for (int m = gw; m < S; m += 2 * NGW) {
        const int m2 = m + NGW; const bool two = m2 < S; const int mn = m + 2 * NGW;
        if (mn < S) X0_LOAD(mn, nv, nv2);
        float ss = 0.f, ss2 = 0.f;
#pragma unroll
        for (int j = 0; j < 4; ++j) { ss += (v[j].x * v[j].x + v[j].y * v[j].y) + (v[j].z * v[j].z + v[j].w * v[j].w); ss2 += (v2[j].x * v2[j].x + v2[j].y * v2[j].y) + (v2[j].z * v2[j].z + v2[j].w * v2[j].w); }
        const float tot = wave_sum(ss), tot2 = wave_sum(ss2);
        u32x2* o8 = (u32x2*)(xb + (size_t)m * D) + F.lane;
#pragma unroll
        for (int j = 0; j < 4; ++j) { u32x2 w; w.x = cvtpk(v[j].x, v[j].y); w.y = cvtpk(v[j].z, v[j].w); o8[64 * j] = w; }
        if (F.lane == 0) *(f32x4*)(pssq + (size_t)m * 4) = (f32x4){tot, 0.f, 0.f, 0.f};
        if (two) {
            u32x2* o82 = (u32x2*)(xb + (size_t)m2 * D) + F.lane;
#pragma unroll
            for (int j = 0; j < 4; ++j) { u32x2 w; w.x = cvtpk(v2[j].x, v2[j].y); w.y = cvtpk(v2[j].z, v2[j].w); o82[64 * j] = w; }
            if (F.lane == 0) *(f32x4*)(pssq + (size_t)m2 * 4) = (f32x4){tot2, 0.f, 0.f, 0.f};
        }
#pragma unroll
        for (int j = 0; j < 4; ++j) { v[j] = nv[j]; v2[j] = nv2[j]; }
    }
#undef X0_LOAD
}
__device__ __forceinline__ void glr_phase(const Frame& F0, const bf16_t* __restrict__ H, const bf16_t* __restrict__ WglrT, float* __restrict__ glr, const float* __restrict__ pssq, const float* __restrict__ bias) {
    const Frame F = opaque(F0);
    const int l15 = F.lane & 15, q = F.lane >> 4, mt = F.wave & 3, kh = F.wave >> 2;
    LAS f32x4* part = (LAS f32x4*)F.lds;
    for (int rb = F.vcu; rb < S / 64; rb += F.G) {
        const int row0 = rb * 64 + mt * 16;
        const bf16_t* ap = H + (size_t)(row0 + l15) * D + 8 * q + kh * 512;
        const bf16_t* bp = WglrT + (size_t)l15 * D + 8 * q + kh * 512;
        f32x4 acc = {0.f, 0.f, 0.f, 0.f};
#pragma unroll 16
        for (int ks = 0; ks < 16; ++ks) {
            const bf16x8 av = *(const bf16x8*)(ap + ks * 32), bv = *(const bf16x8*)(bp + ks * 32);
            acc = __builtin_amdgcn_mfma_f32_16x16x32_bf16(av, bv, acc, 0, 0, 0);
        }
        if (kh) part[mt * 64 + F.lane] = acc;
        lds_barrier();
        if (!kh) { acc += part[mt * 64 + F.lane]; const float bb = bias[l15];
#pragma unroll
            for (int r = 0; r < 4; ++r) { const f32x4 q4 = *(const f32x4*)(pssq + (size_t)(row0 + 4 * q + r) * 4);
                const float rs = __builtin_amdgcn_rsqf(((q4.x + q4.y) + (q4.z + q4.w)) * (1.0f / 1024.0f) + EPS);
                glr[(size_t)(row0 + 4 * q + r) * 16 + l15] = acc[r] * rs + bb; } }
        lds_barrier();
    }
}
typedef short v4i16_t __attribute__((ext_vector_type(4)));
__device__ __forceinline__ s16x4 vtr(const LAS unsigned char* p) { return __builtin_bit_cast(s16x4, __builtin_amdgcn_ds_read_tr16_b64_v4i16((LAS v4i16_t*)p)); }
__device__ __forceinline__ int crow(int reg, int h) { return (reg & 3) + 8 * (reg >> 2) + 4 * h; }
__device__ __forceinline__ unsigned off_b(unsigned row, unsigned ch) { return 272u * row + 16u * ch; }
__device__ __forceinline__ unsigned off_c(unsigned row, unsigned ch) { return 320u * row + 16u * ch; }
__device__ __forceinline__ unsigned tr_addr(unsigned lane, unsigned c, unsigned rowblk) {
    const unsigned blk = (lane >> 4) & 1, q = (lane & 15) >> 2, p = lane & 3;
    return off_c(rowblk + q, 4 * c + 2 * blk + (p >> 1)) + 8 * (p & 1);
}
constexpr int GL_IMG = 64 * 272, GL_IMT = 64 * 320, GL_PST = 144;
constexpr int GL_QD = 0, GL_KI = GL_IMG, GL_KT = 2 * GL_IMG, GL_V = GL_KT + GL_IMT, GL_P = GL_V + 2 * GL_IMT, GL_SEG = GL_P + 64 * GL_PST, GL_DEC = GL_SEG + 2048, GL_RED = GL_DEC + 512;
constexpr int GL_OST = GL_RED + 2048, GL_OSTW = 528;
static_assert(GL_RED + 2048 <= RING_BYTES && GL_OST + 64 * GL_OSTW <= MISC_OFF, "gla lds");
#define MFMA32(a, b, c) __builtin_amdgcn_mfma_f32_32x32x16_bf16((a), (b), (c), 0, 0, 0)

struct GlaPre { f32x4 ga, gb; unsigned qk[16]; };
__device__ __forceinline__ void gla_prefetch_g(const Frame& F, const float* __restrict__ GLR, int t0, GlaPre& P) {
    const int ib = F.wave >> 2, l31 = F.lane & 31, h = F.lane >> 5;
    const float* gp = GLR + (size_t)(t0 + 32 * ib + l31) * 16 + 8 * h;
    P.ga = *(const f32x4*)gp; P.gb = *(const f32x4*)(gp + 4);
}
template <bool WITH_Q>
__device__ __forceinline__ void gla_prefetch(const Frame& F, const bf16_t* __restrict__ QKV, const float* __restrict__ GLR, int t0, int hd, GlaPre& P);
template <bool WITH_Q>
__device__ __forceinline__ void gla_prefetch_qk(const Frame& F, const bf16_t* __restrict__ QKV, int t0, int hd, GlaPre& P) {
    const int w = F.wave, ib = w >> 2, db = w & 3, l31 = F.lane & 31, h = F.lane >> 5;
    const unsigned odd = l31 & 1;
#pragma unroll
    for (int r = 0; r < 16; ++r)
        P.qk[r] = ((const unsigned*)(QKV + (size_t)(t0 + 32 * ib + crow(r, h)) * 3072 + hd * 128 + 32 * db + (l31 & ~1)))[(WITH_Q && !odd) ? 0 : 256];
}
template <bool WITH_Q>
__device__ __forceinline__ void gla_prefetch(const Frame& F, const bf16_t* __restrict__ QKV, const float* __restrict__ GLR, int t0, int hd, GlaPre& P) {
    gla_prefetch_g(F, GLR, t0, P); gla_prefetch_qk<WITH_Q>(F, QKV, t0, hd, P);
}
struct GlaW { u32x4 bhi, blo; float bias; };
__device__ __forceinline__ void gla_load_w(const float* __restrict__ wupg, const float* __restrict__ bgg, int hd, const Frame& F, GlaW& W) {
    const int db = F.wave & 3, l31 = F.lane & 31, h = F.lane >> 5, d = hd * 128 + 32 * db + l31;
    float wv[8];
#pragma unroll
    for (int j = 0; j < 8; ++j) wv[j] = wupg[(8 * h + j) * 512 + d];
    W.bhi.x = cvtpk(wv[0], wv[1]); W.bhi.y = cvtpk(wv[2], wv[3]); W.bhi.z = cvtpk(wv[4], wv[5]); W.bhi.w = cvtpk(wv[6], wv[7]);
    W.blo.x = cvtpk(wv[0] - bflo(W.bhi.x), wv[1] - bfhi(W.bhi.x)); W.blo.y = cvtpk(wv[2] - bflo(W.bhi.y), wv[3] - bfhi(W.bhi.y));
    W.blo.z = cvtpk(wv[4] - bflo(W.bhi.z), wv[5] - bfhi(W.bhi.z)); W.blo.w = cvtpk(wv[6] - bflo(W.bhi.w), wv[7] - bfhi(W.bhi.w));
    W.bias = bgg[d];
}
template <bool WITH_Q, bool VPRE>
__device__ __forceinline__ float gla_chunk_prep(const Frame& F, const GlaPre& P, const GlaW& W, const bf16_t* __restrict__ QKV, int t0, int hd, const u32x4 (&vpre)[4]) {
    LAS unsigned char* lds = F.lds;
    const int w = F.wave, ib = w >> 2, db = w & 3, l31 = F.lane & 31, h = F.lane >> 5, d = 32 * db + l31;
    u32x4 vv[4];
#pragma unroll
    for (int k = 0; k < 4; ++k) { const int c = F.tid + 512 * k, j = c >> 5, ch = c & 31; vv[k] = VPRE ? vpre[k] : *(const u32x4*)(QKV + (size_t)(t0 + j) * 3072 + 1024 + hd * 256 + ch * 8); }
    u32x4 ahi, alo;
    ahi.x = cvtpk(P.ga.x, P.ga.y); ahi.y = cvtpk(P.ga.z, P.ga.w); ahi.z = cvtpk(P.gb.x, P.gb.y); ahi.w = cvtpk(P.gb.z, P.gb.w);
    alo.x = cvtpk(P.ga.x - bflo(ahi.x), P.ga.y - bfhi(ahi.x)); alo.y = cvtpk(P.ga.z - bflo(ahi.y), P.ga.w - bfhi(ahi.y));
    alo.z = cvtpk(P.gb.x - bflo(ahi.z), P.gb.y - bfhi(ahi.z)); alo.w = cvtpk(P.gb.z - bflo(ahi.w), P.gb.w - bfhi(ahi.w));
    f32x16 X;
#pragma unroll
    for (int r = 0; r < 16; ++r) X[r] = W.bias;
    X = MFMA32(__builtin_bit_cast(bf16x8, ahi), __builtin_bit_cast(bf16x8, W.bhi), X);
    X = MFMA32(__builtin_bit_cast(bf16x8, alo), __builtin_bit_cast(bf16x8, W.bhi), X);
    X = MFMA32(__builtin_bit_cast(bf16x8, ahi), __builtin_bit_cast(bf16x8, W.blo), X);
    float G[16], sk[4];
#pragma unroll
    for (int k = 0; k < 4; ++k) { float run = 0.f;
#pragma unroll
        for (int j = 0; j < 4; ++j) { const float x = X[4 * k + j]; const float l2 = __builtin_amdgcn_logf(1.f + __builtin_amdgcn_exp2f(fabsf(x) * -1.4426950408889634f));
            run = __builtin_fmaf(fminf(x, 0.f), 1.4426950408889634f / 16.f, run); run = __builtin_fmaf(l2, -1.f / 16.f, run); G[4 * k + j] = run; }
        sk[k] = run; }
    float base = 0.f, tot;
    {
        float ps[4];
#pragma unroll
        for (int k = 0; k < 4; ++k) ps[k] = __shfl_xor(sk[k], 32);
#pragma unroll
        for (int k = 0; k < 4; ++k) { const float bk = base + (h ? ps[k] : 0.f);
#pragma unroll
            for (int j = 0; j < 4; ++j) G[4 * k + j] += bk;
            base += sk[k] + ps[k]; }
        tot = base;
    }
    LAS float* HT = (LAS float*)(lds + GL_SEG);
    if (h == 0) HT[ib * 128 + d] = tot;
#pragma unroll
    for (int k = 0; k < 4; ++k) { const int c = F.tid + 512 * k, j = c >> 5, ch = c & 31; *(LAS u32x4*)(lds + GL_V + (ch >> 4) * GL_IMT + off_c(j, ch & 15)) = vv[k]; }
    lds_barrier();
    const float t0h = HT[d], t1h = HT[128 + d], glast = t0h + t1h;
    const float add = ib ? t0h : 0.f;
    const float qs = 0.08838834764831845f;
    const unsigned qksel = WITH_Q ? ((l31 & 1) ? 0x03020706u : 0x05040100u) : ((l31 & 1) ? 0x07060302u : 0x05040100u);
    const float eg = __builtin_amdgcn_exp2f(glast);
#pragma unroll
    for (int r = 0; r < 16; ++r) {
        const int i = 32 * ib + crow(r, h); const float Gv = G[r] + add;
        const unsigned a = off_b(i, d >> 3) + 2 * (d & 7);
        const unsigned raw = P.qk[r];
        const unsigned qkv = WITH_Q ? __builtin_amdgcn_perm((unsigned)__shfl_xor((int)raw, 1), raw, qksel) : __builtin_amdgcn_perm(raw, 0u, qksel);
        const float kf = bfhi(qkv);
        float kt;
        if (WITH_Q) {
            const float ki = kf * __builtin_amdgcn_exp2f(-Gv);
            *(LAS unsigned short*)(lds + GL_QD + a) = (unsigned short)(cvtpk(bflo(qkv) * qs * __builtin_amdgcn_exp2f(Gv), 0.f) & 0xffffu);
            *(LAS unsigned short*)(lds + GL_KI + a) = (unsigned short)(cvtpk(ki, 0.f) & 0xffffu);
            kt = ki * eg;
        } else kt = kf * __builtin_amdgcn_exp2f(glast - Gv);
        *(LAS unsigned short*)(lds + GL_KT + off_c(i, d >> 3) + 2 * (d & 7)) = (unsigned short)(cvtpk(kt, 0.f) & 0xffffu);
    }
    if (ib == 0 && h == 0) ((LAS float*)(lds + GL_DEC))[d] = eg;
    lds_barrier();
    return glast;
}
__device__ __forceinline__ void gla_state_update(const Frame& F, f32x16 (&St)[4]) {
    LAS unsigned char* lds = F.lds;
    const int h = F.lane >> 5, w = F.wave;
    const LAS float* dec = (const LAS float*)(lds + GL_DEC);
#pragma unroll
    for (int db = 0; db < 4; ++db)
#pragma unroll
        for (int g = 0; g < 4; ++g) {
            const f32x4 dv = *(const LAS f32x4*)(dec + 32 * db + 8 * g + 4 * h);
            St[db][4 * g + 0] *= dv.x; St[db][4 * g + 1] *= dv.y; St[db][4 * g + 2] *= dv.z; St[db][4 * g + 3] *= dv.w; }
    const LAS unsigned char* vimg = lds + GL_V + (w >> 2) * GL_IMT;
#pragma unroll
    for (int ks = 0; ks < 4; ++ks) {
        const s16x4 vlo = vtr(vimg + tr_addr(F.lane, w & 3, 16 * ks + 8 * h)), vhi = vtr(vimg + tr_addr(F.lane, w & 3, 16 * ks + 8 * h + 4));
        const bf16x8 vb = __builtin_shufflevector(vlo, vhi, 0, 1, 2, 3, 4, 5, 6, 7);
#pragma unroll
        for (int db = 0; db < 4; ++db) {
            const s16x4 klo = vtr(lds + GL_KT + tr_addr(F.lane, db, 16 * ks + 8 * h)), khi = vtr(lds + GL_KT + tr_addr(F.lane, db, 16 * ks + 8 * h + 4));
            const bf16x8 ka = __builtin_shufflevector(klo, khi, 0, 1, 2, 3, 4, 5, 6, 7);
            St[db] = MFMA32(ka, vb, St[db]);
        }
    }
}
__device__ __forceinline__ void gla_g1(const Frame& F0, const bf16_t* __restrict__ QKV, const float* __restrict__ GLR, const float* __restrict__ wupg, const float* __restrict__ bgg, float* __restrict__ SBUF, float* __restrict__ DG) {
    const Frame F = opaque(F0);
    const int h = F.lane >> 5, w = F.wave;
    young_half_prio_on(F);
    for (int u = F.vcu; u < 256; u += F.G) {
        const int gi = u >> 2, hd = u & 3;
        f32x16 St[4];
#pragma unroll
        for (int db = 0; db < 4; ++db)
#pragma unroll
            for (int r = 0; r < 16; ++r) St[db][r] = 0.f;
        float gsum = 0.f;
        GlaPre P; gla_prefetch<false>(F, QKV, GLR, gi * 256, hd, P);
        u32x4 vpre[4];
#define GLA_VPRE(t0_) do { _Pragma("unroll") for (int k_ = 0; k_ < 4; ++k_) { const int c_ = F.tid + 512 * k_, j_ = c_ >> 5, ch_ = c_ & 31; vpre[k_] = *(const u32x4*)(QKV + (size_t)((t0_) + j_) * 3072 + 1024 + hd * 256 + ch_ * 8); } } while (0)
        GLA_VPRE(gi * 256);
        GlaW W; gla_load_w(wupg, bgg, hd, F, W);
#pragma unroll 1
        for (int c = 0; c < 4; ++c) {
            gsum += gla_chunk_prep<false, true>(F, P, W, QKV, gi * 256 + c * 64, hd, vpre);
            if (c < 3) { gla_prefetch<false>(F, QKV, GLR, gi * 256 + (c + 1) * 64, hd, P); GLA_VPRE(gi * 256 + (c + 1) * 64); }
            gla_state_update(F, St);
            lds_barrier();
        }
        float* sp = SBUF + ((size_t)u * 128) * 256 + 32 * w + (F.lane & 31);
#pragma unroll
        for (int db = 0; db < 4; ++db)
#pragma unroll
            for (int r = 0; r < 16; ++r) sp[(size_t)(32 * db + crow(r, h)) * 256] = St[db][r];
        if ((w >> 2) == 0 && h == 0) DG[u * 128 + 32 * (w & 3) + (F.lane & 31)] = __builtin_amdgcn_exp2f(gsum);
    }
    young_half_prio_off(F);
}
__device__ __forceinline__ void gla_g2(const Frame& F0, float* __restrict__ SBUF, const float* __restrict__ DG) {
    const Frame F = opaque(F0);
    for (int e = F.vcu * NTHR + F.tid; e < 4 * 128 * 256; e += F.G * NTHR) {
        const int hd = e >> 15, d = (e >> 8) & 127;
        float run = 0.f;
#pragma unroll 1
        for (int g0 = 0; g0 < 64; g0 += 8) {
            float tmp[8], dec[8];
#pragma unroll
            for (int k = 0; k < 8; ++k) { const int g = g0 + k; tmp[k] = __builtin_nontemporal_load(SBUF + (size_t)(g * 4 + hd) * 32768 + (e & 32767)); dec[k] = DG[(g * 4 + hd) * 128 + d]; }
#pragma unroll
            for (int k = 0; k < 8; ++k) { const int g = g0 + k; SBUF[(size_t)(g * 4 + hd) * 32768 + (e & 32767)] = run; run = dec[k] * run + tmp[k]; }
        }
    }
}
__device__ __forceinline__ void gla_g3(const Frame& F0, const bf16_t* __restrict__ QKV, const float* __restrict__ GLR, const float* __restrict__ wupg, const float* __restrict__ bgg,
                                       const float* __restrict__ SBUF, const float* __restrict__ og, bf16_t* __restrict__ MIX) {
    const Frame F = opaque(F0);
    LAS unsigned char* lds = F.lds;
    const int h = F.lane >> 5, w = F.wave, l31 = F.lane & 31;
    young_half_prio_on(F);
    for (int u = F.vcu; u < 256; u += F.G) {
        const int gi = u >> 2, hd = u & 3;
        f32x16 St[4];
        { const float* sp = SBUF + ((size_t)u * 128) * 256 + 32 * w + l31;
#pragma unroll
          for (int db = 0; db < 4; ++db)
#pragma unroll
              for (int r = 0; r < 16; ++r) St[db][r] = __builtin_nontemporal_load(sp + (size_t)(32 * db + crow(r, h)) * 256); }
#pragma unroll 1
        for (int c = 0; c < 4; ++c) {
            const int t0 = gi * 256 + c * 64;
            {
                GlaPre P; gla_prefetch<true>(F, QKV, GLR, t0, hd, P);
                const float* wupc = wupg; asm volatile("" : "+s"(wupc));
                GlaW W; gla_load_w(wupc, bgg, hd, F, W);
                u32x4 vdum[4]; (void)gla_chunk_prep<true, false>(F, P, W, QKV, t0, hd, vdum); }
            if (w < 3) {
                const int ib = (w >= 1), jb = (w == 2);
                f32x16 acc;
#pragma unroll
                for (int r = 0; r < 16; ++r) acc[r] = 0.f;
#pragma unroll
                for (int s = 0; s < 8; ++s) {
                    const bf16x8 a = *(const LAS bf16x8*)(lds + GL_QD + off_b(32 * ib + l31, 2 * s + h));
                    const bf16x8 b = *(const LAS bf16x8*)(lds + GL_KI + off_b(32 * jb + l31, 2 * s + h));
                    acc = MFMA32(a, b, acc);
                }
                const int jabs = 32 * jb + l31;
#pragma unroll
                for (int r = 0; r < 16; ++r) { const int iabs = 32 * ib + crow(r, h); const float pv = (jabs <= iabs) ? acc[r] : 0.f;
                    *(LAS unsigned short*)(lds + GL_P + iabs * GL_PST + 2 * jabs) = (unsigned short)(cvtpk(pv, 0.f) & 0xffffu); }
            }
            f32x16 oT[2];
#pragma unroll
            for (int ib = 0; ib < 2; ++ib)
#pragma unroll
                for (int r = 0; r < 16; ++r) oT[ib][r] = 0.f;
#pragma unroll
            for (int db = 0; db < 4; ++db)
#pragma unroll
                for (int s = 0; s < 2; ++s) {
                    u32x4 pk; pk.x = cvtpk(St[db][8 * s + 0], St[db][8 * s + 1]); pk.y = cvtpk(St[db][8 * s + 2], St[db][8 * s + 3]); pk.z = cvtpk(St[db][8 * s + 4], St[db][8 * s + 5]); pk.w = cvtpk(St[db][8 * s + 6], St[db][8 * s + 7]);
                    const bf16x8 xa = __builtin_bit_cast(bf16x8, pk);
#pragma unroll
                    for (int ib = 0; ib < 2; ++ib) {
                        const u32x2 qlo = *(const LAS u32x2*)(lds + GL_QD + off_b(32 * ib + l31, 4 * db + 2 * s + 0) + 8 * h);
                        const u32x2 qhi = *(const LAS u32x2*)(lds + GL_QD + off_b(32 * ib + l31, 4 * db + 2 * s + 1) + 8 * h);
                        u32x4 qq; qq.x = qlo.x; qq.y = qlo.y; qq.z = qhi.x; qq.w = qhi.y;
                        oT[ib] = MFMA32(xa, __builtin_bit_cast(bf16x8, qq), oT[ib]);
                    }
                }
            __syncthreads();
#pragma unroll
            for (int k = 0; k < 4; ++k) { const int cidx = F.tid + 512 * k;
                __builtin_amdgcn_global_load_lds((const unsigned*)(QKV + (size_t)(t0 + (cidx >> 5)) * 3072 + 2048 + hd * 256 + 8 * (cidx & 31)), (LAS unsigned*)(lds + GL_QD + (512 * k + 64 * w) * 16), 16, 0, 0); }
            {
                const LAS unsigned char* vimg = lds + GL_V + (w >> 2) * GL_IMT;
#pragma unroll
                for (int ks = 0; ks < 4; ++ks) {
                    const s16x4 vlo = vtr(vimg + tr_addr(F.lane, w & 3, 16 * ks + 8 * h)), vhi = vtr(vimg + tr_addr(F.lane, w & 3, 16 * ks + 8 * h + 4));
                    const bf16x8 va = __builtin_shufflevector(vlo, vhi, 0, 1, 2, 3, 4, 5, 6, 7);
#pragma unroll
                    for (int ib = 0; ib < 2; ++ib) {
                        if (ib == 0 && ks >= 2) continue;
                        const int irow = 32 * ib + l31;
                        const bf16x8 pb = *(const LAS bf16x8*)(lds + GL_P + irow * GL_PST + 16 * (2 * ks + h));
                        oT[ib] = MFMA32(va, pb, oT[ib]);
                    }
                }
            }
            float ssq[2];
#pragma unroll
            for (int ib = 0; ib < 2; ++ib) { float s = 0.f;
#pragma unroll
                for (int r = 0; r < 16; ++r) s += oT[ib][r] * oT[ib][r];
                s += __shfl_xor(s, 32); ssq[ib] = s; }
            if (h == 0) { ((LAS float*)(lds + GL_RED))[w * 64 + l31] = ssq[0]; ((LAS float*)(lds + GL_RED))[w * 64 + 32 + l31] = ssq[1]; }
            lds_barrier();
            const float* ogp = og; asm volatile("" : "+s"(ogp));
#pragma unroll
            for (int ib = 0; ib < 2; ++ib) {
                float tot = 0.f;
#pragma unroll
                for (int ww = 0; ww < 8; ++ww) tot += ((LAS float*)(lds + GL_RED))[ww * 64 + 32 * ib + l31];
                const float rn = __builtin_amdgcn_rsqf(tot * (1.f / 256.f) + EPS);
#pragma unroll
                for (int g = 0; g < 4; ++g) {
                    const int e0 = 32 * w + 8 * g + 4 * h;
                    const f32x4 ogv = *(const f32x4*)(ogp + e0);
                    u32x2 o; o.x = cvtpk(oT[ib][4 * g + 0] * rn * ogv.x, oT[ib][4 * g + 1] * rn * ogv.y); o.y = cvtpk(oT[ib][4 * g + 2] * rn * ogv.z, oT[ib][4 * g + 3] * rn * ogv.w);
                    *(LAS u32x2*)(lds + GL_OST + (32 * ib + l31) * GL_OSTW + 2 * e0) = o;
                }
            }
            if (c < 3) gla_state_update(F, St);
            asm volatile("s_waitcnt vmcnt(0)" ::: "memory");
            __syncthreads();
#pragma unroll 2
            for (int k = 0; k < 4; ++k) { const int cidx = F.tid + 512 * k, row = cidx >> 5, ch = cidx & 31;
                const u32x4 yv = *(const LAS u32x4*)(lds + GL_OST + row * GL_OSTW + 16 * ch); const u32x4 rg = *(const LAS u32x4*)(lds + GL_QD + cidx * 16);
                const float y[8] = {bflo(yv.x), bfhi(yv.x), bflo(yv.y), bfhi(yv.y), bflo(yv.z), bfhi(yv.z), bflo(yv.w), bfhi(yv.w)};
                const float rr[8] = {bflo(rg.x), bfhi(rg.x), bflo(rg.y), bfhi(rg.y), bflo(rg.z), bfhi(rg.z), bflo(rg.w), bfhi(rg.w)};
                float z[8];
#pragma unroll
                for (int e = 0; e < 8; ++e) z[e] = y[e] * rr[e] * __builtin_amdgcn_rcpf(1.f + __expf(-rr[e]));
                u32x4 o; o.x = cvtpk(z[0], z[1]); o.y = cvtpk(z[2], z[3]); o.z = cvtpk(z[4], z[5]); o.w = cvtpk(z[6], z[7]);
                *(u32x4*)(MIX + (size_t)(t0 + row) * D + hd * 256 + 8 * ch) = o; }
        }
    }
    young_half_prio_off(F);
}
constexpr int MB_LIST_H = 516096;
__device__ __forceinline__ int mb_list_off(int n) { return 256 * (63 * n - (n * (n - 1)) / 2); }
constexpr int MB_OST = 2 * 128 * 256, MB_OSTW = 32 * 264;
typedef int mb_i4 __attribute__((ext_vector_type(4)));
constexpr int MB_PRE = MB_OST + 8 * MB_OSTW, MB_DESC = MB_PRE + 2064, MB_NDESC = 64, MB_END = MB_DESC + MB_NDESC * 16;
static_assert(MB_END <= MISC_OFF, "moba lds");

__device__ __forceinline__ void moba_m1_tile(const Frame& F, int pm, int pn, bf16_t* __restrict__ QKV, const float* __restrict__ COS, const float* __restrict__ SIN,
                                             const float* __restrict__ qg, const float* __restrict__ kg, float* __restrict__ KMEAN) {
    LAS unsigned char* lds = F.lds;
    const int which = (pn >= 4), h0 = 2 * (pn & 3);
    const int ts = F.lane >> 4, hs = (F.lane >> 3) & 1, j = F.lane & 7;
    const float* g = which ? kg : qg;
    const float gsc = which ? 1.0f : (0.08838834764831845f * 1.4426950408889634f);
    float g1[8], g2[8], a1[8], a2[8];
#pragma unroll
    for (int e = 0; e < 8; ++e) { g1[e] = g[8 * j + e] * gsc; g2[e] = g[64 + 8 * j + e] * gsc; a1[e] = 0.f; a2[e] = 0.f; }
    u32x4 ra, rb; f32x4 c0, c1, s0, s1;
#define M1_LOAD(it_) do { const int t_ = pm * 256 + ((it_) * 8 + F.wave) * 4 + ts; const bf16_t* p_ = QKV + (size_t)t_ * 3072 + which * 1024 + (h0 + hs) * 128 + 8 * j; \
        ra = *(const u32x4*)p_; rb = *(const u32x4*)(p_ + 64); \
        c0 = *(const f32x4*)(COS + (size_t)t_ * 64 + 8 * j); c1 = *(const f32x4*)(COS + (size_t)t_ * 64 + 8 * j + 4); \
        s0 = *(const f32x4*)(SIN + (size_t)t_ * 64 + 8 * j); s1 = *(const f32x4*)(SIN + (size_t)t_ * 64 + 8 * j + 4); } while (0)
    M1_LOAD(0);
#pragma unroll 2
    for (int it = 0; it < 8; ++it) {
        const int t = pm * 256 + (it * 8 + F.wave) * 4 + ts;
        bf16_t* p = QKV + (size_t)t * 3072 + which * 1024 + (h0 + hs) * 128 + 8 * j;
        float x1[8] = {bflo(ra.x), bfhi(ra.x), bflo(ra.y), bfhi(ra.y), bflo(ra.z), bfhi(ra.z), bflo(ra.w), bfhi(ra.w)};
        float x2[8] = {bflo(rb.x), bfhi(rb.x), bflo(rb.y), bfhi(rb.y), bflo(rb.z), bfhi(rb.z), bflo(rb.w), bfhi(rb.w)};
        const float cs[8] = {c0.x, c0.y, c0.z, c0.w, c1.x, c1.y, c1.z, c1.w};
        const float sn[8] = {s0.x, s0.y, s0.z, s0.w, s1.x, s1.y, s1.z, s1.w};
        if (it + 1 < 8) M1_LOAD(it + 1);
        float ss = 0.f;
#pragma unroll
        for (int e = 0; e < 8; ++e) ss += x1[e] * x1[e] + x2[e] * x2[e];
        ss += __shfl_xor(ss, 1); ss += __shfl_xor(ss, 2); ss += __shfl_xor(ss, 4);
        const float r = __builtin_amdgcn_rsqf(ss * (1.f / 128.f) + EPS);
        float o1[8], o2[8];
#pragma unroll
        for (int e = 0; e < 8; ++e) { const float y1 = x1[e] * r * g1[e], y2 = x2[e] * r * g2[e]; o1[e] = y1 * cs[e] - y2 * sn[e]; o2[e] = y2 * cs[e] + y1 * sn[e]; }
        if (which) {
#pragma unroll
            for (int e = 0; e < 8; ++e) { a1[e] += o1[e]; a2[e] += o2[e]; } }
        u32x4 wa, wb;
        wa.x = cvtpk(o1[0], o1[1]); wa.y = cvtpk(o1[2], o1[3]); wa.z = cvtpk(o1[4], o1[5]); wa.w = cvtpk(o1[6], o1[7]);
        wb.x = cvtpk(o2[0], o2[1]); wb.y = cvtpk(o2[2], o2[3]); wb.z = cvtpk(o2[4], o2[5]); wb.w = cvtpk(o2[6], o2[7]);
        *(u32x4*)p = wa; *(u32x4*)(p + 64) = wb;
    }
#undef M1_LOAD
    if (which) {
#pragma unroll
        for (int e = 0; e < 8; ++e) { a1[e] += __shfl_xor(a1[e], 16); a1[e] += __shfl_xor(a1[e], 32); a2[e] += __shfl_xor(a2[e], 16); a2[e] += __shfl_xor(a2[e], 32); }
        LAS float* red = (LAS float*)lds;
        if (ts == 0) {
#pragma unroll
            for (int e = 0; e < 8; ++e) { red[(F.wave * 2 + hs) * 128 + 8 * j + e] = a1[e]; red[(F.wave * 2 + hs) * 128 + 64 + 8 * j + e] = a2[e]; } }
        lds_barrier();
        if (F.tid < 256) { const int hh = F.tid >> 7, d = F.tid & 127; float s = 0.f;
#pragma unroll
            for (int w = 0; w < 8; ++w) s += red[(w * 2 + hh) * 128 + d];
            KMEAN[((size_t)(h0 + hh) * 64 + pm) * 128 + d] = s * (1.f / 256.f); }
        lds_barrier();
    }
}
__device__ __forceinline__ void moba_m1_tail(const Frame& F0, int G, int c, bf16_t* __restrict__ QKV, const float* __restrict__ COS, const float* __restrict__ SIN,
                                             const float* __restrict__ qg, const float* __restrict__ kg, float* __restrict__ KMEAN) {
    const Frame F = opaque(F0);
    pg8::StaticOrder So; So.init(S, 3072, G, c);
#pragma unroll 1
    for (int i = 0; i < 3; ++i) {
        pg8::Unit u; if (!So.next(i, u)) break;
        if (u.pn < 8) moba_m1_tile(F, u.pm, u.pn, QKV, COS, SIN, qg, kg, KMEAN);
    }
}
#define MB_INS_ORD(v, i) do { const float v_ = (v); const int i_ = (i); \
    const bool b0_ = v_ > v0, b1_ = v_ > v1, b2_ = v_ > v2; \
    if (b0_) { v2 = v1; i2 = i1; v1 = v0; i1 = i0; v0 = v_; i0 = i_; } else if (b1_) { v2 = v1; i2 = i1; v1 = v_; i1 = i_; } else if (b2_) { v2 = v_; i2 = i_; } } while (0)
#define MB_INS(v, i) do { const float v_ = (v); const int i_ = (i); \
    const bool b0_ = v_ > v0 || (v_ == v0 && i_ < i0), b1_ = v_ > v1 || (v_ == v1 && i_ < i1), b2_ = v_ > v2 || (v_ == v2 && i_ < i2); \
    if (b0_) { v2 = v1; i2 = i1; v1 = v0; i1 = i0; v0 = v_; i0 = i_; } else if (b1_) { v2 = v1; i2 = i1; v1 = v_; i1 = i_; } else if (b2_) { v2 = v_; i2 = i_; } } while (0)
__device__ __forceinline__ void moba_m2(const Frame& F0, const bf16_t* __restrict__ QKV, const float* __restrict__ KMEAN, unsigned* __restrict__ gcnt, int* __restrict__ LIST) {
    const Frame F = opaque(F0);
    LAS unsigned char* lds = F.lds;
    LAS int* cntl = (LAS int*)lds;
    const int h2 = F.lane >> 5, l31 = F.lane & 31, w = F.wave;
    young_half_prio_on(F);
    for (int u = F.vcu; u < 512; u += F.G) {
        const int b = u >> 3, h = u & 7;
        if (b == 0) continue;
        if (F.tid < 64) cntl[F.tid] = 0;
        const int t = b * 256 + 32 * w + l31;
        bf16x8 qf[8];
#pragma unroll
        for (int s = 0; s < 8; ++s) qf[s] = *(const bf16x8*)(QKV + (size_t)t * 3072 + h * 128 + 16 * s + 8 * h2);
#pragma unroll
        for (int k = 0; k < 4; ++k) { const int idx = F.tid + 512 * k, nr = idx >> 5, c4 = (idx & 31) * 4;
            if (nr < b) { const f32x4 v = *(const f32x4*)(KMEAN + ((size_t)h * 64 + nr) * 128 + c4);
                u32x2 hi; hi.x = cvtpk(v.x, v.y); hi.y = cvtpk(v.z, v.w);
                u32x2 lo; lo.x = cvtpk(v.x - bflo(hi.x), v.y - bfhi(hi.x)); lo.y = cvtpk(v.z - bflo(hi.y), v.w - bfhi(hi.y));
                *(LAS u32x2*)(lds + 1024 + nr * 272 + c4 * 2) = hi; *(LAS u32x2*)(lds + 1024 + 64 * 272 + nr * 272 + c4 * 2) = lo; } }
        lds_barrier();
        float v0 = -INFINITY, v1 = -INFINITY, v2 = -INFINITY; int i0 = 64, i1 = 64, i2 = 64;
#pragma unroll
        for (int nb = 0; nb < 2; ++nb) {
            if (nb == 1 && b <= 32) continue;
            f32x16 acc;
#pragma unroll
            for (int r = 0; r < 16; ++r) acc[r] = 0.f;
            const LAS unsigned char* khp = lds + 1024 + (32 * nb + l31) * 272 + 16 * h2;
#pragma unroll
            for (int s = 0; s < 8; ++s) {
                const bf16x8 hi = *(const LAS bf16x8*)(khp + 32 * s), lo = *(const LAS bf16x8*)(khp + 64 * 272 + 32 * s);
                acc = MFMA32(hi, qf[s], acc);
                acc = MFMA32(lo, qf[s], acc);
            }
#pragma unroll
            for (int r = 0; r < 16; ++r) { const int n = 32 * nb + crow(r, h2); const float gv = (n < b) ? acc[r] : -INFINITY; MB_INS_ORD(gv, n); }
        }
        { const float p0 = __shfl_xor(v0, 32), p1 = __shfl_xor(v1, 32), p2 = __shfl_xor(v2, 32); const int q0 = __shfl_xor(i0, 32), q1 = __shfl_xor(i1, 32), q2 = __shfl_xor(i2, 32);
          MB_INS(p0, q0); MB_INS(p1, q1); MB_INS(p2, q2); }
        int pos0 = 0, pos1 = 0, pos2 = 0;
        const bool e0 = (h2 == 0) && (v0 > -INFINITY), e1 = (h2 == 0) && (v1 > -INFINITY), e2 = (h2 == 0) && (v2 > -INFINITY);
        if (e0) pos0 = __hip_atomic_fetch_add(cntl + i0, 1, __ATOMIC_RELAXED, __HIP_MEMORY_SCOPE_WORKGROUP);
        if (e1) pos1 = __hip_atomic_fetch_add(cntl + i1, 1, __ATOMIC_RELAXED, __HIP_MEMORY_SCOPE_WORKGROUP);
        if (e2) pos2 = __hip_atomic_fetch_add(cntl + i2, 1, __ATOMIC_RELAXED, __HIP_MEMORY_SCOPE_WORKGROUP);
        lds_barrier();
        if (F.tid < 64) { const int c = cntl[F.tid]; int base = 0; if (c > 0) base = (int)__hip_atomic_fetch_add(gcnt + h * 64 + F.tid, (unsigned)c, __ATOMIC_RELAXED, __HIP_MEMORY_SCOPE_AGENT); cntl[64 + F.tid] = base; }
        lds_barrier();
        int* lst = LIST + (size_t)h * MB_LIST_H;
        if (e0) lst[mb_list_off(i0) + cntl[64 + i0] + pos0] = (t << 2) | 0;
        if (e1) lst[mb_list_off(i1) + cntl[64 + i1] + pos1] = (t << 2) | 1;
        if (e2) lst[mb_list_off(i2) + cntl[64 + i2] + pos2] = (t << 2) | 2;
        lds_barrier();
    }
    young_half_prio_off(F);
}
constexpr int MB_HALF = 128 * 256;
__device__ __forceinline__ unsigned off_x(unsigned row, unsigned ch) { return 256u * row + 16u * (ch ^ (((row & 3) << 2) | ((row >> 2) & 3))); }
__device__ __forceinline__ void mb_decode(int v, const LAS int* pre, const unsigned* __restrict__ gcnt, int& h, int& n, int& count, int& lbase, bool& own) {
    if (v < 512) { n = v >> 3; h = v & 7; count = 256; lbase = 0; own = true; return; }
    const int x = v - 512; int lo_ = 0, hi_ = 511;
    while (lo_ < hi_) { const int mid = (lo_ + hi_) >> 1; if (pre[mid] > x) hi_ = mid; else lo_ = mid + 1; }
    const int hn = lo_; h = hn >> 6; n = hn & 63;
    const int tile = x - (hn ? pre[hn - 1] : 0);
    count = (int)gcnt[hn] - tile * 256; if (count > 256) count = 256;
    lbase = h * MB_LIST_H + mb_list_off(n) + tile * 256; own = false;
}
#define MB_STAGE(hh_, nn_, hf_, buf_) do { _Pragma("unroll") for (int k_ = 0; k_ < 4; ++k_) { const int pc_ = w * 4 + k_;               \
        const int r_ = 4 * pc_ + (F.lane >> 4); const int ch_ = (F.lane & 15) ^ (((r_ & 3) << 2) | ((r_ >> 2) & 3)); \
        const bf16_t* src_ = QKV + (size_t)((nn_) * 256 + (hf_) * 128 + r_) * 3072 + 1024 + (hh_) * 128 + 8 * ch_; \
        __builtin_amdgcn_global_load_lds((const unsigned*)src_, (LAS unsigned*)(lds + (buf_) * 2 * MB_HALF + pc_ * 1024), 16, 0, 0); \
        __builtin_amdgcn_global_load_lds((const unsigned*)(src_ + 1024), (LAS unsigned*)(lds + (buf_) * 2 * MB_HALF + MB_HALF + pc_ * 1024), 16, 0, 0); } } while (0)
#define MB_VMWAIT() asm volatile("s_waitcnt vmcnt(0)" ::: "memory")
#define MB_ENT(entv_, own_, nn_, cnt_, lb_) do { const int qi_ = 32 * w + l31; \
        if (own_) entv_ = (((nn_) * 256 + qi_) << 2) | 3; else entv_ = (qi_ < (cnt_)) ? LIST[(lb_) + qi_] : -1; } while (0)
#define MB_GATHER(entv_, qv_, nn_, hh_) do { \
        const int tq_ = (entv_ >= 0) ? (entv_ >> 2) : ((nn_) * 256); \
        _Pragma("unroll") for (int s_ = 0; s_ < 8; ++s_) qv_[s_] = *(const bf16x8*)(QKV + (size_t)tq_ * 3072 + (hh_) * 128 + 16 * s_ + 8 * h2); } while (0)
#define MB_COMPUTE(buf_, hf_, nkt_, own_) do { \
        const LAS unsigned char* kb_ = lds + (buf_) * 2 * MB_HALF + 256 * l31; \
        const LAS unsigned char* vb_ = lds + (buf_) * 2 * MB_HALF + MB_HALF + 256 * (4 * h2 + vq) + 8 * (vp & 1); \
        _Pragma("unroll 1") for (int kt_ = 0; kt_ < (nkt_); ++kt_) { \
            bf16x8 ka_[8]; \
            _Pragma("unroll") for (int s_ = 0; s_ < 8; ++s_) ka_[s_] = *(const LAS bf16x8*)(kb_ + kt_ * (32 * 256) + 16 * ((2 * s_ + h2) ^ fK)); \
            f32x16 acc_; _Pragma("unroll") for (int r_ = 0; r_ < 16; ++r_) acc_[r_] = 0.f; \
            _Pragma("unroll") for (int s_ = 0; s_ < 8; ++s_) acc_ = MFMA32(ka_[s_], qf[s_], acc_); \
            s16x4 vl0_[4], vh0_[4]; \
            _Pragma("unroll") for (int db_ = 0; db_ < 4; ++db_) { const LAS unsigned char* vp_ = vb_ + (kt_ * 32) * 256 + 64 * (db_ ^ vq); \
                vl0_[db_] = vtr(vp_ + 16 * (vj ^ h2)); vh0_[db_] = vtr(vp_ + 8 * 256 + 16 * (vj ^ (2 + h2))); } \
            float pr_[16]; \
            _Pragma("unroll") for (int r_ = 0; r_ < 16; ++r_) { float p_ = __builtin_amdgcn_exp2f(acc_[r_]); if ((own_) && (128 * (hf_) + 32 * kt_ + crow(r_, h2) > 32 * w + l31)) p_ = 0.f; pr_[r_] = p_; lsum += p_; } \
            { u32x4 pk_; pk_.x = cvtpk(pr_[0], pr_[1]); pk_.y = cvtpk(pr_[2], pr_[3]); pk_.z = cvtpk(pr_[4], pr_[5]); pk_.w = cvtpk(pr_[6], pr_[7]); \
              const bf16x8 pb_ = __builtin_bit_cast(bf16x8, pk_); \
              _Pragma("unroll") for (int db_ = 0; db_ < 4; ++db_) O[db_] = MFMA32(__builtin_shufflevector(vl0_[db_], vh0_[db_], 0, 1, 2, 3, 4, 5, 6, 7), pb_, O[db_]); } \
            _Pragma("unroll") for (int db_ = 0; db_ < 4; ++db_) { const LAS unsigned char* vp_ = vb_ + (kt_ * 32 + 16) * 256 + 64 * (db_ ^ vq); \
                vl0_[db_] = vtr(vp_ + 16 * (vj ^ h2)); vh0_[db_] = vtr(vp_ + 8 * 256 + 16 * (vj ^ (2 + h2))); } \
            { u32x4 pk_; pk_.x = cvtpk(pr_[8], pr_[9]); pk_.y = cvtpk(pr_[10], pr_[11]); pk_.z = cvtpk(pr_[12], pr_[13]); pk_.w = cvtpk(pr_[14], pr_[15]); \
              const bf16x8 pb_ = __builtin_bit_cast(bf16x8, pk_); \
              _Pragma("unroll") for (int db_ = 0; db_ < 4; ++db_) O[db_] = MFMA32(__builtin_shufflevector(vl0_[db_], vh0_[db_], 0, 1, 2, 3, 4, 5, 6, 7), pb_, O[db_]); } } } while (0)
template <int MODE  >
__device__ __forceinline__ void moba_m3(const Frame& F0, const bf16_t* __restrict__ QKV, const unsigned* __restrict__ gcnt, const int* __restrict__ LIST,
                                        bf16_t* __restrict__ OPART01, bf16_t* __restrict__ OPART2, bf16_t* __restrict__ MIX, float* __restrict__ LPART) {
    const Frame F = opaque(F0);
    LAS unsigned char* lds = F.lds;
    LAS int* pre = (LAS int*)(lds + MB_PRE);
    const int h2 = F.lane >> 5, l31 = F.lane & 31, w = F.wave;
    const int fK = ((l31 & 3) << 2) | ((l31 >> 2) & 3);
    const int vq = (F.lane & 15) >> 2, vp = F.lane & 3, vj = 2 * ((F.lane >> 4) & 1) + (vp >> 1);
    if (MODE == 0) {
        if (w == 0) {
            int inc[8]; int run = 0;
#pragma unroll
            for (int jj = 0; jj < 8; ++jj) { run += ((int)gcnt[8 * F.lane + jj] + 255) >> 8; inc[jj] = run; }
            int tot = run;
#pragma unroll
            for (int o = 1; o < 64; o <<= 1) { const int y = __shfl_up(tot, o); if (F.lane >= o) tot += y; }
            const int excl = tot - run;
#pragma unroll
            for (int jj = 0; jj < 8; ++jj) pre[8 * F.lane + jj] = excl + inc[jj];
        }
        __syncthreads();
    }
    const int total = MODE ? 512 : (512 + pre[511]);
    const int u_lo = MODE ? 0 : 512, u_hi = MODE ? 512 : total;
    const int n_units = MODE ? ((F.vcu < 256) ? 2 : 0) : ((u_hi - u_lo - F.vcu + F.G - 1) / F.G);
    if (n_units <= 0) return;
    young_half_prio_on(F);
#define MB_UNIT_V(it_) (MODE ? (((F.vcu >> 2) << 3) + 2 * (F.vcu & 3) + (it_)) : (u_lo + F.vcu + (it_) * F.G))
    int h, n, count, lbase; bool own;
    LAS int* desc = (LAS int*)(lds + MB_DESC);
    if (MODE == 0) {
        if (w == 0 && F.lane < n_units && F.lane < MB_NDESC) { int h_, n_, c_, lb_; bool o_; mb_decode(MB_UNIT_V(F.lane), pre, gcnt, h_, n_, c_, lb_, o_); *(LAS mb_i4*)(desc + 4 * F.lane) = (mb_i4){h_, n_, c_, lb_}; }
        __syncthreads();
    }
#define MB_DECODE(it_, h_, n_, c_, lb_, o_) do { if (MODE == 0 && (it_) < MB_NDESC) { const mb_i4 d_ = *(const LAS mb_i4*)(desc + 4 * (it_)); h_ = __builtin_amdgcn_readfirstlane(d_.x); n_ = __builtin_amdgcn_readfirstlane(d_.y); c_ = __builtin_amdgcn_readfirstlane(d_.z); lb_ = __builtin_amdgcn_readfirstlane(d_.w); o_ = false; } \
        else mb_decode(MB_UNIT_V(it_), pre, gcnt, h_, n_, c_, lb_, o_); } while (0)
    MB_DECODE(0, h, n, count, lbase, own);
    int ent; bf16x8 qf[8];
    MB_ENT(ent, ((MODE == 0) ? false : own), n, count, lbase);
    MB_GATHER(ent, qf, n, h);
    MB_STAGE(h, n, 0, 0);
    MB_VMWAIT();
    __syncthreads();
#pragma unroll 1
    for (int it = 0; it < n_units; ++it) {
        f32x16 O[4];
#pragma unroll
        for (int db = 0; db < 4; ++db)
#pragma unroll
            for (int r = 0; r < 16; ++r) O[db][r] = 0.f;
        float lsum = 0.f;
        MB_STAGE(h, n, 1, 1);
        const bool more = (it + 1 < n_units);
        int h_n = h, n_n = n, count_n = count, lbase_n = lbase; bool own_n = own;
        int ent_n = -1;
        if (more) { MB_DECODE(it + 1, h_n, n_n, count_n, lbase_n, own_n); MB_ENT(ent_n, ((MODE == 0) ? false : own_n), n_n, count_n, lbase_n); }
        { const bool ownf = (MODE == 0) ? false : own; const int nkt = ownf ? ((w + 1 < 4) ? (w + 1) : 4) : 4; MB_COMPUTE(0, 0, nkt, ownf); }
        MB_VMWAIT();
        __syncthreads();
        const int tq_n = (ent_n >= 0) ? (ent_n >> 2) : (n_n * 256);
        float lpre = 0.f;
        if (MODE == 1) {
            const int tq = n * 256 + 32 * w + l31, nsel = (tq >> 8) < 3 ? (tq >> 8) : 3;
#pragma unroll
            for (int sl = 0; sl < 3; ++sl) if (sl < nsel) lpre += LPART[((size_t)sl * S + tq) * 8 + h];
        }
        if (more) MB_STAGE(h_n, n_n, 0, 0);
        { const bool ownf = (MODE == 0) ? false : own; const int nkt = ownf ? ((w >= 4) ? (w - 3) : 0) : 4; MB_COMPUTE(1, 1, nkt, ownf); }
        const int ent_c = ent, h_c = h;
        u32x4 ppA[4][3], ppB[4][3];
        const int c_tq0 = (ent_c >> 2) - l31, c_ch = F.lane & 15, c_nsel = (c_tq0 >> 8) < 3 ? (c_tq0 >> 8) : 3;
#define MB_PLOAD(pp_, ib_) do { _Pragma("unroll") for (int i_ = 0; i_ < 4; ++i_) { const int tq_ = c_tq0 + 4 * (4 * (ib_) + i_) + (F.lane >> 4); \
            _Pragma("unroll") for (int sl_ = 0; sl_ < 3; ++sl_) pp_[i_][sl_] = (sl_ < c_nsel) ? __builtin_nontemporal_load((const u32x4*)(((sl_ == 2) ? (OPART2 + (size_t)tq_ * D) : (OPART01 + ((size_t)sl_ * S + tq_) * D)) + h_c * 128 + 8 * c_ch)) : (u32x4){0u, 0u, 0u, 0u}; } } while (0)
        if (MODE == 1) MB_PLOAD(ppA, 0);
        if (more) {
#pragma unroll
            for (int s_ = 0; s_ < 8; ++s_) qf[s_] = *(const bf16x8*)(QKV + (size_t)tq_n * 3072 + h_n * 128 + 16 * s_ + 8 * h2); }
        lsum += __shfl_xor(lsum, 32);
        if (MODE == 0) { if (ent_c >= 0 && h2 == 0) LPART[((size_t)(ent_c & 3) * S + (ent_c >> 2)) * 8 + h_c] = lsum; }
        float linv = 0.f;
        if (MODE == 1) linv = __builtin_amdgcn_rcpf(lsum + lpre);
        lds_barrier();
        {
            LAS unsigned char* ost = lds + MB_OST + w * MB_OSTW;
#pragma unroll
            for (int db = 0; db < 4; ++db)
#pragma unroll
                for (int g = 0; g < 4; ++g) { u32x2 o; o.x = cvtpk(O[db][4 * g + 0], O[db][4 * g + 1]); o.y = cvtpk(O[db][4 * g + 2], O[db][4 * g + 3]);
                    *(LAS u32x2*)(ost + l31 * 264 + 2 * (32 * db + 8 * g + 4 * h2)) = o; }
            asm volatile("s_waitcnt lgkmcnt(0)" ::: "memory");
            if (MODE == 1) MB_PLOAD(ppB, 1);
            if (MODE == 0) {
#pragma unroll
                for (int i = 0; i < 8; ++i) {
                    const int row = 4 * i + (F.lane >> 4), ch = F.lane & 15;
                    const int er = __shfl(ent_c, row);
                    const u32x4 v = *(const LAS u32x4*)(ost + row * 264 + 16 * ch);
                    if (er >= 0) { const int sl = er & 3, tq = er >> 2;
                        bf16_t* dst = ((sl == 2) ? (OPART2 + (size_t)tq * D) : (OPART01 + ((size_t)sl * S + tq) * D)) + h_c * 128 + 8 * ch;
                        *(u32x4*)dst = v; }
                }
            } else {
                const int tq0 = c_tq0, ch = c_ch;
#define MB_PCOMB(pp_, ib_) do { _Pragma("unroll") for (int i = 0; i < 4; ++i) { const int row = 4 * (4 * (ib_) + i) + (F.lane >> 4), tq = tq0 + row; \
                        const float li = __shfl(linv, row); \
                        const u32x4 v = *(const LAS u32x4*)(ost + row * 264 + 16 * ch); \
                        float o[8] = {bflo(v.x), bfhi(v.x), bflo(v.y), bfhi(v.y), bflo(v.z), bfhi(v.z), bflo(v.w), bfhi(v.w)}; \
                        _Pragma("unroll") for (int sl = 0; sl < 3; ++sl) { const u32x4 p = pp_[i][sl]; \
                            o[0] += bflo(p.x); o[1] += bfhi(p.x); o[2] += bflo(p.y); o[3] += bfhi(p.y); o[4] += bflo(p.z); o[5] += bfhi(p.z); o[6] += bflo(p.w); o[7] += bfhi(p.w); } \
                        u32x4 r; r.x = cvtpk(o[0] * li, o[1] * li); r.y = cvtpk(o[2] * li, o[3] * li); r.z = cvtpk(o[4] * li, o[5] * li); r.w = cvtpk(o[6] * li, o[7] * li); \
                        *(u32x4*)(MIX + (size_t)tq * D + h_c * 128 + 8 * ch) = r; } } while (0)
                MB_PCOMB(ppA, 0);
                MB_PCOMB(ppB, 1);
#undef MB_PCOMB
            }
        }
#undef MB_PLOAD
        if (more) { h = h_n; n = n_n; count = count_n; lbase = lbase_n; own = own_n; ent = ent_n; }
        if (MODE == 1) { asm volatile("s_waitcnt vmcnt(8)" ::: "memory"); lds_barrier(); } else { MB_VMWAIT(); __syncthreads(); }
    }
    young_half_prio_off(F);
#undef MB_DECODE
#undef MB_UNIT_V
}
__device__ __forceinline__ float wave_max(float v) {
#pragma unroll
    for (int o = 1; o < 64; o <<= 1) v = fmaxf(v, __shfl_xor(v, o));
    return v;
}
__device__ __forceinline__ float logsigmoid_f(float x) { return fminf(x, 0.f) - log1pf(expf(-fabsf(x))); }
__global__ void nk_gla_gate(const float* __restrict__ glr, const float* __restrict__ wup, const float* __restrict__ bg, float* __restrict__ g) {
    const size_t idx = (size_t)blockIdx.x * blockDim.x + threadIdx.x;
    const int t = (int)(idx >> 9), j = (int)(idx & 511);
    float acc = bg[j];
#pragma unroll
    for (int r = 0; r < 16; ++r) acc += glr[(size_t)t * 16 + r] * wup[r * 512 + j];
    g[idx] = logsigmoid_f(acc) * (1.f / 16.f);
}
__global__ __launch_bounds__(256) void nk_gla_recur(const bf16_t* __restrict__ qkv, const float* __restrict__ g, float* __restrict__ o) {
    __shared__ float sq[16][128], sk[16][128], sa[16][128];
    const int h = blockIdx.x, tid = threadIdx.x;
    float St[128];
#pragma unroll
    for (int d = 0; d < 128; ++d) St[d] = 0.f;
    const float qs = 0.08838834764831845f;
    for (int t0 = 0; t0 < S; t0 += 16) {
        float vv[16];
#pragma unroll
        for (int tt = 0; tt < 16; ++tt) vv[tt] = bf2f(qkv[(size_t)(t0 + tt) * 3072 + 1024 + h * 256 + tid]);
#pragma unroll
        for (int i = 0; i < 8; ++i) {
            const int e = tid + i * 256, tok = e >> 7, d = e & 127;
            const bf16_t* row = qkv + (size_t)(t0 + tok) * 3072;
            sq[tok][d] = bf2f(row[h * 128 + d]) * qs;
            sk[tok][d] = bf2f(row[512 + h * 128 + d]);
            sa[tok][d] = expf(g[(size_t)(t0 + tok) * 512 + h * 128 + d]);
        }
        __syncthreads();
#pragma unroll 1
        for (int tt = 0; tt < 16; ++tt) {
            const float v = vv[0];
#pragma unroll
            for (int i = 0; i < 15; ++i) vv[i] = vv[i + 1];
            float acc = 0.f;
#pragma unroll
            for (int d = 0; d < 128; ++d) { St[d] = sa[tt][d] * St[d] + sk[tt][d] * v; acc += sq[tt][d] * St[d]; }
            o[(size_t)(t0 + tt) * D + h * 256 + tid] = acc;
        }
        __syncthreads();
    }
}
__global__ __launch_bounds__(256) void nk_gla_post(const float* __restrict__ o, const bf16_t* __restrict__ qkv, const float* __restrict__ og, bf16_t* __restrict__ mix) {
    const int w = blockIdx.x * 4 + (threadIdx.x >> 6), lane = threadIdx.x & 63;
    const int t = w >> 2, h = w & 3;
    f32x4 v = *(const f32x4*)(o + (size_t)t * D + h * 256 + lane * 4);
    const float ss = wave_sum(v.x * v.x + v.y * v.y + v.z * v.z + v.w * v.w);
    const float r = 1.0f / sqrtf(ss * (1.f / 256.f) + EPS);
    const f32x4 gg = *(const f32x4*)(og + lane * 4);
    const bf16_t* rp = qkv + (size_t)t * 3072 + 2048 + h * 256 + lane * 4;
    bf16_t* mp = mix + (size_t)t * D + h * 256 + lane * 4;
#pragma unroll
    for (int e = 0; e < 4; ++e) { const float rr = bf2f(rp[e]); const float y = v[e] * r * gg[e] * (rr / (1.f + expf(-rr))); mp[e] = (bf16_t)(cvtpk(y, 0.f) & 0xffffu); }
}
__global__ __launch_bounds__(256) void nk_moba_qk(bf16_t* __restrict__ qkv, const int* __restrict__ pos, const float* __restrict__ qg, const float* __restrict__ kg) {
    const int w = blockIdx.x * 4 + (threadIdx.x >> 6), lane = threadIdx.x & 63;
    const int t = w >> 4, which = (w >> 3) & 1, h = w & 7;
    bf16_t* p = qkv + (size_t)t * 3072 + which * 1024 + h * 128;
    const float* g = which ? kg : qg;
    float t1 = bf2f(p[lane]), t2 = bf2f(p[lane + 64]);
    const float ss = wave_sum(t1 * t1 + t2 * t2);
    const float r = 1.0f / sqrtf(ss * (1.f / 128.f) + EPS);
    t1 = t1 * r * g[lane]; t2 = t2 * r * g[lane + 64];
    const float inv_freq = (float)exp2(-(double)lane * (13.287712379549449 / 64.0));
    const float angf = (float)pos[t] * inv_freq;
    float cs, sn; sincos_acc((double)angf, sn, cs);
    p[lane] = (bf16_t)(cvtpk(t1 * cs - t2 * sn, 0.f) & 0xffffu);
    p[lane + 64] = (bf16_t)(cvtpk(t2 * cs + t1 * sn, 0.f) & 0xffffu);
}
__global__ __launch_bounds__(128) void nk_moba_kmean(const bf16_t* __restrict__ qkv, float* __restrict__ kmean) {
    const int h = blockIdx.x >> 6, n = blockIdx.x & 63, d = threadIdx.x;
    float acc = 0.f;
    for (int j = 0; j < 256; ++j) acc += bf2f(qkv[(size_t)(n * 256 + j) * 3072 + 1024 + h * 128 + d]);
    kmean[(size_t)blockIdx.x * 128 + d] = acc * (1.f / 256.f);
}
__global__ __launch_bounds__(64) void nk_moba_attn(const bf16_t* __restrict__ qkv, const float* __restrict__ kmean, bf16_t* __restrict__ out) {
    __shared__ float sq[128];
    __shared__ float sp[1024];
    __shared__ int skey[1024];
    const int t = blockIdx.x >> 3, h = blockIdx.x & 7, lane = threadIdx.x;
    const bf16_t* qp = qkv + (size_t)t * 3072 + h * 128;
    sq[lane] = bf2f(qp[lane]); sq[lane + 64] = bf2f(qp[lane + 64]);
    __syncthreads();
    const int own = t >> 8;
    float gate = -INFINITY;
    if (lane < own) {
        const float* km = kmean + ((size_t)h * 64 + lane) * 128;
        float a = 0.f;
        for (int d = 0; d < 128; ++d) a += sq[d] * km[d];
        gate = a;
    }
    int s0 = -1, s1 = -1, s2 = -1;
#pragma unroll
    for (int j = 0; j < 3; ++j) {
        const float m = wave_max(gate);
        int idx = -1;
        if (m > -INFINITY) { const unsigned long long b = __ballot(gate == m); idx = __ffsll((long long)b) - 1; }
        if (j == 0) s0 = idx; else if (j == 1) s1 = idx; else s2 = idx;
        if (lane == idx) gate = -INFINITY;
    }
    int nk = 0;
    if (s0 >= 0) { for (int i = lane; i < 256; i += 64) skey[nk + i] = s0 * 256 + i; nk += 256; }
    if (s1 >= 0) { for (int i = lane; i < 256; i += 64) skey[nk + i] = s1 * 256 + i; nk += 256; }
    if (s2 >= 0) { for (int i = lane; i < 256; i += 64) skey[nk + i] = s2 * 256 + i; nk += 256; }
    const int nown = t - own * 256 + 1;
    for (int i = lane; i < nown; i += 64) skey[nk + i] = own * 256 + i;
    nk += nown;
    __syncthreads();
    const float scale = 0.08838834764831845f;
    float mx = -INFINITY;
    for (int i = lane; i < nk; i += 64) {
        const bf16_t* kp = qkv + (size_t)skey[i] * 3072 + 1024 + h * 128;
        float a = 0.f;
        for (int d = 0; d < 128; d += 8) { const u32x4 kk = *(const u32x4*)(kp + d);
            a += sq[d] * bflo(kk.x) + sq[d + 1] * bfhi(kk.x) + sq[d + 2] * bflo(kk.y) + sq[d + 3] * bfhi(kk.y) + sq[d + 4] * bflo(kk.z) + sq[d + 5] * bfhi(kk.z) + sq[d + 6] * bflo(kk.w) + sq[d + 7] * bfhi(kk.w); }
        a *= scale; sp[i] = a; mx = fmaxf(mx, a);
    }
    mx = wave_max(mx);
    float sum = 0.f;
    for (int i = lane; i < nk; i += 64) { const float p = expf(sp[i] - mx); sp[i] = p; sum += p; }
    sum = wave_sum(sum);
    __syncthreads();
    float o0 = 0.f, o1 = 0.f;
    for (int i = 0; i < nk; ++i) {
        const bf16_t* vp = qkv + (size_t)skey[i] * 3072 + 2048 + h * 128;
        const float p = sp[i];
        o0 += p * bf2f(vp[lane]); o1 += p * bf2f(vp[lane + 64]);
    }
    const float inv = 1.f / sum;
    out[(size_t)t * D + h * 128 + lane] = (bf16_t)(cvtpk(o0 * inv, 0.f) & 0xffffu);
    out[(size_t)t * D + h * 128 + lane + 64] = (bf16_t)(cvtpk(o1 * inv, 0.f) & 0xffffu);
}
constexpr int PH_PER_LAYER = 10, PH_L0 = 2, N_PHASES = PH_L0 + DEPTH * PH_PER_LAYER;
__global__ void __launch_bounds__(NTHR, 2) mega(MegaArgs args) {
    extern __shared__ __attribute__((aligned(16))) unsigned char lds_raw[];
    Frame F;
    F.lds = (LAS unsigned char*)lds_raw;
    F.tid = threadIdx.x; F.lane = F.tid & 63; F.wave = __builtin_amdgcn_readfirstlane(F.tid >> 6);
    F.G = gridDim.x; { const int bx = blockIdx.x; F.vcu = (F.G % 8 == 0) ? (bx % 8) * (F.G / 8) + bx / 8 : bx; }
    volatile LAS unsigned* MISC = (volatile LAS unsigned*)(F.lds + MISC_OFF);
    unsigned char* ws = args.ws;
    unsigned* ctl = (unsigned*)(ws + WS_CTL);
    for (int u = F.tid; u < (LDS_BYTES - MISC_OFF) / 4; u += NTHR) ((LAS unsigned*)(F.lds + MISC_OFF))[u] = 0u;
    __syncthreads();
    XcdBarrier bar = xcd_barrier_post(ctl + CW_BAR, MISC + 8);
    const int lo = args.ph_lo, hi = args.ph_hi;
#define IN(k) (lo <= (k) && (k) < hi)
#define SEAM(k) do { if (lo <= (k) && (k) + 1 < hi) xcd_barrier(bar); } while (0)
    const float* mod = (const float*)(ws + WS_MOD);
    bf16_t* MIX = (bf16_t*)(ws + WS_MIX); bf16_t* QKV = (bf16_t*)(ws + WS_QKV); bf16_t* HID = (bf16_t*)(ws + WS_HID);
    float* xout = args.out;
    bf16_t* XB = (bf16_t*)(ws + WS_XB);
    float* PSSQ = (float*)(ws + WS_PSSQ); const float* BIAS = (const float*)(ws + WS_BIAS);

    if (IN(0)) { p0_prologue(F, args); x0_phase(F, args.in[0], XB, PSSQ); }
    if (lo < 0) cg::this_grid().sync();
    if (lo <= 0 && 1 < hi) xcd_barrier(bar);
    if (F.tid == 0) {
        unsigned okc = (F.G == 256) ? 1u : 0u;
#pragma unroll
        for (unsigned jx = 0; jx < 16; ++jx) { const unsigned cc = xb_ld(ctl + CW_BAR + XB_XCNT(jx)); if (jx < 8 ? (cc != 32u) : (cc != 0u)) okc = 0u; }
        MISC[4] = okc;
    }
    __syncthreads();
    const bool xl_ok = (MISC[4] != 0u) && (lo == 0);
    const int cv = xl_ok ? (int)(MISC[11] + 8u * MISC[10]) : (int)blockIdx.x;
    if (xl_ok) F.vcu = (int)(MISC[11] * 32u + 4u * (MISC[10] & 7u) + (MISC[10] >> 3));
    const unsigned pgid = (unsigned)F.vcu >> 2;
#define LSEAM(k) do { if (lo <= (k) && (k) + 1 < hi) { if (xl_ok) xcd_local_barrier(bar, 32u); else xcd_barrier(bar); } } while (0)
#define GSEAM(k) do { if (lo <= (k) && (k) + 1 < hi) { if (xl_ok) xcd_group_barrier(bar, pgid); else xcd_barrier(bar); } } while (0)
    if (IN(1)) { const Frame Fq = opaque(F); tr_run<true>(Fq, args); }
    SEAM(1);
#pragma unroll 1
    for (int L = 0; L < DEPTH; ++L) {
        const int pb = PH_L0 + L * PH_PER_LAYER, j = L >> 1;
        const float* m = mod + (size_t)L * 6 * D;
        if (pb + PH_PER_LAYER <= lo || pb >= hi) continue;
        if ((L & 1) == 0) {
            if (IN(pb + 0)) {
                pg8::Gemm g{XB, (const bf16_t*)(ws + WS_WGIN) + (size_t)j * 3072 * D, S, 3072, D}; pg8::StaticOrder So; So.init(S, 3072, F.G, cv);
                pg8::EpiBf16<0> E{QKV, 3072, nullptr, PSSQ, BIAS + L * BIAS_IN_LD};
                pg8::gemm_phase<pg8::EpiBf16<0>, pg8::StaticOrder, true, true>(F.lds, g, So, E);
                glr_phase(F, XB, (const bf16_t*)(ws + WS_WGLR) + (size_t)j * 16 * D, (float*)(ws + WS_GLR), PSSQ, BIAS + L * BIAS_IN_LD + 3072);
            }
            GSEAM(pb + 0);
        } else {
            if (IN(pb + 0)) {
                pg8::Gemm g{XB, (const bf16_t*)(ws + WS_WMIN) + (size_t)j * 3072 * D, S, 3072, D}; pg8::StaticOrder So; So.init(S, 3072, F.G, cv);
                pg8::EpiBf16<0> E{QKV, 3072, nullptr, PSSQ, BIAS + L * BIAS_IN_LD};
                pg8::gemm_phase<pg8::EpiBf16<0>, pg8::StaticOrder, true, true>(F.lds, g, So, E);
                asm volatile("s_waitcnt vmcnt(0)" ::: "memory"); __syncthreads();
                moba_m1_tail(F, F.G, cv, QKV, (const float*)(args.ws + WS_COS), (const float*)(args.ws + WS_SIN), args.in[13] + (size_t)j * 128, args.in[14] + (size_t)j * 128, (float*)(args.ws + WS_KMEAN));
            }
            SEAM(pb + 0);
        }
        if ((L & 1) == 0) {
            unsigned char* ws = args.ws; asm volatile("" : "+s"(ws));
            const float* wupg = args.in[8] + (size_t)j * 16 * 512; const float* bgg = args.in[9] + (size_t)j * 512;
            if (IN(pb + 1)) gla_g1(F, QKV, (const float*)(ws + WS_GLR), wupg, bgg, (float*)(ws + WS_SBUF), (float*)(ws + WS_DG));
            SEAM(pb + 1);
            if (IN(pb + 2)) gla_g2(F, (float*)(ws + WS_SBUF), (const float*)(ws + WS_DG));
            SEAM(pb + 2);
            if (IN(pb + 3)) gla_g3(F, QKV, (const float*)(ws + WS_GLR), wupg, bgg, (const float*)(ws + WS_SBUF), args.in[10] + (size_t)j * 256, MIX);
            if (lo <= pb + 3 && pb + 5 < hi) { if (xl_ok) xcd_local_barrier(bar, 32u); else xcd_barrier(bar); }
        } else {
            unsigned char* ws = args.ws; asm volatile("" : "+s"(ws));
            unsigned* gcnt = (unsigned*)(ws + WS_CTL) + CW_MCNT + j * 512;
            if (IN(pb + 2)) moba_m2(F, QKV, (const float*)(ws + WS_KMEAN), gcnt, (int*)(ws + WS_LIST));
            SEAM(pb + 2);
            if (IN(pb + 3)) moba_m3<0>(F, QKV, gcnt, (const int*)(ws + WS_LIST), (bf16_t*)xout, (bf16_t*)(ws + WS_AUX), MIX, (float*)(ws + WS_LPART));
            SEAM(pb + 3);
            if (IN(pb + 4)) moba_m3<1>(F, QKV, gcnt, (const int*)(ws + WS_LIST), (bf16_t*)xout, (bf16_t*)(ws + WS_AUX), MIX, (float*)(ws + WS_LPART));
            if (L + 1 < DEPTH) LSEAM(pb + 4); else SEAM(pb + 4);
        }
        if (IN(pb + 5)) {
            const bf16_t* wo = ((L & 1) == 0) ? (const bf16_t*)(ws + WS_WGOUT) + (size_t)j * D * D : (const bf16_t*)(ws + WS_WMOUT) + (size_t)j * D * D;
            pg8::Gemm g{MIX, wo, S, D, D}; pg8::StaticOrder So; So.init(S, D, F.G, cv);
            pg8::EpiResidSsq<false> E{XB, XB, D, m + 2 * D, PSSQ};
            pg8::gemm_phase<pg8::EpiResidSsq<false>, pg8::StaticOrder, false, true>(F.lds, g, So, E);
        }
        GSEAM(pb + 5);
        if (IN(pb + 7)) {
            pg8::Gemm g{XB, (const bf16_t*)(ws + WS_W1) + (size_t)L * DFF * D, S, DFF, D}; pg8::StaticOrder So; So.init(S, DFF, F.G, cv);
            pg8::EpiBf16<1> E{QKV, DFF, xl_ok ? (bf16_t*)(ws + WS_AUX) : nullptr, PSSQ, BIAS + BIAS_UP_OFF + L * 4096}; if (!xl_ok) E.O = HID;
            pg8::gemm_phase<pg8::EpiBf16<1>, pg8::StaticOrder, true, true>(F.lds, g, So, E);
        }
        GSEAM(pb + 7);
        if (IN(pb + 8)) {
            pg8::Gemm g{xl_ok ? QKV : HID, (const bf16_t*)(ws + WS_W2) + (size_t)L * D * DFF, S, D, DFF, xl_ok ? (const bf16_t*)(ws + WS_AUX) : nullptr}; pg8::StaticOrder So; So.init(S, D, F.G, cv);
            pg8::EpiResid E{XB, xout, D, m + 5 * D};
            if (L + 1 < DEPTH) {
                pg8::EpiResidSsq<false> EN{XB, XB, D, m + 5 * D, PSSQ};
                pg8::gemm_phase<pg8::EpiResidSsq<false>, pg8::StaticOrder, false, true>(F.lds, g, So, EN);
            } else
            pg8::gemm_phase<pg8::EpiResid, pg8::StaticOrder, false, true>(F.lds, g, So, E);
        }
        if (L + 1 < DEPTH) LSEAM(pb + 8);
    }
#undef IN
#undef SEAM
}
static int g_grid = 0;
static void launch_mega(MegaArgs a, int lo, int hi, hipStream_t stream) {
    a.ph_lo = lo; a.ph_hi = hi;
    void* params[] = {&a};
    hipError_t e = hipLaunchCooperativeKernel((const void*)mega, dim3(g_grid), dim3(NTHR), params, LDS_BYTES, stream);
    if (e != hipSuccess) fprintf(stderr, "cooperative launch failed: %s (grid %d)\n", hipGetErrorString(e), g_grid);
}
extern "C" void kernel_launch(void* const* d_in, const int* in_sizes, int n_in, void* d_out, int out_size, void* d_ws, size_t ws_size, hipStream_t stream) {
    if (g_grid == 0) {
        int dev = 0, cus = 0, per_cu = 0;
        (void)hipGetDevice(&dev);
        (void)hipDeviceGetAttribute(&cus, hipDeviceAttributeMultiprocessorCount, dev);
        (void)hipFuncSetAttribute((const void*)mega, hipFuncAttributeMaxDynamicSharedMemorySize, LDS_BYTES);
        (void)hipOccupancyMaxActiveBlocksPerMultiprocessor(&per_cu, (const void*)mega, NTHR, LDS_BYTES);
        if (per_cu < 1) { fprintf(stderr, "occupancy query says %d blocks/CU\n", per_cu); per_cu = 1; }
        g_grid = cus;
        if (ws_size < WS_END || n_in != 18) { fprintf(stderr, "bad ws_size %zu / n_in %d\n", ws_size, n_in); g_grid = -1; }
    }
    if (g_grid < 0) return;
    (void)hipMemsetAsync((char*)d_ws + WS_CTL, 0, CTL_ZERO_BYTES, stream);
    MegaArgs a{};
    for (int i = 0; i < 18; ++i) a.in[i] = (const float*)d_in[i];
    a.out = (float*)d_out; a.ws = (unsigned char*)d_ws;
    launch_mega(a, 0, N_PHASES, stream);
}
```
